# Optimizing an MI355X kernel written in HIP

```python
import jax
import jax.numpy as jnp
from jax import lax
import numpy as np

D_MODEL = 1024
BATCH = 8
SEQ = 4096
DEPTH = 2

MLA_HEADS = 4
MLA_NOPE = 128
MLA_ROPE = 64
MLA_V = 128
Q_LORA = 256
KV_LORA = 128
ROPE_THETA = 10000.0
MLA_WIDTH = MLA_HEADS * MLA_V
RWKV_WIDTH = D_MODEL - MLA_WIDTH
RWKV_HEAD = 64
RWKV_HEADS = RWKV_WIDTH // RWKV_HEAD
DECAY_LORA = 64
AAA_LORA = 64
MV_LORA = 32
GATE_LORA = 128
D_FF_DENSE = 2816
N_EXPERTS = 8
TOP_K = 2
D_FF_EXPERT = 3584
Q_BLOCK = 128
NORM_EPS = 1e-6
GN_EPS = 64e-5
L2_EPS = 1e-12
N_DENSE = (DEPTH + 1) // 2
N_MOE = DEPTH // 2
N_VRES = DEPTH - 1
MLA_COLS = Q_LORA + KV_LORA + MLA_ROPE
RWKV_COLS = 3 * RWKV_WIDTH + DECAY_LORA + AAA_LORA + GATE_LORA

kernel_name = 'hybrid_mla_rwkv7_moe_adaln'


def rms_norm(x, g):
    xf = x.astype(jnp.float32)
    y = xf * lax.rsqrt(jnp.mean(xf * xf, axis=-1, keepdims=True) + NORM_EPS)
    return (y * g.astype(jnp.float32)).astype(x.dtype)


def apply_rope(t, positions):
    half = t.shape[-1] // 2
    inv_freq = ROPE_THETA ** (-jnp.arange(half, dtype=jnp.float32) / half)
    ang = positions.astype(jnp.float32)[:, :, None, None] * inv_freq
    cos, sin = jnp.cos(ang), jnp.sin(ang)
    tf = t.astype(jnp.float32)
    t1, t2 = tf[..., :half], tf[..., half:]
    return jnp.concatenate([t1 * cos - t2 * sin, t2 * cos + t1 * sin], axis=-1).astype(t.dtype)


def token_shift(p, mu):
    prev = jnp.pad(p[:, :-1], ((0, 0), (1, 0), (0, 0)))
    return p + (prev - p) * mu


def swiglu(h, wg, wu, wd):
    return (jax.nn.silu(h @ wg) * (h @ wu)) @ wd


def causal_mla_attention(q_nope, q_pe, k_nope, k_pe, v):
    bsz, seq, heads, _ = q_nope.shape
    nb = seq // Q_BLOCK
    scale = (MLA_NOPE + MLA_ROPE) ** -0.5
    key_idx = jnp.arange(seq)

    def to_blocks(t):
        return jnp.moveaxis(t.reshape(bsz, nb, Q_BLOCK, *t.shape[2:]), 1, 0)

    def one_block(args):
        qn, qp, blk = args
        s = (jnp.einsum('bqhd,bkhd->bhqk', qn, k_nope)
             + jnp.einsum('bqhr,bkr->bhqk', qp, k_pe))
        s = s.astype(jnp.float32) * scale
        q_idx = blk * Q_BLOCK + jnp.arange(Q_BLOCK)
        s = jnp.where(key_idx[None, :] <= q_idx[:, None], s, -jnp.inf)
        prob = jax.nn.softmax(s, axis=-1).astype(v.dtype)
        return jnp.einsum('bhqk,bkhd->bqhd', prob, v)

    out = lax.map(one_block, (to_blocks(q_nope), to_blocks(q_pe), jnp.arange(nb)))
    return jnp.moveaxis(out, 0, 1).reshape(bsz, seq, heads * v.shape[-1])


def mla_mixer(p, positions, g_q, w_uq, g_kv, w_ukv, g_out):
    bsz, seq, _ = p.shape
    c_q = rms_norm(p[..., :Q_LORA], g_q)
    c_kv = rms_norm(p[..., Q_LORA:Q_LORA + KV_LORA], g_kv)
    k_pe = apply_rope(p[..., Q_LORA + KV_LORA:MLA_COLS][:, :, None, :], positions)[:, :, 0]
    q = (c_q @ w_uq).reshape(bsz, seq, MLA_HEADS, MLA_NOPE + MLA_ROPE)
    q_nope = q[..., :MLA_NOPE]
    q_pe = apply_rope(q[..., MLA_NOPE:], positions)
    kv = (c_kv @ w_ukv).reshape(bsz, seq, MLA_HEADS, MLA_NOPE + MLA_V)
    k_nope, v = kv[..., :MLA_NOPE], kv[..., MLA_NOPE:]
    o = causal_mla_attention(q_nope, q_pe, k_nope, k_pe, v)
    return rms_norm(o, g_out)


def rwkv7_recurrence(r, decay, k, v, a, b):
    bsz, seq, heads, n = r.shape

    def step(state, inp):
        r_t, w_t, k_t, v_t, a_t, b_t = inp
        sa = jnp.einsum('bhij,bhj->bhi', state, a_t)
        state = (state * w_t[:, :, None, :] + sa[..., None] * b_t[:, :, None, :]
                 + v_t[..., None] * k_t[:, :, None, :])
        return state, jnp.einsum('bhij,bhj->bhi', state, r_t)

    xs = tuple(jnp.moveaxis(t.astype(jnp.float32), 1, 0) for t in (r, decay, k, v, a, b))
    s0 = jnp.zeros((bsz, heads, n, n), jnp.float32)
    _, y = lax.scan(step, s0, xs)
    return jnp.moveaxis(y, 0, 1)


def rwkv7_mixer(p, v_first, w0, w2, a0, a2, g2, k_k, k_a, r_k, ln_w, ln_b, v0, v2):
    bsz, seq, _ = p.shape
    sizes = [RWKV_WIDTH, RWKV_WIDTH, RWKV_WIDTH, DECAY_LORA, AAA_LORA, GATE_LORA]
    offs = [int(o) for o in np.cumsum([0] + sizes)]
    r, k, v, w_d, a_d, g_d = (p[..., offs[i]:offs[i + 1]] for i in range(6))

    w_log = -jax.nn.softplus(-(w0 + jnp.tanh(w_d) @ w2)) - 0.5
    decay = jnp.exp(-jnp.exp(w_log.astype(jnp.float32)))
    if v_first is None:
        v_first = v
    else:
        v = v + (v_first - v) * jax.nn.sigmoid(v0 + p[..., offs[6]:] @ v2)
    a = jax.nn.sigmoid(a0 + a_d @ a2)
    g = jax.nn.sigmoid(g_d) @ g2

    def heads(t):
        return t.reshape(bsz, seq, RWKV_HEADS, RWKV_HEAD)

    kk = heads(k * k_k).astype(jnp.float32)
    kk = kk / jnp.maximum(jnp.sqrt(jnp.sum(kk * kk, axis=-1, keepdims=True)), L2_EPS)
    k = k * (1 + (a - 1) * k_a)
    rh, kh, vh, ah = heads(r), heads(k), heads(v), heads(a)
    y = rwkv7_recurrence(rh, heads(decay), kh, vh, -kk, kk * ah)
    mean = jnp.mean(y, axis=-1, keepdims=True)
    var = jnp.mean(jnp.square(y - mean), axis=-1, keepdims=True)
    y = (y - mean) * lax.rsqrt(var + GN_EPS)
    y = y * ln_w.reshape(RWKV_HEADS, RWKV_HEAD) + ln_b.reshape(RWKV_HEADS, RWKV_HEAD)
    bonus = jnp.sum(rh * kh * r_k, axis=-1, keepdims=True) * vh
    out = (y.astype(p.dtype) + bonus).reshape(bsz, seq, RWKV_WIDTH) * g
    return out, v_first


def moe_swiglu(h, w_router, b_router, wg, wu, wd):
    logits = (h @ w_router + b_router).astype(jnp.float32)
    top_val, top_idx = lax.top_k(logits, TOP_K)
    top_w = jax.nn.softmax(top_val, axis=-1)
    gates = jnp.sum(jax.nn.one_hot(top_idx, N_EXPERTS, dtype=jnp.float32) * top_w[..., None],
                    axis=-2).astype(h.dtype)
    out = jnp.zeros_like(h)
    for e in range(N_EXPERTS):
        out = out + gates[..., e:e + 1] * swiglu(h, wg[e], wu[e], wd[e])
    return out


def setup_inputs(seed: int = 0) -> dict:
    key = jax.random.key(seed)
    ks = iter(jax.random.split(key, 64))
    D = D_MODEL

    def nrm(shape, scale):
        return jax.random.normal(next(ks), shape, jnp.float32) * scale

    def gain(shape):
        return 1.0 + nrm(shape, 0.02)

    def unif(shape, lo, hi):
        return jax.random.uniform(next(ks), shape, jnp.float32, lo, hi)

    pos_offset = jax.random.randint(next(ks), (BATCH, 1), 0, 1024, dtype=jnp.int32)
    positions = pos_offset + jnp.arange(SEQ, dtype=jnp.int32)[None, :]
    return {
        'x': nrm((BATCH, SEQ, D), 1.0),
        'c': nrm((BATCH, D), 1.0),
        'positions': positions,
        'w_ada': nrm((DEPTH, D, 6 * D), 0.5 * D ** -0.5),
        'b_ada': nrm((DEPTH, 6 * D), 0.01),
        'g_norm_mix': gain((DEPTH, D)),
        'g_norm_ffn': gain((DEPTH, D)),
        'w_in': nrm((DEPTH, D, MLA_COLS + RWKV_COLS), D ** -0.5),
        'w_in_vres': nrm((N_VRES, D, MV_LORA), D ** -0.5),
        'g_q_norm': gain((DEPTH, Q_LORA)),
        'w_uq': nrm((DEPTH, Q_LORA, MLA_HEADS * (MLA_NOPE + MLA_ROPE)), Q_LORA ** -0.5),
        'g_kv_norm': gain((DEPTH, KV_LORA)),
        'w_ukv': nrm((DEPTH, KV_LORA, MLA_HEADS * (MLA_NOPE + MLA_V)), KV_LORA ** -0.5),
        'g_attn_out': gain((DEPTH, MLA_WIDTH)),
        'mu_shift': unif((DEPTH, RWKV_COLS), 0.0, 1.0),
        'mu_shift_vres': unif((N_VRES, MV_LORA), 0.0, 1.0),
        'w0': unif((DEPTH, RWKV_WIDTH), -6.0, -1.0),
        'w2': nrm((DEPTH, DECAY_LORA, RWKV_WIDTH), 0.5 * DECAY_LORA ** -0.5),
        'a0': nrm((DEPTH, RWKV_WIDTH), 0.1),
        'a2': nrm((DEPTH, AAA_LORA, RWKV_WIDTH), 0.5 * AAA_LORA ** -0.5),
        'g2': nrm((DEPTH, GATE_LORA, RWKV_WIDTH), GATE_LORA ** -0.5),
        'v0': nrm((N_VRES, RWKV_WIDTH), 0.1),
        'v2': nrm((N_VRES, MV_LORA, RWKV_WIDTH), 0.5 * MV_LORA ** -0.5),
        'k_k': 1.0 + nrm((DEPTH, RWKV_WIDTH), 0.1),
        'k_a': 1.0 + nrm((DEPTH, RWKV_WIDTH), 0.1),
        'r_k': nrm((DEPTH, RWKV_HEADS, RWKV_HEAD), 0.1),
        'ln_x_w': gain((DEPTH, RWKV_WIDTH)),
        'ln_x_b': nrm((DEPTH, RWKV_WIDTH), 0.01),
        'w_out': nrm((DEPTH, D, D), D ** -0.5),
        'w_ffn_gate': nrm((N_DENSE, D, D_FF_DENSE), D ** -0.5),
        'w_ffn_up': nrm((N_DENSE, D, D_FF_DENSE), D ** -0.5),
        'w_ffn_down': nrm((N_DENSE, D_FF_DENSE, D), D_FF_DENSE ** -0.5),
        'w_router': nrm((N_MOE, D, N_EXPERTS), D ** -0.5),
        'b_router': nrm((N_MOE, N_EXPERTS), 0.01),
        'w_exp_gate': nrm((N_MOE, N_EXPERTS, D, D_FF_EXPERT), D ** -0.5),
        'w_exp_up': nrm((N_MOE, N_EXPERTS, D, D_FF_EXPERT), D ** -0.5),
        'w_exp_down': nrm((N_MOE, N_EXPERTS, D_FF_EXPERT, D), D_FF_EXPERT ** -0.5),
        'g_final': gain((D,)),
    }


def reference(x, c, positions, w_ada, b_ada, g_norm_mix, g_norm_ffn, w_in, w_in_vres,
              g_q_norm, w_uq, g_kv_norm, w_ukv, g_attn_out, mu_shift, mu_shift_vres,
              w0, w2, a0, a2, g2, v0, v2, k_k, k_a, r_k, ln_x_w, ln_x_b, w_out,
              w_ffn_gate, w_ffn_up, w_ffn_down, w_router, b_router,
              w_exp_gate, w_exp_up, w_exp_down, g_final):
    cond = jax.nn.silu(c)
    v_first = None
    for l in range(DEPTH):
        mod = cond @ w_ada[l] + b_ada[l]
        sh1, sc1, gt1, sh2, sc2, gt2 = (m[:, None, :] for m in jnp.split(mod, 6, axis=-1))

        h = rms_norm(x, g_norm_mix[l]) * (1 + sc1) + sh1
        if l == 0:
            w_cat, mu = w_in[l], mu_shift[l]
            v0_l, v2_l = None, None
        else:
            w_cat = jnp.concatenate([w_in[l], w_in_vres[l - 1]], axis=-1)
            mu = jnp.concatenate([mu_shift[l], mu_shift_vres[l - 1]], axis=-1)
            v0_l, v2_l = v0[l - 1], v2[l - 1]
        proj = h @ w_cat
        y_mla = mla_mixer(proj[..., :MLA_COLS], positions, g_q_norm[l], w_uq[l],
                          g_kv_norm[l], w_ukv[l], g_attn_out[l])
        y_rwkv, v_first = rwkv7_mixer(token_shift(proj[..., MLA_COLS:], mu), v_first,
                                      w0[l], w2[l], a0[l], a2[l], g2[l], k_k[l], k_a[l],
                                      r_k[l], ln_x_w[l], ln_x_b[l], v0_l, v2_l)
        x = x + gt1 * (jnp.concatenate([y_mla, y_rwkv], axis=-1) @ w_out[l])

        h = rms_norm(x, g_norm_ffn[l]) * (1 + sc2) + sh2
        i = l // 2
        if l % 2 == 0:
            f = swiglu(h, w_ffn_gate[i], w_ffn_up[i], w_ffn_down[i])
        else:
            f = moe_swiglu(h, w_router[i], b_router[i], w_exp_gate[i], w_exp_up[i], w_exp_down[i])
        x = x + gt2 * f
    return rms_norm(x, g_final)
```

```cpp
#include <hip/hip_runtime.h>
#include <cstdio>
#include <cstdint>
namespace pg8 {
#define PG8_LAS __attribute__((address_space(3)))
typedef unsigned short bf16_t;
typedef short bf16x8 __attribute__((ext_vector_type(8)));
typedef float f32x4 __attribute__((ext_vector_type(4)));
typedef unsigned u32x4 __attribute__((ext_vector_type(4)));
constexpr int BM = 256, BK = 64, HALF = 128, HTB = HALF * BK * 2  , STAGE_BYTES = 8 * HTB, NXCD = 8, WGM = 8;

__host__ __device__ __forceinline__ int lds_byte(int r, int c) { const int st = (r >> 4) * 2 + (c >> 5), rr = r & 15, cc = c & 31, ob = rr * 64 + cc * 2; return st * 1024 + (ob ^ (((ob >> 9) & 1) << 5)); }
__host__ __device__ __forceinline__ void stage_rc(int b, int& R, int& C) { const int st = b / 1024, sb = b % 1024, swz = sb ^ (((sb >> 9) & 1) << 5); R = (st >> 1) * 16 + swz / 64; C = (st & 1) * 32 + (swz % 64) / 2; }
__host__ __device__ __forceinline__ int perm32(int rho) { const int n = rho >> 4, i = rho & 15; return 8 * (i >> 2) + 4 * n + (i & 3); }

struct Unit { int pm, pn; };
struct Gemm { const bf16_t* A; const bf16_t* Bt; int M, N, K; const int* ridx; const int* tile_e; size_t e_stride; };

struct StaticOrder {
    int nM, nN, nwg, G, c;
    __host__ __device__ void init(int M, int N, int G_, int c_) { nM = M / BM; nN = N / BM; nwg = nM * nN; G = G_; c = c_; }
    __host__ __device__ bool next(int i, Unit& u) const {
        const long L = (long)i * G + c; if (L >= nwg) return false;
        int wgid = (int)L; { const int q = nwg / NXCD, r = nwg % NXCD, xcd = wgid % NXCD, off = wgid / NXCD; wgid = (xcd < r ? xcd * (q + 1) : r * (q + 1) + (xcd - r) * q) + off; }
        const int nig = WGM * nN, gid = wgid / nig, fm = gid * WGM, gsz = (nM - fm) < WGM ? (nM - fm) : WGM;
        u.pm = fm + ((wgid % nig) % gsz); u.pn = (wgid % nig) / gsz; return true;
    }
    __device__ __forceinline__ void a_ready(const Unit&) const {}
    __device__ __forceinline__ void done(const Unit&) const {}
};

__device__ __forceinline__ unsigned cvt_pk_bf16(float lo, float hi) { unsigned r; asm volatile("v_cvt_pk_bf16_f32 %0, %1, %2" : "=v"(r) : "v"(lo), "v"(hi)); return r; }
typedef float f32x2 __attribute__((ext_vector_type(2)));
__device__ __forceinline__ f32x2 gelu_pk(f32x2 v) {
    const f32x2 av = __builtin_elementwise_abs(v), d = av * 0.2316418882f + 1.0f;
    f32x2 t; t.x = __builtin_amdgcn_rcpf(d.x); t.y = __builtin_amdgcn_rcpf(d.y);
    f32x2 q = t * 0.5307027145f + (-0.7265760135f); q = q * t + 0.7107068705f; q = q * t + (-0.142248368f); q = q * t + 0.127414796f; q = q * t;
    const f32x2 s = (v * v) * (-0.72134752044f);
    f32x2 e; e.x = __builtin_amdgcn_exp2f(s.x); e.y = __builtin_amdgcn_exp2f(s.y);
    const f32x2 m = v * (q * e), r = v - m;
    f32x2 o; o.x = v.x < 0.f ? m.x : r.x; o.y = v.y < 0.f ? m.y : r.y; return o;
}

template <int ACT  > struct EpiBf16 {
    static constexpr bool PERM = true, AFTER_DRAIN = false; static_assert(ACT == 0 || ACT == 1, "EpiBf16: ACT is 0 (none) or 1 (gelu_pk)");
    bf16_t* O; int ldc; const float* bias; int split_cols; size_t split_stride; float scale0;
    __device__ __forceinline__ void operator()(const f32x4 (&acc)[2][2][4][2], const Unit& u, int wr, int wc, int fr, int fq) const {
        const int row0 = u.pm * BM + wr * 64 + fr; int colt = u.pn * BM; bf16_t* base = O;
        float sc = 1.f; if (split_cols) { const int t = colt / split_cols; base += (size_t)t * split_stride; colt -= t * split_cols; if (t == 0) sc = scale0; }
        const int col0 = colt + wc * 32 + 8 * fq, bcol0 = u.pn * BM + wc * 32 + 8 * fq;
        f32x4 bv[2][2];
#pragma unroll
        for (int bj = 0; bj < 2; ++bj)
#pragma unroll
            for (int n = 0; n < 2; ++n) bv[bj][n] = bias ? *(const f32x4*)(bias + bcol0 + bj * HALF + 4 * n) : (f32x4){0.f, 0.f, 0.f, 0.f};
#pragma unroll
        for (int ai = 0; ai < 2; ++ai)
#pragma unroll
            for (int m = 0; m < 4; ++m) { bf16_t* rowp = base + (size_t)(row0 + ai * HALF + m * 16) * ldc + col0;
#pragma unroll
                for (int bj = 0; bj < 2; ++bj) { f32x4 v0 = acc[ai][bj][m][0] + bv[bj][0], v1 = acc[ai][bj][m][1] + bv[bj][1];
                    if (ACT == 1) { f32x2 a = gelu_pk((f32x2){v0[0], v0[1]}), b = gelu_pk((f32x2){v0[2], v0[3]}), c = gelu_pk((f32x2){v1[0], v1[1]}), d = gelu_pk((f32x2){v1[2], v1[3]});
                        v0 = (f32x4){a.x, a.y, b.x, b.y}; v1 = (f32x4){c.x, c.y, d.x, d.y}; }
                    v0 = v0 * sc; v1 = v1 * sc; u32x4 w; w.x = cvt_pk_bf16(v0[0], v0[1]); w.y = cvt_pk_bf16(v0[2], v0[3]); w.z = cvt_pk_bf16(v1[0], v1[1]); w.w = cvt_pk_bf16(v1[2], v1[3]);
                    *(u32x4*)(rowp + bj * HALF) = w; } }
    }
};

__device__ __forceinline__ float bf2f(unsigned short v) { return __uint_as_float(((unsigned)v) << 16); }
__device__ __forceinline__ float bflo(unsigned w) { return __uint_as_float(w << 16); }
__device__ __forceinline__ float bfhi(unsigned w) { return __uint_as_float(w & 0xffff0000u); }
__device__ __forceinline__ float fsigmoid(float x) { return __builtin_amdgcn_rcpf(1.0f + __builtin_amdgcn_exp2f(-1.4426950408889634f * x)); }
__device__ __forceinline__ u32x4 pack8f(const f32x4 a, const f32x4 b) { u32x4 w; w.x = cvt_pk_bf16(a[0], a[1]); w.y = cvt_pk_bf16(a[2], a[3]); w.z = cvt_pk_bf16(b[0], b[1]); w.w = cvt_pk_bf16(b[2], b[3]); return w; }
__device__ __forceinline__ void unpack8(const u32x4 w, f32x4& a, f32x4& b) { a = (f32x4){bflo(w.x), bfhi(w.x), bflo(w.y), bfhi(w.y)}; b = (f32x4){bflo(w.z), bfhi(w.z), bflo(w.w), bfhi(w.w)}; }

struct EpiKV { static constexpr bool PERM = true, AFTER_DRAIN = false;
    bf16_t* Kb; bf16_t* Vb;
    __device__ __forceinline__ void operator()(const f32x4 (&acc)[2][2][4][2], const Unit& u, int wr, int wc, int fr, int fq) const {
        const int row0 = u.pm * BM + wr * 64 + fr, h = u.pn, col = wc * 32 + 8 * fq;
#pragma unroll
        for (int ai = 0; ai < 2; ++ai)
#pragma unroll
            for (int m = 0; m < 4; ++m) { const int row = row0 + ai * HALF + m * 16; const int b = row >> 12, s = row & 4095;
                const size_t tok = (size_t)(b * 4 + h) * 4096 + s;
                *(u32x4*)(Kb + tok * 192 + col) = pack8f(acc[ai][0][m][0], acc[ai][0][m][1]);
                *(u32x4*)(Vb + tok * 128 + col) = pack8f(acc[ai][1][m][0], acc[ai][1][m][1]); }
    }
};

struct EpiResid { static constexpr bool PERM = false, AFTER_DRAIN = false;
    const float* base; float* out; const float* gate;
    __device__ __forceinline__ void operator()(const f32x4 (&acc)[2][2][4][2], const Unit& u, int wr, int wc, int fr, int fq) const {
        const int row0 = u.pm * BM + wr * 64 + fr, col0 = u.pn * BM + wc * 32 + 4 * fq, b = (u.pm * BM) >> 12;
        f32x4 gv[2][2];
#pragma unroll
        for (int bj = 0; bj < 2; ++bj)
#pragma unroll
            for (int n = 0; n < 2; ++n) gv[bj][n] = *(const f32x4*)(gate + b * 6144 + col0 + bj * HALF + n * 16);
#pragma unroll
        for (int ai = 0; ai < 2; ++ai)
#pragma unroll
            for (int m = 0; m < 4; ++m) { const size_t off = (size_t)(row0 + ai * HALF + m * 16) * 1024 + col0;
#pragma unroll
                for (int bj = 0; bj < 2; ++bj)
#pragma unroll
                    for (int n = 0; n < 2; ++n) { const f32x4 bs = *(const f32x4*)(base + off + bj * HALF + n * 16); *(f32x4*)(out + off + bj * HALF + n * 16) = bs + gv[bj][n] * acc[ai][bj][m][n]; } }
    }
};

struct EpiSwiGLU { static constexpr bool PERM = true, AFTER_DRAIN = false;
    bf16_t* Hd; int ldh;
    __device__ __forceinline__ void operator()(const f32x4 (&acc)[2][2][4][2], const Unit& u, int wr, int wc, int fr, int fq) const {
        const int row0 = u.pm * BM + wr * 64 + fr, col = u.pn * HALF + wc * 32 + 8 * fq;
#pragma unroll
        for (int ai = 0; ai < 2; ++ai)
#pragma unroll
            for (int m = 0; m < 4; ++m) { f32x4 r[2];
#pragma unroll
                for (int n = 0; n < 2; ++n) { const f32x4 g = acc[ai][0][m][n], up = acc[ai][1][m][n];
#pragma unroll
                    for (int e = 0; e < 4; ++e) r[n][e] = g[e] * fsigmoid(g[e]) * up[e]; }
                *(u32x4*)(Hd + (size_t)(row0 + ai * HALF + m * 16) * ldh + col) = pack8f(r[0], r[1]); }
    }
};

struct EpiMoE2 { static constexpr bool PERM = false, AFTER_DRAIN = false;
    float* out; const float* gate; const int* ridx; const float* rgw;
    __device__ __forceinline__ void operator()(const f32x4 (&acc)[2][2][4][2], const Unit& u, int wr, int wc, int fr, int fq) const {
        const int row0 = u.pm * BM + wr * 64 + fr, col0 = u.pn * BM + wc * 32 + 4 * fq;
#pragma unroll
        for (int ai = 0; ai < 2; ++ai)
#pragma unroll
            for (int m = 0; m < 4; ++m) { const int srow = row0 + ai * HALF + m * 16; const int tok = ridx[srow];
                if (tok >= 0) { const float gw = rgw[srow]; const float* gp = gate + (tok >> 12) * 6144 + col0; float* op = out + (size_t)tok * 1024 + col0;
#pragma unroll
                    for (int bj = 0; bj < 2; ++bj)
#pragma unroll
                        for (int n = 0; n < 2; ++n) { const f32x4 gv = *(const f32x4*)(gp + bj * HALF + n * 16); const f32x4 bs = *(const f32x4*)(op + bj * HALF + n * 16);
                            *(f32x4*)(op + bj * HALF + n * 16) = bs + (gv * gw) * acc[ai][bj][m][n]; } } }
    }
};

struct EpiLora { static constexpr bool PERM = true, AFTER_DRAIN = false;
    const float *w0, *a0, *v0, *k_k, *k_a;
    float* LW; bf16_t* Kraw; bf16_t* KK; bf16_t* BV; bf16_t* G; bf16_t* Vraw; const bf16_t* VF;
    __device__ __forceinline__ void operator()(const f32x4 (&acc)[2][2][4][2], const Unit& u, int wr, int wc, int fr, int fq) const {
        const int row0 = u.pm * BM + wr * 64 + fr, seg = u.pn >> 1, cb = 256 * (u.pn & 1) + 64 * wc + 8 * fq;
        if (seg == 0) {
            f32x4 p[2][2];
#pragma unroll
            for (int bj = 0; bj < 2; ++bj) { p[bj][0] = *(const f32x4*)(w0 + cb + 32 * bj); p[bj][1] = *(const f32x4*)(w0 + cb + 32 * bj + 4); }
#pragma unroll
            for (int ai = 0; ai < 2; ++ai)
#pragma unroll
                for (int m = 0; m < 4; ++m) { float* rp = LW + (size_t)(row0 + ai * HALF + m * 16) * 512 + cb;
#pragma unroll
                    for (int bj = 0; bj < 2; ++bj)
#pragma unroll
                        for (int n = 0; n < 2; ++n) { f32x4 o;
#pragma unroll
                            for (int e = 0; e < 4; ++e) o[e] = -0.6065306597126334f * fsigmoid(p[bj][n][e] + acc[ai][bj][m][n][e]);
                            *(f32x4*)(rp + 32 * bj + 4 * n) = o; } }
        } else if (seg == 1) {
#pragma unroll
            for (int ai = 0; ai < 2; ++ai)
#pragma unroll
                for (int m = 0; m < 4; ++m) { const size_t ro = (size_t)(row0 + ai * HALF + m * 16) * 512 + cb;
                    float ss = 0.f;
#pragma unroll
                    for (int bj = 0; bj < 2; ++bj) { f32x4 kv[2]; unpack8(*(const u32x4*)(Kraw + ro + 32 * bj), kv[0], kv[1]);
#pragma unroll
                        for (int n = 0; n < 2; ++n) { const f32x4 pk = *(const f32x4*)(k_k + cb + 32 * bj + 4 * n); const f32x4 t = kv[n] * pk; ss += (t[0] * t[0] + t[1] * t[1]) + (t[2] * t[2] + t[3] * t[3]); } }
                    ss += __uint_as_float((unsigned)__builtin_amdgcn_ds_swizzle((int)__float_as_uint(ss), 0x1f | (16 << 10)));
                    { const auto rr = __builtin_amdgcn_permlane32_swap(__float_as_uint(ss), __float_as_uint(ss), false, false); ss = __uint_as_float(rr[0]) + __uint_as_float(rr[1]); }
                    const float inv = 1.0f / fmaxf(sqrtf(ss), 1e-12f);
                    asm volatile("" ::: "memory");
#pragma unroll
                    for (int bj = 0; bj < 2; ++bj) { f32x4 kv[2], k2[2], kk2[2], b2[2]; unpack8(*(const u32x4*)(Kraw + ro + 32 * bj), kv[0], kv[1]);
#pragma unroll
                        for (int n = 0; n < 2; ++n) { const f32x4 pa = *(const f32x4*)(a0 + cb + 32 * bj + 4 * n), pk = *(const f32x4*)(k_k + cb + 32 * bj + 4 * n), pq = *(const f32x4*)(k_a + cb + 32 * bj + 4 * n);
#pragma unroll
                            for (int e = 0; e < 4; ++e) { const float a = fsigmoid(pa[e] + acc[ai][bj][m][n][e]), kkn = kv[n][e] * pk[e] * inv; kk2[n][e] = kkn; b2[n][e] = kkn * a; k2[n][e] = kv[n][e] * (1.0f + (a - 1.0f) * pq[e]); } }
                        *(u32x4*)(Kraw + ro + 32 * bj) = pack8f(k2[0], k2[1]); *(u32x4*)(KK + ro + 32 * bj) = pack8f(kk2[0], kk2[1]); *(u32x4*)(BV + ro + 32 * bj) = pack8f(b2[0], b2[1]); }
                    asm volatile("" ::: "memory"); }
        } else if (seg == 2) {
#pragma unroll
            for (int ai = 0; ai < 2; ++ai)
#pragma unroll
                for (int m = 0; m < 4; ++m) { bf16_t* rp = G + (size_t)(row0 + ai * HALF + m * 16) * 512 + cb;
#pragma unroll
                    for (int bj = 0; bj < 2; ++bj) *(u32x4*)(rp + 32 * bj) = pack8f(acc[ai][bj][m][0], acc[ai][bj][m][1]); }
        } else {
            f32x4 p[2][2];
#pragma unroll
            for (int bj = 0; bj < 2; ++bj) { p[bj][0] = *(const f32x4*)(v0 + cb + 32 * bj); p[bj][1] = *(const f32x4*)(v0 + cb + 32 * bj + 4); }
#pragma unroll
            for (int ai = 0; ai < 2; ++ai)
#pragma unroll
                for (int m = 0; m < 4; ++m) { const size_t ro = (size_t)(row0 + ai * HALF + m * 16) * 512 + cb;
#pragma unroll
                    for (int bj = 0; bj < 2; ++bj) { f32x4 vv[2], vf[2], o[2]; unpack8(*(const u32x4*)(Vraw + ro + 32 * bj), vv[0], vv[1]); unpack8(*(const u32x4*)(VF + ro + 32 * bj), vf[0], vf[1]);
#pragma unroll
                        for (int n = 0; n < 2; ++n)
#pragma unroll
                            for (int e = 0; e < 4; ++e) o[n][e] = vv[n][e] + (vf[n][e] - vv[n][e]) * fsigmoid(p[bj][n][e] + acc[ai][bj][m][n][e]);
                        *(u32x4*)(Vraw + ro + 32 * bj) = pack8f(o[0], o[1]); } }
        }
    }
};
template <class Epi, class Sched, bool ALIGN_EPI = false, bool SP2 = false, int MODE = 0>
__device__ __forceinline__ void gemm_phase(PG8_LAS unsigned char* lds, const Gemm g, const Sched& S, const Epi& E) {
    int tid_ = threadIdx.x; asm volatile("" : "+v"(tid_));
    const int tid = tid_, wid = __builtin_amdgcn_readfirstlane(tid >> 6), lane = tid & 63, wr = wid >> 2, wc = wid & 3, fr = lane & 15, fq = lane >> 4;
    int K_ = g.K; asm volatile("" : "+s"(K_));
    const int K = K_, nt = K / BK;
    unsigned voffA[2], voffB[2]; int gR[2], gC[2]; unsigned vAc[2][2], vAn[2][2];
    static_assert(SP2 || MODE == 0, "MODE != 0 needs SP2");
#pragma unroll
    for (int i = 0; i < 2; ++i) { int R, C; stage_rc(tid * 16 + i * 8192, R, C); const int Rb = Epi::PERM ? ((R & ~31) + perm32(R & 31)) : R;
        voffA[i] = (unsigned)(R * K + C) * 2u; voffB[i] = (unsigned)(Rb * K + C) * 2u; gR[i] = R; gC[i] = C; }
    const size_t kstep = (size_t)(BK * 2);
    const size_t hstep = (size_t)HALF * K * 2;
    const size_t tstep = 2 * hstep;
    const unsigned ldsw = (unsigned)wid * 1024u;
    const int aoff = lds_byte(wr * 64 + fr, fq * 8), boff = lds_byte(wc * 32 + fr, fq * 8);
#define PG8_SA(b, h) (((b) * 2 + (h)) * HTB)
#define PG8_SB(b, h) ((4 + (b) * 2 + (h)) * HTB)
#define PG8_STAGE(bufoff, gbase, voff) do { _Pragma("unroll") for (int _i = 0; _i < 2; ++_i) \
        __builtin_amdgcn_global_load_lds((const unsigned*)((const char*)(gbase) + (voff)[_i]), (PG8_LAS unsigned*)(lds + (bufoff) + ldsw + _i * 8192), 16, 0, 0); } while (0)
#define PG8_GATHER(dst, U) do { _Pragma("unroll") for (int _h = 0; _h < 2; ++_h) _Pragma("unroll") for (int _i = 0; _i < 2; ++_i) { \
        int _r = g.ridx[(U).pm * BM + _h * HALF + gR[_i]]; _r = _r < 0 ? 0 : _r; dst[_h][_i] = (unsigned)(_r * K + gC[_i]) * 2u; } } while (0)
#define PG8_STAGE_A(bufoff, kptr, h, NXT) do { if constexpr (MODE == 1) { _Pragma("unroll") for (int _i = 0; _i < 2; ++_i) \
        __builtin_amdgcn_global_load_lds((const unsigned*)((const char*)(kptr) + ((NXT) ? vAn[h][_i] : vAc[h][_i])), (PG8_LAS unsigned*)(lds + (bufoff) + ldsw + _i * 8192), 16, 0, 0); } \
    else { PG8_STAGE(bufoff, (kptr) + (h) * hstep, voffA); } } while (0)
#define PG8_APTR(U) ((MODE == 1) ? (const char*)g.A : (const char*)g.A + (size_t)(U).pm * tstep)
#define PG8_BPTR(U) ((MODE != 0) ? (const char*)g.Bt + (size_t)g.tile_e[(U).pm] * g.e_stride + (size_t)(U).pn * tstep : (const char*)g.Bt + (size_t)(U).pn * tstep)
#define PG8_LDA(dst, b, h) do { _Pragma("unroll") for (int m = 0; m < 4; ++m) _Pragma("unroll") for (int k = 0; k < 2; ++k) dst[m][k] = *(const PG8_LAS bf16x8*)(lds + PG8_SA(b, h) + aoff + m * 2048 + k * 1024); } while (0)
#define PG8_LDB(dst, b, h) do { _Pragma("unroll") for (int n = 0; n < 2; ++n) _Pragma("unroll") for (int k = 0; k < 2; ++k) dst[n][k] = *(const PG8_LAS bf16x8*)(lds + PG8_SB(b, h) + boff + n * 2048 + k * 1024); } while (0)
#define PG8_MMA(ai, bj, At, Bt) do { __builtin_amdgcn_s_setprio(1); _Pragma("unroll") for (int m = 0; m < 4; ++m) _Pragma("unroll") for (int n = 0; n < 2; ++n) _Pragma("unroll") for (int k = 0; k < 2; ++k) \
        acc[ai][bj][m][n] = __builtin_amdgcn_mfma_f32_16x16x32_bf16(Bt[n][k], At[m][k], acc[ai][bj][m][n], 0, 0, 0); __builtin_amdgcn_s_setprio(0); } while (0)
#define PG8_WAIT_V(n) asm volatile("s_waitcnt vmcnt(" #n ")" ::: "memory")
#define PG8_WAIT_L(n) asm volatile("s_waitcnt lgkmcnt(" #n ")" ::: "memory")
#define PG8_BAR __builtin_amdgcn_s_barrier()
#define PG8_SCHED __builtin_amdgcn_sched_barrier(0)
    Unit cur, nxt; int ui = 0;
    if (!S.next(0, cur)) return;
    f32x4 acc[2][2][4][2];
#pragma unroll
    for (int a = 0; a < 2; ++a)
#pragma unroll
        for (int b = 0; b < 2; ++b)
#pragma unroll
            for (int m = 0; m < 4; ++m)
#pragma unroll
                for (int n = 0; n < 2; ++n) acc[a][b][m][n] = (f32x4){0.f, 0.f, 0.f, 0.f};
    bf16x8 At[4][2], B0[2][2], B1[2][2];
    const char* cA = PG8_APTR(cur); const char* cB = PG8_BPTR(cur);
    if constexpr (MODE == 1) { PG8_GATHER(vAc, cur); }
    S.a_ready(cur);
    if constexpr (SP2) {
        PG8_STAGE(PG8_SB(0, 0), cB, voffB); PG8_STAGE(PG8_SB(0, 1), cB + hstep, voffB); PG8_STAGE_A(PG8_SA(0, 0), cA, 0, false); PG8_STAGE_A(PG8_SA(0, 1), cA, 1, false);
        if (wr == 1) PG8_BAR;
        PG8_WAIT_V(2); PG8_BAR;
        PG8_STAGE(PG8_SB(1, 0), cB + kstep, voffB); PG8_STAGE_A(PG8_SA(1, 0), cA + kstep, 0, false); PG8_STAGE(PG8_SB(1, 1), cB + hstep + kstep, voffB);
        PG8_WAIT_V(6); PG8_BAR;
    } else {
        PG8_STAGE(PG8_SB(0, 0), cB, voffB); PG8_STAGE(PG8_SA(0, 0), cA, voffA); PG8_STAGE(PG8_SB(0, 1), cB + hstep, voffB); PG8_STAGE(PG8_SA(0, 1), cA + hstep, voffA);
        if (wr == 1) PG8_BAR;
        PG8_WAIT_V(4); PG8_BAR;
        PG8_STAGE(PG8_SB(1, 0), cB + kstep, voffB); PG8_STAGE(PG8_SA(1, 0), cA + kstep, voffA); PG8_STAGE(PG8_SB(1, 1), cB + hstep + kstep, voffB);
        PG8_WAIT_V(6); PG8_BAR;
    }
    for (;;) {
        const bool has_next = S.next(ui + 1, nxt);
        const char* nA = has_next ? PG8_APTR(nxt) : cA; const char* nB = has_next ? PG8_BPTR(nxt) : cB;
        if constexpr (MODE == 1) { if (has_next) { PG8_GATHER(vAn, nxt); asm volatile("s_waitcnt vmcnt(0)" ::: "memory"); } else { vAn[0][0] = vAc[0][0]; vAn[0][1] = vAc[0][1]; vAn[1][0] = vAc[1][0]; vAn[1][1] = vAc[1][1]; } }
        for (int t = 0; t < nt; t += 2) {
            const bool last = (t == nt - 2);
            const char* a1 = cA + (size_t)(t + 1) * kstep;
            const char* a2 = last ? nA : cA + (size_t)(t + 2) * kstep; const char* b2 = last ? nB : cB + (size_t)(t + 2) * kstep;
            const char* a3 = a2 + kstep; const char* b3 = b2 + kstep;
            if (last && has_next) S.a_ready(nxt);
            if constexpr (SP2) {
            PG8_LDB(B0, 0, 0); PG8_LDB(B1, 0, 1); PG8_SCHED; PG8_LDA(At, 0, 0); PG8_STAGE_A(PG8_SA(1, 1), a1, 1, false);
            PG8_WAIT_V(8); PG8_WAIT_L(0); PG8_BAR; PG8_MMA(0, 0, At, B0); PG8_MMA(0, 1, At, B1); PG8_BAR; PG8_SCHED;
            PG8_LDA(At, 0, 1); PG8_STAGE(PG8_SB(0, 0), b2, voffB); PG8_STAGE(PG8_SB(0, 1), b2 + hstep, voffB); PG8_STAGE_A(PG8_SA(0, 0), a2, 0, last);
            PG8_WAIT_V(8); PG8_WAIT_L(0); PG8_BAR; PG8_MMA(1, 0, At, B0); PG8_MMA(1, 1, At, B1); PG8_BAR; PG8_SCHED;
            PG8_LDB(B0, 1, 0); PG8_LDB(B1, 1, 1); PG8_SCHED; PG8_LDA(At, 1, 0); PG8_STAGE_A(PG8_SA(0, 1), a2, 1, last);
            PG8_WAIT_V(8); PG8_WAIT_L(0); PG8_BAR; PG8_MMA(0, 0, At, B0); PG8_MMA(0, 1, At, B1); PG8_BAR; PG8_SCHED;
            PG8_LDA(At, 1, 1); PG8_STAGE(PG8_SB(1, 0), b3, voffB); PG8_STAGE(PG8_SB(1, 1), b3 + hstep, voffB); PG8_STAGE_A(PG8_SA(1, 0), a3, 0, last);
            PG8_WAIT_V(8); PG8_WAIT_L(0); PG8_BAR; PG8_MMA(1, 0, At, B0); PG8_MMA(1, 1, At, B1); PG8_BAR; PG8_SCHED;
            } else {
            PG8_LDB(B0, 0, 0); PG8_SCHED; PG8_LDA(At, 0, 0); PG8_STAGE(PG8_SA(1, 1), a1 + hstep, voffA);
            PG8_WAIT_L(8); PG8_BAR; PG8_WAIT_L(0); PG8_MMA(0, 0, At, B0); PG8_BAR; PG8_SCHED;
            PG8_LDB(B1, 0, 1); PG8_STAGE(PG8_SB(0, 0), b2, voffB);
            PG8_BAR; PG8_WAIT_L(0); PG8_MMA(0, 1, At, B1); PG8_BAR;
            PG8_LDA(At, 0, 1); PG8_STAGE(PG8_SA(0, 0), a2, voffA);
            PG8_BAR; PG8_WAIT_L(0); PG8_MMA(1, 0, At, B0); PG8_BAR; PG8_SCHED;
            PG8_STAGE(PG8_SB(0, 1), b2 + hstep, voffB);
            PG8_WAIT_V(6); PG8_BAR; PG8_MMA(1, 1, At, B1); PG8_BAR;
            PG8_LDB(B0, 1, 0); PG8_SCHED; PG8_LDA(At, 1, 0); PG8_STAGE(PG8_SA(0, 1), a2 + hstep, voffA);
            PG8_WAIT_L(8); PG8_BAR; PG8_WAIT_L(0); PG8_MMA(0, 0, At, B0); PG8_BAR; PG8_SCHED;
            PG8_LDB(B1, 1, 1); PG8_STAGE(PG8_SB(1, 0), b3, voffB);
            PG8_BAR; PG8_WAIT_L(0); PG8_MMA(0, 1, At, B1); PG8_BAR;
            PG8_LDA(At, 1, 1); PG8_STAGE(PG8_SA(1, 0), a3, voffA);
            PG8_BAR; PG8_WAIT_L(0); PG8_MMA(1, 0, At, B0); PG8_BAR; PG8_SCHED;
            PG8_STAGE(PG8_SB(1, 1), b3 + hstep, voffB);
            PG8_WAIT_V(6); PG8_BAR; PG8_MMA(1, 1, At, B1); PG8_BAR;
            }
        }
        if constexpr (ALIGN_EPI) { if (wr == 0) PG8_BAR; }
        if constexpr (!Epi::AFTER_DRAIN) { E(acc, cur, wr, wc, fr, fq); S.done(cur); }
        if (!has_next) break;
#pragma unroll
        for (int a = 0; a < 2; ++a)
#pragma unroll
            for (int b = 0; b < 2; ++b)
#pragma unroll
                for (int m = 0; m < 4; ++m)
#pragma unroll
                    for (int n = 0; n < 2; ++n) acc[a][b][m][n] = (f32x4){0.f, 0.f, 0.f, 0.f};
        cur = nxt; cA = nA; cB = nB; ++ui;
        if constexpr (MODE == 1) { vAc[0][0] = vAn[0][0]; vAc[0][1] = vAn[0][1]; vAc[1][0] = vAn[1][0]; vAc[1][1] = vAn[1][1]; }
        if constexpr (ALIGN_EPI) { if (wr == 1) PG8_BAR; }
    }
    PG8_WAIT_V(0);
    if constexpr (!ALIGN_EPI) { if (wr == 0) PG8_BAR; }
    PG8_BAR;
    if constexpr (Epi::AFTER_DRAIN) { E.fused(acc, cur, wr, wc, fr, fq, lds, wid, lane); S.done(cur); }
#undef PG8_SA
#undef PG8_SB
#undef PG8_STAGE
#undef PG8_STAGE_A
#undef PG8_GATHER
#undef PG8_APTR
#undef PG8_BPTR
#undef PG8_LDA
#undef PG8_LDB
#undef PG8_MMA
#undef PG8_WAIT_V
#undef PG8_WAIT_L
#undef PG8_BAR
#undef PG8_SCHED
}
}

#define GAS __attribute__((address_space(1)))
#define LAS __attribute__((address_space(3)))
typedef unsigned short bf16;
typedef unsigned v4u __attribute__((ext_vector_type(4)));
typedef unsigned v2u __attribute__((ext_vector_type(2)));
typedef float f32x4 __attribute__((ext_vector_type(4)));
typedef float f32x16 __attribute__((ext_vector_type(16)));
typedef short bf16x8 __attribute__((ext_vector_type(8)));
typedef short s16x4 __attribute__((ext_vector_type(4)));
typedef GAS unsigned gu32;
#define RLX_AGENT __ATOMIC_RELAXED, __HIP_MEMORY_SCOPE_AGENT
#define LDS_WAIT() asm volatile("s_waitcnt lgkmcnt(0)" ::: "memory")
#define VM_WAIT() asm volatile("s_waitcnt vmcnt(0)" ::: "memory")
using pg8::bf2f; using pg8::bflo; using pg8::bfhi; using pg8::fsigmoid; using pg8::cvt_pk_bf16;

#ifndef MK_SPLIT
#define MK_SPLIT 0
#endif

constexpr int NWAVES = 8, NTHR = 512;
constexpr int NB = 8, SEQ = 4096, TOK = NB * SEQ, DM = 1024;
constexpr int NPROJ = 2304;
constexpr int NQ = 768, NKV = 1024, KLORA = 384, NLORA = 2048, RW = 512;
constexpr int FFD = 2816, FFE = 3584, NEXP = 8;
constexpr int MODLD = 6144;
constexpr int PASS_TILES = 136;
constexpr int PASS_ROWS = PASS_TILES * 256;

constexpr size_t MiB = 1u << 20;
constexpr size_t WS_CTL = 0, CTL_ZERO_BYTES = 64 * 1024;
constexpr size_t WS_MOD = 1 * MiB;
constexpr size_t WS_ROUTE = 2 * MiB;
constexpr size_t WS_WIN = 4 * MiB;
constexpr size_t WS_WUQ = WS_WIN + 2ull * NPROJ * DM * 2;
constexpr size_t WS_WUKV = WS_WUQ + 2ull * NQ * 256 * 2;
constexpr size_t WS_WLORA = WS_WUKV + 2ull * NKV * 128 * 2;
constexpr size_t WS_WOUT = WS_WLORA + 2ull * NLORA * KLORA * 2;
constexpr size_t WS_WF1 = WS_WOUT + 2ull * DM * DM * 2;
constexpr size_t WS_WF2 = WS_WF1 + 2ull * FFD * DM * 2;
constexpr size_t WS_WEND = WS_WF2 + (size_t)DM * FFD * 2;
constexpr size_t WS_VFIRST = 38 * MiB;
constexpr size_t WS_ARENA = 70 * MiB;
static_assert(WS_WEND <= WS_VFIRST, "weights overflow");
constexpr size_t A_H = WS_ARENA + 0 * MiB;
constexpr size_t A_PROJ = WS_ARENA + 64 * MiB;
constexpr size_t A_CQ = WS_ARENA + 208 * MiB;
constexpr size_t A_CKV = WS_ARENA + 224 * MiB;
constexpr size_t A_LA = WS_ARENA + 232 * MiB;
constexpr size_t A_KB = WS_ARENA + 256 * MiB;
constexpr size_t A_R = WS_ARENA + 304 * MiB;
constexpr size_t A_KRAW = WS_ARENA + 336 * MiB;
constexpr size_t A_VRAW = WS_ARENA + 368 * MiB;
constexpr size_t A_VB = WS_ARENA + 400 * MiB;
constexpr size_t A_KK = WS_ARENA + 432 * MiB;
constexpr size_t A_BV = WS_ARENA + 464 * MiB;
constexpr size_t A_Q = WS_ARENA + 0 * MiB;
constexpr size_t A_LW = WS_ARENA + 64 * MiB;
constexpr size_t A_G = WS_ARENA + 128 * MiB;
constexpr size_t A_YCAT = WS_ARENA + 160 * MiB;
constexpr size_t A_HID = WS_ARENA + 64 * MiB;
constexpr size_t A_WE1 = WS_ARENA + 304 * MiB;
constexpr size_t A_WE2 = WS_ARENA + 416 * MiB;
constexpr size_t WS_END = WS_ARENA + 504 * MiB;
static_assert(A_HID + (size_t)PASS_ROWS * FFE * 2 <= A_WE1, "moe hidden overflow");
constexpr size_t RT_SEL = WS_ROUTE;
constexpr size_t RT_GW = RT_SEL + (size_t)TOK * 8;
constexpr size_t RT_CNT = RT_GW + (size_t)TOK * 8;
constexpr size_t RT_RIDX = RT_CNT + 256 * 16 * 4;
constexpr size_t RT_RGW = RT_RIDX + 2ull * PASS_ROWS * 4;
constexpr size_t RT_TILE = RT_RGW + 2ull * PASS_ROWS * 4;
static_assert(RT_TILE + 2 * (PASS_TILES + 8) * 4 <= WS_WIN, "route tables overflow");
constexpr int CW_QCTR = 64;
constexpr int CW_BAR = 4096;

constexpr int RING_BYTES = 131072;
constexpr int LDSCTL_OFF = RING_BYTES, MISC_OFF = LDSCTL_OFF + 320, PTAB_OFF = LDSCTL_OFF + 1024;
constexpr int LDS_BYTES = 147456;

#define XB_TMO      128
#define XB_XCNT(j)  (256  + 64 * (j))
#define XB_XSUB(j)  (1280 + 64 * (j))
#define XB_XGEN(j)  (2304 + 64 * (j))
#define XB_TOP      3328
#define XB_TOPGEN   3392
#define XCD_BAR_WORDS 3456
#define XB_SPIN_CAP (1u << 18)

__device__ __forceinline__ unsigned xb_ld(unsigned* p)              { return __hip_atomic_load(p, __ATOMIC_RELAXED, __HIP_MEMORY_SCOPE_AGENT); }
__device__ __forceinline__ unsigned xb_add(unsigned* p, unsigned v) { return __hip_atomic_fetch_add(p, v, __ATOMIC_RELAXED, __HIP_MEMORY_SCOPE_AGENT); }
__device__ __forceinline__ unsigned xb_xcc_id() { return (unsigned)__builtin_amdgcn_s_getreg((3 << 11) | 20) & 0xFu; }
#define XB_SPIN(cond, bar) do { unsigned _sp = 0; while (cond) { __builtin_amdgcn_s_sleep(1); \
    if ((++_sp & 255u) == 0u) { if (xb_ld(&(bar)[XB_TMO])) break; if (_sp > XB_SPIN_CAP) { atomicAdd(&(bar)[XB_TMO], 1u); break; } } } } while (0)

struct XcdBarrier {
    unsigned* bar; unsigned x;
    volatile LAS unsigned* st;
};

__device__ __forceinline__ XcdBarrier xcd_barrier_post(unsigned* bar, volatile LAS unsigned* st) {
    XcdBarrier b; b.bar = bar; b.x = xb_xcc_id(); b.st = st;
    if (threadIdx.x == 0) (void)xb_add(&bar[XB_XCNT(b.x)], 1u);
    return b;
}
__device__ __forceinline__ void xcd_barrier_complete(unsigned* bar, unsigned x, unsigned& nloc, unsigned& nx) {
    const unsigned G = gridDim.x * gridDim.y * gridDim.z;
    unsigned sum, cnt, mine, sp = 0u;
    for (;;) {
        sum = 0u; cnt = 0u; mine = 0u;
#pragma unroll
        for (unsigned j = 0; j < 16; ++j) { const unsigned c = xb_ld(&bar[XB_XCNT(j)]); sum += c; cnt += (c > 0u) ? 1u : 0u; mine = (j == x) ? c : mine; }
        if (sum == G) break;
        __builtin_amdgcn_s_sleep(1);
        if ((++sp & 255u) == 0u) { if (xb_ld(&bar[XB_TMO])) break; if (sp > XB_SPIN_CAP) { atomicAdd(&bar[XB_TMO], 1u); break; } }
    }
    nloc = mine > 0u ? mine : 1u; nx = cnt > 0u ? cnt : 1u;
}

__device__ __forceinline__ void xcd_barrier(const XcdBarrier& b) {
    asm volatile("s_waitcnt vmcnt(0)" ::: "memory");
    __syncthreads();
    if (threadIdx.x == 0) {
        unsigned* bar = b.bar;
        __builtin_amdgcn_s_waitcnt(0);
        unsigned nloc = b.st[0], nx = b.st[1];
        if (nloc == 0u) { xcd_barrier_complete(bar, b.x, nloc, nx); b.st[0] = nloc; b.st[1] = nx; }
        const unsigned old = xb_add(&bar[XB_XSUB(b.x)], 1u);
        const unsigned gen = old / nloc;
        if (old + 1u == (gen + 1u) * nloc) {
            __builtin_amdgcn_fence(__ATOMIC_RELEASE, "agent");
            asm volatile("s_waitcnt vmcnt(0)" ::: "memory");
            const unsigned og = xb_add(&bar[XB_TOP], 1u);
            const unsigned tg = og / nx;
            if (og + 1u == (tg + 1u) * nx) xb_add(&bar[XB_TOPGEN], 1u);
            else XB_SPIN(xb_ld(&bar[XB_TOPGEN]) == tg, bar);
            __builtin_amdgcn_fence(__ATOMIC_ACQUIRE, "agent");
            xb_add(&bar[XB_XGEN(b.x)], 1u);
            asm volatile("s_waitcnt vmcnt(0)" ::: "memory");
        } else {
            XB_SPIN(xb_ld(&bar[XB_XGEN(b.x)]) == gen, bar);
            __builtin_amdgcn_fence(__ATOMIC_ACQUIRE, "agent");
            asm volatile("s_waitcnt vmcnt(0)" ::: "memory");
        }
    }
    __syncthreads();
}


template <int X> __device__ __forceinline__ float lane_xor(float v) {
    if constexpr (X == 32) { const auto rr = __builtin_amdgcn_permlane32_swap(__float_as_uint(v), __float_as_uint(v), false, false); return __uint_as_float((threadIdx.x & 32) ? rr[0] : rr[1]); }
    else return __uint_as_float((unsigned)__builtin_amdgcn_ds_swizzle((int)__float_as_uint(v), 0x1f | (X << 10)));
}
__device__ __forceinline__ float wave_sum(float v) {
    v += lane_xor<1>(v); v += lane_xor<2>(v); v += lane_xor<4>(v); v += lane_xor<8>(v); v += lane_xor<16>(v);
    { const auto rr = __builtin_amdgcn_permlane32_swap(__float_as_uint(v), __float_as_uint(v), false, false); v = __uint_as_float(rr[0]) + __uint_as_float(rr[1]); }
    return v;
}
__device__ __forceinline__ v4u pk8(const float* f) { v4u w; w.x = cvt_pk_bf16(f[0], f[1]); w.y = cvt_pk_bf16(f[2], f[3]); w.z = cvt_pk_bf16(f[4], f[5]); w.w = cvt_pk_bf16(f[6], f[7]); return w; }
__device__ __forceinline__ void up8(const v4u w, float* f) { f[0] = bflo(w.x); f[1] = bfhi(w.x); f[2] = bflo(w.y); f[3] = bfhi(w.y); f[4] = bflo(w.z); f[5] = bfhi(w.z); f[6] = bflo(w.w); f[7] = bfhi(w.w); }

__device__ __forceinline__ void tr_item(const float* W, int ldw, bf16* WT, int ldk, int k0, int n0, int drow0, LAS float* scr, int lane) {
#pragma unroll 8
    for (int i = 0; i < 32; ++i) { const int kk = 2 * i + (lane >> 5); scr[kk * 33 + (lane & 31)] = W[(size_t)(k0 + kk) * ldw + n0 + (lane & 31)]; }
    LDS_WAIT(); asm volatile("" ::: "memory");
    const int c = lane & 7;
#pragma unroll
    for (int j = 0; j < 4; ++j) { const int n = (lane >> 3) + 8 * j; const LAS float* s = scr + (8 * c) * 33 + n;
        v4u o; o.x = cvt_pk_bf16(s[0 * 33], s[1 * 33]); o.y = cvt_pk_bf16(s[2 * 33], s[3 * 33]); o.z = cvt_pk_bf16(s[4 * 33], s[5 * 33]); o.w = cvt_pk_bf16(s[6 * 33], s[7 * 33]);
        *(GAS v4u*)(WT + (size_t)(drow0 + n) * ldk + k0 + 8 * c) = o; }
    LDS_WAIT(); asm volatile("" ::: "memory");
}
__device__ __forceinline__ void conv_item(const float* W, int K, int N, bf16* WT, int ldk, int mode, int row_off, int item, LAS float* scr, int lane) {
    const int nblk = N / 32, kb = item / nblk, nb = item % nblk, n0 = 32 * nb;
    int drow = n0 + row_off;
    if (mode != 0) drow = 256 * (n0 >> 7) + (n0 & 127) + (mode == 2 ? 128 : 0);
    tr_item(W, N, WT, ldk, 64 * kb, n0, drow, scr, lane);
}
struct In { const float* p[38]; };
struct InT { volatile LAS unsigned* t;
    __device__ __forceinline__ const float* operator[](int i) const { const unsigned lo = __builtin_amdgcn_readfirstlane(t[2 * i]), hi = __builtin_amdgcn_readfirstlane(t[2 * i + 1]);
        return (const float*)(((unsigned long long)hi << 32) | (unsigned long long)lo); } };

__device__ __forceinline__ void p0_weights(const InT in, unsigned char* ws, LAS unsigned char* lds, int gw, int NGW, int wave, int lane, int gtid, int NGT) {
    LAS float* scr = (LAS float*)(lds + wave * 16384);
    constexpr int I_IN = 16 * 70, I_VR = 16, I_UQ = 4 * 24, I_UKV = 2 * 32, I_OUT = 16 * 32, I_G = 16 * 88, I_D = 44 * 32;
    constexpr int PER_L = I_IN + I_UQ + I_UKV + I_OUT;
    constexpr int NITEMS = 2 * PER_L + I_VR + 2 * I_G + I_D;
    for (int it = gw; it < NITEMS; it += NGW) {
        int r = it;
        if (r < 2 * PER_L) { const int l = r / PER_L; r -= l * PER_L;
            if (r < I_IN) { conv_item(in[7] + (size_t)l * DM * 2240, DM, 2240, (bf16*)(ws + WS_WIN) + (size_t)l * NPROJ * DM, DM, 0, 0, r, scr, lane); continue; } r -= I_IN;
            if (r < I_UQ) { conv_item(in[10] + (size_t)l * 256 * NQ, 256, NQ, (bf16*)(ws + WS_WUQ) + (size_t)l * NQ * 256, 256, 0, 0, r, scr, lane); continue; } r -= I_UQ;
            if (r < I_UKV) { conv_item(in[12] + (size_t)l * 128 * NKV, 128, NKV, (bf16*)(ws + WS_WUKV) + (size_t)l * NKV * 128, 128, 0, 0, r, scr, lane); continue; } r -= I_UKV;
            conv_item(in[28] + (size_t)l * DM * DM, DM, DM, (bf16*)(ws + WS_WOUT) + (size_t)l * DM * DM, DM, 0, 0, r, scr, lane); continue; }
        r -= 2 * PER_L;
        if (r < I_VR) { conv_item(in[8], DM, 32, (bf16*)(ws + WS_WIN) + (size_t)NPROJ * DM, DM, 0, 2240, r, scr, lane); continue; } r -= I_VR;
        if (r < I_G) { conv_item(in[29], DM, FFD, (bf16*)(ws + WS_WF1), DM, 1, 0, r, scr, lane); continue; } r -= I_G;
        if (r < I_G) { conv_item(in[30], DM, FFD, (bf16*)(ws + WS_WF1), DM, 2, 0, r, scr, lane); continue; } r -= I_G;
        conv_item(in[31], FFD, DM, (bf16*)(ws + WS_WF2), FFD, 0, 0, r, scr, lane);
    }
    { const int n0 = 64 * 128, n1 = 32 * 128;
      for (int i = gtid; i < n0 + n1; i += NGT) { const bool l1 = i >= n0; const int j = l1 ? i - n0 : i; const int row = (l1 ? 2272 : 2240) + j / 128, ch = j % 128;
          *(GAS v4u*)((bf16*)(ws + WS_WIN) + ((size_t)(l1 ? NPROJ : 0) + row) * DM + ch * 8) = (v4u){0u, 0u, 0u, 0u}; } }
    const float* pw2 = in[17]; const float* pa2 = in[19]; const float* pg2 = in[20]; const float* pv2 = in[22];
    for (int i = gtid; i < 2 * NLORA * (KLORA / 8); i += NGT) {
        const int l = i / (NLORA * 48), rem = i % (NLORA * 48), k8 = rem / NLORA, pos = rem % NLORA;
        const int seg = pos >> 9, p9 = pos & 511, ct = p9 >> 8, p8 = p9 & 255, bj = p8 >> 7, wc = (p8 >> 5) & 3, x = p8 & 31;
        const int oc = 256 * ct + 64 * wc + 32 * bj + x;
        const int k0 = k8 * 8;
        const float* src = nullptr; int kr = 0;
        if (seg == 0 && k0 < 64) { src = pw2 + (size_t)l * 64 * RW; kr = k0; }
        else if (seg == 1 && k0 >= 64 && k0 < 128) { src = pa2 + (size_t)l * 64 * RW; kr = k0 - 64; }
        else if (seg == 2 && k0 >= 128 && k0 < 256) { src = pg2 + (size_t)l * 128 * RW; kr = k0 - 128; }
        else if (seg == 3 && l == 1 && k0 >= 256 && k0 < 288) { src = pv2; kr = k0 - 256; }
        float f[8];
#pragma unroll
        for (int e = 0; e < 8; ++e) f[e] = src ? src[(size_t)(kr + e) * RW + oc] : 0.f;
        *(GAS v4u*)((bf16*)(ws + WS_WLORA) + ((size_t)l * NLORA + pos) * KLORA + k0) = pk8(f);
    }
}
__device__ __forceinline__ void p_expert_weights(const InT in, unsigned char* ws, LAS unsigned char* lds, int gw, int NGW, int wave, int lane) {
    LAS float* scr = (LAS float*)(lds + wave * 16384);
    constexpr int IPJ = 1792;
    for (int it = gw; it < 24 * IPJ; it += NGW) { const int job = it / IPJ, r = it % IPJ, e = job / 3, kind = job % 3;
        if (kind == 0) conv_item(in[34] + (size_t)e * DM * FFE, DM, FFE, (bf16*)(ws + A_WE1) + (size_t)e * 2 * FFE * DM, DM, 1, 0, r, scr, lane);
        else if (kind == 1) conv_item(in[35] + (size_t)e * DM * FFE, DM, FFE, (bf16*)(ws + A_WE1) + (size_t)e * 2 * FFE * DM, DM, 2, 0, r, scr, lane);
        else conv_item(in[36] + (size_t)e * FFE * DM, FFE, DM, (bf16*)(ws + A_WE2) + (size_t)e * DM * FFE, FFE, 0, 0, r, scr, lane); }
}
__device__ __forceinline__ void p0_mod(const InT in, unsigned char* ws, LAS unsigned char* lds, int vcu, int G, int wave, int lane, int tid) {
    LAS float* cond = (LAS float*)lds;
    LAS float* red = (LAS float*)(lds + 32768);
    const float* cin = in[1]; const float* wada = in[3]; const float* bada = in[4];
    for (int i = tid; i < NB * DM; i += NTHR) { const float c = cin[i]; cond[i] = c * fsigmoid(c); }
    __syncthreads();
    float* MOD = (float*)(ws + WS_MOD);
    for (int it = vcu; it < 2 * (MODLD / 64); it += G) { const int l = it / (MODLD / 64), n0 = (it % (MODLD / 64)) * 64;
        const float* W = wada + (size_t)l * DM * MODLD + n0 + lane;
        float a[8] = {0.f, 0.f, 0.f, 0.f, 0.f, 0.f, 0.f, 0.f};
#pragma unroll 4
        for (int k = wave * 128; k < wave * 128 + 128; ++k) { const float w = W[(size_t)k * MODLD];
#pragma unroll
            for (int b = 0; b < 8; ++b) a[b] += cond[b * DM + k] * w; }
#pragma unroll
        for (int b = 0; b < 8; ++b) red[(wave * 8 + b) * 64 + lane] = a[b];
        __syncthreads();
        { const int b = tid >> 6, n = tid & 63; float s = bada[(size_t)l * MODLD + n0 + n];
#pragma unroll
          for (int w = 0; w < 8; ++w) s += red[(w * 8 + b) * 64 + n];
          MOD[((size_t)l * NB + b) * MODLD + n0 + n] = s; }
        __syncthreads();
    }
}

template <bool ROUTER>
__device__ __forceinline__ void norm_phase(const float* xin, const float* g, const float* modl, int sh_off, bf16* H, const float* wr, const float* br, unsigned char* ws,
                                           LAS unsigned char* lds, int vcu, int G, int wave, int lane, int tid) {
    LAS int* cntl = (LAS int*)lds;
    for (int blk = vcu; blk < TOK / 128; blk += G) {
        if (ROUTER) { if (tid < 16) cntl[tid] = 0; __syncthreads(); }
        const int row0 = blk * 128 + wave * 16, b = row0 >> 12;
        const float* shp = modl + (size_t)b * MODLD + sh_off; const float* scp = shp + 1024;
        f32x4 gs[4], sh[4];
#pragma unroll
        for (int j = 0; j < 4; ++j) { const int c = 4 * lane + 256 * j; const f32x4 gg = *(const f32x4*)(g + c), sc = *(const f32x4*)(scp + c); gs[j] = gg * (sc + 1.0f); sh[j] = *(const f32x4*)(shp + c); }
        for (int r = 0; r < 16; ++r) { const int row = row0 + r;
            const GAS f32x4* xr = (const GAS f32x4*)(xin + (size_t)row * DM) + lane;
            f32x4 v[4]; float s = 0.f;
#pragma unroll
            for (int j = 0; j < 4; ++j) { v[j] = xr[64 * j]; s += (v[j].x * v[j].x + v[j].y * v[j].y) + (v[j].z * v[j].z + v[j].w * v[j].w); }
            const float rstd = 1.0f / sqrtf(wave_sum(s) * (1.0f / DM) + 1e-6f);
            GAS unsigned long long* o8 = (GAS unsigned long long*)(H + (size_t)row * DM) + lane;
#pragma unroll
            for (int j = 0; j < 4; ++j) { v[j] = v[j] * rstd * gs[j] + sh[j]; o8[64 * j] = (unsigned long long)cvt_pk_bf16(v[j].x, v[j].y) | ((unsigned long long)cvt_pk_bf16(v[j].z, v[j].w) << 32); }
            if (ROUTER) {
                float lg[8];
#pragma unroll
                for (int e = 0; e < 8; ++e) lg[e] = 0.f;
#pragma unroll
                for (int j = 0; j < 4; ++j)
#pragma unroll
                    for (int i = 0; i < 4; ++i) { const f32x4 w0 = *(const f32x4*)(wr + (size_t)(4 * lane + 256 * j + i) * 8), w1 = *(const f32x4*)(wr + (size_t)(4 * lane + 256 * j + i) * 8 + 4); const float hv = v[j][i];
                        lg[0] += hv * w0.x; lg[1] += hv * w0.y; lg[2] += hv * w0.z; lg[3] += hv * w0.w; lg[4] += hv * w1.x; lg[5] += hv * w1.y; lg[6] += hv * w1.z; lg[7] += hv * w1.w; }
#pragma unroll
                for (int e = 0; e < 8; ++e) lg[e] = wave_sum(lg[e]) + br[e];
                unsigned key[8];
#pragma unroll
                for (int e = 0; e < 8; ++e) { const unsigned u = __float_as_uint(lg[e]); const unsigned kx = (u & 0x80000000u) ? ~u : (u | 0x80000000u); key[e] = (kx & ~7u) | (unsigned)(7 - e); }
                unsigned k1 = key[0];
#pragma unroll
                for (int e = 1; e < 8; ++e) k1 = key[e] > k1 ? key[e] : k1;
                unsigned k2 = 0u;
#pragma unroll
                for (int e = 0; e < 8; ++e) { const unsigned t = (key[e] == k1) ? 0u : key[e]; k2 = t > k2 ? t : k2; }
                k1 = (unsigned)__builtin_amdgcn_readfirstlane((int)k1); k2 = (unsigned)__builtin_amdgcn_readfirstlane((int)k2);
                const int i1 = 7 - (int)(k1 & 7u), i2 = 7 - (int)(k2 & 7u);
                const float v1 = __uint_as_float((k1 & 0x80000000u) ? (k1 & 0x7fffffffu) : ~k1), v2 = __uint_as_float((k2 & 0x80000000u) ? (k2 & 0x7fffffffu) : ~k2);
                const float w2 = 1.0f / (1.0f + __expf(v1 - v2)), w1 = 1.0f - w2;
                if (lane == 0) { *(GAS int*)(ws + RT_SEL + (size_t)row * 8) = i1; *(GAS int*)(ws + RT_SEL + (size_t)row * 8 + 4) = i2; *(GAS float*)(ws + RT_GW + (size_t)row * 8) = w1; *(GAS float*)(ws + RT_GW + (size_t)row * 8 + 4) = w2;
                    atomicAdd((int*)&cntl[i1], 1); atomicAdd((int*)&cntl[8 + i2], 1); }
            }
        }
        if (ROUTER) {
            __syncthreads();
            if (tid < 16) *(GAS int*)(ws + RT_CNT + ((size_t)blk * 16 + tid) * 4) = cntl[tid];
            __syncthreads();
        }
    }
}
__device__ __forceinline__ void final_norm(float* x, const float* g, int gw, int NGW, int lane) {
    f32x4 gs[4];
#pragma unroll
    for (int j = 0; j < 4; ++j) gs[j] = *(const f32x4*)(g + 4 * lane + 256 * j);
    for (int row = gw; row < TOK; row += NGW) { GAS f32x4* xr = (GAS f32x4*)(x + (size_t)row * DM) + lane; f32x4 v[4]; float s = 0.f;
#pragma unroll
        for (int j = 0; j < 4; ++j) { v[j] = xr[64 * j]; s += (v[j].x * v[j].x + v[j].y * v[j].y) + (v[j].z * v[j].z + v[j].w * v[j].w); }
        const float rstd = 1.0f / sqrtf(wave_sum(s) * (1.0f / DM) + 1e-6f);
#pragma unroll
        for (int j = 0; j < 4; ++j) xr[64 * j] = v[j] * rstd * gs[j]; }
}

__device__ __forceinline__ void rw_chunk(int l, int m, bool first, int ci, const bf16* prow, const float* mu_l, const float* mu_v, unsigned char* ws) {
    const int cr = ci * 8 - 448;
    float p[8], q[8], mu[8];
    up8(*(const GAS v4u*)(prow + ci * 8), p);
    if (first) {
#pragma unroll
        for (int e = 0; e < 8; ++e) q[e] = 0.f; }
    else up8(*(const GAS v4u*)(prow - NPROJ + ci * 8), q);
    const float* mup = (cr < 1792) ? mu_l + cr : mu_v + (cr - 1792);
    *(f32x4*)mu = *(const f32x4*)mup; *(f32x4*)(mu + 4) = *(const f32x4*)(mup + 4);
    float xs[8];
#pragma unroll
    for (int e = 0; e < 8; ++e) xs[e] = p[e] + (q[e] - p[e]) * mu[e];
    bf16* dst;
    if (cr < 512) dst = (bf16*)(ws + A_R) + (size_t)m * RW + cr;
    else if (cr < 1024) dst = (bf16*)(ws + A_KRAW) + (size_t)m * RW + (cr - 512);
    else if (cr < 1536) dst = (bf16*)(ws + (l == 0 ? WS_VFIRST : A_VRAW)) + (size_t)m * RW + (cr - 1024);
    else if (cr < 1600) { dst = (bf16*)(ws + A_LA) + (size_t)m * KLORA + (cr - 1536);
#pragma unroll
        for (int e = 0; e < 8; ++e) xs[e] = 1.0f - 2.0f * __builtin_amdgcn_rcpf(1.0f + __builtin_amdgcn_exp2f(2.885390081777927f * xs[e])); }
    else if (cr < 1664) dst = (bf16*)(ws + A_LA) + (size_t)m * KLORA + 64 + (cr - 1600);
    else if (cr < 1792) { dst = (bf16*)(ws + A_LA) + (size_t)m * KLORA + 128 + (cr - 1664);
#pragma unroll
        for (int e = 0; e < 8; ++e) xs[e] = fsigmoid(xs[e]); }
    else dst = (bf16*)(ws + A_LA) + (size_t)m * KLORA + 256 + (cr - 1792);
    *(GAS v4u*)dst = pk8(xs);
}
__device__ __forceinline__ void prep_phase(int l, const InT in, unsigned char* ws, int gw, int NGW, int lane) {
    const bf16* PROJ = (const bf16*)(ws + A_PROJ);
    const int* pos = (const int*)in[2]; const float* mu_l = in[14] + (size_t)l * 1792; const float* mu_v = in[15];
    float gn[8];
    { const float* gp = (lane < 32) ? in[9] + (size_t)l * 256 + lane * 8 : in[11] + (size_t)l * 128 + ((lane - 32) & 15) * 8;
#pragma unroll
      for (int e = 0; e < 8; ++e) gn[e] = gp[e]; }
    float frq[8];
#pragma unroll
    for (int e = 0; e < 8; ++e) { const int i = 8 * (lane & 3) + e; frq[e] = __builtin_amdgcn_exp2f(-(float)i * (13.287712379549449f / 32.0f)) * 0.15915494309189535f; }
    for (int m = gw; m < TOK; m += NGW) {
        const bf16* prow = PROJ + (size_t)m * NPROJ; const bool first = (m & (SEQ - 1)) == 0;
        float p[8]; up8(*(const GAS v4u*)(prow + lane * 8), p);
        float ss = 0.f;
#pragma unroll
        for (int e = 0; e < 8; ++e) ss += p[e] * p[e];
        const float sq = wave_sum(lane < 32 ? ss : 0.f), skv = wave_sum((lane >= 32 && lane < 48) ? ss : 0.f);
        float oth[8];
#pragma unroll
        for (int e = 0; e < 8; ++e) oth[e] = lane_xor<4>(p[e]);
        if (lane < 32) { const float rstd = 1.0f / sqrtf(sq * (1.0f / 256.0f) + 1e-6f); float o[8];
#pragma unroll
            for (int e = 0; e < 8; ++e) o[e] = p[e] * rstd * gn[e];
            *(GAS v4u*)((bf16*)(ws + A_CQ) + (size_t)m * 256 + lane * 8) = pk8(o); }
        else if (lane < 48) { const float rstd = 1.0f / sqrtf(skv * (1.0f / 128.0f) + 1e-6f); float o[8];
#pragma unroll
            for (int e = 0; e < 8; ++e) o[e] = p[e] * rstd * gn[e];
            *(GAS v4u*)((bf16*)(ws + A_CKV) + (size_t)m * 128 + (lane - 32) * 8) = pk8(o); }
        else if (lane < 56) { const float ps = (float)pos[m]; const bool hi = lane >= 52; float o[8];
#pragma unroll
            for (int e = 0; e < 8; ++e) { float rev = ps * frq[e]; rev -= rintf(rev); const float cs = __builtin_amdgcn_cosf(rev), sn = __builtin_amdgcn_sinf(rev);
                o[e] = hi ? (p[e] * cs + oth[e] * sn) : (p[e] * cs - oth[e] * sn); }
            const v4u w = pk8(o); const int b = m >> 12, s = m & (SEQ - 1); const int dim = 128 + (hi ? 32 : 0) + 8 * (lane & 3);
#pragma unroll
            for (int h = 0; h < 4; ++h) *(GAS v4u*)((bf16*)(ws + A_KB) + ((size_t)(b * 4 + h) * SEQ + s) * 192 + dim) = w; }
        else rw_chunk(l, m, first, lane, prow, mu_l, mu_v, ws);
#pragma unroll
        for (int j = 1; j < 4; ++j) rw_chunk(l, m, first, lane + 64 * j, prow, mu_l, mu_v, ws);
        if (lane < 24 || (l == 1 && lane < 28)) rw_chunk(l, m, first, lane + 256, prow, mu_l, mu_v, ws);
        else if (lane >= 32 && lane < 48 && (l == 0 || lane >= 36)) *(GAS v4u*)((bf16*)(ws + A_LA) + (size_t)m * KLORA + lane * 8) = (v4u){0u, 0u, 0u, 0u};
    }
}
__device__ __forceinline__ void onorm_phase(const float* g, unsigned char* ws, int gw, int NGW, int lane) {
    float gn[8];
#pragma unroll
    for (int e = 0; e < 8; ++e) gn[e] = g[lane * 8 + e];
    for (int m = gw; m < TOK; m += NGW) { GAS v4u* pp = (GAS v4u*)((bf16*)(ws + A_YCAT) + (size_t)m * DM + lane * 8); float p[8]; up8(*pp, p); float ss = 0.f;
#pragma unroll
        for (int e = 0; e < 8; ++e) ss += p[e] * p[e];
        const float rstd = 1.0f / sqrtf(wave_sum(ss) * (1.0f / 512.0f) + 1e-6f);
#pragma unroll
        for (int e = 0; e < 8; ++e) p[e] = p[e] * rstd * gn[e];
        *pp = pk8(p); }
}

__device__ __forceinline__ void route_scatter(unsigned char* ws, LAS unsigned char* lds, int vcu, int G, int wave, int lane, int tid) {
    LAS int* tot = (LAS int*)lds;
    LAS int* seg = tot + 16;
    LAS int* base = seg + 32;
    const GAS int* CNT = (const GAS int*)(ws + RT_CNT);
    if (tid < 16) { int s = 0; for (int w = 0; w < 256; ++w) s += CNT[w * 16 + tid]; tot[tid] = s; }
    __syncthreads();
    if (tid < 2) { int a = 0; for (int e = 0; e < 8; ++e) { seg[tid * 9 + e] = a; a += (tot[tid * 8 + e] + 255) & ~255; } seg[tid * 9 + 8] = a; }
    __syncthreads();
    GAS int* RIDX = (GAS int*)(ws + RT_RIDX); GAS float* RGW = (GAS float*)(ws + RT_RGW);
    if (vcu == 0 && tid < 2) { GAS int* TL = (GAS int*)(ws + RT_TILE) + tid * (PASS_TILES + 8); const int nt = seg[tid * 9 + 8] >> 8; TL[0] = nt;
        for (int e = 0; e < 8; ++e) for (int t = seg[tid * 9 + e] >> 8; t < (seg[tid * 9 + e + 1] >> 8); ++t) TL[8 + t] = e; }
    for (int pe = vcu; pe < 16; pe += G) { const int k = pe >> 3, e = pe & 7; const int s0 = seg[k * 9 + e] + tot[pe], s1 = seg[k * 9 + e + 1];
        for (int i = s0 + tid; i < s1; i += NTHR) { RIDX[k * PASS_ROWS + i] = -1; RGW[k * PASS_ROWS + i] = 0.f; } }
    for (int blk = vcu; blk < TOK / 128; blk += G) {
        __syncthreads();
        if (tid < 16) { int s = 0; for (int w = 0; w < blk; ++w) s += CNT[w * 16 + tid]; base[tid] = seg[(tid >> 3) * 9 + (tid & 7)] + s; }
        __syncthreads();
        if (wave < 2) { const int k = wave;
            int run[8];
#pragma unroll
            for (int e = 0; e < 8; ++e) run[e] = base[k * 8 + e];
            for (int r = 0; r < 2; ++r) { const int row = blk * 128 + r * 64 + lane; const int ex = *(const GAS int*)(ws + RT_SEL + (size_t)row * 8 + 4 * k); const float gwv = *(const GAS float*)(ws + RT_GW + (size_t)row * 8 + 4 * k);
                int mypos = 0;
#pragma unroll
                for (int e = 0; e < 8; ++e) { const unsigned long long mk = __ballot(ex == e); const int rank = __popcll(mk & ((1ull << lane) - 1ull)); if (ex == e) mypos = run[e] + rank; run[e] += __popcll(mk); }
                RIDX[k * PASS_ROWS + mypos] = row; RGW[k * PASS_ROWS + mypos] = gwv; } }
    }
}

namespace att {
constexpr int KVB = 64, KROW = 400, SHM_K = KVB * KROW, SHM_V = KVB * 128 * 2;
constexpr int OFF_V = 0, OFF_K = 2 * SHM_V, OFF_WS = OFF_K + 2 * SHM_K, LDS_BYTES = OFF_WS + NWAVES * 64 * 4;
static_assert(LDS_BYTES <= RING_BYTES, "attention LDS");
#define SBAR() __builtin_amdgcn_sched_barrier(0)
__device__ __forceinline__ int v_st(int k, int c) { const int kk = (k & ~0xC) | ((k & 4) << 1) | ((k & 8) >> 1); return ((kk >> 3) * 4 + (c >> 5)) * 512 + ((kk & 7) * 32 + (c & 31)) * 2; }
__device__ __forceinline__ int v_rd_base(int lane) { return ((lane & 3) << 3) | (((lane >> 2) & 3) << 6) | (((lane >> 4) & 1) << 5) | (((lane >> 5) & 1) << 8); }
constexpr int v_rd_off(int d0, int ks, int half) { return d0 * 512 + ks * 4096 + half * 2048; }
__device__ __forceinline__ int crow(int r, int hi) { return (r & 3) + 8 * (r >> 2) + 4 * hi; }
__device__ __forceinline__ unsigned cvtpk(float lo, float hi) { unsigned r; asm volatile("v_cvt_pk_bf16_f32 %0, %1, %2" : "=v"(r) : "v"(lo), "v"(hi)); return r; }
__device__ __forceinline__ void mask_tile(f32x16& p0, f32x16& p1, int dq) {
    const float NEG = -__builtin_inff();
#pragma unroll
    for (int r = 0; r < 16; ++r) { const int c = (r & 3) + 8 * (r >> 2);
        if (dq - c < 0) p0[r] = NEG;
        if (dq - c - 32 < 0) p1[r] = NEG; }
}
template <int VB>
__device__ __forceinline__ void pv_tile(f32x16* o, int vb0, bf16x8 pa0, bf16x8 pa1, bf16x8 pa2, bf16x8 pa3) {
#define TRRD(dst, off) asm volatile("ds_read_b64_tr_b16 %0, %1 offset:%2" : "=&v"(dst) : "v"(vb0), "i"(off) : "memory")
#define PV_D0(d0) do { s16x4 l0, l1, l2, l3, h0, h1, h2, h3; constexpr int b_ = VB * SHM_V + v_rd_off(d0, 0, 0); \
        TRRD(l0, b_); TRRD(h0, b_ + 2048); TRRD(l1, b_ + 4096); TRRD(h1, b_ + 6144); TRRD(l2, b_ + 8192); TRRD(h2, b_ + 10240); TRRD(l3, b_ + 12288); TRRD(h3, b_ + 14336); \
        asm volatile("s_waitcnt lgkmcnt(0)" ::: "memory"); SBAR(); \
        o[d0] = __builtin_amdgcn_mfma_f32_32x32x16_bf16(pa0, (bf16x8){l0[0], l0[1], l0[2], l0[3], h0[0], h0[1], h0[2], h0[3]}, o[d0], 0, 0, 0); \
        o[d0] = __builtin_amdgcn_mfma_f32_32x32x16_bf16(pa1, (bf16x8){l1[0], l1[1], l1[2], l1[3], h1[0], h1[1], h1[2], h1[3]}, o[d0], 0, 0, 0); \
        o[d0] = __builtin_amdgcn_mfma_f32_32x32x16_bf16(pa2, (bf16x8){l2[0], l2[1], l2[2], l2[3], h2[0], h2[1], h2[2], h2[3]}, o[d0], 0, 0, 0); \
        o[d0] = __builtin_amdgcn_mfma_f32_32x32x16_bf16(pa3, (bf16x8){l3[0], l3[1], l3[2], l3[3], h3[0], h3[1], h3[2], h3[3]}, o[d0], 0, 0, 0); } while (0)
    PV_D0(0); PV_D0(1); PV_D0(2); PV_D0(3);
#undef PV_D0
#undef TRRD
}
template <int KBUF>
__device__ __forceinline__ void qkt(f32x16& p0, f32x16& p1, LAS unsigned char* lds, int r32, int hi, const bf16x8* qr) {
    p0 = f32x16{}; p1 = f32x16{};
    const LAS unsigned char* a = lds + OFF_K + KBUF * SHM_K + r32 * KROW + hi * 16;
#pragma unroll
    for (int d0 = 0; d0 < 12; ++d0) {
        const bf16x8 b0 = *(const LAS bf16x8*)(a + d0 * 32);
        const bf16x8 b1 = *(const LAS bf16x8*)(a + 32 * KROW + d0 * 32);
        p0 = __builtin_amdgcn_mfma_f32_32x32x16_bf16(b0, qr[d0], p0, 0, 0, 0);
        p1 = __builtin_amdgcn_mfma_f32_32x32x16_bf16(b1, qr[d0], p1, 0, 0, 0); }
}
__device__ __forceinline__ void attn_unit(int b, int h, int qb, const bf16* Q, const bf16* K, const bf16* V, bf16* O, const int* pos, LAS unsigned char* lds) {
    int tid_ = threadIdx.x; asm volatile("" : "+v"(tid_));
    const int tid = tid_, wid = __builtin_amdgcn_readfirstlane(tid >> 6), lane = tid & 63, r32 = lane & 31, hi = lane >> 5;
    const int m0 = b * SEQ + qb * 256 + wid * 32;
    const int qpos = qb * 256 + wid * 32;
    bf16x8 qr[12];
    { const bf16* qp = Q + (size_t)(m0 + r32) * NQ + h * 192 + hi * 8; const float C2 = 0.07216878364870323f * 1.4426950408889634f;
      float f[12][8];
#pragma unroll
      for (int d0 = 0; d0 < 12; ++d0) up8(*(const GAS v4u*)(qp + d0 * 16), f[d0]);
      const float ps = (float)pos[m0 + r32];
#pragma unroll
      for (int g = 0; g < 2; ++g)
#pragma unroll
          for (int e = 0; e < 8; ++e) { const int i = 16 * g + 8 * hi + e; float rev = ps * (__builtin_amdgcn_exp2f(-(float)i * (13.287712379549449f / 32.0f)) * 0.15915494309189535f); rev -= rintf(rev);
              const float cs = __builtin_amdgcn_cosf(rev), sn = __builtin_amdgcn_sinf(rev); const float t1 = f[8 + g][e], t2 = f[10 + g][e];
              f[8 + g][e] = t1 * cs - t2 * sn; f[10 + g][e] = t2 * cs + t1 * sn; }
#pragma unroll
      for (int d0 = 0; d0 < 12; ++d0) { v4u w; w.x = cvtpk(f[d0][0] * C2, f[d0][1] * C2); w.y = cvtpk(f[d0][2] * C2, f[d0][3] * C2); w.z = cvtpk(f[d0][4] * C2, f[d0][5] * C2); w.w = cvtpk(f[d0][6] * C2, f[d0][7] * C2);
          qr[d0] = __builtin_bit_cast(bf16x8, w); } }
    const bf16* Kh = K + (size_t)(b * 4 + h) * SEQ * 192; const bf16* Vh = V + (size_t)(b * 4 + h) * SEQ * 128;
    const int NT = (qb + 1) * 4;
    LAS float* wsl = (LAS float*)(lds + OFF_WS) + wid * 64; LAS float* li_l = wsl; LAS float* al_l = wsl + 32;
    float m_reg = -1e30f, l_reg = 0.f; f32x16 o[4] = {};
    const int sr = tid >> 4, sc = (tid & 15) * 8, vst0 = v_st(sr, sc), vst1 = v_st(32 + sr, sc);
    const int vb0 = (int)(uintptr_t)(lds + OFF_V) + v_rd_base(lane);
    int kq[3], kl[3];
#pragma unroll
    for (int i = 0; i < 3; ++i) { const int q = tid + 512 * i; kq[i] = q * 8; kl[i] = (q / 24) * KROW + (q % 24) * 16; }
    v4u sk[3], sv[2];
#define ST_LOAD(t) do { const bf16* kp_ = Kh + (size_t)(t) * KVB * 192; const bf16* vp_ = Vh + (size_t)(t) * KVB * 128; \
        _Pragma("unroll") for (int i = 0; i < 3; ++i) sk[i] = *(const GAS v4u*)(kp_ + kq[i]); \
        sv[0] = *(const GAS v4u*)(vp_ + (size_t)sr * 128 + sc); sv[1] = *(const GAS v4u*)(vp_ + (size_t)(32 + sr) * 128 + sc); } while (0)
#define ST_WRITE(bf) do { _Pragma("unroll") for (int i = 0; i < 3; ++i) *(LAS v4u*)(lds + OFF_K + (bf) * SHM_K + kl[i]) = sk[i]; \
        *(LAS v4u*)(lds + OFF_V + (bf) * SHM_V + vst0) = sv[0]; *(LAS v4u*)(lds + OFF_V + (bf) * SHM_V + vst1) = sv[1]; } while (0)
#define TILE_STEP(t, BF) do { f32x16 p0, p1; \
        if ((t) + 1 < NT) ST_LOAD((t) + 1); \
        qkt<BF>(p0, p1, lds, r32, hi, qr); \
        { const int kb_ = (t) * KVB; if (kb_ + KVB - 1 > qpos) mask_tile(p0, p1, qpos + r32 - 4 * hi - kb_); } \
        float pmax = p0[0]; _Pragma("unroll") for (int r = 1; r < 16; ++r) pmax = fmaxf(pmax, p0[r]); _Pragma("unroll") for (int r = 0; r < 16; ++r) pmax = fmaxf(pmax, p1[r]); \
        { auto rr = __builtin_amdgcn_permlane32_swap(__float_as_uint(pmax), __float_as_uint(pmax), false, false); pmax = fmaxf(__uint_as_float(rr[0]), __uint_as_float(rr[1])); } \
        const float mn = fmaxf(m_reg, pmax), alpha = __builtin_amdgcn_exp2f(m_reg - mn); m_reg = mn; \
        float psum = 0.f; \
        _Pragma("unroll") for (int r = 0; r < 16; ++r) { p0[r] = __builtin_amdgcn_exp2f(p0[r] - mn); p1[r] = __builtin_amdgcn_exp2f(p1[r] - mn); psum += p0[r] + p1[r]; } \
        { auto rr = __builtin_amdgcn_permlane32_swap(__float_as_uint(psum), __float_as_uint(psum), false, false); psum = __uint_as_float(rr[0]) + __uint_as_float(rr[1]); } \
        l_reg = l_reg * alpha + psum; \
        bf16x8 pa0, pa1, pa2, pa3; \
        PK4(p0, 0, pa0); PK4(p0, 8, pa1); PK4(p1, 0, pa2); PK4(p1, 8, pa3); \
        if (__any(alpha < 1.f)) { if (hi == 0) al_l[r32] = alpha; asm volatile("s_waitcnt lgkmcnt(0)" ::: "memory"); \
            _Pragma("unroll") for (int d_ = 0; d_ < 4; ++d_) _Pragma("unroll") for (int r = 0; r < 16; ++r) o[d_][r] *= al_l[crow(r, hi)]; } \
        pv_tile<BF>(o, vb0, pa0, pa1, pa2, pa3); \
        if ((t) + 1 < NT) { VM_WAIT(); ST_WRITE(1 - (BF)); } \
        __syncthreads(); } while (0)
#define PK4(P, B_, OUT) do { unsigned a0 = cvtpk(P[B_+0], P[B_+1]), a1 = cvtpk(P[B_+2], P[B_+3]); \
        unsigned b0 = cvtpk(P[B_+4], P[B_+5]), b1 = cvtpk(P[B_+6], P[B_+7]); \
        auto r0 = __builtin_amdgcn_permlane32_swap(a0, b0, false, false); auto r1 = __builtin_amdgcn_permlane32_swap(a1, b1, false, false); \
        v4u w = {r0[0], r1[0], r0[1], r1[1]}; OUT = __builtin_bit_cast(bf16x8, w); } while (0)
    __syncthreads();
    ST_LOAD(0); VM_WAIT(); ST_WRITE(0);
    __syncthreads();
    for (int t = 0; t < NT; t += 2) { TILE_STEP(t, 0); TILE_STEP(t + 1, 1); }
#undef PK4
#undef TILE_STEP
#undef ST_LOAD
#undef ST_WRITE
    if (hi == 0) li_l[r32] = l_reg;
    asm volatile("s_waitcnt lgkmcnt(0)" ::: "memory");
    float rli[16];
#pragma unroll
    for (int r = 0; r < 16; ++r) rli[r] = __builtin_amdgcn_rcpf(li_l[crow(r, hi)]);
    bf16* Ow = O + (size_t)m0 * DM + h * 128;
#pragma unroll
    for (int r = 0; r < 16; ++r) { const int orow = crow(r, hi);
#pragma unroll
        for (int d0 = 0; d0 < 4; ++d0) { const float v = o[d0][r] * rli[r]; const float vn = lane_xor<1>(v);
            if ((r32 & 1) == 0) *(GAS unsigned*)(Ow + (size_t)orow * DM + d0 * 32 + r32) = cvtpk(v, vn); } }
}
}

__device__ __forceinline__ void rwkv_seq_unit(int l, int b, int hd, const InT in, unsigned char* ws, LAS unsigned char* ldsw  , int lane) {
    constexpr int CH = 8;
    LAS float* buf = (LAS float*)ldsw;
    const bf16* R = (const bf16*)(ws + A_R); const bf16* Kp = (const bf16*)(ws + A_KRAW); const bf16* KK = (const bf16*)(ws + A_KK); const bf16* BV = (const bf16*)(ws + A_BV);
    const bf16* Vv = (const bf16*)(ws + ((l == 0) ? WS_VFIRST : A_VRAW)); const bf16* Gg = (const bf16*)(ws + A_G); const float* LW = (const float*)(ws + A_LW);
    bf16* Y = (bf16*)(ws + A_YCAT);
    const int c = hd * 64 + lane;
    const float* prk = in[25]; const float* plw = in[26]; const float* plb = in[27];
    const float rkj = prk[(size_t)l * RW + c], lnw = plw[(size_t)l * RW + c], lnb = plb[(size_t)l * RW + c];
    float S[64];
#pragma unroll
    for (int j = 0; j < 64; ++j) S[j] = 0.f;
    for (int t0 = 0; t0 < SEQ; t0 += CH) {
        float vv[CH], gg[CH], bon[CH];
#pragma unroll
        for (int s = 0; s < CH; ++s) { const size_t o = (size_t)(b * SEQ + t0 + s) * RW + c;
            const float r = bf2f(R[o]), k = bf2f(Kp[o]), kk = bf2f(KK[o]), bb = bf2f(BV[o]), w = __expf(LW[o]);
            buf[(s * 5 + 0) * 64 + lane] = r; buf[(s * 5 + 1) * 64 + lane] = w; buf[(s * 5 + 2) * 64 + lane] = k; buf[(s * 5 + 3) * 64 + lane] = -kk; buf[(s * 5 + 4) * 64 + lane] = bb;
            vv[s] = bf2f(Vv[o]); gg[s] = bf2f(Gg[o]); bon[s] = wave_sum(r * k * rkj); }
        LDS_WAIT(); asm volatile("" ::: "memory");
#pragma unroll 1
        for (int s = 0; s < CH; ++s) {
            const LAS f32x4* pr = (const LAS f32x4*)(buf + (s * 5 + 0) * 64); const LAS f32x4* pw = (const LAS f32x4*)(buf + (s * 5 + 1) * 64);
            const LAS f32x4* pk = (const LAS f32x4*)(buf + (s * 5 + 2) * 64); const LAS f32x4* pa = (const LAS f32x4*)(buf + (s * 5 + 3) * 64); const LAS f32x4* pb = (const LAS f32x4*)(buf + (s * 5 + 4) * 64);
            float sa = 0.f;
#pragma unroll
            for (int j4 = 0; j4 < 16; ++j4) { const f32x4 a = pa[j4]; sa += S[4 * j4] * a.x + S[4 * j4 + 1] * a.y + S[4 * j4 + 2] * a.z + S[4 * j4 + 3] * a.w; }
            float v_s = vv[0], g_s = gg[0], bo_s = bon[0];
#pragma unroll
            for (int q = 1; q < CH; ++q) if (s == q) { v_s = vv[q]; g_s = gg[q]; bo_s = bon[q]; }
            float y = 0.f;
#pragma unroll
            for (int j4 = 0; j4 < 16; ++j4) { const f32x4 w = pw[j4], bb = pb[j4], k = pk[j4], r = pr[j4];
                S[4 * j4]     = S[4 * j4]     * w.x + sa * bb.x + v_s * k.x; y += S[4 * j4] * r.x;
                S[4 * j4 + 1] = S[4 * j4 + 1] * w.y + sa * bb.y + v_s * k.y; y += S[4 * j4 + 1] * r.y;
                S[4 * j4 + 2] = S[4 * j4 + 2] * w.z + sa * bb.z + v_s * k.z; y += S[4 * j4 + 2] * r.z;
                S[4 * j4 + 3] = S[4 * j4 + 3] * w.w + sa * bb.w + v_s * k.w; y += S[4 * j4 + 3] * r.w; }
            const float mean = wave_sum(y) * (1.0f / 64.0f); const float d = y - mean; const float var = wave_sum(d * d) * (1.0f / 64.0f);
            const float yn = d * (1.0f / sqrtf(var + 64e-5f)) * lnw + lnb;
            const float outv = (yn + bo_s * v_s) * g_s;
            Y[(size_t)(b * SEQ + t0 + s) * DM + 512 + c] = (bf16)(cvt_pk_bf16(outv, 0.f) & 0xffffu);
        }
        LDS_WAIT(); asm volatile("" ::: "memory");
    }
}

constexpr int N_PHASES = 25;
struct Args { In in; float* out; unsigned char* ws; int ph_lo, ph_hi; };
static_assert(sizeof(Args) == 38 * 8 + 8 + 8 + 8, "Args has padding");

__global__ void __launch_bounds__(NTHR, 2) mega_fwd(Args args) {
    extern __shared__ __attribute__((aligned(16))) unsigned char lds_raw[];
    LAS unsigned char* lds = (LAS unsigned char*)lds_raw;
#define OPAQUE_IDS(TID0, BX0) int tid = (TID0); asm volatile("" : "+v"(tid)); int bx = (BX0); asm volatile("" : "+s"(bx)); \
    const int lane = tid & 63, wave = __builtin_amdgcn_readfirstlane(tid >> 6); const int G = gridDim.x; \
    const int vcu = (G % 8 == 0) ? (bx % 8) * (G / 8) + bx / 8 : bx; \
    const int gw = vcu * NWAVES + wave, NGW = G * NWAVES, gtid = vcu * NTHR + tid, NGT = G * NTHR; (void)gw; (void)NGW; (void)gtid; (void)NGT; (void)lane
    OPAQUE_IDS(threadIdx.x, blockIdx.x);
    for (int u = tid; u < (LDS_BYTES - LDSCTL_OFF) / 4; u += NTHR) ((LAS unsigned*)(lds + LDSCTL_OFF))[u] = 0u;
    __syncthreads();
    if (tid < 40) { const unsigned long long v = (tid < 38) ? (unsigned long long)args.in.p[tid] : (tid == 38 ? (unsigned long long)args.ws : (unsigned long long)args.out);
        ((LAS unsigned*)(lds + PTAB_OFF))[2 * tid] = (unsigned)v; ((LAS unsigned*)(lds + PTAB_OFF))[2 * tid + 1] = (unsigned)(v >> 32); }
    __syncthreads();
    const InT in{(volatile LAS unsigned*)(lds + PTAB_OFF)};
    gu32* ctl = (gu32*)(args.ws + WS_CTL);
    XcdBarrier bar; bar.bar = (unsigned*)(ctl + CW_BAR); bar.x = 0; bar.st = nullptr;
    if (!MK_SPLIT) bar = xcd_barrier_post((unsigned*)(ctl + CW_BAR), (volatile LAS unsigned*)(lds + MISC_OFF) + 8);
    const int lo = args.ph_lo, hi = args.ph_hi;
#ifndef PH_MASK
#define PH_MASK 0xffffffffu
#endif
#define IN_PH(bit, k) (((PH_MASK >> (bit)) & 1u) && lo <= (k) && (k) < hi)
#define BAR_AFTER(k) do { if ((k) + 1 < hi) { if (!MK_SPLIT) xcd_barrier(bar); } } while (0)
#define PH_PTRS unsigned char* ws = (unsigned char*)in[38]; float* out = (float*)in[39]; const float* modl = (const float*)(ws + WS_MOD) + (size_t)l * NB * MODLD; (void)out; (void)modl

    if (IN_PH(0, 0)) { const int l = 0; PH_PTRS; p0_mod(in, ws, lds, vcu, G, wave, lane, tid); __syncthreads(); p0_weights(in, ws, lds, gw, NGW, wave, lane, gtid, NGT); BAR_AFTER(0); }

    {
        constexpr int l = 0;
        const int pb = 1 + 10 * l;
        OPAQUE_IDS(threadIdx.x, blockIdx.x);
        if (IN_PH(1, pb + 0)) { PH_PTRS; const float* xres = (l == 0) ? in[0] : out; norm_phase<false>(xres, in[5] + (size_t)l * DM, modl, 0, (bf16*)(ws + A_H), nullptr, nullptr, ws, lds, vcu, G, wave, lane, tid); BAR_AFTER(pb + 0); }
        if (IN_PH(2, pb + 1)) { PH_PTRS;
            pg8::Gemm g{(const bf16*)(ws + A_H), (const bf16*)(ws + WS_WIN) + (size_t)l * NPROJ * DM, TOK, NPROJ, DM, nullptr, nullptr, 0};
            pg8::StaticOrder S; S.init(TOK, NPROJ, G, bx);
            pg8::EpiBf16<0> E{(bf16*)(ws + A_PROJ), NPROJ, nullptr, 0, 0, 1.f};
            pg8::gemm_phase<pg8::EpiBf16<0>, pg8::StaticOrder, true, true, 0>(lds, g, S, E);
            BAR_AFTER(pb + 1); }
        if (IN_PH(3, pb + 2)) { PH_PTRS; prep_phase(l, in, ws, gw, NGW, lane); BAR_AFTER(pb + 2); }
        if (IN_PH(4, pb + 3)) { PH_PTRS;
#ifndef P4_MASK
#define P4_MASK 7
#endif
            if (P4_MASK & 1) { pg8::Gemm g{(const bf16*)(ws + A_CQ), (const bf16*)(ws + WS_WUQ) + (size_t)l * NQ * 256, TOK, NQ, 256, nullptr, nullptr, 0};
              pg8::StaticOrder S; S.init(TOK, NQ, G, (bx + G / 2) % G);
              pg8::EpiBf16<0> E{(bf16*)(ws + A_Q), NQ, nullptr, 0, 0, 1.f};
              pg8::gemm_phase<pg8::EpiBf16<0>, pg8::StaticOrder, true, true, 0>(lds, g, S, E); }
            __syncthreads();
            if (P4_MASK & 2) { pg8::Gemm g{(const bf16*)(ws + A_CKV), (const bf16*)(ws + WS_WUKV) + (size_t)l * NKV * 128, TOK, NKV, 128, nullptr, nullptr, 0};
              pg8::StaticOrder S; S.init(TOK, NKV, G, bx);
              pg8::EpiKV E{(bf16*)(ws + A_KB), (bf16*)(ws + A_VB)};
              pg8::gemm_phase<pg8::EpiKV, pg8::StaticOrder, true, true, 0>(lds, g, S, E); }
            __syncthreads();
            if (P4_MASK & 4) { const int nl = (l == 0) ? 1536 : NLORA;
              pg8::Gemm g{(const bf16*)(ws + A_LA), (const bf16*)(ws + WS_WLORA) + (size_t)l * NLORA * KLORA, TOK, nl, KLORA, nullptr, nullptr, 0};
              pg8::StaticOrder S; S.init(TOK, nl, G, bx);
              pg8::EpiLora E{in[16] + (size_t)l * RW, in[18] + (size_t)l * RW, in[21], in[23] + (size_t)l * RW, in[24] + (size_t)l * RW,
                             (float*)(ws + A_LW), (bf16*)(ws + A_KRAW), (bf16*)(ws + A_KK), (bf16*)(ws + A_BV), (bf16*)(ws + A_G), (bf16*)(ws + A_VRAW), (const bf16*)(ws + WS_VFIRST)};
              pg8::gemm_phase<pg8::EpiLora, pg8::StaticOrder, true, true, 0>(lds, g, S, E); }
            BAR_AFTER(pb + 3); }
        if (IN_PH(5, pb + 4)) { PH_PTRS;
            if (vcu < 16) { if (wave < 4) { const int unit = vcu * 4 + wave; rwkv_seq_unit(l, unit >> 3, unit & 7, in, ws, lds + wave * 10240, lane); } __syncthreads(); }
            volatile LAS unsigned* qslot = (volatile LAS unsigned*)(lds + MISC_OFF) + 16;
            for (;;) {
                __syncthreads();
                if (tid == 0) qslot[0] = __hip_atomic_fetch_add(ctl + CW_QCTR + 64 * l, 1u, RLX_AGENT);
                __syncthreads();
                const int u = (int)qslot[0];
                if (u >= 512) break;
                const int qb = 15 - (u >> 5), bh = u & 31;
                att::attn_unit(bh >> 2, bh & 3, qb, (const bf16*)(ws + A_Q), (const bf16*)(ws + A_KB), (const bf16*)(ws + A_VB), (bf16*)(ws + A_YCAT), (const int*)in[2], lds);
            }
            BAR_AFTER(pb + 4); }
        if (IN_PH(6, pb + 5)) { PH_PTRS; onorm_phase(in[13] + (size_t)l * 512, ws, gw, NGW, lane); if (l == 1) p_expert_weights(in, ws, lds, gw, NGW, wave, lane); BAR_AFTER(pb + 5); }
        if (IN_PH(7, pb + 6)) { PH_PTRS; const float* xres = (l == 0) ? in[0] : out;
            pg8::Gemm g{(const bf16*)(ws + A_YCAT), (const bf16*)(ws + WS_WOUT) + (size_t)l * DM * DM, TOK, DM, DM, nullptr, nullptr, 0};
            pg8::StaticOrder S; S.init(TOK, DM, G, bx);
            pg8::EpiResid E{xres, out, modl + 2048};
            pg8::gemm_phase<pg8::EpiResid, pg8::StaticOrder, true, true, 0>(lds, g, S, E);
            BAR_AFTER(pb + 6); }
        if (IN_PH(8, pb + 7)) { PH_PTRS;
            if (l == 0) norm_phase<false>(out, in[6] + (size_t)l * DM, modl, 3072, (bf16*)(ws + A_H), nullptr, nullptr, ws, lds, vcu, G, wave, lane, tid);
            else norm_phase<true>(out, in[6] + (size_t)l * DM, modl, 3072, (bf16*)(ws + A_H), in[32], in[33], ws, lds, vcu, G, wave, lane, tid);
            BAR_AFTER(pb + 7); }
        if (l == 0) {
            if (IN_PH(9, 9)) { PH_PTRS;
                pg8::Gemm g{(const bf16*)(ws + A_H), (const bf16*)(ws + WS_WF1), TOK, 2 * FFD, DM, nullptr, nullptr, 0};
                pg8::StaticOrder S; S.init(TOK, 2 * FFD, G, bx);
                pg8::EpiSwiGLU E{(bf16*)(ws + A_HID), FFD};
                pg8::gemm_phase<pg8::EpiSwiGLU, pg8::StaticOrder, true, true, 0>(lds, g, S, E);
                BAR_AFTER(9); }
            if (IN_PH(10, 10)) { PH_PTRS;
                pg8::Gemm g{(const bf16*)(ws + A_HID), (const bf16*)(ws + WS_WF2), TOK, DM, FFD, nullptr, nullptr, 0};
                pg8::StaticOrder S; S.init(TOK, DM, G, bx);
                pg8::EpiResid E{out, out, modl + 5120};
                pg8::gemm_phase<pg8::EpiResid, pg8::StaticOrder, true, true, 0>(lds, g, S, E);
                BAR_AFTER(10); }
        } else {
            if (IN_PH(11, 19)) { PH_PTRS; route_scatter(ws, lds, vcu, G, wave, lane, tid); BAR_AFTER(19); }
#pragma unroll
            for (int k = 0; k < 2; ++k) {
                if (IN_PH(12, 20 + 2 * k)) { PH_PTRS; const int* TL = (const int*)(ws + RT_TILE) + k * (PASS_TILES + 8); const int* ridx = (const int*)(ws + RT_RIDX) + (size_t)k * PASS_ROWS;
                    const int nt = __builtin_amdgcn_readfirstlane(TL[0]);
                    pg8::Gemm g{(const bf16*)(ws + A_H), (const bf16*)(ws + A_WE1), nt * 256, 2 * FFE, DM, ridx, TL + 8, (size_t)2 * FFE * DM * 2};
                    pg8::StaticOrder S; S.init(nt * 256, 2 * FFE, G, bx);
                    pg8::EpiSwiGLU E{(bf16*)(ws + A_HID), FFE};
                    pg8::gemm_phase<pg8::EpiSwiGLU, pg8::StaticOrder, true, true, 1>(lds, g, S, E);
                    BAR_AFTER(20 + 2 * k); }
                if (IN_PH(13, 21 + 2 * k)) { PH_PTRS; const int* TL = (const int*)(ws + RT_TILE) + k * (PASS_TILES + 8); const int* ridx = (const int*)(ws + RT_RIDX) + (size_t)k * PASS_ROWS; const float* rgw = (const float*)(ws + RT_RGW) + (size_t)k * PASS_ROWS;
                    const int nt = __builtin_amdgcn_readfirstlane(TL[0]);
                    pg8::Gemm g{(const bf16*)(ws + A_HID), (const bf16*)(ws + A_WE2), nt * 256, DM, FFE, nullptr, TL + 8, (size_t)DM * FFE * 2};
                    pg8::StaticOrder S; S.init(nt * 256, DM, G, bx);
                    pg8::EpiMoE2 E{out, modl + 5120, ridx, rgw};
                    pg8::gemm_phase<pg8::EpiMoE2, pg8::StaticOrder, true, true, 2>(lds, g, S, E);
                    BAR_AFTER(21 + 2 * k); }
            }
        }
    }
    {
        constexpr int l = 1;
        const int pb = 1 + 10 * l;
        OPAQUE_IDS(threadIdx.x, blockIdx.x);
        if (IN_PH(1, pb + 0)) { PH_PTRS; const float* xres = (l == 0) ? in[0] : out; norm_phase<false>(xres, in[5] + (size_t)l * DM, modl, 0, (bf16*)(ws + A_H), nullptr, nullptr, ws, lds, vcu, G, wave, lane, tid); BAR_AFTER(pb + 0); }
        if (IN_PH(2, pb + 1)) { PH_PTRS;
            pg8::Gemm g{(const bf16*)(ws + A_H), (const bf16*)(ws + WS_WIN) + (size_t)l * NPROJ * DM, TOK, NPROJ, DM, nullptr, nullptr, 0};
            pg8::StaticOrder S; S.init(TOK, NPROJ, G, bx);
            pg8::EpiBf16<0> E{(bf16*)(ws + A_PROJ), NPROJ, nullptr, 0, 0, 1.f};
            pg8::gemm_phase<pg8::EpiBf16<0>, pg8::StaticOrder, true, true, 0>(lds, g, S, E);
            BAR_AFTER(pb + 1); }
        if (IN_PH(3, pb + 2)) { PH_PTRS; prep_phase(l, in, ws, gw, NGW, lane); BAR_AFTER(pb + 2); }
        if (IN_PH(4, pb + 3)) { PH_PTRS;
#ifndef P4_MASK
#define P4_MASK 7
#endif
            if (P4_MASK & 1) { pg8::Gemm g{(const bf16*)(ws + A_CQ), (const bf16*)(ws + WS_WUQ) + (size_t)l * NQ * 256, TOK, NQ, 256, nullptr, nullptr, 0};
              pg8::StaticOrder S; S.init(TOK, NQ, G, (bx + G / 2) % G);
              pg8::EpiBf16<0> E{(bf16*)(ws + A_Q), NQ, nullptr, 0, 0, 1.f};
              pg8::gemm_phase<pg8::EpiBf16<0>, pg8::StaticOrder, true, true, 0>(lds, g, S, E); }
            __syncthreads();
            if (P4_MASK & 2) { pg8::Gemm g{(const bf16*)(ws + A_CKV), (const bf16*)(ws + WS_WUKV) + (size_t)l * NKV * 128, TOK, NKV, 128, nullptr, nullptr, 0};
              pg8::StaticOrder S; S.init(TOK, NKV, G, bx);
              pg8::EpiKV E{(bf16*)(ws + A_KB), (bf16*)(ws + A_VB)};
              pg8::gemm_phase<pg8::EpiKV, pg8::StaticOrder, true, true, 0>(lds, g, S, E); }
            __syncthreads();
            if (P4_MASK & 4) { const int nl = (l == 0) ? 1536 : NLORA;
              pg8::Gemm g{(const bf16*)(ws + A_LA), (const bf16*)(ws + WS_WLORA) + (size_t)l * NLORA * KLORA, TOK, nl, KLORA, nullptr, nullptr, 0};
              pg8::StaticOrder S; S.init(TOK, nl, G, bx);
              pg8::EpiLora E{in[16] + (size_t)l * RW, in[18] + (size_t)l * RW, in[21], in[23] + (size_t)l * RW, in[24] + (size_t)l * RW,
                             (float*)(ws + A_LW), (bf16*)(ws + A_KRAW), (bf16*)(ws + A_KK), (bf16*)(ws + A_BV), (bf16*)(ws + A_G), (bf16*)(ws + A_VRAW), (const bf16*)(ws + WS_VFIRST)};
              pg8::gemm_phase<pg8::EpiLora, pg8::StaticOrder, true, true, 0>(lds, g, S, E); }
            BAR_AFTER(pb + 3); }
        if (IN_PH(5, pb + 4)) { PH_PTRS;
            if (vcu < 16) { if (wave < 4) { const int unit = vcu * 4 + wave; rwkv_seq_unit(l, unit >> 3, unit & 7, in, ws, lds + wave * 10240, lane); } __syncthreads(); }
            volatile LAS unsigned* qslot = (volatile LAS unsigned*)(lds + MISC_OFF) + 16;
            for (;;) {
                __syncthreads();
                if (tid == 0) qslot[0] = __hip_atomic_fetch_add(ctl + CW_QCTR + 64 * l, 1u, RLX_AGENT);
                __syncthreads();
                const int u = (int)qslot[0];
                if (u >= 512) break;
                const int qb = 15 - (u >> 5), bh = u & 31;
                att::attn_unit(bh >> 2, bh & 3, qb, (const bf16*)(ws + A_Q), (const bf16*)(ws + A_KB), (const bf16*)(ws + A_VB), (bf16*)(ws + A_YCAT), (const int*)in[2], lds);
            }
            BAR_AFTER(pb + 4); }
        if (IN_PH(6, pb + 5)) { PH_PTRS; onorm_phase(in[13] + (size_t)l * 512, ws, gw, NGW, lane); if (l == 1) p_expert_weights(in, ws, lds, gw, NGW, wave, lane); BAR_AFTER(pb + 5); }
        if (IN_PH(7, pb + 6)) { PH_PTRS; const float* xres = (l == 0) ? in[0] : out;
            pg8::Gemm g{(const bf16*)(ws + A_YCAT), (const bf16*)(ws + WS_WOUT) + (size_t)l * DM * DM, TOK, DM, DM, nullptr, nullptr, 0};
            pg8::StaticOrder S; S.init(TOK, DM, G, bx);
            pg8::EpiResid E{xres, out, modl + 2048};
            pg8::gemm_phase<pg8::EpiResid, pg8::StaticOrder, true, true, 0>(lds, g, S, E);
            BAR_AFTER(pb + 6); }
        if (IN_PH(8, pb + 7)) { PH_PTRS;
            if (l == 0) norm_phase<false>(out, in[6] + (size_t)l * DM, modl, 3072, (bf16*)(ws + A_H), nullptr, nullptr, ws, lds, vcu, G, wave, lane, tid);
            else norm_phase<true>(out, in[6] + (size_t)l * DM, modl, 3072, (bf16*)(ws + A_H), in[32], in[33], ws, lds, vcu, G, wave, lane, tid);
            BAR_AFTER(pb + 7); }
        if (l == 0) {
            if (IN_PH(9, 9)) { PH_PTRS;
                pg8::Gemm g{(const bf16*)(ws + A_H), (const bf16*)(ws + WS_WF1), TOK, 2 * FFD, DM, nullptr, nullptr, 0};
                pg8::StaticOrder S; S.init(TOK, 2 * FFD, G, bx);
                pg8::EpiSwiGLU E{(bf16*)(ws + A_HID), FFD};
                pg8::gemm_phase<pg8::EpiSwiGLU, pg8::StaticOrder, true, true, 0>(lds, g, S, E);
                BAR_AFTER(9); }
            if (IN_PH(10, 10)) { PH_PTRS;
                pg8::Gemm g{(const bf16*)(ws + A_HID), (const bf16*)(ws + WS_WF2), TOK, DM, FFD, nullptr, nullptr, 0};
                pg8::StaticOrder S; S.init(TOK, DM, G, bx);
                pg8::EpiResid E{out, out, modl + 5120};
                pg8::gemm_phase<pg8::EpiResid, pg8::StaticOrder, true, true, 0>(lds, g, S, E);
                BAR_AFTER(10); }
        } else {
            if (IN_PH(11, 19)) { PH_PTRS; route_scatter(ws, lds, vcu, G, wave, lane, tid); BAR_AFTER(19); }
#pragma unroll
            for (int k = 0; k < 2; ++k) {
                if (IN_PH(12, 20 + 2 * k)) { PH_PTRS; const int* TL = (const int*)(ws + RT_TILE) + k * (PASS_TILES + 8); const int* ridx = (const int*)(ws + RT_RIDX) + (size_t)k * PASS_ROWS;
                    const int nt = __builtin_amdgcn_readfirstlane(TL[0]);
                    pg8::Gemm g{(const bf16*)(ws + A_H), (const bf16*)(ws + A_WE1), nt * 256, 2 * FFE, DM, ridx, TL + 8, (size_t)2 * FFE * DM * 2};
                    pg8::StaticOrder S; S.init(nt * 256, 2 * FFE, G, bx);
                    pg8::EpiSwiGLU E{(bf16*)(ws + A_HID), FFE};
                    pg8::gemm_phase<pg8::EpiSwiGLU, pg8::StaticOrder, true, true, 1>(lds, g, S, E);
                    BAR_AFTER(20 + 2 * k); }
                if (IN_PH(13, 21 + 2 * k)) { PH_PTRS; const int* TL = (const int*)(ws + RT_TILE) + k * (PASS_TILES + 8); const int* ridx = (const int*)(ws + RT_RIDX) + (size_t)k * PASS_ROWS; const float* rgw = (const float*)(ws + RT_RGW) + (size_t)k * PASS_ROWS;
                    const int nt = __builtin_amdgcn_readfirstlane(TL[0]);
                    pg8::Gemm g{(const bf16*)(ws + A_HID), (const bf16*)(ws + A_WE2), nt * 256, DM, FFE, nullptr, TL + 8, (size_t)DM * FFE * 2};
                    pg8::StaticOrder S; S.init(nt * 256, DM, G, bx);
                    pg8::EpiMoE2 E{out, modl + 5120, ridx, rgw};
                    pg8::gemm_phase<pg8::EpiMoE2, pg8::StaticOrder, true, true, 2>(lds, g, S, E);
                    BAR_AFTER(21 + 2 * k); }
            }
        }
    }
    if (IN_PH(14, 24)) { const int l = 1; PH_PTRS; OPAQUE_IDS(threadIdx.x, blockIdx.x); final_norm(out, in[37], gw, NGW, lane); }
#undef IN_PH
#undef BAR_AFTER
}

extern "C" void kernel_launch(void* const* d_in, const int* in_sizes, int n_in, void* d_out, int out_size, void* d_ws, size_t ws_size, hipStream_t stream) {
    static int grid = 0;
    if (grid == 0) {
        if (n_in != 38 || in_sizes[0] != TOK * DM || out_size != TOK * DM || ws_size < WS_END) {
            fprintf(stderr, "kernel_launch: unexpected problem (n_in %d, in0 %d, out %d, ws %zu, need %zu); nothing launched\n", n_in, n_in > 0 ? in_sizes[0] : -1, out_size, ws_size, (size_t)WS_END); grid = -1; return; }
        int dev = 0, cus = 0, per_cu = 0;
        if (hipGetDevice(&dev) != hipSuccess || hipDeviceGetAttribute(&cus, hipDeviceAttributeMultiprocessorCount, dev) != hipSuccess) { grid = -1; return; }
        if (hipFuncSetAttribute((const void*)mega_fwd, hipFuncAttributeMaxDynamicSharedMemorySize, LDS_BYTES) != hipSuccess) { fprintf(stderr, "kernel_launch: hipFuncSetAttribute failed\n"); grid = -1; return; }
        if (hipOccupancyMaxActiveBlocksPerMultiprocessor(&per_cu, (const void*)mega_fwd, NTHR, LDS_BYTES) != hipSuccess || per_cu < 1) { fprintf(stderr, "kernel_launch: occupancy query says %d\n", per_cu); }
        (void)hipGetLastError();
        grid = cus;
    }
    if (grid < 0) return;
    (void)hipMemsetAsync((char*)d_ws + WS_CTL, 0, CTL_ZERO_BYTES, stream);
    Args a{};
    for (int i = 0; i < 38; ++i) a.in.p[i] = (const float*)d_in[i];
    a.out = (float*)d_out; a.ws = (unsigned char*)d_ws;
#if MK_SPLIT
    for (int p = 0; p < N_PHASES; ++p) { a.ph_lo = p; a.ph_hi = p + 1; hipLaunchKernelGGL(mega_fwd, dim3(grid), dim3(NTHR), LDS_BYTES, stream, a); }
#else
    a.ph_lo = 0; a.ph_hi = N_PHASES;
    hipLaunchKernelGGL(mega_fwd, dim3(grid), dim3(NTHR), LDS_BYTES, stream, a);
#endif
    const hipError_t le = hipPeekAtLastError();
    if (le != hipSuccess) fprintf(stderr, "kernel_launch: launch failed: %s\n", hipGetErrorName(le));
}
```

```cpp
#include <hip/hip_runtime.h>
#include <cstdio>
#include <cstdint>
namespace pg8 {
#define PG8_LAS __attribute__((address_space(3)))
typedef unsigned short bf16_t;
typedef short bf16x8 __attribute__((ext_vector_type(8)));
typedef float f32x4 __attribute__((ext_vector_type(4)));
typedef unsigned u32x4 __attribute__((ext_vector_type(4)));
constexpr int BM = 256, BK = 64, HALF = 128, HTB = HALF * BK * 2  , STAGE_BYTES = 8 * HTB, NXCD = 8, WGM = 8;

__host__ __device__ __forceinline__ int lds_byte(int r, int c) { const int st = (r >> 4) * 2 + (c >> 5), rr = r & 15, cc = c & 31, ob = rr * 64 + cc * 2; return st * 1024 + (ob ^ (((ob >> 9) & 1) << 5)); }
__host__ __device__ __forceinline__ void stage_rc(int b, int& R, int& C) { const int st = b / 1024, sb = b % 1024, swz = sb ^ (((sb >> 9) & 1) << 5); R = (st >> 1) * 16 + swz / 64; C = (st & 1) * 32 + (swz % 64) / 2; }
__host__ __device__ __forceinline__ int perm32(int rho) { const int n = rho >> 4, i = rho & 15; return 8 * (i >> 2) + 4 * n + (i & 3); }

struct Unit { int pm, pn; };
struct Gemm { const bf16_t* A; const bf16_t* Bt; int M, N, K; const int* ridx; const int* tile_e; size_t e_stride; };

struct StaticOrder {
    int nM, nN, nwg, G, c;
    __host__ __device__ void init(int M, int N, int G_, int c_) { nM = M / BM; nN = N / BM; nwg = nM * nN; G = G_; c = c_; }
    __host__ __device__ bool next(int i, Unit& u) const {
        const long L = (long)i * G + c; if (L >= nwg) return false;
        int wgid = (int)L; { const int q = nwg / NXCD, r = nwg % NXCD, xcd = wgid % NXCD, off = wgid / NXCD; wgid = (xcd < r ? xcd * (q + 1) : r * (q + 1) + (xcd - r) * q) + off; }
        const int nig = WGM * nN, gid = wgid / nig, fm = gid * WGM, gsz = (nM - fm) < WGM ? (nM - fm) : WGM;
        u.pm = fm + ((wgid % nig) % gsz); u.pn = (wgid % nig) / gsz; return true;
    }
    __device__ __forceinline__ void a_ready(const Unit&) const {}
    __device__ __forceinline__ void done(const Unit&) const {}
};

__device__ __forceinline__ unsigned cvt_pk_bf16(float lo, float hi) { unsigned r; asm volatile("v_cvt_pk_bf16_f32 %0, %1, %2" : "=v"(r) : "v"(lo), "v"(hi)); return r; }
typedef float f32x2 __attribute__((ext_vector_type(2)));
__device__ __forceinline__ f32x2 gelu_pk(f32x2 v) {
    const f32x2 av = __builtin_elementwise_abs(v), d = av * 0.2316418882f + 1.0f;
    f32x2 t; t.x = __builtin_amdgcn_rcpf(d.x); t.y = __builtin_amdgcn_rcpf(d.y);
    f32x2 q = t * 0.5307027145f + (-0.7265760135f); q = q * t + 0.7107068705f; q = q * t + (-0.142248368f); q = q * t + 0.127414796f; q = q * t;
    const f32x2 s = (v * v) * (-0.72134752044f);
    f32x2 e; e.x = __builtin_amdgcn_exp2f(s.x); e.y = __builtin_amdgcn_exp2f(s.y);
    const f32x2 m = v * (q * e), r = v - m;
    f32x2 o; o.x = v.x < 0.f ? m.x : r.x; o.y = v.y < 0.f ? m.y : r.y; return o;
}

template <int ACT  > struct EpiBf16 {
    static constexpr bool PERM = true, AFTER_DRAIN = false; static_assert(ACT == 0 || ACT == 1, "EpiBf16: ACT is 0 (none) or 1 (gelu_pk)");
    bf16_t* O; int ldc; const float* bias; int split_cols; size_t split_stride; float scale0;
    __device__ __forceinline__ void operator()(const f32x4 (&acc)[2][2][4][2], const Unit& u, int wr, int wc, int fr, int fq) const {
        const int row0 = u.pm * BM + wr * 64 + fr; int colt = u.pn * BM; bf16_t* base = O;
        float sc = 1.f; if (split_cols) { const int t = colt / split_cols; base += (size_t)t * split_stride; colt -= t * split_cols; if (t == 0) sc = scale0; }
        const int col0 = colt + wc * 32 + 8 * fq, bcol0 = u.pn * BM + wc * 32 + 8 * fq;
        f32x4 bv[2][2];
#pragma unroll
        for (int bj = 0; bj < 2; ++bj)
#pragma unroll
            for (int n = 0; n < 2; ++n) bv[bj][n] = bias ? *(const f32x4*)(bias + bcol0 + bj * HALF + 4 * n) : (f32x4){0.f, 0.f, 0.f, 0.f};
#pragma unroll
        for (int ai = 0; ai < 2; ++ai)
#pragma unroll
            for (int m = 0; m < 4; ++m) { bf16_t* rowp = base + (size_t)(row0 + ai * HALF + m * 16) * ldc + col0;
#pragma unroll
                for (int bj = 0; bj < 2; ++bj) { f32x4 v0 = acc[ai][bj][m][0] + bv[bj][0], v1 = acc[ai][bj][m][1] + bv[bj][1];
                    if (ACT == 1) { f32x2 a = gelu_pk((f32x2){v0[0], v0[1]}), b = gelu_pk((f32x2){v0[2], v0[3]}), c = gelu_pk((f32x2){v1[0], v1[1]}), d = gelu_pk((f32x2){v1[2], v1[3]});
                        v0 = (f32x4){a.x, a.y, b.x, b.y}; v1 = (f32x4){c.x, c.y, d.x, d.y}; }
                    v0 = v0 * sc; v1 = v1 * sc; u32x4 w; w.x = cvt_pk_bf16(v0[0], v0[1]); w.y = cvt_pk_bf16(v0[2], v0[3]); w.z = cvt_pk_bf16(v1[0], v1[1]); w.w = cvt_pk_bf16(v1[2], v1[3]);
                    *(u32x4*)(rowp + bj * HALF) = w; } }
    }
};

__device__ __forceinline__ float bf2f(unsigned short v) { return __uint_as_float(((unsigned)v) << 16); }
__device__ __forceinline__ float bflo(unsigned w) { return __uint_as_float(w << 16); }
__device__ __forceinline__ float bfhi(unsigned w) { return __uint_as_float(w & 0xffff0000u); }
__device__ __forceinline__ float fsigmoid(float x) { return __builtin_amdgcn_rcpf(1.0f + __builtin_amdgcn_exp2f(-1.4426950408889634f * x)); }
__device__ __forceinline__ u32x4 pack8f(const f32x4 a, const f32x4 b) { u32x4 w; w.x = cvt_pk_bf16(a[0], a[1]); w.y = cvt_pk_bf16(a[2], a[3]); w.z = cvt_pk_bf16(b[0], b[1]); w.w = cvt_pk_bf16(b[2], b[3]); return w; }
__device__ __forceinline__ void unpack8(const u32x4 w, f32x4& a, f32x4& b) { a = (f32x4){bflo(w.x), bfhi(w.x), bflo(w.y), bfhi(w.y)}; b = (f32x4){bflo(w.z), bfhi(w.z), bflo(w.w), bfhi(w.w)}; }

struct EpiKV { static constexpr bool PERM = true, AFTER_DRAIN = false;
    bf16_t* Kb; bf16_t* Vb;
    __device__ __forceinline__ void operator()(const f32x4 (&acc)[2][2][4][2], const Unit& u, int wr, int wc, int fr, int fq) const {
        const int row0 = u.pm * BM + wr * 64 + fr, h = u.pn, col = wc * 32 + 8 * fq;
#pragma unroll
        for (int ai = 0; ai < 2; ++ai)
#pragma unroll
            for (int m = 0; m < 4; ++m) { const int row = row0 + ai * HALF + m * 16; const int b = row >> 12, s = row & 4095;
                const size_t tok = (size_t)(b * 4 + h) * 4096 + s;
                *(u32x4*)(Kb + tok * 192 + col) = pack8f(acc[ai][0][m][0], acc[ai][0][m][1]);
                *(u32x4*)(Vb + tok * 128 + col) = pack8f(acc[ai][1][m][0], acc[ai][1][m][1]); }
    }
};

struct EpiResid { static constexpr bool PERM = false, AFTER_DRAIN = false;
    const float* base; float* out; const float* gate;
    __device__ __forceinline__ void operator()(const f32x4 (&acc)[2][2][4][2], const Unit& u, int wr, int wc, int fr, int fq) const {
        const int row0 = u.pm * BM + wr * 64 + fr, col0 = u.pn * BM + wc * 32 + 4 * fq, b = (u.pm * BM) >> 12;
        f32x4 gv[2][2];
#pragma unroll
        for (int bj = 0; bj < 2; ++bj)
#pragma unroll
            for (int n = 0; n < 2; ++n) gv[bj][n] = *(const f32x4*)(gate + b * 6144 + col0 + bj * HALF + n * 16);
#pragma unroll
        for (int ai = 0; ai < 2; ++ai)
#pragma unroll
            for (int m = 0; m < 4; ++m) { const size_t off = (size_t)(row0 + ai * HALF + m * 16) * 1024 + col0;
#pragma unroll
                for (int bj = 0; bj < 2; ++bj)
#pragma unroll
                    for (int n = 0; n < 2; ++n) { const f32x4 bs = *(const f32x4*)(base + off + bj * HALF + n * 16); *(f32x4*)(out + off + bj * HALF + n * 16) = bs + gv[bj][n] * acc[ai][bj][m][n]; } }
    }
};

struct EpiSwiGLU { static constexpr bool PERM = true, AFTER_DRAIN = false;
    bf16_t* Hd; int ldh;
    __device__ __forceinline__ void operator()(const f32x4 (&acc)[2][2][4][2], const Unit& u, int wr, int wc, int fr, int fq) const {
        const int row0 = u.pm * BM + wr * 64 + fr, col = u.pn * HALF + wc * 32 + 8 * fq;
#pragma unroll
        for (int ai = 0; ai < 2; ++ai)
#pragma unroll
            for (int m = 0; m < 4; ++m) { f32x4 r[2];
#pragma unroll
                for (int n = 0; n < 2; ++n) { const f32x4 g = acc[ai][0][m][n], up = acc[ai][1][m][n];
#pragma unroll
                    for (int e = 0; e < 4; ++e) r[n][e] = g[e] * fsigmoid(g[e]) * up[e]; }
                *(u32x4*)(Hd + (size_t)(row0 + ai * HALF + m * 16) * ldh + col) = pack8f(r[0], r[1]); }
    }
};

struct EpiMoE2 { static constexpr bool PERM = false, AFTER_DRAIN = false;
    float* out; const float* gate; const int* ridx; const float* rgw;
    __device__ __forceinline__ void operator()(const f32x4 (&acc)[2][2][4][2], const Unit& u, int wr, int wc, int fr, int fq) const {
        const int row0 = u.pm * BM + wr * 64 + fr, col0 = u.pn * BM + wc * 32 + 4 * fq;
#pragma unroll
        for (int ai = 0; ai < 2; ++ai)
#pragma unroll
            for (int m = 0; m < 4; ++m) { const int srow = row0 + ai * HALF + m * 16; const int tok = ridx[srow];
                if (tok >= 0) { const float gw = rgw[srow]; const float* gp = gate + (tok >> 12) * 6144 + col0; float* op = out + (size_t)tok * 1024 + col0;
#pragma unroll
                    for (int bj = 0; bj < 2; ++bj)
#pragma unroll
                        for (int n = 0; n < 2; ++n) { const f32x4 gv = *(const f32x4*)(gp + bj * HALF + n * 16); const f32x4 bs = *(const f32x4*)(op + bj * HALF + n * 16);
                            *(f32x4*)(op + bj * HALF + n * 16) = bs + (gv * gw) * acc[ai][bj][m][n]; } } }
    }
};

struct EpiLora { static constexpr bool PERM = true, AFTER_DRAIN = false;
    const float *w0, *a0, *v0, *k_k, *k_a;
    float* LW; bf16_t* Kraw; bf16_t* KK; bf16_t* BV; bf16_t* G; bf16_t* Vraw; const bf16_t* VF; const bf16_t* Rr; const float* r_k; float* BON;
    __device__ __forceinline__ void operator()(const f32x4 (&acc)[2][2][4][2], const Unit& u, int wr, int wc, int fr, int fq) const {
        const int row0 = u.pm * BM + wr * 64 + fr, seg = u.pn >> 1, cb = 256 * (u.pn & 1) + 64 * wc + 8 * fq;
        if (seg == 0) {
            f32x4 p[2][2];
#pragma unroll
            for (int bj = 0; bj < 2; ++bj) { p[bj][0] = *(const f32x4*)(w0 + cb + 32 * bj); p[bj][1] = *(const f32x4*)(w0 + cb + 32 * bj + 4); }
#pragma unroll
            for (int ai = 0; ai < 2; ++ai)
#pragma unroll
                for (int m = 0; m < 4; ++m) { float* rp = LW + (size_t)(row0 + ai * HALF + m * 16) * 512 + cb;
#pragma unroll
                    for (int bj = 0; bj < 2; ++bj)
#pragma unroll
                        for (int n = 0; n < 2; ++n) { f32x4 o;
#pragma unroll
                            for (int e = 0; e < 4; ++e) o[e] = -0.6065306597126334f * fsigmoid(p[bj][n][e] + acc[ai][bj][m][n][e]);
                            *(f32x4*)(rp + 32 * bj + 4 * n) = o; } }
        } else if (seg == 1) {
#pragma unroll
            for (int ai = 0; ai < 2; ++ai)
#pragma unroll
                for (int m = 0; m < 4; ++m) { const size_t ro = (size_t)(row0 + ai * HALF + m * 16) * 512 + cb;
                    float ss = 0.f;
#pragma unroll
                    for (int bj = 0; bj < 2; ++bj) { f32x4 kv[2]; unpack8(*(const u32x4*)(Kraw + ro + 32 * bj), kv[0], kv[1]);
#pragma unroll
                        for (int n = 0; n < 2; ++n) { const f32x4 pk = *(const f32x4*)(k_k + cb + 32 * bj + 4 * n); const f32x4 t = kv[n] * pk; ss += (t[0] * t[0] + t[1] * t[1]) + (t[2] * t[2] + t[3] * t[3]); } }
                    ss += __uint_as_float((unsigned)__builtin_amdgcn_ds_swizzle((int)__float_as_uint(ss), 0x1f | (16 << 10)));
                    { const auto rr = __builtin_amdgcn_permlane32_swap(__float_as_uint(ss), __float_as_uint(ss), false, false); ss = __uint_as_float(rr[0]) + __uint_as_float(rr[1]); }
                    const float inv = 1.0f / fmaxf(sqrtf(ss), 1e-12f);
                    asm volatile("" ::: "memory");
                    float bsum = 0.f;
#pragma unroll
                    for (int bj = 0; bj < 2; ++bj) { f32x4 kv[2], rv[2], k2[2], kk2[2], b2[2]; unpack8(*(const u32x4*)(Kraw + ro + 32 * bj), kv[0], kv[1]); unpack8(*(const u32x4*)(Rr + ro + 32 * bj), rv[0], rv[1]);
#pragma unroll
                        for (int n = 0; n < 2; ++n) { const f32x4 pa = *(const f32x4*)(a0 + cb + 32 * bj + 4 * n), pk = *(const f32x4*)(k_k + cb + 32 * bj + 4 * n), pq = *(const f32x4*)(k_a + cb + 32 * bj + 4 * n), pr = *(const f32x4*)(r_k + cb + 32 * bj + 4 * n);
#pragma unroll
                            for (int e = 0; e < 4; ++e) { const float a = fsigmoid(pa[e] + acc[ai][bj][m][n][e]), kkn = kv[n][e] * pk[e] * inv; kk2[n][e] = kkn; b2[n][e] = kkn * a; k2[n][e] = kv[n][e] * (1.0f + (a - 1.0f) * pq[e]);
                                bsum += rv[n][e] * bflo(cvt_pk_bf16(k2[n][e], 0.f)) * pr[e]; } }
                        *(u32x4*)(Kraw + ro + 32 * bj) = pack8f(k2[0], k2[1]); *(u32x4*)(KK + ro + 32 * bj) = pack8f(kk2[0], kk2[1]); *(u32x4*)(BV + ro + 32 * bj) = pack8f(b2[0], b2[1]); }
                    bsum += __uint_as_float((unsigned)__builtin_amdgcn_ds_swizzle((int)__float_as_uint(bsum), 0x1f | (16 << 10)));
                    { const auto rr = __builtin_amdgcn_permlane32_swap(__float_as_uint(bsum), __float_as_uint(bsum), false, false); bsum = __uint_as_float(rr[0]) + __uint_as_float(rr[1]); }
                    if (fq == 0) BON[(size_t)(row0 + ai * HALF + m * 16) * 8 + 4 * (u.pn & 1) + wc] = bsum;
                    asm volatile("" ::: "memory"); }
        } else if (seg == 2) {
#pragma unroll
            for (int ai = 0; ai < 2; ++ai)
#pragma unroll
                for (int m = 0; m < 4; ++m) { bf16_t* rp = G + (size_t)(row0 + ai * HALF + m * 16) * 512 + cb;
#pragma unroll
                    for (int bj = 0; bj < 2; ++bj) *(u32x4*)(rp + 32 * bj) = pack8f(acc[ai][bj][m][0], acc[ai][bj][m][1]); }
        } else {
            f32x4 p[2][2];
#pragma unroll
            for (int bj = 0; bj < 2; ++bj) { p[bj][0] = *(const f32x4*)(v0 + cb + 32 * bj); p[bj][1] = *(const f32x4*)(v0 + cb + 32 * bj + 4); }
#pragma unroll
            for (int ai = 0; ai < 2; ++ai)
#pragma unroll
                for (int m = 0; m < 4; ++m) { const size_t ro = (size_t)(row0 + ai * HALF + m * 16) * 512 + cb;
#pragma unroll
                    for (int bj = 0; bj < 2; ++bj) { f32x4 vv[2], vf[2], o[2]; unpack8(*(const u32x4*)(Vraw + ro + 32 * bj), vv[0], vv[1]); unpack8(*(const u32x4*)(VF + ro + 32 * bj), vf[0], vf[1]);
#pragma unroll
                        for (int n = 0; n < 2; ++n)
#pragma unroll
                            for (int e = 0; e < 4; ++e) o[n][e] = vv[n][e] + (vf[n][e] - vv[n][e]) * fsigmoid(p[bj][n][e] + acc[ai][bj][m][n][e]);
                        *(u32x4*)(Vraw + ro + 32 * bj) = pack8f(o[0], o[1]); } }
        }
    }
};
template <class Epi, class Sched, bool ALIGN_EPI = false, bool SP2 = false, int MODE = 0>
__device__ __forceinline__ void gemm_phase(PG8_LAS unsigned char* lds, const Gemm g, const Sched& S, const Epi& E) {
    int tid_ = threadIdx.x; asm volatile("" : "+v"(tid_));
    const int tid = tid_, wid = __builtin_amdgcn_readfirstlane(tid >> 6), lane = tid & 63, wr = wid >> 2, wc = wid & 3, fr = lane & 15, fq = lane >> 4;
    int K_ = g.K; asm volatile("" : "+s"(K_));
    const int K = K_, nt = K / BK;
    unsigned voffA[2], voffB[2]; int gR[2], gC[2]; unsigned vAc[2][2], vAn[2][2];
    static_assert(SP2 || MODE == 0, "MODE != 0 needs SP2");
#pragma unroll
    for (int i = 0; i < 2; ++i) { int R, C; stage_rc(tid * 16 + i * 8192, R, C); const int Rb = Epi::PERM ? ((R & ~31) + perm32(R & 31)) : R;
        voffA[i] = (unsigned)(R * K + C) * 2u; voffB[i] = (unsigned)(Rb * K + C) * 2u; gR[i] = R; gC[i] = C; }
    const size_t kstep = (size_t)(BK * 2);
    const size_t hstep = (size_t)HALF * K * 2;
    const size_t tstep = 2 * hstep;
    const unsigned ldsw = (unsigned)wid * 1024u;
    const int aoff = lds_byte(wr * 64 + fr, fq * 8), boff = lds_byte(wc * 32 + fr, fq * 8);
#define PG8_SA(b, h) (((b) * 2 + (h)) * HTB)
#define PG8_SB(b, h) ((4 + (b) * 2 + (h)) * HTB)
#define PG8_STAGE(bufoff, gbase, voff) do { _Pragma("unroll") for (int _i = 0; _i < 2; ++_i) \
        __builtin_amdgcn_global_load_lds((const unsigned*)((const char*)(gbase) + (voff)[_i]), (PG8_LAS unsigned*)(lds + (bufoff) + ldsw + _i * 8192), 16, 0, 0); } while (0)
#define PG8_GATHER(dst, U) do { _Pragma("unroll") for (int _h = 0; _h < 2; ++_h) _Pragma("unroll") for (int _i = 0; _i < 2; ++_i) { \
        int _r = g.ridx[(U).pm * BM + _h * HALF + gR[_i]]; _r = _r < 0 ? 0 : _r; dst[_h][_i] = (unsigned)(_r * K + gC[_i]) * 2u; } } while (0)
#define PG8_STAGE_A(bufoff, kptr, h, NXT) do { if constexpr (MODE == 1) { _Pragma("unroll") for (int _i = 0; _i < 2; ++_i) \
        __builtin_amdgcn_global_load_lds((const unsigned*)((const char*)(kptr) + ((NXT) ? vAn[h][_i] : vAc[h][_i])), (PG8_LAS unsigned*)(lds + (bufoff) + ldsw + _i * 8192), 16, 0, 0); } \
    else { PG8_STAGE(bufoff, (kptr) + (h) * hstep, voffA); } } while (0)
#define PG8_APTR(U) ((MODE == 1) ? (const char*)g.A : (const char*)g.A + (size_t)(U).pm * tstep)
#define PG8_BPTR(U) ((MODE != 0) ? (const char*)g.Bt + (size_t)g.tile_e[(U).pm] * g.e_stride + (size_t)(U).pn * tstep : (const char*)g.Bt + (size_t)(U).pn * tstep)
#define PG8_LDA(dst, b, h) do { _Pragma("unroll") for (int m = 0; m < 4; ++m) _Pragma("unroll") for (int k = 0; k < 2; ++k) dst[m][k] = *(const PG8_LAS bf16x8*)(lds + PG8_SA(b, h) + aoff + m * 2048 + k * 1024); } while (0)
#define PG8_LDB(dst, b, h) do { _Pragma("unroll") for (int n = 0; n < 2; ++n) _Pragma("unroll") for (int k = 0; k < 2; ++k) dst[n][k] = *(const PG8_LAS bf16x8*)(lds + PG8_SB(b, h) + boff + n * 2048 + k * 1024); } while (0)
#define PG8_MMA(ai, bj, At, Bt) do { __builtin_amdgcn_s_setprio(1); _Pragma("unroll") for (int m = 0; m < 4; ++m) _Pragma("unroll") for (int n = 0; n < 2; ++n) _Pragma("unroll") for (int k = 0; k < 2; ++k) \
        acc[ai][bj][m][n] = __builtin_amdgcn_mfma_f32_16x16x32_bf16(Bt[n][k], At[m][k], acc[ai][bj][m][n], 0, 0, 0); __builtin_amdgcn_s_setprio(0); } while (0)
#define PG8_WAIT_V(n) asm volatile("s_waitcnt vmcnt(" #n ")" ::: "memory")
#define PG8_WAIT_L(n) asm volatile("s_waitcnt lgkmcnt(" #n ")" ::: "memory")
#define PG8_BAR __builtin_amdgcn_s_barrier()
#define PG8_SCHED __builtin_amdgcn_sched_barrier(0)
    Unit cur, nxt; int ui = 0;
    if (!S.next(0, cur)) return;
    f32x4 acc[2][2][4][2];
#pragma unroll
    for (int a = 0; a < 2; ++a)
#pragma unroll
        for (int b = 0; b < 2; ++b)
#pragma unroll
            for (int m = 0; m < 4; ++m)
#pragma unroll
                for (int n = 0; n < 2; ++n) acc[a][b][m][n] = (f32x4){0.f, 0.f, 0.f, 0.f};
    bf16x8 At[4][2], B0[2][2], B1[2][2];
    const char* cA = PG8_APTR(cur); const char* cB = PG8_BPTR(cur);
    if constexpr (MODE == 1) { PG8_GATHER(vAc, cur); }
    S.a_ready(cur);
    if constexpr (SP2) {
        PG8_STAGE(PG8_SB(0, 0), cB, voffB); PG8_STAGE(PG8_SB(0, 1), cB + hstep, voffB); PG8_STAGE_A(PG8_SA(0, 0), cA, 0, false); PG8_STAGE_A(PG8_SA(0, 1), cA, 1, false);
        if (wr == 1) PG8_BAR;
        PG8_WAIT_V(2); PG8_BAR;
        PG8_STAGE(PG8_SB(1, 0), cB + kstep, voffB); PG8_STAGE_A(PG8_SA(1, 0), cA + kstep, 0, false); PG8_STAGE(PG8_SB(1, 1), cB + hstep + kstep, voffB);
        PG8_WAIT_V(6); PG8_BAR;
    } else {
        PG8_STAGE(PG8_SB(0, 0), cB, voffB); PG8_STAGE(PG8_SA(0, 0), cA, voffA); PG8_STAGE(PG8_SB(0, 1), cB + hstep, voffB); PG8_STAGE(PG8_SA(0, 1), cA + hstep, voffA);
        if (wr == 1) PG8_BAR;
        PG8_WAIT_V(4); PG8_BAR;
        PG8_STAGE(PG8_SB(1, 0), cB + kstep, voffB); PG8_STAGE(PG8_SA(1, 0), cA + kstep, voffA); PG8_STAGE(PG8_SB(1, 1), cB + hstep + kstep, voffB);
        PG8_WAIT_V(6); PG8_BAR;
    }
    for (;;) {
        const bool has_next = S.next(ui + 1, nxt);
        const char* nA = has_next ? PG8_APTR(nxt) : cA; const char* nB = has_next ? PG8_BPTR(nxt) : cB;
        if constexpr (MODE == 1) { if (has_next) { PG8_GATHER(vAn, nxt); asm volatile("s_waitcnt vmcnt(0)" ::: "memory"); } else { vAn[0][0] = vAc[0][0]; vAn[0][1] = vAc[0][1]; vAn[1][0] = vAc[1][0]; vAn[1][1] = vAc[1][1]; } }
        for (int t = 0; t < nt; t += 2) {
            const bool last = (t == nt - 2);
            const char* a1 = cA + (size_t)(t + 1) * kstep;
            const char* a2 = last ? nA : cA + (size_t)(t + 2) * kstep; const char* b2 = last ? nB : cB + (size_t)(t + 2) * kstep;
            const char* a3 = a2 + kstep; const char* b3 = b2 + kstep;
            if (last && has_next) S.a_ready(nxt);
            if constexpr (SP2) {
            PG8_LDB(B0, 0, 0); PG8_LDB(B1, 0, 1); PG8_SCHED; PG8_LDA(At, 0, 0); PG8_STAGE_A(PG8_SA(1, 1), a1, 1, false);
            PG8_WAIT_V(8); PG8_WAIT_L(0); PG8_BAR; PG8_MMA(0, 0, At, B0); PG8_MMA(0, 1, At, B1); PG8_BAR; PG8_SCHED;
            PG8_LDA(At, 0, 1); PG8_STAGE(PG8_SB(0, 0), b2, voffB); PG8_STAGE(PG8_SB(0, 1), b2 + hstep, voffB); PG8_STAGE_A(PG8_SA(0, 0), a2, 0, last);
            PG8_WAIT_V(8); PG8_WAIT_L(0); PG8_BAR; PG8_MMA(1, 0, At, B0); PG8_MMA(1, 1, At, B1); PG8_BAR; PG8_SCHED;
            PG8_LDB(B0, 1, 0); PG8_LDB(B1, 1, 1); PG8_SCHED; PG8_LDA(At, 1, 0); PG8_STAGE_A(PG8_SA(0, 1), a2, 1, last);
            PG8_WAIT_V(8); PG8_WAIT_L(0); PG8_BAR; PG8_MMA(0, 0, At, B0); PG8_MMA(0, 1, At, B1); PG8_BAR; PG8_SCHED;
            PG8_LDA(At, 1, 1); PG8_STAGE(PG8_SB(1, 0), b3, voffB); PG8_STAGE(PG8_SB(1, 1), b3 + hstep, voffB); PG8_STAGE_A(PG8_SA(1, 0), a3, 0, last);
            PG8_WAIT_V(8); PG8_WAIT_L(0); PG8_BAR; PG8_MMA(1, 0, At, B0); PG8_MMA(1, 1, At, B1); PG8_BAR; PG8_SCHED;
            } else {
            PG8_LDB(B0, 0, 0); PG8_SCHED; PG8_LDA(At, 0, 0); PG8_STAGE(PG8_SA(1, 1), a1 + hstep, voffA);
            PG8_WAIT_L(8); PG8_BAR; PG8_WAIT_L(0); PG8_MMA(0, 0, At, B0); PG8_BAR; PG8_SCHED;
            PG8_LDB(B1, 0, 1); PG8_STAGE(PG8_SB(0, 0), b2, voffB);
            PG8_BAR; PG8_WAIT_L(0); PG8_MMA(0, 1, At, B1); PG8_BAR;
            PG8_LDA(At, 0, 1); PG8_STAGE(PG8_SA(0, 0), a2, voffA);
            PG8_BAR; PG8_WAIT_L(0); PG8_MMA(1, 0, At, B0); PG8_BAR; PG8_SCHED;
            PG8_STAGE(PG8_SB(0, 1), b2 + hstep, voffB);
            PG8_WAIT_V(6); PG8_BAR; PG8_MMA(1, 1, At, B1); PG8_BAR;
            PG8_LDB(B0, 1, 0); PG8_SCHED; PG8_LDA(At, 1, 0); PG8_STAGE(PG8_SA(0, 1), a2 + hstep, voffA);
            PG8_WAIT_L(8); PG8_BAR; PG8_WAIT_L(0); PG8_MMA(0, 0, At, B0); PG8_BAR; PG8_SCHED;
            PG8_LDB(B1, 1, 1); PG8_STAGE(PG8_SB(1, 0), b3, voffB);
            PG8_BAR; PG8_WAIT_L(0); PG8_MMA(0, 1, At, B1); PG8_BAR;
            PG8_LDA(At, 1, 1); PG8_STAGE(PG8_SA(1, 0), a3, voffA);
            PG8_BAR; PG8_WAIT_L(0); PG8_MMA(1, 0, At, B0); PG8_BAR; PG8_SCHED;
            PG8_STAGE(PG8_SB(1, 1), b3 + hstep, voffB);
            PG8_WAIT_V(6); PG8_BAR; PG8_MMA(1, 1, At, B1); PG8_BAR;
            }
        }
        if constexpr (ALIGN_EPI) { if (wr == 0) PG8_BAR; }
        if constexpr (!Epi::AFTER_DRAIN) { E(acc, cur, wr, wc, fr, fq); S.done(cur); }
        if (!has_next) break;
#pragma unroll
        for (int a = 0; a < 2; ++a)
#pragma unroll
            for (int b = 0; b < 2; ++b)
#pragma unroll
                for (int m = 0; m < 4; ++m)
#pragma unroll
                    for (int n = 0; n < 2; ++n) acc[a][b][m][n] = (f32x4){0.f, 0.f, 0.f, 0.f};
        cur = nxt; cA = nA; cB = nB; ++ui;
        if constexpr (MODE == 1) { vAc[0][0] = vAn[0][0]; vAc[0][1] = vAn[0][1]; vAc[1][0] = vAn[1][0]; vAc[1][1] = vAn[1][1]; }
        if constexpr (ALIGN_EPI) { if (wr == 1) PG8_BAR; }
    }
    PG8_WAIT_V(0);
    if constexpr (!ALIGN_EPI) { if (wr == 0) PG8_BAR; }
    PG8_BAR;
    if constexpr (Epi::AFTER_DRAIN) { E.fused(acc, cur, wr, wc, fr, fq, lds, wid, lane); S.done(cur); }
#undef PG8_SA
#undef PG8_SB
#undef PG8_STAGE
#undef PG8_STAGE_A
#undef PG8_GATHER
#undef PG8_APTR
#undef PG8_BPTR
#undef PG8_LDA
#undef PG8_LDB
#undef PG8_MMA
#undef PG8_WAIT_V
#undef PG8_WAIT_L
#undef PG8_BAR
#undef PG8_SCHED
}
}

#define GAS __attribute__((address_space(1)))
#define LAS __attribute__((address_space(3)))
typedef unsigned short bf16;
typedef unsigned v4u __attribute__((ext_vector_type(4)));
typedef unsigned v2u __attribute__((ext_vector_type(2)));
typedef float f32x4 __attribute__((ext_vector_type(4)));
typedef float f32x16 __attribute__((ext_vector_type(16)));
typedef short bf16x8 __attribute__((ext_vector_type(8)));
typedef short s16x4 __attribute__((ext_vector_type(4)));
typedef GAS unsigned gu32;
#define RLX_AGENT __ATOMIC_RELAXED, __HIP_MEMORY_SCOPE_AGENT
#define LDS_WAIT() asm volatile("s_waitcnt lgkmcnt(0)" ::: "memory")
#define VM_WAIT() asm volatile("s_waitcnt vmcnt(0)" ::: "memory")
using pg8::bf2f; using pg8::bflo; using pg8::bfhi; using pg8::fsigmoid; using pg8::cvt_pk_bf16;

#ifndef MK_SPLIT
#define MK_SPLIT 0
#endif

constexpr int NWAVES = 8, NTHR = 512;
constexpr int NB = 8, SEQ = 4096, TOK = NB * SEQ, DM = 1024;
constexpr int NPROJ = 2304;
constexpr int NQ = 768, NKV = 1024, KLORA = 384, NLORA = 2048, RW = 512;
constexpr int FFD = 2816, FFE = 3584, NEXP = 8;
constexpr int MODLD = 6144;
constexpr int PASS_TILES = 136;
constexpr int PASS_ROWS = PASS_TILES * 256;

constexpr size_t MiB = 1u << 20;
constexpr size_t WS_CTL = 0, CTL_ZERO_BYTES = 64 * 1024;
constexpr size_t WS_MOD = 1 * MiB;
constexpr size_t WS_ROUTE = 2 * MiB;
constexpr size_t WS_WIN = 4 * MiB;
constexpr size_t WS_WUQ = WS_WIN + 2ull * NPROJ * DM * 2;
constexpr size_t WS_WUKV = WS_WUQ + 2ull * NQ * 256 * 2;
constexpr size_t WS_WLORA = WS_WUKV + 2ull * NKV * 128 * 2;
constexpr size_t WS_WOUT = WS_WLORA + 2ull * NLORA * KLORA * 2;
constexpr size_t WS_WF1 = WS_WOUT + 2ull * DM * DM * 2;
constexpr size_t WS_WF2 = WS_WF1 + 2ull * FFD * DM * 2;
constexpr size_t WS_WEND = WS_WF2 + (size_t)DM * FFD * 2;
constexpr size_t WS_VFIRST = 38 * MiB;
constexpr size_t WS_ARENA = 70 * MiB;
static_assert(WS_WEND <= WS_VFIRST, "weights overflow");
constexpr size_t A_H = WS_ARENA + 0 * MiB;
constexpr size_t A_PROJ = WS_ARENA + 64 * MiB;
constexpr size_t A_CQ = WS_ARENA + 208 * MiB;
constexpr size_t A_CKV = WS_ARENA + 224 * MiB;
constexpr size_t A_LA = WS_ARENA + 232 * MiB;
constexpr size_t A_KB = WS_ARENA + 256 * MiB;
constexpr size_t A_R = WS_ARENA + 304 * MiB;
constexpr size_t A_KRAW = WS_ARENA + 336 * MiB;
constexpr size_t A_VRAW = WS_ARENA + 368 * MiB;
constexpr size_t A_VB = WS_ARENA + 400 * MiB;
constexpr size_t A_KK = WS_ARENA + 432 * MiB;
constexpr size_t A_BV = WS_ARENA + 464 * MiB;
constexpr size_t A_BON = WS_ARENA + 496 * MiB;
constexpr size_t A_Q = WS_ARENA + 0 * MiB;
constexpr size_t A_LW = WS_ARENA + 64 * MiB;
constexpr size_t A_G = WS_ARENA + 128 * MiB;
constexpr size_t A_YCAT = WS_ARENA + 160 * MiB;
constexpr size_t A_HID = WS_ARENA + 64 * MiB;
constexpr size_t A_WE1 = WS_ARENA + 304 * MiB;
constexpr size_t A_WE2 = WS_ARENA + 416 * MiB;
constexpr size_t WS_END = WS_ARENA + 504 * MiB;
static_assert(A_HID + (size_t)PASS_ROWS * FFE * 2 <= A_WE1, "moe hidden overflow");
constexpr size_t RT_SEL = WS_ROUTE;
constexpr size_t RT_GW = RT_SEL + (size_t)TOK * 8;
constexpr size_t RT_CNT = RT_GW + (size_t)TOK * 8;
constexpr size_t RT_RIDX = RT_CNT + 256 * 16 * 4;
constexpr size_t RT_RGW = RT_RIDX + 2ull * PASS_ROWS * 4;
constexpr size_t RT_TILE = RT_RGW + 2ull * PASS_ROWS * 4;
static_assert(RT_TILE + 2 * (PASS_TILES + 8) * 4 <= WS_WIN, "route tables overflow");
constexpr int CW_QCTR = 64;
constexpr int CW_BAR = 4096;

constexpr int RING_BYTES = 155648;
constexpr int LDSCTL_OFF = RING_BYTES, MISC_OFF = LDSCTL_OFF + 320, PTAB_OFF = LDSCTL_OFF + 1024;
constexpr int LDS_BYTES = 163840;

#define XB_TMO      128
#define XB_XCNT(j)  (256  + 64 * (j))
#define XB_XSUB(j)  (1280 + 64 * (j))
#define XB_XGEN(j)  (2304 + 64 * (j))
#define XB_TOP      3328
#define XB_TOPGEN   3392
#define XCD_BAR_WORDS 3456
#define XB_SPIN_CAP (1u << 18)

__device__ __forceinline__ unsigned xb_ld(unsigned* p)              { return __hip_atomic_load(p, __ATOMIC_RELAXED, __HIP_MEMORY_SCOPE_AGENT); }
__device__ __forceinline__ unsigned xb_add(unsigned* p, unsigned v) { return __hip_atomic_fetch_add(p, v, __ATOMIC_RELAXED, __HIP_MEMORY_SCOPE_AGENT); }
__device__ __forceinline__ unsigned xb_xcc_id() { return (unsigned)__builtin_amdgcn_s_getreg((3 << 11) | 20) & 0xFu; }
#define XB_SPIN(cond, bar) do { unsigned _sp = 0; while (cond) { __builtin_amdgcn_s_sleep(1); \
    if ((++_sp & 255u) == 0u) { if (xb_ld(&(bar)[XB_TMO])) break; if (_sp > XB_SPIN_CAP) { atomicAdd(&(bar)[XB_TMO], 1u); break; } } } } while (0)

struct XcdBarrier {
    unsigned* bar; unsigned x;
    volatile LAS unsigned* st;
};

__device__ __forceinline__ XcdBarrier xcd_barrier_post(unsigned* bar, volatile LAS unsigned* st) {
    XcdBarrier b; b.bar = bar; b.x = xb_xcc_id(); b.st = st;
    if (threadIdx.x == 0) (void)xb_add(&bar[XB_XCNT(b.x)], 1u);
    return b;
}
__device__ __forceinline__ void xcd_barrier_complete(unsigned* bar, unsigned x, unsigned& nloc, unsigned& nx) {
    const unsigned G = gridDim.x * gridDim.y * gridDim.z;
    unsigned sum, cnt, mine, sp = 0u;
    for (;;) {
        sum = 0u; cnt = 0u; mine = 0u;
#pragma unroll
        for (unsigned j = 0; j < 16; ++j) { const unsigned c = xb_ld(&bar[XB_XCNT(j)]); sum += c; cnt += (c > 0u) ? 1u : 0u; mine = (j == x) ? c : mine; }
        if (sum == G) break;
        __builtin_amdgcn_s_sleep(1);
        if ((++sp & 255u) == 0u) { if (xb_ld(&bar[XB_TMO])) break; if (sp > XB_SPIN_CAP) { atomicAdd(&bar[XB_TMO], 1u); break; } }
    }
    nloc = mine > 0u ? mine : 1u; nx = cnt > 0u ? cnt : 1u;
}

__device__ __forceinline__ void xcd_barrier(const XcdBarrier& b) {
    asm volatile("s_waitcnt vmcnt(0)" ::: "memory");
    __syncthreads();
    if (threadIdx.x == 0) {
        unsigned* bar = b.bar;
        __builtin_amdgcn_s_waitcnt(0);
        unsigned nloc = b.st[0], nx = b.st[1];
        if (nloc == 0u) { xcd_barrier_complete(bar, b.x, nloc, nx); b.st[0] = nloc; b.st[1] = nx; }
        const unsigned old = xb_add(&bar[XB_XSUB(b.x)], 1u);
        const unsigned gen = old / nloc;
        if (old + 1u == (gen + 1u) * nloc) {
            __builtin_amdgcn_fence(__ATOMIC_RELEASE, "agent");
            asm volatile("s_waitcnt vmcnt(0)" ::: "memory");
            const unsigned og = xb_add(&bar[XB_TOP], 1u);
            const unsigned tg = og / nx;
            if (og + 1u == (tg + 1u) * nx) xb_add(&bar[XB_TOPGEN], 1u);
            else XB_SPIN(xb_ld(&bar[XB_TOPGEN]) == tg, bar);
            __builtin_amdgcn_fence(__ATOMIC_ACQUIRE, "agent");
            xb_add(&bar[XB_XGEN(b.x)], 1u);
            asm volatile("s_waitcnt vmcnt(0)" ::: "memory");
        } else {
            XB_SPIN(xb_ld(&bar[XB_XGEN(b.x)]) == gen, bar);
            __builtin_amdgcn_fence(__ATOMIC_ACQUIRE, "agent");
            asm volatile("s_waitcnt vmcnt(0)" ::: "memory");
        }
    }
    __syncthreads();
}


template <int X> __device__ __forceinline__ float lane_xor(float v) {
    if constexpr (X == 32) { const auto rr = __builtin_amdgcn_permlane32_swap(__float_as_uint(v), __float_as_uint(v), false, false); return __uint_as_float((threadIdx.x & 32) ? rr[0] : rr[1]); }
    else return __uint_as_float((unsigned)__builtin_amdgcn_ds_swizzle((int)__float_as_uint(v), 0x1f | (X << 10)));
}
__device__ __forceinline__ float wave_sum(float v) {
    v += lane_xor<1>(v); v += lane_xor<2>(v); v += lane_xor<4>(v); v += lane_xor<8>(v); v += lane_xor<16>(v);
    { const auto rr = __builtin_amdgcn_permlane32_swap(__float_as_uint(v), __float_as_uint(v), false, false); v = __uint_as_float(rr[0]) + __uint_as_float(rr[1]); }
    return v;
}
__device__ __forceinline__ v4u pk8(const float* f) { v4u w; w.x = cvt_pk_bf16(f[0], f[1]); w.y = cvt_pk_bf16(f[2], f[3]); w.z = cvt_pk_bf16(f[4], f[5]); w.w = cvt_pk_bf16(f[6], f[7]); return w; }
__device__ __forceinline__ void up8(const v4u w, float* f) { f[0] = bflo(w.x); f[1] = bfhi(w.x); f[2] = bflo(w.y); f[3] = bfhi(w.y); f[4] = bflo(w.z); f[5] = bfhi(w.z); f[6] = bflo(w.w); f[7] = bfhi(w.w); }

__device__ __forceinline__ void tr_item(const float* W, int ldw, bf16* WT, int ldk, int k0, int n0, int drow0, LAS float* scr, int lane) {
#pragma unroll 8
    for (int i = 0; i < 32; ++i) { const int kk = 2 * i + (lane >> 5); scr[kk * 33 + (lane & 31)] = W[(size_t)(k0 + kk) * ldw + n0 + (lane & 31)]; }
    LDS_WAIT(); asm volatile("" ::: "memory");
    const int c = lane & 7;
#pragma unroll
    for (int j = 0; j < 4; ++j) { const int n = (lane >> 3) + 8 * j; const LAS float* s = scr + (8 * c) * 33 + n;
        v4u o; o.x = cvt_pk_bf16(s[0 * 33], s[1 * 33]); o.y = cvt_pk_bf16(s[2 * 33], s[3 * 33]); o.z = cvt_pk_bf16(s[4 * 33], s[5 * 33]); o.w = cvt_pk_bf16(s[6 * 33], s[7 * 33]);
        *(GAS v4u*)(WT + (size_t)(drow0 + n) * ldk + k0 + 8 * c) = o; }
    LDS_WAIT(); asm volatile("" ::: "memory");
}
__device__ __forceinline__ void conv_item(const float* W, int K, int N, bf16* WT, int ldk, int mode, int row_off, int item, LAS float* scr, int lane) {
    const int nblk = N / 32, kb = item / nblk, nb = item % nblk, n0 = 32 * nb;
    int drow = n0 + row_off;
    if (mode != 0) drow = 256 * (n0 >> 7) + (n0 & 127) + (mode == 2 ? 128 : 0);
    tr_item(W, N, WT, ldk, 64 * kb, n0, drow, scr, lane);
}
struct In { const float* p[38]; };
struct InT { volatile LAS unsigned* t;
    __device__ __forceinline__ const float* operator[](int i) const { const unsigned lo = __builtin_amdgcn_readfirstlane(t[2 * i]), hi = __builtin_amdgcn_readfirstlane(t[2 * i + 1]);
        return (const float*)(((unsigned long long)hi << 32) | (unsigned long long)lo); } };

__device__ __forceinline__ void p0_weights(const InT in, unsigned char* ws, LAS unsigned char* lds, int gw, int NGW, int wave, int lane, int gtid, int NGT) {
    LAS float* scr = (LAS float*)(lds + wave * 16384);
    constexpr int I_IN = 16 * 70, I_VR = 16, I_UQ = 4 * 24, I_UKV = 2 * 32, I_OUT = 16 * 32, I_G = 16 * 88, I_D = 44 * 32;
    constexpr int PER_L = I_IN + I_UQ + I_UKV + I_OUT;
    constexpr int NITEMS = 2 * PER_L + I_VR + 2 * I_G + I_D;
    for (int it = gw; it < NITEMS; it += NGW) {
        int r = it;
        if (r < 2 * PER_L) { const int l = r / PER_L; r -= l * PER_L;
            if (r < I_IN) { conv_item(in[7] + (size_t)l * DM * 2240, DM, 2240, (bf16*)(ws + WS_WIN) + (size_t)l * NPROJ * DM, DM, 0, 0, r, scr, lane); continue; } r -= I_IN;
            if (r < I_UQ) { conv_item(in[10] + (size_t)l * 256 * NQ, 256, NQ, (bf16*)(ws + WS_WUQ) + (size_t)l * NQ * 256, 256, 0, 0, r, scr, lane); continue; } r -= I_UQ;
            if (r < I_UKV) { conv_item(in[12] + (size_t)l * 128 * NKV, 128, NKV, (bf16*)(ws + WS_WUKV) + (size_t)l * NKV * 128, 128, 0, 0, r, scr, lane); continue; } r -= I_UKV;
            conv_item(in[28] + (size_t)l * DM * DM, DM, DM, (bf16*)(ws + WS_WOUT) + (size_t)l * DM * DM, DM, 0, 0, r, scr, lane); continue; }
        r -= 2 * PER_L;
        if (r < I_VR) { conv_item(in[8], DM, 32, (bf16*)(ws + WS_WIN) + (size_t)NPROJ * DM, DM, 0, 2240, r, scr, lane); continue; } r -= I_VR;
        if (r < I_G) { conv_item(in[29], DM, FFD, (bf16*)(ws + WS_WF1), DM, 1, 0, r, scr, lane); continue; } r -= I_G;
        if (r < I_G) { conv_item(in[30], DM, FFD, (bf16*)(ws + WS_WF1), DM, 2, 0, r, scr, lane); continue; } r -= I_G;
        conv_item(in[31], FFD, DM, (bf16*)(ws + WS_WF2), FFD, 0, 0, r, scr, lane);
    }
    { const int n0 = 64 * 128, n1 = 32 * 128;
      for (int i = gtid; i < n0 + n1; i += NGT) { const bool l1 = i >= n0; const int j = l1 ? i - n0 : i; const int row = (l1 ? 2272 : 2240) + j / 128, ch = j % 128;
          *(GAS v4u*)((bf16*)(ws + WS_WIN) + ((size_t)(l1 ? NPROJ : 0) + row) * DM + ch * 8) = (v4u){0u, 0u, 0u, 0u}; } }
    const float* pw2 = in[17]; const float* pa2 = in[19]; const float* pg2 = in[20]; const float* pv2 = in[22];
    for (int i = gtid; i < 2 * NLORA * (KLORA / 8); i += NGT) {
        const int l = i / (NLORA * 48), rem = i % (NLORA * 48), k8 = rem / NLORA, pos = rem % NLORA;
        const int seg = pos >> 9, p9 = pos & 511, ct = p9 >> 8, p8 = p9 & 255, bj = p8 >> 7, wc = (p8 >> 5) & 3, x = p8 & 31;
        const int oc = 256 * ct + 64 * wc + 32 * bj + x;
        const int k0 = k8 * 8;
        const float* src = nullptr; int kr = 0;
        if (seg == 0 && k0 < 64) { src = pw2 + (size_t)l * 64 * RW; kr = k0; }
        else if (seg == 1 && k0 >= 64 && k0 < 128) { src = pa2 + (size_t)l * 64 * RW; kr = k0 - 64; }
        else if (seg == 2 && k0 >= 128 && k0 < 256) { src = pg2 + (size_t)l * 128 * RW; kr = k0 - 128; }
        else if (seg == 3 && l == 1 && k0 >= 256 && k0 < 288) { src = pv2; kr = k0 - 256; }
        float f[8];
#pragma unroll
        for (int e = 0; e < 8; ++e) f[e] = src ? src[(size_t)(kr + e) * RW + oc] : 0.f;
        *(GAS v4u*)((bf16*)(ws + WS_WLORA) + ((size_t)l * NLORA + pos) * KLORA + k0) = pk8(f);
    }
}
__device__ __forceinline__ void p_expert_weights(const InT in, unsigned char* ws, LAS unsigned char* lds, int gw, int NGW, int wave, int lane) {
    LAS float* scr = (LAS float*)(lds + wave * 16384);
    constexpr int IPJ = 1792;
    for (int it = gw; it < 24 * IPJ; it += NGW) { const int job = it / IPJ, r = it % IPJ, e = job / 3, kind = job % 3;
        if (kind == 0) conv_item(in[34] + (size_t)e * DM * FFE, DM, FFE, (bf16*)(ws + A_WE1) + (size_t)e * 2 * FFE * DM, DM, 1, 0, r, scr, lane);
        else if (kind == 1) conv_item(in[35] + (size_t)e * DM * FFE, DM, FFE, (bf16*)(ws + A_WE1) + (size_t)e * 2 * FFE * DM, DM, 2, 0, r, scr, lane);
        else conv_item(in[36] + (size_t)e * FFE * DM, FFE, DM, (bf16*)(ws + A_WE2) + (size_t)e * DM * FFE, FFE, 0, 0, r, scr, lane); }
}
__device__ __forceinline__ void p0_mod(const InT in, unsigned char* ws, LAS unsigned char* lds, int vcu, int G, int wave, int lane, int tid) {
    LAS float* cond = (LAS float*)lds;
    LAS float* red = (LAS float*)(lds + 32768);
    const float* cin = in[1]; const float* wada = in[3]; const float* bada = in[4];
    for (int i = tid; i < NB * DM; i += NTHR) { const float c = cin[i]; cond[i] = c * fsigmoid(c); }
    __syncthreads();
    float* MOD = (float*)(ws + WS_MOD);
    for (int it = vcu; it < 2 * (MODLD / 64); it += G) { const int l = it / (MODLD / 64), n0 = (it % (MODLD / 64)) * 64;
        const float* W = wada + (size_t)l * DM * MODLD + n0 + lane;
        float a[8] = {0.f, 0.f, 0.f, 0.f, 0.f, 0.f, 0.f, 0.f};
#pragma unroll 4
        for (int k = wave * 128; k < wave * 128 + 128; ++k) { const float w = W[(size_t)k * MODLD];
#pragma unroll
            for (int b = 0; b < 8; ++b) a[b] += cond[b * DM + k] * w; }
#pragma unroll
        for (int b = 0; b < 8; ++b) red[(wave * 8 + b) * 64 + lane] = a[b];
        __syncthreads();
        { const int b = tid >> 6, n = tid & 63; float s = bada[(size_t)l * MODLD + n0 + n];
#pragma unroll
          for (int w = 0; w < 8; ++w) s += red[(w * 8 + b) * 64 + n];
          MOD[((size_t)l * NB + b) * MODLD + n0 + n] = s; }
        __syncthreads();
    }
}

template <bool ROUTER>
__device__ __forceinline__ void norm_phase(const float* xin, const float* g, const float* modl, int sh_off, bf16* H, const float* wr, const float* br, unsigned char* ws,
                                           LAS unsigned char* lds, int vcu, int G, int wave, int lane, int tid) {
    LAS int* cntl = (LAS int*)lds;
    for (int blk = vcu; blk < TOK / 128; blk += G) {
        if (ROUTER) { if (tid < 16) cntl[tid] = 0; __syncthreads(); }
        const int row0 = blk * 128 + wave * 16, b = row0 >> 12;
        const float* shp = modl + (size_t)b * MODLD + sh_off; const float* scp = shp + 1024;
        f32x4 gs[4], sh[4];
#pragma unroll
        for (int j = 0; j < 4; ++j) { const int c = 4 * lane + 256 * j; const f32x4 gg = *(const f32x4*)(g + c), sc = *(const f32x4*)(scp + c); gs[j] = gg * (sc + 1.0f); sh[j] = *(const f32x4*)(shp + c); }
        for (int r = 0; r < 16; ++r) { const int row = row0 + r;
            const GAS f32x4* xr = (const GAS f32x4*)(xin + (size_t)row * DM) + lane;
            f32x4 v[4]; float s = 0.f;
#pragma unroll
            for (int j = 0; j < 4; ++j) { v[j] = xr[64 * j]; s += (v[j].x * v[j].x + v[j].y * v[j].y) + (v[j].z * v[j].z + v[j].w * v[j].w); }
            const float rstd = 1.0f / sqrtf(wave_sum(s) * (1.0f / DM) + 1e-6f);
            GAS unsigned long long* o8 = (GAS unsigned long long*)(H + (size_t)row * DM) + lane;
#pragma unroll
            for (int j = 0; j < 4; ++j) { v[j] = v[j] * rstd * gs[j] + sh[j]; o8[64 * j] = (unsigned long long)cvt_pk_bf16(v[j].x, v[j].y) | ((unsigned long long)cvt_pk_bf16(v[j].z, v[j].w) << 32); }
            if (ROUTER) {
                float lg[8];
#pragma unroll
                for (int e = 0; e < 8; ++e) lg[e] = 0.f;
#pragma unroll
                for (int j = 0; j < 4; ++j)
#pragma unroll
                    for (int i = 0; i < 4; ++i) { const f32x4 w0 = *(const f32x4*)(wr + (size_t)(4 * lane + 256 * j + i) * 8), w1 = *(const f32x4*)(wr + (size_t)(4 * lane + 256 * j + i) * 8 + 4); const float hv = v[j][i];
                        lg[0] += hv * w0.x; lg[1] += hv * w0.y; lg[2] += hv * w0.z; lg[3] += hv * w0.w; lg[4] += hv * w1.x; lg[5] += hv * w1.y; lg[6] += hv * w1.z; lg[7] += hv * w1.w; }
#pragma unroll
                for (int e = 0; e < 8; ++e) lg[e] = wave_sum(lg[e]) + br[e];
                unsigned key[8];
#pragma unroll
                for (int e = 0; e < 8; ++e) { const unsigned u = __float_as_uint(lg[e]); const unsigned kx = (u & 0x80000000u) ? ~u : (u | 0x80000000u); key[e] = (kx & ~7u) | (unsigned)(7 - e); }
                unsigned k1 = key[0];
#pragma unroll
                for (int e = 1; e < 8; ++e) k1 = key[e] > k1 ? key[e] : k1;
                unsigned k2 = 0u;
#pragma unroll
                for (int e = 0; e < 8; ++e) { const unsigned t = (key[e] == k1) ? 0u : key[e]; k2 = t > k2 ? t : k2; }
                k1 = (unsigned)__builtin_amdgcn_readfirstlane((int)k1); k2 = (unsigned)__builtin_amdgcn_readfirstlane((int)k2);
                const int i1 = 7 - (int)(k1 & 7u), i2 = 7 - (int)(k2 & 7u);
                const float v1 = __uint_as_float((k1 & 0x80000000u) ? (k1 & 0x7fffffffu) : ~k1), v2 = __uint_as_float((k2 & 0x80000000u) ? (k2 & 0x7fffffffu) : ~k2);
                const float w2 = 1.0f / (1.0f + __expf(v1 - v2)), w1 = 1.0f - w2;
                if (lane == 0) { *(GAS int*)(ws + RT_SEL + (size_t)row * 8) = i1; *(GAS int*)(ws + RT_SEL + (size_t)row * 8 + 4) = i2; *(GAS float*)(ws + RT_GW + (size_t)row * 8) = w1; *(GAS float*)(ws + RT_GW + (size_t)row * 8 + 4) = w2;
                    atomicAdd((int*)&cntl[i1], 1); atomicAdd((int*)&cntl[8 + i2], 1); }
            }
        }
        if (ROUTER) {
            __syncthreads();
            if (tid < 16) *(GAS int*)(ws + RT_CNT + ((size_t)blk * 16 + tid) * 4) = cntl[tid];
            __syncthreads();
        }
    }
}
__device__ __forceinline__ void final_norm(float* x, const float* g, int gw, int NGW, int lane) {
    f32x4 gs[4];
#pragma unroll
    for (int j = 0; j < 4; ++j) gs[j] = *(const f32x4*)(g + 4 * lane + 256 * j);
    for (int row = gw; row < TOK; row += NGW) { GAS f32x4* xr = (GAS f32x4*)(x + (size_t)row * DM) + lane; f32x4 v[4]; float s = 0.f;
#pragma unroll
        for (int j = 0; j < 4; ++j) { v[j] = xr[64 * j]; s += (v[j].x * v[j].x + v[j].y * v[j].y) + (v[j].z * v[j].z + v[j].w * v[j].w); }
        const float rstd = 1.0f / sqrtf(wave_sum(s) * (1.0f / DM) + 1e-6f);
#pragma unroll
        for (int j = 0; j < 4; ++j) xr[64 * j] = v[j] * rstd * gs[j]; }
}

__device__ __forceinline__ void rw_chunk(int l, int m, bool first, int ci, const bf16* prow, const float* mu_l, const float* mu_v, unsigned char* ws) {
    const int cr = ci * 8 - 448;
    float p[8], q[8], mu[8];
    up8(*(const GAS v4u*)(prow + ci * 8), p);
    if (first) {
#pragma unroll
        for (int e = 0; e < 8; ++e) q[e] = 0.f; }
    else up8(*(const GAS v4u*)(prow - NPROJ + ci * 8), q);
    const float* mup = (cr < 1792) ? mu_l + cr : mu_v + (cr - 1792);
    *(f32x4*)mu = *(const f32x4*)mup; *(f32x4*)(mu + 4) = *(const f32x4*)(mup + 4);
    float xs[8];
#pragma unroll
    for (int e = 0; e < 8; ++e) xs[e] = p[e] + (q[e] - p[e]) * mu[e];
    bf16* dst;
    if (cr < 512) dst = (bf16*)(ws + A_R) + (size_t)m * RW + cr;
    else if (cr < 1024) dst = (bf16*)(ws + A_KRAW) + (size_t)m * RW + (cr - 512);
    else if (cr < 1536) dst = (bf16*)(ws + (l == 0 ? WS_VFIRST : A_VRAW)) + (size_t)m * RW + (cr - 1024);
    else if (cr < 1600) { dst = (bf16*)(ws + A_LA) + (size_t)m * KLORA + (cr - 1536);
#pragma unroll
        for (int e = 0; e < 8; ++e) xs[e] = 1.0f - 2.0f * __builtin_amdgcn_rcpf(1.0f + __builtin_amdgcn_exp2f(2.885390081777927f * xs[e])); }
    else if (cr < 1664) dst = (bf16*)(ws + A_LA) + (size_t)m * KLORA + 64 + (cr - 1600);
    else if (cr < 1792) { dst = (bf16*)(ws + A_LA) + (size_t)m * KLORA + 128 + (cr - 1664);
#pragma unroll
        for (int e = 0; e < 8; ++e) xs[e] = fsigmoid(xs[e]); }
    else dst = (bf16*)(ws + A_LA) + (size_t)m * KLORA + 256 + (cr - 1792);
    *(GAS v4u*)dst = pk8(xs);
}
__device__ __forceinline__ void prep_phase(int l, const InT in, unsigned char* ws, int gw, int NGW, int lane) {
    const bf16* PROJ = (const bf16*)(ws + A_PROJ);
    const int* pos = (const int*)in[2]; const float* mu_l = in[14] + (size_t)l * 1792; const float* mu_v = in[15];
    float gn[8];
    { const float* gp = (lane < 32) ? in[9] + (size_t)l * 256 + lane * 8 : in[11] + (size_t)l * 128 + ((lane - 32) & 15) * 8;
#pragma unroll
      for (int e = 0; e < 8; ++e) gn[e] = gp[e]; }
    float frq[8];
#pragma unroll
    for (int e = 0; e < 8; ++e) { const int i = 8 * (lane & 3) + e; frq[e] = __builtin_amdgcn_exp2f(-(float)i * (13.287712379549449f / 32.0f)) * 0.15915494309189535f; }
    for (int m = gw; m < TOK; m += NGW) {
        const bf16* prow = PROJ + (size_t)m * NPROJ; const bool first = (m & (SEQ - 1)) == 0;
        float p[8]; up8(*(const GAS v4u*)(prow + lane * 8), p);
        float ss = 0.f;
#pragma unroll
        for (int e = 0; e < 8; ++e) ss += p[e] * p[e];
        const float sq = wave_sum(lane < 32 ? ss : 0.f), skv = wave_sum((lane >= 32 && lane < 48) ? ss : 0.f);
        float oth[8];
#pragma unroll
        for (int e = 0; e < 8; ++e) oth[e] = lane_xor<4>(p[e]);
        if (lane < 32) { const float rstd = 1.0f / sqrtf(sq * (1.0f / 256.0f) + 1e-6f); float o[8];
#pragma unroll
            for (int e = 0; e < 8; ++e) o[e] = p[e] * rstd * gn[e];
            *(GAS v4u*)((bf16*)(ws + A_CQ) + (size_t)m * 256 + lane * 8) = pk8(o); }
        else if (lane < 48) { const float rstd = 1.0f / sqrtf(skv * (1.0f / 128.0f) + 1e-6f); float o[8];
#pragma unroll
            for (int e = 0; e < 8; ++e) o[e] = p[e] * rstd * gn[e];
            *(GAS v4u*)((bf16*)(ws + A_CKV) + (size_t)m * 128 + (lane - 32) * 8) = pk8(o); }
        else if (lane < 56) { const float ps = (float)pos[m]; const bool hi = lane >= 52; float o[8];
#pragma unroll
            for (int e = 0; e < 8; ++e) { float rev = ps * frq[e]; rev -= rintf(rev); const float cs = __builtin_amdgcn_cosf(rev), sn = __builtin_amdgcn_sinf(rev);
                o[e] = hi ? (p[e] * cs + oth[e] * sn) : (p[e] * cs - oth[e] * sn); }
            const v4u w = pk8(o); const int b = m >> 12, s = m & (SEQ - 1); const int dim = 128 + (hi ? 32 : 0) + 8 * (lane & 3);
#pragma unroll
            for (int h = 0; h < 4; ++h) *(GAS v4u*)((bf16*)(ws + A_KB) + ((size_t)(b * 4 + h) * SEQ + s) * 192 + dim) = w; }
        else rw_chunk(l, m, first, lane, prow, mu_l, mu_v, ws);
#pragma unroll
        for (int j = 1; j < 4; ++j) rw_chunk(l, m, first, lane + 64 * j, prow, mu_l, mu_v, ws);
        if (lane < 24 || (l == 1 && lane < 28)) rw_chunk(l, m, first, lane + 256, prow, mu_l, mu_v, ws);
        else if (lane >= 32 && lane < 48 && (l == 0 || lane >= 36)) *(GAS v4u*)((bf16*)(ws + A_LA) + (size_t)m * KLORA + lane * 8) = (v4u){0u, 0u, 0u, 0u};
    }
}
__device__ __forceinline__ void onorm_phase(const float* g, unsigned char* ws, int gw, int NGW, int lane) {
    float gn[8];
#pragma unroll
    for (int e = 0; e < 8; ++e) gn[e] = g[lane * 8 + e];
    for (int m = gw; m < TOK; m += NGW) { GAS v4u* pp = (GAS v4u*)((bf16*)(ws + A_YCAT) + (size_t)m * DM + lane * 8); float p[8]; up8(*pp, p); float ss = 0.f;
#pragma unroll
        for (int e = 0; e < 8; ++e) ss += p[e] * p[e];
        const float rstd = 1.0f / sqrtf(wave_sum(ss) * (1.0f / 512.0f) + 1e-6f);
#pragma unroll
        for (int e = 0; e < 8; ++e) p[e] = p[e] * rstd * gn[e];
        *pp = pk8(p); }
}

__device__ __forceinline__ void route_scatter(unsigned char* ws, LAS unsigned char* lds, int vcu, int G, int wave, int lane, int tid) {
    LAS int* tot = (LAS int*)lds;
    LAS int* seg = tot + 16;
    LAS int* base = seg + 32;
    const GAS int* CNT = (const GAS int*)(ws + RT_CNT);
    if (tid < 16) { int s = 0; for (int w = 0; w < 256; ++w) s += CNT[w * 16 + tid]; tot[tid] = s; }
    __syncthreads();
    if (tid < 2) { int a = 0; for (int e = 0; e < 8; ++e) { seg[tid * 9 + e] = a; a += (tot[tid * 8 + e] + 255) & ~255; } seg[tid * 9 + 8] = a; }
    __syncthreads();
    GAS int* RIDX = (GAS int*)(ws + RT_RIDX); GAS float* RGW = (GAS float*)(ws + RT_RGW);
    if (vcu == 0 && tid < 2) { GAS int* TL = (GAS int*)(ws + RT_TILE) + tid * (PASS_TILES + 8); const int nt = seg[tid * 9 + 8] >> 8; TL[0] = nt;
        for (int e = 0; e < 8; ++e) for (int t = seg[tid * 9 + e] >> 8; t < (seg[tid * 9 + e + 1] >> 8); ++t) TL[8 + t] = e; }
    for (int pe = vcu; pe < 16; pe += G) { const int k = pe >> 3, e = pe & 7; const int s0 = seg[k * 9 + e] + tot[pe], s1 = seg[k * 9 + e + 1];
        for (int i = s0 + tid; i < s1; i += NTHR) { RIDX[k * PASS_ROWS + i] = -1; RGW[k * PASS_ROWS + i] = 0.f; } }
    for (int blk = vcu; blk < TOK / 128; blk += G) {
        __syncthreads();
        if (tid < 16) { int s = 0; for (int w = 0; w < blk; ++w) s += CNT[w * 16 + tid]; base[tid] = seg[(tid >> 3) * 9 + (tid & 7)] + s; }
        __syncthreads();
        if (wave < 2) { const int k = wave;
            int run[8];
#pragma unroll
            for (int e = 0; e < 8; ++e) run[e] = base[k * 8 + e];
            for (int r = 0; r < 2; ++r) { const int row = blk * 128 + r * 64 + lane; const int ex = *(const GAS int*)(ws + RT_SEL + (size_t)row * 8 + 4 * k); const float gwv = *(const GAS float*)(ws + RT_GW + (size_t)row * 8 + 4 * k);
                int mypos = 0;
#pragma unroll
                for (int e = 0; e < 8; ++e) { const unsigned long long mk = __ballot(ex == e); const int rank = __popcll(mk & ((1ull << lane) - 1ull)); if (ex == e) mypos = run[e] + rank; run[e] += __popcll(mk); }
                RIDX[k * PASS_ROWS + mypos] = row; RGW[k * PASS_ROWS + mypos] = gwv; } }
    }
}

namespace att {
constexpr int KVB = 64, KROW = 400, SHM_K = KVB * KROW, SHM_V = KVB * 128 * 2;
constexpr int OFF_V = 0, OFF_K = 2 * SHM_V, OFF_WS = OFF_K + 2 * SHM_K, LDS_BYTES = OFF_WS + NWAVES * 64 * 4;
static_assert(LDS_BYTES <= RING_BYTES, "attention LDS");
#define SBAR() __builtin_amdgcn_sched_barrier(0)
__device__ __forceinline__ int v_st(int k, int c) { const int kk = (k & ~0xC) | ((k & 4) << 1) | ((k & 8) >> 1); return ((kk >> 3) * 4 + (c >> 5)) * 512 + ((kk & 7) * 32 + (c & 31)) * 2; }
__device__ __forceinline__ int v_rd_base(int lane) { return ((lane & 3) << 3) | (((lane >> 2) & 3) << 6) | (((lane >> 4) & 1) << 5) | (((lane >> 5) & 1) << 8); }
constexpr int v_rd_off(int d0, int ks, int half) { return d0 * 512 + ks * 4096 + half * 2048; }
__device__ __forceinline__ int crow(int r, int hi) { return (r & 3) + 8 * (r >> 2) + 4 * hi; }
__device__ __forceinline__ unsigned cvtpk(float lo, float hi) { unsigned r; asm volatile("v_cvt_pk_bf16_f32 %0, %1, %2" : "=v"(r) : "v"(lo), "v"(hi)); return r; }
__device__ __forceinline__ void mask_tile(f32x16& p0, f32x16& p1, int dq) {
    const float NEG = -__builtin_inff();
#pragma unroll
    for (int r = 0; r < 16; ++r) { const int c = (r & 3) + 8 * (r >> 2);
        if (dq - c < 0) p0[r] = NEG;
        if (dq - c - 32 < 0) p1[r] = NEG; }
}
template <int VB>
__device__ __forceinline__ void pv_tile(f32x16* o, int vb0, bf16x8 pa0, bf16x8 pa1, bf16x8 pa2, bf16x8 pa3) {
#define TRRD(dst, off) asm volatile("ds_read_b64_tr_b16 %0, %1 offset:%2" : "=&v"(dst) : "v"(vb0), "i"(off) : "memory")
#define PV_D0(d0) do { s16x4 l0, l1, l2, l3, h0, h1, h2, h3; constexpr int b_ = VB * SHM_V + v_rd_off(d0, 0, 0); \
        TRRD(l0, b_); TRRD(h0, b_ + 2048); TRRD(l1, b_ + 4096); TRRD(h1, b_ + 6144); TRRD(l2, b_ + 8192); TRRD(h2, b_ + 10240); TRRD(l3, b_ + 12288); TRRD(h3, b_ + 14336); \
        asm volatile("s_waitcnt lgkmcnt(0)" ::: "memory"); SBAR(); \
        o[d0] = __builtin_amdgcn_mfma_f32_32x32x16_bf16(pa0, (bf16x8){l0[0], l0[1], l0[2], l0[3], h0[0], h0[1], h0[2], h0[3]}, o[d0], 0, 0, 0); \
        o[d0] = __builtin_amdgcn_mfma_f32_32x32x16_bf16(pa1, (bf16x8){l1[0], l1[1], l1[2], l1[3], h1[0], h1[1], h1[2], h1[3]}, o[d0], 0, 0, 0); \
        o[d0] = __builtin_amdgcn_mfma_f32_32x32x16_bf16(pa2, (bf16x8){l2[0], l2[1], l2[2], l2[3], h2[0], h2[1], h2[2], h2[3]}, o[d0], 0, 0, 0); \
        o[d0] = __builtin_amdgcn_mfma_f32_32x32x16_bf16(pa3, (bf16x8){l3[0], l3[1], l3[2], l3[3], h3[0], h3[1], h3[2], h3[3]}, o[d0], 0, 0, 0); } while (0)
    PV_D0(0); PV_D0(1); PV_D0(2); PV_D0(3);
#undef PV_D0
#undef TRRD
}
template <int KBUF>
__device__ __forceinline__ void qkt(f32x16& p0, f32x16& p1, LAS unsigned char* lds, int r32, int hi, const bf16x8* qr) {
    p0 = f32x16{}; p1 = f32x16{};
    const LAS unsigned char* a = lds + OFF_K + KBUF * SHM_K + r32 * KROW + hi * 16;
#pragma unroll
    for (int d0 = 0; d0 < 12; ++d0) {
        const bf16x8 b0 = *(const LAS bf16x8*)(a + d0 * 32);
        const bf16x8 b1 = *(const LAS bf16x8*)(a + 32 * KROW + d0 * 32);
        p0 = __builtin_amdgcn_mfma_f32_32x32x16_bf16(b0, qr[d0], p0, 0, 0, 0);
        p1 = __builtin_amdgcn_mfma_f32_32x32x16_bf16(b1, qr[d0], p1, 0, 0, 0); }
}
__device__ __forceinline__ void attn_unit(int b, int h, int qb, const bf16* Q, const bf16* K, const bf16* V, bf16* O, const int* pos, LAS unsigned char* lds) {
    int tid_ = threadIdx.x; asm volatile("" : "+v"(tid_));
    const int tid = tid_, wid = __builtin_amdgcn_readfirstlane(tid >> 6), lane = tid & 63, r32 = lane & 31, hi = lane >> 5;
    const int m0 = b * SEQ + qb * 256 + wid * 32;
    const int qpos = qb * 256 + wid * 32;
    bf16x8 qr[12];
    { const bf16* qp = Q + (size_t)(m0 + r32) * NQ + h * 192 + hi * 8; const float C2 = 0.07216878364870323f * 1.4426950408889634f;
      float f[12][8];
#pragma unroll
      for (int d0 = 0; d0 < 12; ++d0) up8(*(const GAS v4u*)(qp + d0 * 16), f[d0]);
      const float ps = (float)pos[m0 + r32];
#pragma unroll
      for (int g = 0; g < 2; ++g)
#pragma unroll
          for (int e = 0; e < 8; ++e) { const int i = 16 * g + 8 * hi + e; float rev = ps * (__builtin_amdgcn_exp2f(-(float)i * (13.287712379549449f / 32.0f)) * 0.15915494309189535f); rev -= rintf(rev);
              const float cs = __builtin_amdgcn_cosf(rev), sn = __builtin_amdgcn_sinf(rev); const float t1 = f[8 + g][e], t2 = f[10 + g][e];
              f[8 + g][e] = t1 * cs - t2 * sn; f[10 + g][e] = t2 * cs + t1 * sn; }
#pragma unroll
      for (int d0 = 0; d0 < 12; ++d0) { v4u w; w.x = cvtpk(f[d0][0] * C2, f[d0][1] * C2); w.y = cvtpk(f[d0][2] * C2, f[d0][3] * C2); w.z = cvtpk(f[d0][4] * C2, f[d0][5] * C2); w.w = cvtpk(f[d0][6] * C2, f[d0][7] * C2);
          qr[d0] = __builtin_bit_cast(bf16x8, w); } }
    const bf16* Kh = K + (size_t)(b * 4 + h) * SEQ * 192; const bf16* Vh = V + (size_t)(b * 4 + h) * SEQ * 128;
    const int NT = (qb + 1) * 4;
    LAS float* wsl = (LAS float*)(lds + OFF_WS) + wid * 64; LAS float* li_l = wsl; LAS float* al_l = wsl + 32;
    float m_reg = -1e30f, l_reg = 0.f; f32x16 o[4] = {};
    const int sr = tid >> 4, sc = (tid & 15) * 8, vst0 = v_st(sr, sc), vst1 = v_st(32 + sr, sc);
    const int vb0 = (int)(uintptr_t)(lds + OFF_V) + v_rd_base(lane);
    int kq[3], kl[3];
#pragma unroll
    for (int i = 0; i < 3; ++i) { const int q = tid + 512 * i; kq[i] = q * 8; kl[i] = (q / 24) * KROW + (q % 24) * 16; }
    v4u sk[3], sv[2];
#define ST_LOAD(t) do { const bf16* kp_ = Kh + (size_t)(t) * KVB * 192; const bf16* vp_ = Vh + (size_t)(t) * KVB * 128; \
        _Pragma("unroll") for (int i = 0; i < 3; ++i) sk[i] = *(const GAS v4u*)(kp_ + kq[i]); \
        sv[0] = *(const GAS v4u*)(vp_ + (size_t)sr * 128 + sc); sv[1] = *(const GAS v4u*)(vp_ + (size_t)(32 + sr) * 128 + sc); } while (0)
#define ST_WRITE(bf) do { _Pragma("unroll") for (int i = 0; i < 3; ++i) *(LAS v4u*)(lds + OFF_K + (bf) * SHM_K + kl[i]) = sk[i]; \
        *(LAS v4u*)(lds + OFF_V + (bf) * SHM_V + vst0) = sv[0]; *(LAS v4u*)(lds + OFF_V + (bf) * SHM_V + vst1) = sv[1]; } while (0)
#define TILE_STEP(t, BF) do { f32x16 p0, p1; \
        if ((t) + 1 < NT) ST_LOAD((t) + 1); \
        qkt<BF>(p0, p1, lds, r32, hi, qr); \
        { const int kb_ = (t) * KVB; if (kb_ + KVB - 1 > qpos) mask_tile(p0, p1, qpos + r32 - 4 * hi - kb_); } \
        float pmax = p0[0]; _Pragma("unroll") for (int r = 1; r < 16; ++r) pmax = fmaxf(pmax, p0[r]); _Pragma("unroll") for (int r = 0; r < 16; ++r) pmax = fmaxf(pmax, p1[r]); \
        { auto rr = __builtin_amdgcn_permlane32_swap(__float_as_uint(pmax), __float_as_uint(pmax), false, false); pmax = fmaxf(__uint_as_float(rr[0]), __uint_as_float(rr[1])); } \
        const float mn = fmaxf(m_reg, pmax), alpha = __builtin_amdgcn_exp2f(m_reg - mn); m_reg = mn; \
        float psum = 0.f; \
        _Pragma("unroll") for (int r = 0; r < 16; ++r) { p0[r] = __builtin_amdgcn_exp2f(p0[r] - mn); p1[r] = __builtin_amdgcn_exp2f(p1[r] - mn); psum += p0[r] + p1[r]; } \
        { auto rr = __builtin_amdgcn_permlane32_swap(__float_as_uint(psum), __float_as_uint(psum), false, false); psum = __uint_as_float(rr[0]) + __uint_as_float(rr[1]); } \
        l_reg = l_reg * alpha + psum; \
        bf16x8 pa0, pa1, pa2, pa3; \
        PK4(p0, 0, pa0); PK4(p0, 8, pa1); PK4(p1, 0, pa2); PK4(p1, 8, pa3); \
        if (__any(alpha < 1.f)) { if (hi == 0) al_l[r32] = alpha; asm volatile("s_waitcnt lgkmcnt(0)" ::: "memory"); \
            _Pragma("unroll") for (int d_ = 0; d_ < 4; ++d_) _Pragma("unroll") for (int r = 0; r < 16; ++r) o[d_][r] *= al_l[crow(r, hi)]; } \
        pv_tile<BF>(o, vb0, pa0, pa1, pa2, pa3); \
        if ((t) + 1 < NT) { VM_WAIT(); ST_WRITE(1 - (BF)); } \
        __syncthreads(); } while (0)
#define PK4(P, B_, OUT) do { unsigned a0 = cvtpk(P[B_+0], P[B_+1]), a1 = cvtpk(P[B_+2], P[B_+3]); \
        unsigned b0 = cvtpk(P[B_+4], P[B_+5]), b1 = cvtpk(P[B_+6], P[B_+7]); \
        auto r0 = __builtin_amdgcn_permlane32_swap(a0, b0, false, false); auto r1 = __builtin_amdgcn_permlane32_swap(a1, b1, false, false); \
        v4u w = {r0[0], r1[0], r0[1], r1[1]}; OUT = __builtin_bit_cast(bf16x8, w); } while (0)
    __syncthreads();
    ST_LOAD(0); VM_WAIT(); ST_WRITE(0);
    __syncthreads();
    for (int t = 0; t < NT; t += 2) { TILE_STEP(t, 0); TILE_STEP(t + 1, 1); }
#undef PK4
#undef TILE_STEP
#undef ST_LOAD
#undef ST_WRITE
    if (hi == 0) li_l[r32] = l_reg;
    asm volatile("s_waitcnt lgkmcnt(0)" ::: "memory");
    float rli[16];
#pragma unroll
    for (int r = 0; r < 16; ++r) rli[r] = __builtin_amdgcn_rcpf(li_l[crow(r, hi)]);
    bf16* Ow = O + (size_t)m0 * DM + h * 128;
#pragma unroll
    for (int r = 0; r < 16; ++r) { const int orow = crow(r, hi);
#pragma unroll
        for (int d0 = 0; d0 < 4; ++d0) { const float v = o[d0][r] * rli[r]; const float vn = lane_xor<1>(v);
            if ((r32 & 1) == 0) *(GAS unsigned*)(Ow + (size_t)orow * DM + d0 * 32 + r32) = cvtpk(v, vn); } }
}
}


namespace rk {
constexpr int RS1 = 144, RS2 = 80;
constexpr int O_AH = 0, O_BH = 4608, O_KH = 9216, O_RH = 13824;
constexpr int O_A2 = 0, O_A3 = 2560, O_A4 = 5120, O_PT = 7680, O_UT = 12800;
constexpr int O_BT = 18432, O_KT = 23552, O_VT = 28672, O_A1 = 33792, O_WC = 37888, UNIT_LDS = 38144;
static_assert(4 * UNIT_LDS <= RING_BYTES, "rwkv precompute LDS");
__device__ __forceinline__ int crow(int r, int hi) { return (r & 3) + 8 * (r >> 2) + 4 * hi; }
__device__ __forceinline__ float xsum32(float v) { const auto rr = __builtin_amdgcn_permlane32_swap(__float_as_uint(v), __float_as_uint(v), false, false); return __uint_as_float(rr[0]) + __uint_as_float(rr[1]); }
#define RK_FRAG(off, row, stride, q) (*(const LAS bf16x8*)(U + (off) + (row) * (stride) + (16 * (q) + 8 * hi) * 2))
#define RK_MFMA(a, b, c) __builtin_amdgcn_mfma_f32_32x32x16_bf16((a), (b), (c), 0, 0, 0)

__device__ __forceinline__ void pre_unit(int l, int b, int hd, int ck, unsigned char* ws, LAS unsigned char* U) {
    int lane_ = (int)__builtin_amdgcn_mbcnt_hi(~0u, __builtin_amdgcn_mbcnt_lo(~0u, 0u)); asm volatile("" : "+v"(lane_));
    const int lane = lane_, r32 = lane & 31, hi = lane >> 5;
    const int tok0 = b * SEQ + ck * 32;
    const size_t gofs = (size_t)tok0 * RW + hd * 64;
    bf16* Rg = (bf16*)(ws + A_R) + gofs; bf16* Kg = (bf16*)(ws + A_KRAW) + gofs; bf16* KKg = (bf16*)(ws + A_KK) + gofs; bf16* BVg = (bf16*)(ws + A_BV) + gofs;
    const bf16* Vg = (const bf16*)(ws + ((l == 0) ? WS_VFIRST : A_VRAW)) + gofs; float* LWg = (float*)(ws + A_LW) + gofs;
    { float L = 0.f, E3 = 1.f;
#pragma unroll 1
      for (int t8 = 0; t8 < 32; t8 += 8) {
          float lwv[8]; unsigned short rv[8], kv[8], kkv[8], bv[8], vv[8];
#pragma unroll
          for (int u = 0; u < 8; ++u) { const size_t o = (size_t)(t8 + u) * RW + lane; lwv[u] = LWg[o]; rv[u] = Rg[o]; kv[u] = Kg[o]; kkv[u] = KKg[o]; bv[u] = BVg[o]; vv[u] = Vg[o]; }
          float bh[8], kh[8];
#pragma unroll
          for (int u = 0; u < 8; ++u) { L += lwv[u]; const float E1 = __expf(L), E2 = __builtin_amdgcn_rcpf(E1);
              const float ah = -bf2f(kkv[u]) * E3, rh = bf2f(rv[u]) * E1; bh[u] = bf2f(bv[u]) * E2; kh[u] = bf2f(kv[u]) * E2; E3 = E1;
              const int t = t8 + u;
              *(LAS unsigned short*)(U + O_AH + t * RS1 + lane * 2) = (unsigned short)cvt_pk_bf16(ah, 0.f);
              *(LAS unsigned short*)(U + O_RH + t * RS1 + lane * 2) = (unsigned short)cvt_pk_bf16(rh, 0.f);
              *(LAS unsigned short*)(U + O_BH + t * RS1 + lane * 2) = (unsigned short)cvt_pk_bf16(bh[u], 0.f);
              *(LAS unsigned short*)(U + O_KH + t * RS1 + lane * 2) = (unsigned short)cvt_pk_bf16(kh[u], 0.f); }
          v4u w;
          w.x = cvt_pk_bf16(bh[0], bh[1]); w.y = cvt_pk_bf16(bh[2], bh[3]); w.z = cvt_pk_bf16(bh[4], bh[5]); w.w = cvt_pk_bf16(bh[6], bh[7]); *(LAS v4u*)(U + O_BT + lane * RS2 + t8 * 2) = w;
          w.x = cvt_pk_bf16(kh[0], kh[1]); w.y = cvt_pk_bf16(kh[2], kh[3]); w.z = cvt_pk_bf16(kh[4], kh[5]); w.w = cvt_pk_bf16(kh[6], kh[7]); *(LAS v4u*)(U + O_KT + lane * RS2 + t8 * 2) = w;
          w.x = (unsigned)vv[0] | ((unsigned)vv[1] << 16); w.y = (unsigned)vv[2] | ((unsigned)vv[3] << 16); w.z = (unsigned)vv[4] | ((unsigned)vv[5] << 16); w.w = (unsigned)vv[6] | ((unsigned)vv[7] << 16); *(LAS v4u*)(U + O_VT + lane * RS2 + t8 * 2) = w;
      }
      *(LAS float*)(U + O_WC + lane * 4) = E3; }
    LDS_WAIT(); asm volatile("" ::: "memory");
    f32x16 X[4];
    f32x16 rhc[2];
    { f32x16 d1 = {}, d2 = {}, d3 = {}, d4 = {};
#pragma unroll
      for (int q = 0; q < 4; ++q) { const bf16x8 fa = RK_FRAG(O_AH, r32, RS1, q), fb = RK_FRAG(O_BH, r32, RS1, q), fk = RK_FRAG(O_KH, r32, RS1, q), fr = RK_FRAG(O_RH, r32, RS1, q);
          d1 = RK_MFMA(fb, fa, d1); d2 = RK_MFMA(fk, fa, d2); d3 = RK_MFMA(fb, fr, d3); d4 = RK_MFMA(fk, fr, d4); }
#pragma unroll
      for (int jt = 0; jt < 2; ++jt)
#pragma unroll
          for (int r = 0; r < 16; ++r) { X[jt][r] = bf2f(*(const LAS unsigned short*)(U + O_AH + crow(r, hi) * RS1 + (r32 + 32 * jt) * 2)); rhc[jt][r] = bf2f(*(const LAS unsigned short*)(U + O_RH + crow(r, hi) * RS1 + (r32 + 32 * jt) * 2)); }
      LDS_WAIT(); asm volatile("" ::: "memory");
#pragma unroll
      for (int r = 0; r < 16; ++r) { const int s = crow(r, hi); const bool lt = s < r32, le = s <= r32; d1[r] = lt ? d1[r] : 0.f; d2[r] = lt ? d2[r] : 0.f; d3[r] = le ? d3[r] : 0.f; d4[r] = le ? d4[r] : 0.f; }
#pragma unroll
      for (int g = 0; g < 4; ++g) { const int so = 8 * g + 4 * hi;
          *(LAS f32x4*)(U + O_A1 + r32 * 128 + so * 4) = (f32x4){d1[4 * g], d1[4 * g + 1], d1[4 * g + 2], d1[4 * g + 3]};
          *(LAS v2u*)(U + O_A2 + r32 * RS2 + so * 2) = (v2u){cvt_pk_bf16(d2[4 * g], d2[4 * g + 1]), cvt_pk_bf16(d2[4 * g + 2], d2[4 * g + 3])};
          *(LAS v2u*)(U + O_A3 + r32 * RS2 + so * 2) = (v2u){cvt_pk_bf16(d3[4 * g], d3[4 * g + 1]), cvt_pk_bf16(d3[4 * g + 2], d3[4 * g + 3])};
          *(LAS v2u*)(U + O_A4 + r32 * RS2 + so * 2) = (v2u){cvt_pk_bf16(d4[4 * g], d4[4 * g + 1]), cvt_pk_bf16(d4[4 * g + 2], d4[4 * g + 3])}; } }
    LDS_WAIT(); asm volatile("" ::: "memory");
    X[2] = f32x16{}; X[3] = f32x16{};
#pragma unroll
    for (int q = 0; q < 2; ++q) { const bf16x8 fa = RK_FRAG(O_A2, r32, RS2, q);
        X[2] = RK_MFMA(fa, RK_FRAG(O_VT, r32, RS2, q), X[2]); X[3] = RK_MFMA(fa, RK_FRAG(O_VT, r32 + 32, RS2, q), X[3]); }
#pragma unroll
    for (int t = 1; t < 32; ++t) {
        float p0 = 0.f, p1 = 0.f, p2 = 0.f, p3 = 0.f;
#pragma unroll
        for (int g = 0; g < 4; ++g) if (8 * g < t) { const f32x4 cf = *(const LAS f32x4*)(U + O_A1 + t * 128 + (8 * g + 4 * hi) * 4);
#pragma unroll
            for (int e = 0; e < 4; ++e) { p0 += cf[e] * X[0][4 * g + e]; p1 += cf[e] * X[1][4 * g + e]; p2 += cf[e] * X[2][4 * g + e]; p3 += cf[e] * X[3][4 * g + e]; } }
        p0 = xsum32(p0); p1 = xsum32(p1); p2 = xsum32(p2); p3 = xsum32(p3);
        const bool own = hi == ((t >> 2) & 1); const int rt = (t & 3) + 4 * (t >> 3);
        X[0][rt] += own ? p0 : 0.f; X[1][rt] += own ? p1 : 0.f; X[2][rt] += own ? p2 : 0.f; X[3][rt] += own ? p3 : 0.f;
    }
#pragma unroll
    for (int tl = 0; tl < 4; ++tl)
#pragma unroll
        for (int g = 0; g < 4; ++g) *(LAS v2u*)(U + (tl < 2 ? O_PT : O_UT) + (r32 + 32 * (tl & 1)) * RS2 + (8 * g + 4 * hi) * 2) = (v2u){cvt_pk_bf16(X[tl][4 * g], X[tl][4 * g + 1]), cvt_pk_bf16(X[tl][4 * g + 2], X[tl][4 * g + 3])};
    LDS_WAIT(); asm volatile("" ::: "memory");
    const float wc0 = *(const LAS float*)(U + O_WC + r32 * 4), wc1 = *(const LAS float*)(U + O_WC + (r32 + 32) * 4);
    { f32x16 y0 = {}, y1 = {};
#pragma unroll
      for (int q = 0; q < 2; ++q) { const bf16x8 f3 = RK_FRAG(O_A3, r32, RS2, q), f4 = RK_FRAG(O_A4, r32, RS2, q);
          rhc[0] = RK_MFMA(f3, RK_FRAG(O_PT, r32, RS2, q), rhc[0]); rhc[1] = RK_MFMA(f3, RK_FRAG(O_PT, r32 + 32, RS2, q), rhc[1]);
          y0 = RK_MFMA(f3, RK_FRAG(O_UT, r32, RS2, q), y0); y1 = RK_MFMA(f3, RK_FRAG(O_UT, r32 + 32, RS2, q), y1);
          y0 = RK_MFMA(f4, RK_FRAG(O_VT, r32, RS2, q), y0); y1 = RK_MFMA(f4, RK_FRAG(O_VT, r32 + 32, RS2, q), y1); }
#pragma unroll
      for (int jt = 0; jt < 2; ++jt) { const int j = r32 + 32 * jt, pj = (j & ~0xC) | ((j & 4) << 1) | ((j & 8) >> 1);
#pragma unroll
          for (int r = 0; r < 16; ++r) Rg[(size_t)crow(r, hi) * RW + pj] = (unsigned short)cvt_pk_bf16(rhc[jt][r], 0.f); }
#pragma unroll
      for (int it = 0; it < 2; ++it)
#pragma unroll
          for (int hf = 0; hf < 2; ++hf) { const f32x16& y = it ? y1 : y0; const int off = ((it * 2 + hf) * 64 + lane) * 16;
              v4u w; w.x = cvt_pk_bf16(y[8 * hf], y[8 * hf + 1]); w.y = cvt_pk_bf16(y[8 * hf + 2], y[8 * hf + 3]); w.z = cvt_pk_bf16(y[8 * hf + 4], y[8 * hf + 5]); w.w = cvt_pk_bf16(y[8 * hf + 6], y[8 * hf + 7]);
              *(GAS v4u*)((unsigned char*)KKg + (size_t)(off >> 7) * (RW * 2) + (off & 127)) = w; } }
#pragma unroll
    for (int tj = 0; tj < 2; ++tj)
#pragma unroll
        for (int tp = 0; tp < 2; ++tp) { f32x16 z = {};
#pragma unroll
            for (int q = 0; q < 2; ++q) z = RK_MFMA(RK_FRAG(O_PT, r32 + 32 * tj, RS2, q), RK_FRAG(O_BT, r32 + 32 * tp, RS2, q), z);
            const float wc = tp ? wc1 : wc0;
#pragma unroll
            for (int r = 0; r < 16; ++r) z[r] = (z[r] + ((tj == tp && crow(r, hi) == r32) ? 1.f : 0.f)) * wc;
#pragma unroll
            for (int hf = 0; hf < 2; ++hf) { const int off = (((tj * 2 + tp) * 2 + hf) * 64 + lane) * 16;
                v4u w; w.x = cvt_pk_bf16(z[8 * hf], z[8 * hf + 1]); w.y = cvt_pk_bf16(z[8 * hf + 2], z[8 * hf + 3]); w.z = cvt_pk_bf16(z[8 * hf + 4], z[8 * hf + 5]); w.w = cvt_pk_bf16(z[8 * hf + 6], z[8 * hf + 7]);
                *(GAS v4u*)((unsigned char*)LWg + (size_t)(off >> 8) * (RW * 4) + (off & 255)) = w; } }
#pragma unroll
    for (int tp = 0; tp < 2; ++tp)
#pragma unroll
        for (int ti = 0; ti < 2; ++ti) { f32x16 z = {};
#pragma unroll
            for (int q = 0; q < 2; ++q) { z = RK_MFMA(RK_FRAG(O_BT, r32 + 32 * tp, RS2, q), RK_FRAG(O_UT, r32 + 32 * ti, RS2, q), z); z = RK_MFMA(RK_FRAG(O_KT, r32 + 32 * tp, RS2, q), RK_FRAG(O_VT, r32 + 32 * ti, RS2, q), z); }
#pragma unroll
            for (int g = 0; g < 4; ++g) { const f32x4 wv = *(const LAS f32x4*)(U + O_WC + (32 * tp + 8 * g + 4 * hi) * 4);
#pragma unroll
                for (int e = 0; e < 4; ++e) z[4 * g + e] *= wv[e]; }
            unsigned char* dst = (unsigned char*)(tp ? BVg : Kg);
#pragma unroll
            for (int hf = 0; hf < 2; ++hf) { const int off = ((ti * 2 + hf) * 64 + lane) * 16;
                v4u w; w.x = cvt_pk_bf16(z[8 * hf], z[8 * hf + 1]); w.y = cvt_pk_bf16(z[8 * hf + 2], z[8 * hf + 3]); w.z = cvt_pk_bf16(z[8 * hf + 4], z[8 * hf + 5]); w.w = cvt_pk_bf16(z[8 * hf + 6], z[8 * hf + 7]);
                *(GAS v4u*)(dst + (size_t)(off >> 7) * (RW * 2) + (off & 127)) = w; } }
    LDS_WAIT(); asm volatile("" ::: "memory");
}

__device__ __forceinline__ void scan_unit(int q, int ih, unsigned char* ws) {
    const int lane = (int)__builtin_amdgcn_mbcnt_hi(~0u, __builtin_amdgcn_mbcnt_lo(~0u, 0u)), r32 = lane & 31, hi = lane >> 5;
    const int b = q >> 3, hd = q & 7;
    const size_t gofs0 = (size_t)b * SEQ * RW + hd * 64;
    const unsigned char* Rg = (const unsigned char*)((const bf16*)(ws + A_R) + gofs0); const unsigned char* Kg = (const unsigned char*)((const bf16*)(ws + A_KRAW) + gofs0);
    const unsigned char* KKg = (const unsigned char*)((const bf16*)(ws + A_KK) + gofs0); const unsigned char* BVg = (const unsigned char*)((const bf16*)(ws + A_BV) + gofs0);
    const unsigned char* LWg = (const unsigned char*)((const float*)(ws + A_LW) + gofs0);
    bf16* Yg = (bf16*)(ws + A_YCAT) + (size_t)b * SEQ * DM + 512 + hd * 64 + 32 * ih + r32;
    int oR[4], oY[2], oM[8], oG[4];
#pragma unroll
    for (int k = 0; k < 4; ++k) oR[k] = r32 * (RW * 2) + (16 * k + 8 * hi) * 2;
#pragma unroll
    for (int hf = 0; hf < 2; ++hf) { const int off = ((ih * 2 + hf) * 64 + lane) * 16; oY[hf] = (off >> 7) * (RW * 2) + (off & 127); }
#pragma unroll
    for (int m = 0; m < 8; ++m) { const int off = (m * 64 + lane) * 16; oM[m] = (off >> 8) * (RW * 4) + (off & 255); }
#pragma unroll
    for (int tp = 0; tp < 2; ++tp)
#pragma unroll
        for (int hf = 0; hf < 2; ++hf) { const int off = ((ih * 2 + hf) * 64 + lane) * 16; oG[tp * 2 + hf] = (off >> 7) * (RW * 2) + (off & 127); }
    f32x16 S0 = {}, S1 = {};
    v4u nR[4], nY[2], nM[8], nG[4];
#define RK_LOADS(ck) do { const size_t cb2 = (size_t)(ck) * 32 * (RW * 2), cb4 = (size_t)(ck) * 32 * (RW * 4); \
        _Pragma("unroll") for (int k = 0; k < 4; ++k) nR[k] = *(const GAS v4u*)(Rg + cb2 + oR[k]); \
        _Pragma("unroll") for (int k = 0; k < 2; ++k) nY[k] = *(const GAS v4u*)(KKg + cb2 + oY[k]); \
        _Pragma("unroll") for (int k = 0; k < 8; ++k) nM[k] = *(const GAS v4u*)(LWg + cb4 + oM[k]); \
        nG[0] = *(const GAS v4u*)(Kg + cb2 + oG[0]); nG[1] = *(const GAS v4u*)(Kg + cb2 + oG[1]); nG[2] = *(const GAS v4u*)(BVg + cb2 + oG[2]); nG[3] = *(const GAS v4u*)(BVg + cb2 + oG[3]); } while (0)
    RK_LOADS(0);
#pragma unroll 1
    for (int ck = 0; ck < SEQ / 32; ++ck) {
        v4u cR[4], cY[2], cM[8], cG[4];
#pragma unroll
        for (int k = 0; k < 4; ++k) cR[k] = nR[k];
#pragma unroll
        for (int k = 0; k < 2; ++k) cY[k] = nY[k];
#pragma unroll
        for (int k = 0; k < 8; ++k) cM[k] = nM[k];
#pragma unroll
        for (int k = 0; k < 4; ++k) cG[k] = nG[k];
        if (ck + 1 < SEQ / 32) RK_LOADS(ck + 1);
        bf16x8 sb[4];
#pragma unroll
        for (int kq = 0; kq < 4; ++kq) { const f32x16& s = (kq >> 1) ? S1 : S0; const int o = 8 * (kq & 1);
            v4u w; w.x = cvt_pk_bf16(s[o], s[o + 1]); w.y = cvt_pk_bf16(s[o + 2], s[o + 3]); w.z = cvt_pk_bf16(s[o + 4], s[o + 5]); w.w = cvt_pk_bf16(s[o + 6], s[o + 7]); sb[kq] = __builtin_bit_cast(bf16x8, w); }
        f32x16 y, n0, n1;
#pragma unroll
        for (int hf = 0; hf < 2; ++hf) { const v4u w = cY[hf]; y[8 * hf] = bflo(w.x); y[8 * hf + 1] = bfhi(w.x); y[8 * hf + 2] = bflo(w.y); y[8 * hf + 3] = bfhi(w.y); y[8 * hf + 4] = bflo(w.z); y[8 * hf + 5] = bfhi(w.z); y[8 * hf + 6] = bflo(w.w); y[8 * hf + 7] = bfhi(w.w); }
#pragma unroll
        for (int hf = 0; hf < 2; ++hf) { const v4u w = cG[hf], x = cG[2 + hf];
            n0[8 * hf] = bflo(w.x); n0[8 * hf + 1] = bfhi(w.x); n0[8 * hf + 2] = bflo(w.y); n0[8 * hf + 3] = bfhi(w.y); n0[8 * hf + 4] = bflo(w.z); n0[8 * hf + 5] = bfhi(w.z); n0[8 * hf + 6] = bflo(w.w); n0[8 * hf + 7] = bfhi(w.w);
            n1[8 * hf] = bflo(x.x); n1[8 * hf + 1] = bfhi(x.x); n1[8 * hf + 2] = bflo(x.y); n1[8 * hf + 3] = bfhi(x.y); n1[8 * hf + 4] = bflo(x.z); n1[8 * hf + 5] = bfhi(x.z); n1[8 * hf + 6] = bflo(x.w); n1[8 * hf + 7] = bfhi(x.w); }
#pragma unroll
        for (int kq = 0; kq < 4; ++kq) {
            y = RK_MFMA(__builtin_bit_cast(bf16x8, cR[kq]), sb[kq], y);
            n0 = RK_MFMA(__builtin_bit_cast(bf16x8, cM[((kq >> 1) * 2 + 0) * 2 + (kq & 1)]), sb[kq], n0);
            n1 = RK_MFMA(__builtin_bit_cast(bf16x8, cM[((kq >> 1) * 2 + 1) * 2 + (kq & 1)]), sb[kq], n1); }
        S0 = n0; S1 = n1;
        bf16* yp = Yg + (size_t)ck * 32 * DM;
#pragma unroll
        for (int r = 0; r < 16; ++r) yp[(size_t)crow(r, hi) * DM] = (unsigned short)cvt_pk_bf16(y[r], 0.f);
    }
#undef RK_LOADS
}
#undef RK_FRAG
#undef RK_MFMA
}

__device__ __forceinline__ void post_phase(int l, const float* gao, const float* lnwp, const float* lnbp, unsigned char* ws, int gw, int NGW, int lane) {
    float gn[8], lw8[8], lb8[8];
#pragma unroll
    for (int e = 0; e < 8; ++e) { gn[e] = gao[lane * 8 + e]; lw8[e] = lnwp[lane * 8 + e]; lb8[e] = lnbp[lane * 8 + e]; }
    const bf16* Vv = (const bf16*)(ws + ((l == 0) ? WS_VFIRST : A_VRAW)); const bf16* Gg = (const bf16*)(ws + A_G); const float* BON = (const float*)(ws + A_BON);
    for (int m = gw; m < TOK; m += NGW) {
        GAS v4u* pp = (GAS v4u*)((bf16*)(ws + A_YCAT) + (size_t)m * DM + lane * 8); float p[8]; up8(*pp, p); float ss = 0.f;
        GAS v4u* py = (GAS v4u*)((bf16*)(ws + A_YCAT) + (size_t)m * DM + 512 + lane * 8); float y[8], v[8], g[8]; up8(*py, y);
        up8(*(const GAS v4u*)(Vv + (size_t)m * RW + lane * 8), v); up8(*(const GAS v4u*)(Gg + (size_t)m * RW + lane * 8), g);
        const float bon = BON[(size_t)m * 8 + (lane >> 3)];
#pragma unroll
        for (int e = 0; e < 8; ++e) ss += p[e] * p[e];
        const float rstd = 1.0f / sqrtf(wave_sum(ss) * (1.0f / 512.0f) + 1e-6f);
#pragma unroll
        for (int e = 0; e < 8; ++e) p[e] = p[e] * rstd * gn[e];
        *pp = pk8(p);
        float s1 = 0.f;
#pragma unroll
        for (int e = 0; e < 8; ++e) s1 += y[e];
        s1 += lane_xor<1>(s1); s1 += lane_xor<2>(s1); s1 += lane_xor<4>(s1);
        const float mean = s1 * (1.0f / 64.0f); float s2 = 0.f;
#pragma unroll
        for (int e = 0; e < 8; ++e) { y[e] -= mean; s2 += y[e] * y[e]; }
        s2 += lane_xor<1>(s2); s2 += lane_xor<2>(s2); s2 += lane_xor<4>(s2);
        const float rs = 1.0f / sqrtf(s2 * (1.0f / 64.0f) + 64e-5f);
#pragma unroll
        for (int e = 0; e < 8; ++e) y[e] = (y[e] * rs * lw8[e] + lb8[e] + bon * v[e]) * g[e];
        *py = pk8(y);
    }
}

constexpr int N_PHASES = 27;
struct Args { In in; float* out; unsigned char* ws; int ph_lo, ph_hi; };
static_assert(sizeof(Args) == 38 * 8 + 8 + 8 + 8, "Args has padding");

__global__ void __launch_bounds__(NTHR, 2) mega_fwd(Args args) {
    extern __shared__ __attribute__((aligned(16))) unsigned char lds_raw[];
    LAS unsigned char* lds = (LAS unsigned char*)lds_raw;
#define OPAQUE_IDS(TID0, BX0) int tid = (TID0); asm volatile("" : "+v"(tid)); int bx = (BX0); asm volatile("" : "+s"(bx)); \
    const int lane = tid & 63, wave = __builtin_amdgcn_readfirstlane(tid >> 6); const int G = gridDim.x; \
    const int vcu = (G % 8 == 0) ? (bx % 8) * (G / 8) + bx / 8 : bx; \
    const int gw = vcu * NWAVES + wave, NGW = G * NWAVES, gtid = vcu * NTHR + tid, NGT = G * NTHR; (void)gw; (void)NGW; (void)gtid; (void)NGT; (void)lane
    OPAQUE_IDS(threadIdx.x, blockIdx.x);
    for (int u = tid; u < (LDS_BYTES - LDSCTL_OFF) / 4; u += NTHR) ((LAS unsigned*)(lds + LDSCTL_OFF))[u] = 0u;
    __syncthreads();
    if (tid < 40) { const unsigned long long v = (tid < 38) ? (unsigned long long)args.in.p[tid] : (tid == 38 ? (unsigned long long)args.ws : (unsigned long long)args.out);
        ((LAS unsigned*)(lds + PTAB_OFF))[2 * tid] = (unsigned)v; ((LAS unsigned*)(lds + PTAB_OFF))[2 * tid + 1] = (unsigned)(v >> 32); }
    __syncthreads();
    const InT in{(volatile LAS unsigned*)(lds + PTAB_OFF)};
    gu32* ctl = (gu32*)(args.ws + WS_CTL);
    XcdBarrier bar; bar.bar = (unsigned*)(ctl + CW_BAR); bar.x = 0; bar.st = nullptr;
    if (!MK_SPLIT) bar = xcd_barrier_post((unsigned*)(ctl + CW_BAR), (volatile LAS unsigned*)(lds + MISC_OFF) + 8);
    const int lo = args.ph_lo, hi = args.ph_hi;
#ifndef PH_MASK
#define PH_MASK 0xffffffffu
#endif
#define IN_PH(bit, k) (((PH_MASK >> (bit)) & 1u) && lo <= (k) && (k) < hi)
#define BAR_AFTER(k) do { if ((k) + 1 < hi) { if (!MK_SPLIT) xcd_barrier(bar); } } while (0)
#define PH_PTRS unsigned char* ws = (unsigned char*)in[38]; float* out = (float*)in[39]; const float* modl = (const float*)(ws + WS_MOD) + (size_t)l * NB * MODLD; (void)out; (void)modl

    if (IN_PH(0, 0)) { const int l = 0; PH_PTRS; p0_mod(in, ws, lds, vcu, G, wave, lane, tid); __syncthreads(); p0_weights(in, ws, lds, gw, NGW, wave, lane, gtid, NGT); BAR_AFTER(0); }

    {
        constexpr int l = 0;
        const int pb = 1 + 11 * l;
        OPAQUE_IDS(threadIdx.x, blockIdx.x);
        if (IN_PH(1, pb + 0)) { PH_PTRS; const float* xres = (l == 0) ? in[0] : out; norm_phase<false>(xres, in[5] + (size_t)l * DM, modl, 0, (bf16*)(ws + A_H), nullptr, nullptr, ws, lds, vcu, G, wave, lane, tid); BAR_AFTER(pb + 0); }
        if (IN_PH(2, pb + 1)) { PH_PTRS;
            pg8::Gemm g{(const bf16*)(ws + A_H), (const bf16*)(ws + WS_WIN) + (size_t)l * NPROJ * DM, TOK, NPROJ, DM, nullptr, nullptr, 0};
            pg8::StaticOrder S; S.init(TOK, NPROJ, G, bx);
            pg8::EpiBf16<0> E{(bf16*)(ws + A_PROJ), NPROJ, nullptr, 0, 0, 1.f};
            pg8::gemm_phase<pg8::EpiBf16<0>, pg8::StaticOrder, true, true, 0>(lds, g, S, E);
            BAR_AFTER(pb + 1); }
        if (IN_PH(3, pb + 2)) { PH_PTRS; prep_phase(l, in, ws, gw, NGW, lane); BAR_AFTER(pb + 2); }
        if (IN_PH(4, pb + 3)) { PH_PTRS;
#ifndef P4_MASK
#define P4_MASK 7
#endif
            if (P4_MASK & 1) { pg8::Gemm g{(const bf16*)(ws + A_CQ), (const bf16*)(ws + WS_WUQ) + (size_t)l * NQ * 256, TOK, NQ, 256, nullptr, nullptr, 0};
              pg8::StaticOrder S; S.init(TOK, NQ, G, (bx + G / 2) % G);
              pg8::EpiBf16<0> E{(bf16*)(ws + A_Q), NQ, nullptr, 0, 0, 1.f};
              pg8::gemm_phase<pg8::EpiBf16<0>, pg8::StaticOrder, true, true, 0>(lds, g, S, E); }
            __syncthreads();
            if (P4_MASK & 2) { pg8::Gemm g{(const bf16*)(ws + A_CKV), (const bf16*)(ws + WS_WUKV) + (size_t)l * NKV * 128, TOK, NKV, 128, nullptr, nullptr, 0};
              pg8::StaticOrder S; S.init(TOK, NKV, G, bx);
              pg8::EpiKV E{(bf16*)(ws + A_KB), (bf16*)(ws + A_VB)};
              pg8::gemm_phase<pg8::EpiKV, pg8::StaticOrder, true, true, 0>(lds, g, S, E); }
            __syncthreads();
            if (P4_MASK & 4) { const int nl = (l == 0) ? 1536 : NLORA;
              pg8::Gemm g{(const bf16*)(ws + A_LA), (const bf16*)(ws + WS_WLORA) + (size_t)l * NLORA * KLORA, TOK, nl, KLORA, nullptr, nullptr, 0};
              pg8::StaticOrder S; S.init(TOK, nl, G, bx);
              pg8::EpiLora E{in[16] + (size_t)l * RW, in[18] + (size_t)l * RW, in[21], in[23] + (size_t)l * RW, in[24] + (size_t)l * RW,
                             (float*)(ws + A_LW), (bf16*)(ws + A_KRAW), (bf16*)(ws + A_KK), (bf16*)(ws + A_BV), (bf16*)(ws + A_G), (bf16*)(ws + A_VRAW), (const bf16*)(ws + WS_VFIRST), (const bf16*)(ws + A_R), in[25] + (size_t)l * RW, (float*)(ws + A_BON)};
              pg8::gemm_phase<pg8::EpiLora, pg8::StaticOrder, true, true, 0>(lds, g, S, E); }
            BAR_AFTER(pb + 3); }
        if (IN_PH(5, pb + 4)) { PH_PTRS;
            if (wave < 4) { for (int u = vcu * 4 + wave; u < 64 * (SEQ / 32); u += G * 4) { const int q = u & 63, ck = u >> 6; rk::pre_unit(l, q >> 3, q & 7, ck, ws, lds + wave * rk::UNIT_LDS); } }
            BAR_AFTER(pb + 4); }
        if (IN_PH(6, pb + 5)) { PH_PTRS;
            if (vcu < 32) { if (wave < 4) { const int si = vcu * 4 + wave; rk::scan_unit(si >> 1, si & 1, ws); } __syncthreads(); }
            volatile LAS unsigned* qslot = (volatile LAS unsigned*)(lds + MISC_OFF) + 16;
            for (;;) {
                __syncthreads();
                if (tid == 0) qslot[0] = __hip_atomic_fetch_add(ctl + CW_QCTR + 64 * l, 1u, RLX_AGENT);
                __syncthreads();
                const int u = (int)qslot[0];
                if (u >= 512) break;
                const int qb = 15 - (u >> 5), bh = u & 31;
                att::attn_unit(bh >> 2, bh & 3, qb, (const bf16*)(ws + A_Q), (const bf16*)(ws + A_KB), (const bf16*)(ws + A_VB), (bf16*)(ws + A_YCAT), (const int*)in[2], lds);
            }
            BAR_AFTER(pb + 5); }
        if (IN_PH(7, pb + 6)) { PH_PTRS; post_phase(l, in[13] + (size_t)l * 512, in[26] + (size_t)l * RW, in[27] + (size_t)l * RW, ws, gw, NGW, lane); if (l == 1) p_expert_weights(in, ws, lds, gw, NGW, wave, lane); BAR_AFTER(pb + 6); }
        if (IN_PH(8, pb + 7)) { PH_PTRS; const float* xres = (l == 0) ? in[0] : out;
            pg8::Gemm g{(const bf16*)(ws + A_YCAT), (const bf16*)(ws + WS_WOUT) + (size_t)l * DM * DM, TOK, DM, DM, nullptr, nullptr, 0};
            pg8::StaticOrder S; S.init(TOK, DM, G, bx);
            pg8::EpiResid E{xres, out, modl + 2048};
            pg8::gemm_phase<pg8::EpiResid, pg8::StaticOrder, true, true, 0>(lds, g, S, E);
            BAR_AFTER(pb + 7); }
        if (IN_PH(9, pb + 8)) { PH_PTRS;
            if (l == 0) norm_phase<false>(out, in[6] + (size_t)l * DM, modl, 3072, (bf16*)(ws + A_H), nullptr, nullptr, ws, lds, vcu, G, wave, lane, tid);
            else norm_phase<true>(out, in[6] + (size_t)l * DM, modl, 3072, (bf16*)(ws + A_H), in[32], in[33], ws, lds, vcu, G, wave, lane, tid);
            BAR_AFTER(pb + 8); }
        if (l == 0) {
            if (IN_PH(10, 10)) { PH_PTRS;
                pg8::Gemm g{(const bf16*)(ws + A_H), (const bf16*)(ws + WS_WF1), TOK, 2 * FFD, DM, nullptr, nullptr, 0};
                pg8::StaticOrder S; S.init(TOK, 2 * FFD, G, bx);
                pg8::EpiSwiGLU E{(bf16*)(ws + A_HID), FFD};
                pg8::gemm_phase<pg8::EpiSwiGLU, pg8::StaticOrder, true, true, 0>(lds, g, S, E);
                BAR_AFTER(10); }
            if (IN_PH(11, 11)) { PH_PTRS;
                pg8::Gemm g{(const bf16*)(ws + A_HID), (const bf16*)(ws + WS_WF2), TOK, DM, FFD, nullptr, nullptr, 0};
                pg8::StaticOrder S; S.init(TOK, DM, G, bx);
                pg8::EpiResid E{out, out, modl + 5120};
                pg8::gemm_phase<pg8::EpiResid, pg8::StaticOrder, true, true, 0>(lds, g, S, E);
                BAR_AFTER(11); }
        } else {
            if (IN_PH(12, 21)) { PH_PTRS; route_scatter(ws, lds, vcu, G, wave, lane, tid); BAR_AFTER(21); }
#pragma unroll
            for (int k = 0; k < 2; ++k) {
                if (IN_PH(13, 22 + 2 * k)) { PH_PTRS; const int* TL = (const int*)(ws + RT_TILE) + k * (PASS_TILES + 8); const int* ridx = (const int*)(ws + RT_RIDX) + (size_t)k * PASS_ROWS;
                    const int nt = __builtin_amdgcn_readfirstlane(TL[0]);
                    pg8::Gemm g{(const bf16*)(ws + A_H), (const bf16*)(ws + A_WE1), nt * 256, 2 * FFE, DM, ridx, TL + 8, (size_t)2 * FFE * DM * 2};
                    pg8::StaticOrder S; S.init(nt * 256, 2 * FFE, G, bx);
                    pg8::EpiSwiGLU E{(bf16*)(ws + A_HID), FFE};
                    pg8::gemm_phase<pg8::EpiSwiGLU, pg8::StaticOrder, true, true, 1>(lds, g, S, E);
                    BAR_AFTER(22 + 2 * k); }
                if (IN_PH(14, 23 + 2 * k)) { PH_PTRS; const int* TL = (const int*)(ws + RT_TILE) + k * (PASS_TILES + 8); const int* ridx = (const int*)(ws + RT_RIDX) + (size_t)k * PASS_ROWS; const float* rgw = (const float*)(ws + RT_RGW) + (size_t)k * PASS_ROWS;
                    const int nt = __builtin_amdgcn_readfirstlane(TL[0]);
                    pg8::Gemm g{(const bf16*)(ws + A_HID), (const bf16*)(ws + A_WE2), nt * 256, DM, FFE, nullptr, TL + 8, (size_t)DM * FFE * 2};
                    pg8::StaticOrder S; S.init(nt * 256, DM, G, bx);
                    pg8::EpiMoE2 E{out, modl + 5120, ridx, rgw};
                    pg8::gemm_phase<pg8::EpiMoE2, pg8::StaticOrder, true, true, 2>(lds, g, S, E);
                    BAR_AFTER(23 + 2 * k); }
            }
        }
    }
    {
        constexpr int l = 1;
        const int pb = 1 + 11 * l;
        OPAQUE_IDS(threadIdx.x, blockIdx.x);
        if (IN_PH(1, pb + 0)) { PH_PTRS; const float* xres = (l == 0) ? in[0] : out; norm_phase<false>(xres, in[5] + (size_t)l * DM, modl, 0, (bf16*)(ws + A_H), nullptr, nullptr, ws, lds, vcu, G, wave, lane, tid); BAR_AFTER(pb + 0); }
        if (IN_PH(2, pb + 1)) { PH_PTRS;
            pg8::Gemm g{(const bf16*)(ws + A_H), (const bf16*)(ws + WS_WIN) + (size_t)l * NPROJ * DM, TOK, NPROJ, DM, nullptr, nullptr, 0};
            pg8::StaticOrder S; S.init(TOK, NPROJ, G, bx);
            pg8::EpiBf16<0> E{(bf16*)(ws + A_PROJ), NPROJ, nullptr, 0, 0, 1.f};
            pg8::gemm_phase<pg8::EpiBf16<0>, pg8::StaticOrder, true, true, 0>(lds, g, S, E);
            BAR_AFTER(pb + 1); }
        if (IN_PH(3, pb + 2)) { PH_PTRS; prep_phase(l, in, ws, gw, NGW, lane); BAR_AFTER(pb + 2); }
        if (IN_PH(4, pb + 3)) { PH_PTRS;
#ifndef P4_MASK
#define P4_MASK 7
#endif
            if (P4_MASK & 1) { pg8::Gemm g{(const bf16*)(ws + A_CQ), (const bf16*)(ws + WS_WUQ) + (size_t)l * NQ * 256, TOK, NQ, 256, nullptr, nullptr, 0};
              pg8::StaticOrder S; S.init(TOK, NQ, G, (bx + G / 2) % G);
              pg8::EpiBf16<0> E{(bf16*)(ws + A_Q), NQ, nullptr, 0, 0, 1.f};
              pg8::gemm_phase<pg8::EpiBf16<0>, pg8::StaticOrder, true, true, 0>(lds, g, S, E); }
            __syncthreads();
            if (P4_MASK & 2) { pg8::Gemm g{(const bf16*)(ws + A_CKV), (const bf16*)(ws + WS_WUKV) + (size_t)l * NKV * 128, TOK, NKV, 128, nullptr, nullptr, 0};
              pg8::StaticOrder S; S.init(TOK, NKV, G, bx);
              pg8::EpiKV E{(bf16*)(ws + A_KB), (bf16*)(ws + A_VB)};
              pg8::gemm_phase<pg8::EpiKV, pg8::StaticOrder, true, true, 0>(lds, g, S, E); }
            __syncthreads();
            if (P4_MASK & 4) { const int nl = (l == 0) ? 1536 : NLORA;
              pg8::Gemm g{(const bf16*)(ws + A_LA), (const bf16*)(ws + WS_WLORA) + (size_t)l * NLORA * KLORA, TOK, nl, KLORA, nullptr, nullptr, 0};
              pg8::StaticOrder S; S.init(TOK, nl, G, bx);
              pg8::EpiLora E{in[16] + (size_t)l * RW, in[18] + (size_t)l * RW, in[21], in[23] + (size_t)l * RW, in[24] + (size_t)l * RW,
                             (float*)(ws + A_LW), (bf16*)(ws + A_KRAW), (bf16*)(ws + A_KK), (bf16*)(ws + A_BV), (bf16*)(ws + A_G), (bf16*)(ws + A_VRAW), (const bf16*)(ws + WS_VFIRST), (const bf16*)(ws + A_R), in[25] + (size_t)l * RW, (float*)(ws + A_BON)};
              pg8::gemm_phase<pg8::EpiLora, pg8::StaticOrder, true, true, 0>(lds, g, S, E); }
            BAR_AFTER(pb + 3); }
        if (IN_PH(5, pb + 4)) { PH_PTRS;
            if (wave < 4) { for (int u = vcu * 4 + wave; u < 64 * (SEQ / 32); u += G * 4) { const int q = u & 63, ck = u >> 6; rk::pre_unit(l, q >> 3, q & 7, ck, ws, lds + wave * rk::UNIT_LDS); } }
            BAR_AFTER(pb + 4); }
        if (IN_PH(6, pb + 5)) { PH_PTRS;
            if (vcu < 32) { if (wave < 4) { const int si = vcu * 4 + wave; rk::scan_unit(si >> 1, si & 1, ws); } __syncthreads(); }
            volatile LAS unsigned* qslot = (volatile LAS unsigned*)(lds + MISC_OFF) + 16;
            for (;;) {
                __syncthreads();
                if (tid == 0) qslot[0] = __hip_atomic_fetch_add(ctl + CW_QCTR + 64 * l, 1u, RLX_AGENT);
                __syncthreads();
                const int u = (int)qslot[0];
                if (u >= 512) break;
                const int qb = 15 - (u >> 5), bh = u & 31;
                att::attn_unit(bh >> 2, bh & 3, qb, (const bf16*)(ws + A_Q), (const bf16*)(ws + A_KB), (const bf16*)(ws + A_VB), (bf16*)(ws + A_YCAT), (const int*)in[2], lds);
            }
            BAR_AFTER(pb + 5); }
        if (IN_PH(7, pb + 6)) { PH_PTRS; post_phase(l, in[13] + (size_t)l * 512, in[26] + (size_t)l * RW, in[27] + (size_t)l * RW, ws, gw, NGW, lane); if (l == 1) p_expert_weights(in, ws, lds, gw, NGW, wave, lane); BAR_AFTER(pb + 6); }
        if (IN_PH(8, pb + 7)) { PH_PTRS; const float* xres = (l == 0) ? in[0] : out;
            pg8::Gemm g{(const bf16*)(ws + A_YCAT), (const bf16*)(ws + WS_WOUT) + (size_t)l * DM * DM, TOK, DM, DM, nullptr, nullptr, 0};
            pg8::StaticOrder S; S.init(TOK, DM, G, bx);
            pg8::EpiResid E{xres, out, modl + 2048};
            pg8::gemm_phase<pg8::EpiResid, pg8::StaticOrder, true, true, 0>(lds, g, S, E);
            BAR_AFTER(pb + 7); }
        if (IN_PH(9, pb + 8)) { PH_PTRS;
            if (l == 0) norm_phase<false>(out, in[6] + (size_t)l * DM, modl, 3072, (bf16*)(ws + A_H), nullptr, nullptr, ws, lds, vcu, G, wave, lane, tid);
            else norm_phase<true>(out, in[6] + (size_t)l * DM, modl, 3072, (bf16*)(ws + A_H), in[32], in[33], ws, lds, vcu, G, wave, lane, tid);
            BAR_AFTER(pb + 8); }
        if (l == 0) {
            if (IN_PH(10, 10)) { PH_PTRS;
                pg8::Gemm g{(const bf16*)(ws + A_H), (const bf16*)(ws + WS_WF1), TOK, 2 * FFD, DM, nullptr, nullptr, 0};
                pg8::StaticOrder S; S.init(TOK, 2 * FFD, G, bx);
                pg8::EpiSwiGLU E{(bf16*)(ws + A_HID), FFD};
                pg8::gemm_phase<pg8::EpiSwiGLU, pg8::StaticOrder, true, true, 0>(lds, g, S, E);
                BAR_AFTER(10); }
            if (IN_PH(11, 11)) { PH_PTRS;
                pg8::Gemm g{(const bf16*)(ws + A_HID), (const bf16*)(ws + WS_WF2), TOK, DM, FFD, nullptr, nullptr, 0};
                pg8::StaticOrder S; S.init(TOK, DM, G, bx);
                pg8::EpiResid E{out, out, modl + 5120};
                pg8::gemm_phase<pg8::EpiResid, pg8::StaticOrder, true, true, 0>(lds, g, S, E);
                BAR_AFTER(11); }
        } else {
            if (IN_PH(12, 21)) { PH_PTRS; route_scatter(ws, lds, vcu, G, wave, lane, tid); BAR_AFTER(21); }
#pragma unroll
            for (int k = 0; k < 2; ++k) {
                if (IN_PH(13, 22 + 2 * k)) { PH_PTRS; const int* TL = (const int*)(ws + RT_TILE) + k * (PASS_TILES + 8); const int* ridx = (const int*)(ws + RT_RIDX) + (size_t)k * PASS_ROWS;
                    const int nt = __builtin_amdgcn_readfirstlane(TL[0]);
                    pg8::Gemm g{(const bf16*)(ws + A_H), (const bf16*)(ws + A_WE1), nt * 256, 2 * FFE, DM, ridx, TL + 8, (size_t)2 * FFE * DM * 2};
                    pg8::StaticOrder S; S.init(nt * 256, 2 * FFE, G, bx);
                    pg8::EpiSwiGLU E{(bf16*)(ws + A_HID), FFE};
                    pg8::gemm_phase<pg8::EpiSwiGLU, pg8::StaticOrder, true, true, 1>(lds, g, S, E);
                    BAR_AFTER(22 + 2 * k); }
                if (IN_PH(14, 23 + 2 * k)) { PH_PTRS; const int* TL = (const int*)(ws + RT_TILE) + k * (PASS_TILES + 8); const int* ridx = (const int*)(ws + RT_RIDX) + (size_t)k * PASS_ROWS; const float* rgw = (const float*)(ws + RT_RGW) + (size_t)k * PASS_ROWS;
                    const int nt = __builtin_amdgcn_readfirstlane(TL[0]);
                    pg8::Gemm g{(const bf16*)(ws + A_HID), (const bf16*)(ws + A_WE2), nt * 256, DM, FFE, nullptr, TL + 8, (size_t)DM * FFE * 2};
                    pg8::StaticOrder S; S.init(nt * 256, DM, G, bx);
                    pg8::EpiMoE2 E{out, modl + 5120, ridx, rgw};
                    pg8::gemm_phase<pg8::EpiMoE2, pg8::StaticOrder, true, true, 2>(lds, g, S, E);
                    BAR_AFTER(23 + 2 * k); }
            }
        }
    }
    if (IN_PH(15, 26)) { const int l = 1; PH_PTRS; OPAQUE_IDS(threadIdx.x, blockIdx.x); final_norm(out, in[37], gw, NGW, lane); }
#undef IN_PH
#undef BAR_AFTER
}

extern "C" void kernel_launch(void* const* d_in, const int* in_sizes, int n_in, void* d_out, int out_size, void* d_ws, size_t ws_size, hipStream_t stream) {
    static int grid = 0;
    if (grid == 0) {
        if (n_in != 38 || in_sizes[0] != TOK * DM || out_size != TOK * DM || ws_size < WS_END) {
            fprintf(stderr, "kernel_launch: unexpected problem (n_in %d, in0 %d, out %d, ws %zu, need %zu); nothing launched\n", n_in, n_in > 0 ? in_sizes[0] : -1, out_size, ws_size, (size_t)WS_END); grid = -1; return; }
        int dev = 0, cus = 0, per_cu = 0;
        if (hipGetDevice(&dev) != hipSuccess || hipDeviceGetAttribute(&cus, hipDeviceAttributeMultiprocessorCount, dev) != hipSuccess) { grid = -1; return; }
        if (hipFuncSetAttribute((const void*)mega_fwd, hipFuncAttributeMaxDynamicSharedMemorySize, LDS_BYTES) != hipSuccess) { fprintf(stderr, "kernel_launch: hipFuncSetAttribute failed\n"); grid = -1; return; }
        if (hipOccupancyMaxActiveBlocksPerMultiprocessor(&per_cu, (const void*)mega_fwd, NTHR, LDS_BYTES) != hipSuccess || per_cu < 1) { fprintf(stderr, "kernel_launch: occupancy query says %d\n", per_cu); }
        (void)hipGetLastError();
        grid = cus;
    }
    if (grid < 0) return;
    (void)hipMemsetAsync((char*)d_ws + WS_CTL, 0, CTL_ZERO_BYTES, stream);
    Args a{};
    for (int i = 0; i < 38; ++i) a.in.p[i] = (const float*)d_in[i];
    a.out = (float*)d_out; a.ws = (unsigned char*)d_ws;
#if MK_SPLIT
    for (int p = 0; p < N_PHASES; ++p) { a.ph_lo = p; a.ph_hi = p + 1; hipLaunchKernelGGL(mega_fwd, dim3(grid), dim3(NTHR), LDS_BYTES, stream, a); }
#else
    a.ph_lo = 0; a.ph_hi = N_PHASES;
    hipLaunchKernelGGL(mega_fwd, dim3(grid), dim3(NTHR), LDS_BYTES, stream, a);
#endif
    const hipError_t le = hipPeekAtLastError();
    if (le != hipSuccess) fprintf(stderr, "kernel_launch: launch failed: %s\n", hipGetErrorName(le));
}
```

```cpp
#include <hip/hip_runtime.h>
#include <cstdio>
#include <cstdint>
namespace pg8 {
#define PG8_LAS __attribute__((address_space(3)))
typedef unsigned short bf16_t;
typedef short bf16x8 __attribute__((ext_vector_type(8)));
typedef float f32x4 __attribute__((ext_vector_type(4)));
typedef unsigned u32x4 __attribute__((ext_vector_type(4)));
constexpr int BM = 256, BK = 64, HALF = 128, HTB = HALF * BK * 2  , STAGE_BYTES = 8 * HTB, NXCD = 8, WGM = 8;

__host__ __device__ __forceinline__ int lds_byte(int r, int c) { const int st = (r >> 4) * 2 + (c >> 5), rr = r & 15, cc = c & 31, ob = rr * 64 + cc * 2; return st * 1024 + (ob ^ (((ob >> 9) & 1) << 5)); }
__host__ __device__ __forceinline__ void stage_rc(int b, int& R, int& C) { const int st = b / 1024, sb = b % 1024, swz = sb ^ (((sb >> 9) & 1) << 5); R = (st >> 1) * 16 + swz / 64; C = (st & 1) * 32 + (swz % 64) / 2; }
__host__ __device__ __forceinline__ int perm32(int rho) { const int n = rho >> 4, i = rho & 15; return 8 * (i >> 2) + 4 * n + (i & 3); }

struct Unit { int pm, pn; };
struct Gemm { const bf16_t* A; const bf16_t* Bt; int M, N, K; const int* ridx; const int* tile_e; size_t e_stride; };

struct StaticOrder {
    int nM, nN, nwg, G, c;
    __host__ __device__ void init(int M, int N, int G_, int c_) { nM = M / BM; nN = N / BM; nwg = nM * nN; G = G_; c = c_; }
    __host__ __device__ bool next(int i, Unit& u) const {
        const long L = (long)i * G + c; if (L >= nwg) return false;
        int wgid = (int)L; { const int q = nwg / NXCD, r = nwg % NXCD, xcd = wgid % NXCD, off = wgid / NXCD; wgid = (xcd < r ? xcd * (q + 1) : r * (q + 1) + (xcd - r) * q) + off; }
        const int nig = WGM * nN, gid = wgid / nig, fm = gid * WGM, gsz = (nM - fm) < WGM ? (nM - fm) : WGM;
        u.pm = fm + ((wgid % nig) % gsz); u.pn = (wgid % nig) / gsz; return true;
    }
    __device__ __forceinline__ void a_ready(const Unit&) const {}
    __device__ __forceinline__ void done(const Unit&) const {}
};

typedef float f32x2_cv __attribute__((ext_vector_type(2))); typedef __bf16 bf16x2_cv __attribute__((ext_vector_type(2)));
__device__ __forceinline__ unsigned cvt_pk_bf16(float lo, float hi) { const f32x2_cv v = {lo, hi}; const bf16x2_cv b = __builtin_convertvector(v, bf16x2_cv); return __builtin_bit_cast(unsigned, b); }
typedef float f32x2 __attribute__((ext_vector_type(2)));
__device__ __forceinline__ f32x2 gelu_pk(f32x2 v) {
    const f32x2 av = __builtin_elementwise_abs(v), d = av * 0.2316418882f + 1.0f;
    f32x2 t; t.x = __builtin_amdgcn_rcpf(d.x); t.y = __builtin_amdgcn_rcpf(d.y);
    f32x2 q = t * 0.5307027145f + (-0.7265760135f); q = q * t + 0.7107068705f; q = q * t + (-0.142248368f); q = q * t + 0.127414796f; q = q * t;
    const f32x2 s = (v * v) * (-0.72134752044f);
    f32x2 e; e.x = __builtin_amdgcn_exp2f(s.x); e.y = __builtin_amdgcn_exp2f(s.y);
    const f32x2 m = v * (q * e), r = v - m;
    f32x2 o; o.x = v.x < 0.f ? m.x : r.x; o.y = v.y < 0.f ? m.y : r.y; return o;
}

template <int ACT  > struct EpiBf16 {
    static constexpr bool PERM = true, AFTER_DRAIN = false; static_assert(ACT == 0 || ACT == 1, "EpiBf16: ACT is 0 (none) or 1 (gelu_pk)");
    bf16_t* O; int ldc; const float* bias; int split_cols; size_t split_stride; float scale0;
    __device__ __forceinline__ void operator()(const f32x4 (&acc)[2][2][4][2], const Unit& u, int wr, int wc, int fr, int fq) const {
        const int row0 = u.pm * BM + wr * 64 + fr; int colt = u.pn * BM; bf16_t* base = O;
        float sc = 1.f; if (split_cols) { const int t = colt / split_cols; base += (size_t)t * split_stride; colt -= t * split_cols; if (t == 0) sc = scale0; }
        const int col0 = colt + wc * 32 + 8 * fq, bcol0 = u.pn * BM + wc * 32 + 8 * fq;
        f32x4 bv[2][2];
#pragma unroll
        for (int bj = 0; bj < 2; ++bj)
#pragma unroll
            for (int n = 0; n < 2; ++n) bv[bj][n] = bias ? *(const f32x4*)(bias + bcol0 + bj * HALF + 4 * n) : (f32x4){0.f, 0.f, 0.f, 0.f};
#pragma unroll
        for (int ai = 0; ai < 2; ++ai)
#pragma unroll
            for (int m = 0; m < 4; ++m) { bf16_t* rowp = base + (size_t)(row0 + ai * HALF + m * 16) * ldc + col0;
#pragma unroll
                for (int bj = 0; bj < 2; ++bj) { f32x4 v0 = acc[ai][bj][m][0] + bv[bj][0], v1 = acc[ai][bj][m][1] + bv[bj][1];
                    if (ACT == 1) { f32x2 a = gelu_pk((f32x2){v0[0], v0[1]}), b = gelu_pk((f32x2){v0[2], v0[3]}), c = gelu_pk((f32x2){v1[0], v1[1]}), d = gelu_pk((f32x2){v1[2], v1[3]});
                        v0 = (f32x4){a.x, a.y, b.x, b.y}; v1 = (f32x4){c.x, c.y, d.x, d.y}; }
                    v0 = v0 * sc; v1 = v1 * sc; u32x4 w; w.x = cvt_pk_bf16(v0[0], v0[1]); w.y = cvt_pk_bf16(v0[2], v0[3]); w.z = cvt_pk_bf16(v1[0], v1[1]); w.w = cvt_pk_bf16(v1[2], v1[3]);
                    *(u32x4*)(rowp + bj * HALF) = w; } }
    }
};

__device__ __forceinline__ float bf2f(unsigned short v) { return __uint_as_float(((unsigned)v) << 16); }
__device__ __forceinline__ float bflo(unsigned w) { return __uint_as_float(w << 16); }
__device__ __forceinline__ float bfhi(unsigned w) { return __uint_as_float(w & 0xffff0000u); }
__device__ __forceinline__ float fsigmoid(float x) { return __builtin_amdgcn_rcpf(1.0f + __builtin_amdgcn_exp2f(-1.4426950408889634f * x)); }
__device__ __forceinline__ u32x4 pack8f(const f32x4 a, const f32x4 b) { u32x4 w; w.x = cvt_pk_bf16(a[0], a[1]); w.y = cvt_pk_bf16(a[2], a[3]); w.z = cvt_pk_bf16(b[0], b[1]); w.w = cvt_pk_bf16(b[2], b[3]); return w; }
__device__ __forceinline__ void unpack8(const u32x4 w, f32x4& a, f32x4& b) { a = (f32x4){bflo(w.x), bfhi(w.x), bflo(w.y), bfhi(w.y)}; b = (f32x4){bflo(w.z), bfhi(w.z), bflo(w.w), bfhi(w.w)}; }

struct EpiKV { static constexpr bool PERM = true, AFTER_DRAIN = false;
    bf16_t* Kb; bf16_t* Vb;
    __device__ __forceinline__ void operator()(const f32x4 (&acc)[2][2][4][2], const Unit& u, int wr, int wc, int fr, int fq) const {
        const int row0 = u.pm * BM + wr * 64 + fr, h = u.pn, col = wc * 32 + 8 * fq;
#pragma unroll
        for (int ai = 0; ai < 2; ++ai)
#pragma unroll
            for (int m = 0; m < 4; ++m) { const int row = row0 + ai * HALF + m * 16; const int b = row >> 12, s = row & 4095;
                const size_t tok = (size_t)(b * 4 + h) * 4096 + s;
                *(u32x4*)(Kb + tok * 192 + col) = pack8f(acc[ai][0][m][0], acc[ai][0][m][1]);
                *(u32x4*)(Vb + tok * 128 + col) = pack8f(acc[ai][1][m][0], acc[ai][1][m][1]); }
    }
};

struct EpiResid { static constexpr bool PERM = false, AFTER_DRAIN = false;
    const float* base; float* out; const float* gate;
    __device__ __forceinline__ void operator()(const f32x4 (&acc)[2][2][4][2], const Unit& u, int wr, int wc, int fr, int fq) const {
        const int row0 = u.pm * BM + wr * 64 + fr, col0 = u.pn * BM + wc * 32 + 4 * fq, b = (u.pm * BM) >> 12;
        f32x4 gv[2][2];
#pragma unroll
        for (int bj = 0; bj < 2; ++bj)
#pragma unroll
            for (int n = 0; n < 2; ++n) gv[bj][n] = *(const f32x4*)(gate + b * 6144 + col0 + bj * HALF + n * 16);
#pragma unroll
        for (int ai = 0; ai < 2; ++ai)
#pragma unroll
            for (int m = 0; m < 4; ++m) { const size_t off = (size_t)(row0 + ai * HALF + m * 16) * 1024 + col0;
#pragma unroll
                for (int bj = 0; bj < 2; ++bj)
#pragma unroll
                    for (int n = 0; n < 2; ++n) { const f32x4 bs = *(const f32x4*)(base + off + bj * HALF + n * 16); *(f32x4*)(out + off + bj * HALF + n * 16) = bs + gv[bj][n] * acc[ai][bj][m][n]; } }
    }
};

struct EpiSwiGLU { static constexpr bool PERM = true, AFTER_DRAIN = false;
    bf16_t* Hd; int ldh;
    __device__ __forceinline__ void operator()(const f32x4 (&acc)[2][2][4][2], const Unit& u, int wr, int wc, int fr, int fq) const {
        const int row0 = u.pm * BM + wr * 64 + fr, col = u.pn * HALF + wc * 32 + 8 * fq;
#pragma unroll
        for (int ai = 0; ai < 2; ++ai)
#pragma unroll
            for (int m = 0; m < 4; ++m) { f32x4 r[2];
#pragma unroll
                for (int n = 0; n < 2; ++n) { const f32x4 g = acc[ai][0][m][n], up = acc[ai][1][m][n];
#pragma unroll
                    for (int e = 0; e < 4; ++e) r[n][e] = g[e] * fsigmoid(g[e]) * up[e]; }
                *(u32x4*)(Hd + (size_t)(row0 + ai * HALF + m * 16) * ldh + col) = pack8f(r[0], r[1]); }
    }
};

struct EpiMoE2 { static constexpr bool PERM = false, AFTER_DRAIN = false;
    float* out; const float* gate; const int* ridx; const float* rgw;
    __device__ __forceinline__ void operator()(const f32x4 (&acc)[2][2][4][2], const Unit& u, int wr, int wc, int fr, int fq) const {
        const int row0 = u.pm * BM + wr * 64 + fr, col0 = u.pn * BM + wc * 32 + 4 * fq;
#pragma unroll
        for (int ai = 0; ai < 2; ++ai)
#pragma unroll
            for (int m = 0; m < 4; ++m) { const int srow = row0 + ai * HALF + m * 16; const int tok = ridx[srow];
                if (tok >= 0) { const float gw = rgw[srow]; const float* gp = gate + (tok >> 12) * 6144 + col0; float* op = out + (size_t)tok * 1024 + col0;
#pragma unroll
                    for (int bj = 0; bj < 2; ++bj)
#pragma unroll
                        for (int n = 0; n < 2; ++n) { const f32x4 gv = *(const f32x4*)(gp + bj * HALF + n * 16); const f32x4 bs = *(const f32x4*)(op + bj * HALF + n * 16);
                            *(f32x4*)(op + bj * HALF + n * 16) = bs + (gv * gw) * acc[ai][bj][m][n]; } } }
    }
};

struct EpiLora { static constexpr bool PERM = true, AFTER_DRAIN = false;
    const float *w0, *a0, *v0, *k_k, *k_a;
    float* LW; bf16_t* Kraw; bf16_t* KK; bf16_t* BV; bf16_t* G; bf16_t* Vraw; const bf16_t* VF; const bf16_t* Rr; const float* r_k; float* BON;
    __device__ __forceinline__ void operator()(const f32x4 (&acc)[2][2][4][2], const Unit& u, int wr, int wc, int fr, int fq) const {
        const int row0 = u.pm * BM + wr * 64 + fr, seg = u.pn >> 1, cb = 256 * (u.pn & 1) + 64 * wc + 8 * fq;
        if (seg == 0) {
            f32x4 p[2][2];
#pragma unroll
            for (int bj = 0; bj < 2; ++bj) { p[bj][0] = *(const f32x4*)(w0 + cb + 32 * bj); p[bj][1] = *(const f32x4*)(w0 + cb + 32 * bj + 4); }
#pragma unroll
            for (int ai = 0; ai < 2; ++ai)
#pragma unroll
                for (int m = 0; m < 4; ++m) { float* rp = LW + (size_t)(row0 + ai * HALF + m * 16) * 512 + cb;
#pragma unroll
                    for (int bj = 0; bj < 2; ++bj)
#pragma unroll
                        for (int n = 0; n < 2; ++n) { f32x4 o;
#pragma unroll
                            for (int e = 0; e < 4; ++e) o[e] = -0.6065306597126334f * fsigmoid(p[bj][n][e] + acc[ai][bj][m][n][e]);
                            *(f32x4*)(rp + 32 * bj + 4 * n) = o; } }
        } else if (seg == 1) {
#pragma unroll
            for (int ai = 0; ai < 2; ++ai)
#pragma unroll
                for (int m = 0; m < 4; ++m) { const size_t ro = (size_t)(row0 + ai * HALF + m * 16) * 512 + cb;
                    float ss = 0.f;
#pragma unroll
                    for (int bj = 0; bj < 2; ++bj) { f32x4 kv[2]; unpack8(*(const u32x4*)(Kraw + ro + 32 * bj), kv[0], kv[1]);
#pragma unroll
                        for (int n = 0; n < 2; ++n) { const f32x4 pk = *(const f32x4*)(k_k + cb + 32 * bj + 4 * n); const f32x4 t = kv[n] * pk; ss += (t[0] * t[0] + t[1] * t[1]) + (t[2] * t[2] + t[3] * t[3]); } }
                    ss += __uint_as_float((unsigned)__builtin_amdgcn_ds_swizzle((int)__float_as_uint(ss), 0x1f | (16 << 10)));
                    { const auto rr = __builtin_amdgcn_permlane32_swap(__float_as_uint(ss), __float_as_uint(ss), false, false); ss = __uint_as_float(rr[0]) + __uint_as_float(rr[1]); }
                    const float inv = 1.0f / fmaxf(sqrtf(ss), 1e-12f);
                    asm volatile("" ::: "memory");
                    float bsum = 0.f;
#pragma unroll
                    for (int bj = 0; bj < 2; ++bj) { f32x4 kv[2], rv[2], k2[2], kk2[2], b2[2]; unpack8(*(const u32x4*)(Kraw + ro + 32 * bj), kv[0], kv[1]); unpack8(*(const u32x4*)(Rr + ro + 32 * bj), rv[0], rv[1]);
#pragma unroll
                        for (int n = 0; n < 2; ++n) { const f32x4 pa = *(const f32x4*)(a0 + cb + 32 * bj + 4 * n), pk = *(const f32x4*)(k_k + cb + 32 * bj + 4 * n), pq = *(const f32x4*)(k_a + cb + 32 * bj + 4 * n), pr = *(const f32x4*)(r_k + cb + 32 * bj + 4 * n);
#pragma unroll
                            for (int e = 0; e < 4; ++e) { const float a = fsigmoid(pa[e] + acc[ai][bj][m][n][e]), kkn = kv[n][e] * pk[e] * inv; kk2[n][e] = kkn; b2[n][e] = kkn * a; k2[n][e] = kv[n][e] * (1.0f + (a - 1.0f) * pq[e]);
                                bsum += rv[n][e] * bflo(cvt_pk_bf16(k2[n][e], 0.f)) * pr[e]; } }
                        *(u32x4*)(Kraw + ro + 32 * bj) = pack8f(k2[0], k2[1]); *(u32x4*)(KK + ro + 32 * bj) = pack8f(kk2[0], kk2[1]); *(u32x4*)(BV + ro + 32 * bj) = pack8f(b2[0], b2[1]); }
                    bsum += __uint_as_float((unsigned)__builtin_amdgcn_ds_swizzle((int)__float_as_uint(bsum), 0x1f | (16 << 10)));
                    { const auto rr = __builtin_amdgcn_permlane32_swap(__float_as_uint(bsum), __float_as_uint(bsum), false, false); bsum = __uint_as_float(rr[0]) + __uint_as_float(rr[1]); }
                    if (fq == 0) BON[(size_t)(row0 + ai * HALF + m * 16) * 8 + 4 * (u.pn & 1) + wc] = bsum;
                    asm volatile("" ::: "memory"); }
        } else if (seg == 2) {
#pragma unroll
            for (int ai = 0; ai < 2; ++ai)
#pragma unroll
                for (int m = 0; m < 4; ++m) { bf16_t* rp = G + (size_t)(row0 + ai * HALF + m * 16) * 512 + cb;
#pragma unroll
                    for (int bj = 0; bj < 2; ++bj) *(u32x4*)(rp + 32 * bj) = pack8f(acc[ai][bj][m][0], acc[ai][bj][m][1]); }
        } else {
            f32x4 p[2][2];
#pragma unroll
            for (int bj = 0; bj < 2; ++bj) { p[bj][0] = *(const f32x4*)(v0 + cb + 32 * bj); p[bj][1] = *(const f32x4*)(v0 + cb + 32 * bj + 4); }
#pragma unroll
            for (int ai = 0; ai < 2; ++ai)
#pragma unroll
                for (int m = 0; m < 4; ++m) { const size_t ro = (size_t)(row0 + ai * HALF + m * 16) * 512 + cb;
#pragma unroll
                    for (int bj = 0; bj < 2; ++bj) { f32x4 vv[2], vf[2], o[2]; unpack8(*(const u32x4*)(Vraw + ro + 32 * bj), vv[0], vv[1]); unpack8(*(const u32x4*)(VF + ro + 32 * bj), vf[0], vf[1]);
#pragma unroll
                        for (int n = 0; n < 2; ++n)
#pragma unroll
                            for (int e = 0; e < 4; ++e) o[n][e] = vv[n][e] + (vf[n][e] - vv[n][e]) * fsigmoid(p[bj][n][e] + acc[ai][bj][m][n][e]);
                        *(u32x4*)(Vraw + ro + 32 * bj) = pack8f(o[0], o[1]); } }
        }
    }
};
template <class Epi, class Sched, bool ALIGN_EPI = false, bool SP2 = false, int MODE = 0>
__device__ __forceinline__ void gemm_phase(PG8_LAS unsigned char* lds, const Gemm g, const Sched& S, const Epi& E) {
    int tid_ = threadIdx.x; asm volatile("" : "+v"(tid_));
    const int tid = tid_, wid = __builtin_amdgcn_readfirstlane(tid >> 6), lane = tid & 63, wr = wid >> 2, wc = wid & 3, fr = lane & 15, fq = lane >> 4;
    int K_ = g.K; asm volatile("" : "+s"(K_));
    const int K = K_, nt = K / BK;
    unsigned voffA[2], voffB[2]; int gR[2], gC[2]; unsigned vAc[2][2], vAn[2][2];
    static_assert(SP2 || MODE == 0, "MODE != 0 needs SP2");
#pragma unroll
    for (int i = 0; i < 2; ++i) { int R, C; stage_rc(tid * 16 + i * 8192, R, C); const int Rb = Epi::PERM ? ((R & ~31) + perm32(R & 31)) : R;
        voffA[i] = (unsigned)(R * K + C) * 2u; voffB[i] = (unsigned)(Rb * K + C) * 2u; gR[i] = R; gC[i] = C; }
    const size_t kstep = (size_t)(BK * 2);
    const size_t hstep = (size_t)HALF * K * 2;
    const size_t tstep = 2 * hstep;
    const unsigned ldsw = (unsigned)wid * 1024u;
    const int aoff = lds_byte(wr * 64 + fr, fq * 8), boff = lds_byte(wc * 32 + fr, fq * 8);
#define PG8_SA(b, h) (((b) * 2 + (h)) * HTB)
#define PG8_SB(b, h) ((4 + (b) * 2 + (h)) * HTB)
#define PG8_STAGE(bufoff, gbase, voff) do { _Pragma("unroll") for (int _i = 0; _i < 2; ++_i) \
        __builtin_amdgcn_global_load_lds((const unsigned*)((const char*)(gbase) + (voff)[_i]), (PG8_LAS unsigned*)(lds + (bufoff) + ldsw + _i * 8192), 16, 0, 0); } while (0)
#define PG8_GATHER(dst, U) do { _Pragma("unroll") for (int _h = 0; _h < 2; ++_h) _Pragma("unroll") for (int _i = 0; _i < 2; ++_i) { \
        int _r = g.ridx[(U).pm * BM + _h * HALF + gR[_i]]; _r = _r < 0 ? 0 : _r; dst[_h][_i] = (unsigned)(_r * K + gC[_i]) * 2u; } } while (0)
#define PG8_STAGE_A(bufoff, kptr, h, NXT) do { if constexpr (MODE == 1) { _Pragma("unroll") for (int _i = 0; _i < 2; ++_i) \
        __builtin_amdgcn_global_load_lds((const unsigned*)((const char*)(kptr) + ((NXT) ? vAn[h][_i] : vAc[h][_i])), (PG8_LAS unsigned*)(lds + (bufoff) + ldsw + _i * 8192), 16, 0, 0); } \
    else { PG8_STAGE(bufoff, (kptr) + (h) * hstep, voffA); } } while (0)
#define PG8_APTR(U) ((MODE == 1) ? (const char*)g.A : (const char*)g.A + (size_t)(U).pm * tstep)
#define PG8_BPTR(U) ((MODE != 0) ? (const char*)g.Bt + (size_t)g.tile_e[(U).pm] * g.e_stride + (size_t)(U).pn * tstep : (const char*)g.Bt + (size_t)(U).pn * tstep)
#define PG8_LDA(dst, b, h) do { _Pragma("unroll") for (int m = 0; m < 4; ++m) _Pragma("unroll") for (int k = 0; k < 2; ++k) dst[m][k] = *(const PG8_LAS bf16x8*)(lds + PG8_SA(b, h) + aoff + m * 2048 + k * 1024); } while (0)
#define PG8_LDB(dst, b, h) do { _Pragma("unroll") for (int n = 0; n < 2; ++n) _Pragma("unroll") for (int k = 0; k < 2; ++k) dst[n][k] = *(const PG8_LAS bf16x8*)(lds + PG8_SB(b, h) + boff + n * 2048 + k * 1024); } while (0)
#define PG8_MMA(ai, bj, At, Bt) do { __builtin_amdgcn_s_setprio(1); _Pragma("unroll") for (int m = 0; m < 4; ++m) _Pragma("unroll") for (int n = 0; n < 2; ++n) _Pragma("unroll") for (int k = 0; k < 2; ++k) \
        acc[ai][bj][m][n] = __builtin_amdgcn_mfma_f32_16x16x32_bf16(Bt[n][k], At[m][k], acc[ai][bj][m][n], 0, 0, 0); __builtin_amdgcn_s_setprio(0); } while (0)
#define PG8_WAIT_V(n) asm volatile("s_waitcnt vmcnt(" #n ")" ::: "memory")
#define PG8_WAIT_L(n) asm volatile("s_waitcnt lgkmcnt(" #n ")" ::: "memory")
#define PG8_BAR __builtin_amdgcn_s_barrier()
#define PG8_SCHED __builtin_amdgcn_sched_barrier(0)
    Unit cur, nxt; int ui = 0;
    if (!S.next(0, cur)) return;
    f32x4 acc[2][2][4][2];
#pragma unroll
    for (int a = 0; a < 2; ++a)
#pragma unroll
        for (int b = 0; b < 2; ++b)
#pragma unroll
            for (int m = 0; m < 4; ++m)
#pragma unroll
                for (int n = 0; n < 2; ++n) acc[a][b][m][n] = (f32x4){0.f, 0.f, 0.f, 0.f};
    bf16x8 At[4][2], B0[2][2], B1[2][2];
    const char* cA = PG8_APTR(cur); const char* cB = PG8_BPTR(cur);
    if constexpr (MODE == 1) { PG8_GATHER(vAc, cur); }
    S.a_ready(cur);
    if constexpr (SP2) {
        PG8_STAGE(PG8_SB(0, 0), cB, voffB); PG8_STAGE(PG8_SB(0, 1), cB + hstep, voffB); PG8_STAGE_A(PG8_SA(0, 0), cA, 0, false); PG8_STAGE_A(PG8_SA(0, 1), cA, 1, false);
        if (wr == 1) PG8_BAR;
        PG8_WAIT_V(2); PG8_BAR;
        PG8_STAGE(PG8_SB(1, 0), cB + kstep, voffB); PG8_STAGE_A(PG8_SA(1, 0), cA + kstep, 0, false); PG8_STAGE(PG8_SB(1, 1), cB + hstep + kstep, voffB);
        PG8_WAIT_V(6); PG8_BAR;
    } else {
        PG8_STAGE(PG8_SB(0, 0), cB, voffB); PG8_STAGE(PG8_SA(0, 0), cA, voffA); PG8_STAGE(PG8_SB(0, 1), cB + hstep, voffB); PG8_STAGE(PG8_SA(0, 1), cA + hstep, voffA);
        if (wr == 1) PG8_BAR;
        PG8_WAIT_V(4); PG8_BAR;
        PG8_STAGE(PG8_SB(1, 0), cB + kstep, voffB); PG8_STAGE(PG8_SA(1, 0), cA + kstep, voffA); PG8_STAGE(PG8_SB(1, 1), cB + hstep + kstep, voffB);
        PG8_WAIT_V(6); PG8_BAR;
    }
    for (;;) {
        const bool has_next = S.next(ui + 1, nxt);
        const char* nA = has_next ? PG8_APTR(nxt) : cA; const char* nB = has_next ? PG8_BPTR(nxt) : cB;
        if constexpr (MODE == 1) { if (has_next) { PG8_GATHER(vAn, nxt); asm volatile("s_waitcnt vmcnt(0)" ::: "memory"); } else { vAn[0][0] = vAc[0][0]; vAn[0][1] = vAc[0][1]; vAn[1][0] = vAc[1][0]; vAn[1][1] = vAc[1][1]; } }
        for (int t = 0; t < nt; t += 2) {
            const bool last = (t == nt - 2);
            const char* a1 = cA + (size_t)(t + 1) * kstep;
            const char* a2 = last ? nA : cA + (size_t)(t + 2) * kstep; const char* b2 = last ? nB : cB + (size_t)(t + 2) * kstep;
            const char* a3 = a2 + kstep; const char* b3 = b2 + kstep;
            if (last && has_next) S.a_ready(nxt);
            if constexpr (SP2) {
            PG8_LDB(B0, 0, 0); PG8_LDB(B1, 0, 1); PG8_SCHED; PG8_LDA(At, 0, 0); PG8_STAGE_A(PG8_SA(1, 1), a1, 1, false);
            PG8_WAIT_V(8); PG8_WAIT_L(0); PG8_BAR; PG8_MMA(0, 0, At, B0); PG8_MMA(0, 1, At, B1); PG8_BAR; PG8_SCHED;
            PG8_LDA(At, 0, 1); PG8_STAGE(PG8_SB(0, 0), b2, voffB); PG8_STAGE(PG8_SB(0, 1), b2 + hstep, voffB); PG8_STAGE_A(PG8_SA(0, 0), a2, 0, last);
            PG8_WAIT_V(8); PG8_WAIT_L(0); PG8_BAR; PG8_MMA(1, 0, At, B0); PG8_MMA(1, 1, At, B1); PG8_BAR; PG8_SCHED;
            PG8_LDB(B0, 1, 0); PG8_LDB(B1, 1, 1); PG8_SCHED; PG8_LDA(At, 1, 0); PG8_STAGE_A(PG8_SA(0, 1), a2, 1, last);
            PG8_WAIT_V(8); PG8_WAIT_L(0); PG8_BAR; PG8_MMA(0, 0, At, B0); PG8_MMA(0, 1, At, B1); PG8_BAR; PG8_SCHED;
            PG8_LDA(At, 1, 1); PG8_STAGE(PG8_SB(1, 0), b3, voffB); PG8_STAGE(PG8_SB(1, 1), b3 + hstep, voffB); PG8_STAGE_A(PG8_SA(1, 0), a3, 0, last);
            PG8_WAIT_V(8); PG8_WAIT_L(0); PG8_BAR; PG8_MMA(1, 0, At, B0); PG8_MMA(1, 1, At, B1); PG8_BAR; PG8_SCHED;
            } else {
            PG8_LDB(B0, 0, 0); PG8_SCHED; PG8_LDA(At, 0, 0); PG8_STAGE(PG8_SA(1, 1), a1 + hstep, voffA);
            PG8_WAIT_L(8); PG8_BAR; PG8_WAIT_L(0); PG8_MMA(0, 0, At, B0); PG8_BAR; PG8_SCHED;
            PG8_LDB(B1, 0, 1); PG8_STAGE(PG8_SB(0, 0), b2, voffB);
            PG8_BAR; PG8_WAIT_L(0); PG8_MMA(0, 1, At, B1); PG8_BAR;
            PG8_LDA(At, 0, 1); PG8_STAGE(PG8_SA(0, 0), a2, voffA);
            PG8_BAR; PG8_WAIT_L(0); PG8_MMA(1, 0, At, B0); PG8_BAR; PG8_SCHED;
            PG8_STAGE(PG8_SB(0, 1), b2 + hstep, voffB);
            PG8_WAIT_V(6); PG8_BAR; PG8_MMA(1, 1, At, B1); PG8_BAR;
            PG8_LDB(B0, 1, 0); PG8_SCHED; PG8_LDA(At, 1, 0); PG8_STAGE(PG8_SA(0, 1), a2 + hstep, voffA);
            PG8_WAIT_L(8); PG8_BAR; PG8_WAIT_L(0); PG8_MMA(0, 0, At, B0); PG8_BAR; PG8_SCHED;
            PG8_LDB(B1, 1, 1); PG8_STAGE(PG8_SB(1, 0), b3, voffB);
            PG8_BAR; PG8_WAIT_L(0); PG8_MMA(0, 1, At, B1); PG8_BAR;
            PG8_LDA(At, 1, 1); PG8_STAGE(PG8_SA(1, 0), a3, voffA);
            PG8_BAR; PG8_WAIT_L(0); PG8_MMA(1, 0, At, B0); PG8_BAR; PG8_SCHED;
            PG8_STAGE(PG8_SB(1, 1), b3 + hstep, voffB);
            PG8_WAIT_V(6); PG8_BAR; PG8_MMA(1, 1, At, B1); PG8_BAR;
            }
        }
        if constexpr (ALIGN_EPI) { if (wr == 0) PG8_BAR; }
        if constexpr (!Epi::AFTER_DRAIN) { E(acc, cur, wr, wc, fr, fq); S.done(cur); }
        if (!has_next) break;
#pragma unroll
        for (int a = 0; a < 2; ++a)
#pragma unroll
            for (int b = 0; b < 2; ++b)
#pragma unroll
                for (int m = 0; m < 4; ++m)
#pragma unroll
                    for (int n = 0; n < 2; ++n) acc[a][b][m][n] = (f32x4){0.f, 0.f, 0.f, 0.f};
        cur = nxt; cA = nA; cB = nB; ++ui;
        if constexpr (MODE == 1) { vAc[0][0] = vAn[0][0]; vAc[0][1] = vAn[0][1]; vAc[1][0] = vAn[1][0]; vAc[1][1] = vAn[1][1]; }
        if constexpr (ALIGN_EPI) { if (wr == 1) PG8_BAR; }
    }
    PG8_WAIT_V(0);
    if constexpr (!ALIGN_EPI) { if (wr == 0) PG8_BAR; }
    PG8_BAR;
    if constexpr (Epi::AFTER_DRAIN) { E.fused(acc, cur, wr, wc, fr, fq, lds, wid, lane); S.done(cur); }
#undef PG8_SA
#undef PG8_SB
#undef PG8_STAGE
#undef PG8_STAGE_A
#undef PG8_GATHER
#undef PG8_APTR
#undef PG8_BPTR
#undef PG8_LDA
#undef PG8_LDB
#undef PG8_MMA
#undef PG8_WAIT_V
#undef PG8_WAIT_L
#undef PG8_BAR
#undef PG8_SCHED
}
}

#define GAS __attribute__((address_space(1)))
#define LAS __attribute__((address_space(3)))
typedef unsigned short bf16;
typedef unsigned v4u __attribute__((ext_vector_type(4)));
typedef unsigned v2u __attribute__((ext_vector_type(2)));
typedef float f32x4 __attribute__((ext_vector_type(4)));
typedef float f32x16 __attribute__((ext_vector_type(16)));
typedef short bf16x8 __attribute__((ext_vector_type(8)));
typedef short s16x4 __attribute__((ext_vector_type(4)));
typedef GAS unsigned gu32;
#define RLX_AGENT __ATOMIC_RELAXED, __HIP_MEMORY_SCOPE_AGENT
#define LDS_WAIT() asm volatile("s_waitcnt lgkmcnt(0)" ::: "memory")
#define VM_WAIT() asm volatile("s_waitcnt vmcnt(0)" ::: "memory")
using pg8::bf2f; using pg8::bflo; using pg8::bfhi; using pg8::fsigmoid; using pg8::cvt_pk_bf16;

#ifndef MK_SPLIT
#define MK_SPLIT 0
#endif

constexpr int NWAVES = 8, NTHR = 512;
constexpr int NB = 8, SEQ = 4096, TOK = NB * SEQ, DM = 1024;
constexpr int NPROJ = 2304;
constexpr int NQ = 768, NKV = 1024, KLORA = 384, NLORA = 2048, RW = 512;
constexpr int FFD = 2816, FFE = 3584, NEXP = 8;
constexpr int MODLD = 6144;
constexpr int PASS_TILES = 136;
constexpr int PASS_ROWS = PASS_TILES * 256;

constexpr size_t MiB = 1u << 20;
constexpr size_t WS_CTL = 0, CTL_ZERO_BYTES = 64 * 1024;
constexpr size_t WS_MOD = 1 * MiB;
constexpr size_t WS_ROUTE = 2 * MiB;
constexpr size_t WS_WIN = 4 * MiB;
constexpr size_t WS_WUQ = WS_WIN + 2ull * NPROJ * DM * 2;
constexpr size_t WS_WUKV = WS_WUQ + 2ull * NQ * 256 * 2;
constexpr size_t WS_WLORA = WS_WUKV + 2ull * NKV * 128 * 2;
constexpr size_t WS_WOUT = WS_WLORA + 2ull * NLORA * KLORA * 2;
constexpr size_t WS_WF1 = WS_WOUT + 2ull * DM * DM * 2;
constexpr size_t WS_WF2 = WS_WF1 + 2ull * FFD * DM * 2;
constexpr size_t WS_WEND = WS_WF2 + (size_t)DM * FFD * 2;
constexpr size_t WS_VFIRST = 38 * MiB;
constexpr size_t WS_ARENA = 70 * MiB;
static_assert(WS_WEND <= WS_VFIRST, "weights overflow");
constexpr size_t A_H = WS_ARENA + 0 * MiB;
constexpr size_t A_PROJ = WS_ARENA + 64 * MiB;
constexpr size_t A_CQ = WS_ARENA + 208 * MiB;
constexpr size_t A_CKV = WS_ARENA + 224 * MiB;
constexpr size_t A_LA = WS_ARENA + 232 * MiB;
constexpr size_t A_KB = WS_ARENA + 256 * MiB;
constexpr size_t A_R = WS_ARENA + 304 * MiB;
constexpr size_t A_KRAW = WS_ARENA + 336 * MiB;
constexpr size_t A_VRAW = WS_ARENA + 368 * MiB;
constexpr size_t A_VB = WS_ARENA + 400 * MiB;
constexpr size_t A_KK = WS_ARENA + 432 * MiB;
constexpr size_t A_BV = WS_ARENA + 464 * MiB;
constexpr size_t A_BON = WS_ARENA + 496 * MiB;
constexpr size_t A_Q = WS_ARENA + 0 * MiB;
constexpr size_t A_LW = WS_ARENA + 64 * MiB;
constexpr size_t A_G = WS_ARENA + 128 * MiB;
constexpr size_t A_YCAT = WS_ARENA + 160 * MiB;
constexpr size_t A_HID = WS_ARENA + 64 * MiB;
constexpr size_t A_WE1 = WS_ARENA + 304 * MiB;
constexpr size_t A_WE2 = WS_ARENA + 416 * MiB;
constexpr size_t WS_END = WS_ARENA + 504 * MiB;
static_assert(A_HID + (size_t)PASS_ROWS * FFE * 2 <= A_WE1, "moe hidden overflow");
constexpr size_t RT_SEL = WS_ROUTE;
constexpr size_t RT_GW = RT_SEL + (size_t)TOK * 8;
constexpr size_t RT_CNT = RT_GW + (size_t)TOK * 8;
constexpr size_t RT_RIDX = RT_CNT + 256 * 16 * 4;
constexpr size_t RT_RGW = RT_RIDX + 2ull * PASS_ROWS * 4;
constexpr size_t RT_TILE = RT_RGW + 2ull * PASS_ROWS * 4;
static_assert(RT_TILE + 2 * (PASS_TILES + 8) * 4 <= WS_WIN, "route tables overflow");
constexpr int CW_QCTR = 64;
constexpr int CW_BAR = 4096;

constexpr int RING_BYTES = 155648;
constexpr int LDSCTL_OFF = RING_BYTES, MISC_OFF = LDSCTL_OFF + 320, PTAB_OFF = LDSCTL_OFF + 1024;
constexpr int LDS_BYTES = 163840;

#define XB_TMO      128
#define XB_XCNT(j)  (256  + 64 * (j))
#define XB_XSUB(j)  (1280 + 64 * (j))
#define XB_XGEN(j)  (2304 + 64 * (j))
#define XB_TOP      3328
#define XB_TOPGEN   3392
#define XCD_BAR_WORDS 3456
#define XB_SPIN_CAP (1u << 18)

__device__ __forceinline__ unsigned xb_ld(unsigned* p)              { return __hip_atomic_load(p, __ATOMIC_RELAXED, __HIP_MEMORY_SCOPE_AGENT); }
__device__ __forceinline__ unsigned xb_add(unsigned* p, unsigned v) { return __hip_atomic_fetch_add(p, v, __ATOMIC_RELAXED, __HIP_MEMORY_SCOPE_AGENT); }
__device__ __forceinline__ unsigned xb_xcc_id() { return (unsigned)__builtin_amdgcn_s_getreg((3 << 11) | 20) & 0xFu; }
#define XB_SPIN(cond, bar) do { unsigned _sp = 0; while (cond) { __builtin_amdgcn_s_sleep(1); \
    if ((++_sp & 255u) == 0u) { if (xb_ld(&(bar)[XB_TMO])) break; if (_sp > XB_SPIN_CAP) { atomicAdd(&(bar)[XB_TMO], 1u); break; } } } } while (0)

struct XcdBarrier {
    unsigned* bar; unsigned x;
    volatile LAS unsigned* st;
};

__device__ __forceinline__ XcdBarrier xcd_barrier_post(unsigned* bar, volatile LAS unsigned* st) {
    XcdBarrier b; b.bar = bar; b.x = xb_xcc_id(); b.st = st;
    if (threadIdx.x == 0) (void)xb_add(&bar[XB_XCNT(b.x)], 1u);
    return b;
}
__device__ __forceinline__ void xcd_barrier_complete(unsigned* bar, unsigned x, unsigned& nloc, unsigned& nx) {
    const unsigned G = gridDim.x * gridDim.y * gridDim.z;
    unsigned sum, cnt, mine, sp = 0u;
    for (;;) {
        sum = 0u; cnt = 0u; mine = 0u;
#pragma unroll
        for (unsigned j = 0; j < 16; ++j) { const unsigned c = xb_ld(&bar[XB_XCNT(j)]); sum += c; cnt += (c > 0u) ? 1u : 0u; mine = (j == x) ? c : mine; }
        if (sum == G) break;
        __builtin_amdgcn_s_sleep(1);
        if ((++sp & 255u) == 0u) { if (xb_ld(&bar[XB_TMO])) break; if (sp > XB_SPIN_CAP) { atomicAdd(&bar[XB_TMO], 1u); break; } }
    }
    nloc = mine > 0u ? mine : 1u; nx = cnt > 0u ? cnt : 1u;
}

__device__ __forceinline__ void xcd_barrier(const XcdBarrier& b) {
    asm volatile("s_waitcnt vmcnt(0)" ::: "memory");
    __syncthreads();
    if (threadIdx.x == 0) {
        unsigned* bar = b.bar;
        __builtin_amdgcn_s_waitcnt(0);
        unsigned nloc = b.st[0], nx = b.st[1];
        if (nloc == 0u) { xcd_barrier_complete(bar, b.x, nloc, nx); b.st[0] = nloc; b.st[1] = nx; }
        const unsigned old = xb_add(&bar[XB_XSUB(b.x)], 1u);
        const unsigned gen = old / nloc;
        if (old + 1u == (gen + 1u) * nloc) {
            __builtin_amdgcn_fence(__ATOMIC_RELEASE, "agent");
            asm volatile("s_waitcnt vmcnt(0)" ::: "memory");
            const unsigned og = xb_add(&bar[XB_TOP], 1u);
            const unsigned tg = og / nx;
            if (og + 1u == (tg + 1u) * nx) xb_add(&bar[XB_TOPGEN], 1u);
            else XB_SPIN(xb_ld(&bar[XB_TOPGEN]) == tg, bar);
            __builtin_amdgcn_fence(__ATOMIC_ACQUIRE, "agent");
            xb_add(&bar[XB_XGEN(b.x)], 1u);
            asm volatile("s_waitcnt vmcnt(0)" ::: "memory");
        } else {
            XB_SPIN(xb_ld(&bar[XB_XGEN(b.x)]) == gen, bar);
            __builtin_amdgcn_fence(__ATOMIC_ACQUIRE, "agent");
            asm volatile("s_waitcnt vmcnt(0)" ::: "memory");
        }
    }
    __syncthreads();
}


template <int X> __device__ __forceinline__ float lane_xor(float v) {
    if constexpr (X == 32) { const auto rr = __builtin_amdgcn_permlane32_swap(__float_as_uint(v), __float_as_uint(v), false, false); return __uint_as_float((threadIdx.x & 32) ? rr[0] : rr[1]); }
    else return __uint_as_float((unsigned)__builtin_amdgcn_ds_swizzle((int)__float_as_uint(v), 0x1f | (X << 10)));
}
__device__ __forceinline__ float wave_sum(float v) {
    v += lane_xor<1>(v); v += lane_xor<2>(v); v += lane_xor<4>(v); v += lane_xor<8>(v); v += lane_xor<16>(v);
    { const auto rr = __builtin_amdgcn_permlane32_swap(__float_as_uint(v), __float_as_uint(v), false, false); v = __uint_as_float(rr[0]) + __uint_as_float(rr[1]); }
    return v;
}
__device__ __forceinline__ v4u pk8(const float* f) { v4u w; w.x = cvt_pk_bf16(f[0], f[1]); w.y = cvt_pk_bf16(f[2], f[3]); w.z = cvt_pk_bf16(f[4], f[5]); w.w = cvt_pk_bf16(f[6], f[7]); return w; }
__device__ __forceinline__ void up8(const v4u w, float* f) { f[0] = bflo(w.x); f[1] = bfhi(w.x); f[2] = bflo(w.y); f[3] = bfhi(w.y); f[4] = bflo(w.z); f[5] = bfhi(w.z); f[6] = bflo(w.w); f[7] = bfhi(w.w); }

__device__ __forceinline__ void tr_item(const float* W, int ldw, bf16* WT, int ldk, int k0, int n0, int drow0, LAS float* scr, int lane) {
#pragma unroll 8
    for (int i = 0; i < 32; ++i) { const int kk = 2 * i + (lane >> 5); scr[kk * 33 + (lane & 31)] = W[(size_t)(k0 + kk) * ldw + n0 + (lane & 31)]; }
    LDS_WAIT(); asm volatile("" ::: "memory");
    const int c = lane & 7;
#pragma unroll
    for (int j = 0; j < 4; ++j) { const int n = (lane >> 3) + 8 * j; const LAS float* s = scr + (8 * c) * 33 + n;
        v4u o; o.x = cvt_pk_bf16(s[0 * 33], s[1 * 33]); o.y = cvt_pk_bf16(s[2 * 33], s[3 * 33]); o.z = cvt_pk_bf16(s[4 * 33], s[5 * 33]); o.w = cvt_pk_bf16(s[6 * 33], s[7 * 33]);
        *(GAS v4u*)(WT + (size_t)(drow0 + n) * ldk + k0 + 8 * c) = o; }
    LDS_WAIT(); asm volatile("" ::: "memory");
}
__device__ __forceinline__ void conv_item(const float* W, int K, int N, bf16* WT, int ldk, int mode, int row_off, int item, LAS float* scr, int lane) {
    const int nblk = N / 32, kb = item / nblk, nb = item % nblk, n0 = 32 * nb;
    int drow = n0 + row_off;
    if (mode != 0) drow = 256 * (n0 >> 7) + (n0 & 127) + (mode == 2 ? 128 : 0);
    tr_item(W, N, WT, ldk, 64 * kb, n0, drow, scr, lane);
}
struct In { const float* p[38]; };
struct InT { volatile LAS unsigned* t;
    __device__ __forceinline__ const float* operator[](int i) const { const unsigned lo = __builtin_amdgcn_readfirstlane(t[2 * i]), hi = __builtin_amdgcn_readfirstlane(t[2 * i + 1]);
        return (const float*)(((unsigned long long)hi << 32) | (unsigned long long)lo); } };

__device__ __forceinline__ void p0_weights(const InT in, unsigned char* ws, LAS unsigned char* lds, int gw, int NGW, int wave, int lane, int gtid, int NGT) {
    LAS float* scr = (LAS float*)(lds + wave * 16384);
    constexpr int I_IN = 16 * 70, I_VR = 16, I_UQ = 4 * 24, I_UKV = 2 * 32, I_OUT = 16 * 32, I_G = 16 * 88, I_D = 44 * 32;
    constexpr int PER_L = I_IN + I_UQ + I_UKV + I_OUT;
    constexpr int NITEMS = 2 * PER_L + I_VR + 2 * I_G + I_D;
    for (int it = gw; it < NITEMS; it += NGW) {
        int r = it;
        if (r < 2 * PER_L) { const int l = r / PER_L; r -= l * PER_L;
            if (r < I_IN) { conv_item(in[7] + (size_t)l * DM * 2240, DM, 2240, (bf16*)(ws + WS_WIN) + (size_t)l * NPROJ * DM, DM, 0, 0, r, scr, lane); continue; } r -= I_IN;
            if (r < I_UQ) { conv_item(in[10] + (size_t)l * 256 * NQ, 256, NQ, (bf16*)(ws + WS_WUQ) + (size_t)l * NQ * 256, 256, 0, 0, r, scr, lane); continue; } r -= I_UQ;
            if (r < I_UKV) { conv_item(in[12] + (size_t)l * 128 * NKV, 128, NKV, (bf16*)(ws + WS_WUKV) + (size_t)l * NKV * 128, 128, 0, 0, r, scr, lane); continue; } r -= I_UKV;
            conv_item(in[28] + (size_t)l * DM * DM, DM, DM, (bf16*)(ws + WS_WOUT) + (size_t)l * DM * DM, DM, 0, 0, r, scr, lane); continue; }
        r -= 2 * PER_L;
        if (r < I_VR) { conv_item(in[8], DM, 32, (bf16*)(ws + WS_WIN) + (size_t)NPROJ * DM, DM, 0, 2240, r, scr, lane); continue; } r -= I_VR;
        if (r < I_G) { conv_item(in[29], DM, FFD, (bf16*)(ws + WS_WF1), DM, 1, 0, r, scr, lane); continue; } r -= I_G;
        if (r < I_G) { conv_item(in[30], DM, FFD, (bf16*)(ws + WS_WF1), DM, 2, 0, r, scr, lane); continue; } r -= I_G;
        conv_item(in[31], FFD, DM, (bf16*)(ws + WS_WF2), FFD, 0, 0, r, scr, lane);
    }
    { const int n0 = 64 * 128, n1 = 32 * 128;
      for (int i = gtid; i < n0 + n1; i += NGT) { const bool l1 = i >= n0; const int j = l1 ? i - n0 : i; const int row = (l1 ? 2272 : 2240) + j / 128, ch = j % 128;
          *(GAS v4u*)((bf16*)(ws + WS_WIN) + ((size_t)(l1 ? NPROJ : 0) + row) * DM + ch * 8) = (v4u){0u, 0u, 0u, 0u}; } }
    const float* pw2 = in[17]; const float* pa2 = in[19]; const float* pg2 = in[20]; const float* pv2 = in[22];
    for (int i = gtid; i < 2 * NLORA * (KLORA / 8); i += NGT) {
        const int l = i / (NLORA * 48), rem = i % (NLORA * 48), k8 = rem / NLORA, pos = rem % NLORA;
        const int seg = pos >> 9, p9 = pos & 511, ct = p9 >> 8, p8 = p9 & 255, bj = p8 >> 7, wc = (p8 >> 5) & 3, x = p8 & 31;
        const int oc = 256 * ct + 64 * wc + 32 * bj + x;
        const int k0 = k8 * 8;
        const float* src = nullptr; int kr = 0;
        if (seg == 0 && k0 < 64) { src = pw2 + (size_t)l * 64 * RW; kr = k0; }
        else if (seg == 1 && k0 >= 64 && k0 < 128) { src = pa2 + (size_t)l * 64 * RW; kr = k0 - 64; }
        else if (seg == 2 && k0 >= 128 && k0 < 256) { src = pg2 + (size_t)l * 128 * RW; kr = k0 - 128; }
        else if (seg == 3 && l == 1 && k0 >= 256 && k0 < 288) { src = pv2; kr = k0 - 256; }
        float f[8];
#pragma unroll
        for (int e = 0; e < 8; ++e) f[e] = src ? src[(size_t)(kr + e) * RW + oc] : 0.f;
        *(GAS v4u*)((bf16*)(ws + WS_WLORA) + ((size_t)l * NLORA + pos) * KLORA + k0) = pk8(f);
    }
}
__device__ __forceinline__ void p_expert_weights(const InT in, unsigned char* ws, LAS unsigned char* lds, int gw, int NGW, int wave, int lane) {
    LAS float* scr = (LAS float*)(lds + wave * 16384);
    constexpr int IPJ = 1792;
    for (int it = gw; it < 24 * IPJ; it += NGW) { const int job = it / IPJ, r = it % IPJ, e = job / 3, kind = job % 3;
        if (kind == 0) conv_item(in[34] + (size_t)e * DM * FFE, DM, FFE, (bf16*)(ws + A_WE1) + (size_t)e * 2 * FFE * DM, DM, 1, 0, r, scr, lane);
        else if (kind == 1) conv_item(in[35] + (size_t)e * DM * FFE, DM, FFE, (bf16*)(ws + A_WE1) + (size_t)e * 2 * FFE * DM, DM, 2, 0, r, scr, lane);
        else conv_item(in[36] + (size_t)e * FFE * DM, FFE, DM, (bf16*)(ws + A_WE2) + (size_t)e * DM * FFE, FFE, 0, 0, r, scr, lane); }
}
__device__ __forceinline__ void p0_mod(const InT in, unsigned char* ws, LAS unsigned char* lds, int vcu, int G, int wave, int lane, int tid) {
    LAS float* cond = (LAS float*)lds;
    LAS float* red = (LAS float*)(lds + 32768);
    const float* cin = in[1]; const float* wada = in[3]; const float* bada = in[4];
    for (int i = tid; i < NB * DM; i += NTHR) { const float c = cin[i]; cond[i] = c * fsigmoid(c); }
    __syncthreads();
    float* MOD = (float*)(ws + WS_MOD);
    for (int it = vcu; it < 2 * (MODLD / 64); it += G) { const int l = it / (MODLD / 64), n0 = (it % (MODLD / 64)) * 64;
        const float* W = wada + (size_t)l * DM * MODLD + n0 + lane;
        float a[8] = {0.f, 0.f, 0.f, 0.f, 0.f, 0.f, 0.f, 0.f};
#pragma unroll 4
        for (int k = wave * 128; k < wave * 128 + 128; ++k) { const float w = W[(size_t)k * MODLD];
#pragma unroll
            for (int b = 0; b < 8; ++b) a[b] += cond[b * DM + k] * w; }
#pragma unroll
        for (int b = 0; b < 8; ++b) red[(wave * 8 + b) * 64 + lane] = a[b];
        __syncthreads();
        { const int b = tid >> 6, n = tid & 63; float s = bada[(size_t)l * MODLD + n0 + n];
#pragma unroll
          for (int w = 0; w < 8; ++w) s += red[(w * 8 + b) * 64 + n];
          MOD[((size_t)l * NB + b) * MODLD + n0 + n] = s; }
        __syncthreads();
    }
}

template <bool ROUTER>
__device__ __forceinline__ void norm_phase(const float* xin, const float* g, const float* modl, int sh_off, bf16* H, const float* wr, const float* br, unsigned char* ws,
                                           LAS unsigned char* lds, int vcu, int G, int wave, int lane, int tid) {
    LAS int* cntl = (LAS int*)lds;
    for (int blk = vcu; blk < TOK / 128; blk += G) {
        if (ROUTER) { if (tid < 16) cntl[tid] = 0; __syncthreads(); }
        const int row0 = blk * 128 + wave * 16, b = row0 >> 12;
        const float* shp = modl + (size_t)b * MODLD + sh_off; const float* scp = shp + 1024;
        f32x4 gs[4], sh[4];
#pragma unroll
        for (int j = 0; j < 4; ++j) { const int c = 4 * lane + 256 * j; const f32x4 gg = *(const f32x4*)(g + c), sc = *(const f32x4*)(scp + c); gs[j] = gg * (sc + 1.0f); sh[j] = *(const f32x4*)(shp + c); }
        for (int r = 0; r < 16; ++r) { const int row = row0 + r;
            const GAS f32x4* xr = (const GAS f32x4*)(xin + (size_t)row * DM) + lane;
            f32x4 v[4]; float s = 0.f;
#pragma unroll
            for (int j = 0; j < 4; ++j) { v[j] = xr[64 * j]; s += (v[j].x * v[j].x + v[j].y * v[j].y) + (v[j].z * v[j].z + v[j].w * v[j].w); }
            const float rstd = 1.0f / sqrtf(wave_sum(s) * (1.0f / DM) + 1e-6f);
            GAS unsigned long long* o8 = (GAS unsigned long long*)(H + (size_t)row * DM) + lane;
#pragma unroll
            for (int j = 0; j < 4; ++j) { v[j] = v[j] * rstd * gs[j] + sh[j]; o8[64 * j] = (unsigned long long)cvt_pk_bf16(v[j].x, v[j].y) | ((unsigned long long)cvt_pk_bf16(v[j].z, v[j].w) << 32); }
            if (ROUTER) {
                float lg[8];
#pragma unroll
                for (int e = 0; e < 8; ++e) lg[e] = 0.f;
#pragma unroll
                for (int j = 0; j < 4; ++j)
#pragma unroll
                    for (int i = 0; i < 4; ++i) { const f32x4 w0 = *(const f32x4*)(wr + (size_t)(4 * lane + 256 * j + i) * 8), w1 = *(const f32x4*)(wr + (size_t)(4 * lane + 256 * j + i) * 8 + 4); const float hv = v[j][i];
                        lg[0] += hv * w0.x; lg[1] += hv * w0.y; lg[2] += hv * w0.z; lg[3] += hv * w0.w; lg[4] += hv * w1.x; lg[5] += hv * w1.y; lg[6] += hv * w1.z; lg[7] += hv * w1.w; }
#pragma unroll
                for (int e = 0; e < 8; ++e) lg[e] = wave_sum(lg[e]) + br[e];
                unsigned key[8];
#pragma unroll
                for (int e = 0; e < 8; ++e) { const unsigned u = __float_as_uint(lg[e]); const unsigned kx = (u & 0x80000000u) ? ~u : (u | 0x80000000u); key[e] = (kx & ~7u) | (unsigned)(7 - e); }
                unsigned k1 = key[0];
#pragma unroll
                for (int e = 1; e < 8; ++e) k1 = key[e] > k1 ? key[e] : k1;
                unsigned k2 = 0u;
#pragma unroll
                for (int e = 0; e < 8; ++e) { const unsigned t = (key[e] == k1) ? 0u : key[e]; k2 = t > k2 ? t : k2; }
                k1 = (unsigned)__builtin_amdgcn_readfirstlane((int)k1); k2 = (unsigned)__builtin_amdgcn_readfirstlane((int)k2);
                const int i1 = 7 - (int)(k1 & 7u), i2 = 7 - (int)(k2 & 7u);
                const float v1 = __uint_as_float((k1 & 0x80000000u) ? (k1 & 0x7fffffffu) : ~k1), v2 = __uint_as_float((k2 & 0x80000000u) ? (k2 & 0x7fffffffu) : ~k2);
                const float w2 = 1.0f / (1.0f + __expf(v1 - v2)), w1 = 1.0f - w2;
                if (lane == 0) { *(GAS int*)(ws + RT_SEL + (size_t)row * 8) = i1; *(GAS int*)(ws + RT_SEL + (size_t)row * 8 + 4) = i2; *(GAS float*)(ws + RT_GW + (size_t)row * 8) = w1; *(GAS float*)(ws + RT_GW + (size_t)row * 8 + 4) = w2;
                    atomicAdd((int*)&cntl[i1], 1); atomicAdd((int*)&cntl[8 + i2], 1); }
            }
        }
        if (ROUTER) {
            __syncthreads();
            if (tid < 16) *(GAS int*)(ws + RT_CNT + ((size_t)blk * 16 + tid) * 4) = cntl[tid];
            __syncthreads();
        }
    }
}
__device__ __forceinline__ void final_norm(float* x, const float* g, int gw, int NGW, int lane) {
    f32x4 gs[4];
#pragma unroll
    for (int j = 0; j < 4; ++j) gs[j] = *(const f32x4*)(g + 4 * lane + 256 * j);
    for (int row = gw; row < TOK; row += NGW) { GAS f32x4* xr = (GAS f32x4*)(x + (size_t)row * DM) + lane; f32x4 v[4]; float s = 0.f;
#pragma unroll
        for (int j = 0; j < 4; ++j) { v[j] = xr[64 * j]; s += (v[j].x * v[j].x + v[j].y * v[j].y) + (v[j].z * v[j].z + v[j].w * v[j].w); }
        const float rstd = 1.0f / sqrtf(wave_sum(s) * (1.0f / DM) + 1e-6f);
#pragma unroll
        for (int j = 0; j < 4; ++j) xr[64 * j] = v[j] * rstd * gs[j]; }
}

__device__ __forceinline__ void rw_chunk(int l, int m, bool first, int ci, const bf16* prow, const float* mu_l, const float* mu_v, unsigned char* ws) {
    const int cr = ci * 8 - 448;
    float p[8], q[8], mu[8];
    up8(*(const GAS v4u*)(prow + ci * 8), p);
    if (first) {
#pragma unroll
        for (int e = 0; e < 8; ++e) q[e] = 0.f; }
    else up8(*(const GAS v4u*)(prow - NPROJ + ci * 8), q);
    const float* mup = (cr < 1792) ? mu_l + cr : mu_v + (cr - 1792);
    *(f32x4*)mu = *(const f32x4*)mup; *(f32x4*)(mu + 4) = *(const f32x4*)(mup + 4);
    float xs[8];
#pragma unroll
    for (int e = 0; e < 8; ++e) xs[e] = p[e] + (q[e] - p[e]) * mu[e];
    bf16* dst;
    if (cr < 512) dst = (bf16*)(ws + A_R) + (size_t)m * RW + cr;
    else if (cr < 1024) dst = (bf16*)(ws + A_KRAW) + (size_t)m * RW + (cr - 512);
    else if (cr < 1536) dst = (bf16*)(ws + (l == 0 ? WS_VFIRST : A_VRAW)) + (size_t)m * RW + (cr - 1024);
    else if (cr < 1600) { dst = (bf16*)(ws + A_LA) + (size_t)m * KLORA + (cr - 1536);
#pragma unroll
        for (int e = 0; e < 8; ++e) xs[e] = 1.0f - 2.0f * __builtin_amdgcn_rcpf(1.0f + __builtin_amdgcn_exp2f(2.885390081777927f * xs[e])); }
    else if (cr < 1664) dst = (bf16*)(ws + A_LA) + (size_t)m * KLORA + 64 + (cr - 1600);
    else if (cr < 1792) { dst = (bf16*)(ws + A_LA) + (size_t)m * KLORA + 128 + (cr - 1664);
#pragma unroll
        for (int e = 0; e < 8; ++e) xs[e] = fsigmoid(xs[e]); }
    else dst = (bf16*)(ws + A_LA) + (size_t)m * KLORA + 256 + (cr - 1792);
    *(GAS v4u*)dst = pk8(xs);
}
__device__ __forceinline__ void prep_phase(int l, const InT in, unsigned char* ws, int gw, int NGW, int lane) {
    const bf16* PROJ = (const bf16*)(ws + A_PROJ);
    const int* pos = (const int*)in[2]; const float* mu_l = in[14] + (size_t)l * 1792; const float* mu_v = in[15];
    float gn[8];
    { const float* gp = (lane < 32) ? in[9] + (size_t)l * 256 + lane * 8 : in[11] + (size_t)l * 128 + ((lane - 32) & 15) * 8;
#pragma unroll
      for (int e = 0; e < 8; ++e) gn[e] = gp[e]; }
    float frq[8];
#pragma unroll
    for (int e = 0; e < 8; ++e) { const int i = 8 * (lane & 3) + e; frq[e] = __builtin_amdgcn_exp2f(-(float)i * (13.287712379549449f / 32.0f)) * 0.15915494309189535f; }
    for (int m = gw; m < TOK; m += NGW) {
        const bf16* prow = PROJ + (size_t)m * NPROJ; const bool first = (m & (SEQ - 1)) == 0;
        float p[8]; up8(*(const GAS v4u*)(prow + lane * 8), p);
        float ss = 0.f;
#pragma unroll
        for (int e = 0; e < 8; ++e) ss += p[e] * p[e];
        const float sq = wave_sum(lane < 32 ? ss : 0.f), skv = wave_sum((lane >= 32 && lane < 48) ? ss : 0.f);
        float oth[8];
#pragma unroll
        for (int e = 0; e < 8; ++e) oth[e] = lane_xor<4>(p[e]);
        if (lane < 32) { const float rstd = 1.0f / sqrtf(sq * (1.0f / 256.0f) + 1e-6f); float o[8];
#pragma unroll
            for (int e = 0; e < 8; ++e) o[e] = p[e] * rstd * gn[e];
            *(GAS v4u*)((bf16*)(ws + A_CQ) + (size_t)m * 256 + lane * 8) = pk8(o); }
        else if (lane < 48) { const float rstd = 1.0f / sqrtf(skv * (1.0f / 128.0f) + 1e-6f); float o[8];
#pragma unroll
            for (int e = 0; e < 8; ++e) o[e] = p[e] * rstd * gn[e];
            *(GAS v4u*)((bf16*)(ws + A_CKV) + (size_t)m * 128 + (lane - 32) * 8) = pk8(o); }
        else if (lane < 56) { const float ps = (float)pos[m]; const bool hi = lane >= 52; float o[8];
#pragma unroll
            for (int e = 0; e < 8; ++e) { float rev = ps * frq[e]; rev -= rintf(rev); const float cs = __builtin_amdgcn_cosf(rev), sn = __builtin_amdgcn_sinf(rev);
                o[e] = hi ? (p[e] * cs + oth[e] * sn) : (p[e] * cs - oth[e] * sn); }
            const v4u w = pk8(o); const int b = m >> 12, s = m & (SEQ - 1); const int dim = 128 + (hi ? 32 : 0) + 8 * (lane & 3);
#pragma unroll
            for (int h = 0; h < 4; ++h) *(GAS v4u*)((bf16*)(ws + A_KB) + ((size_t)(b * 4 + h) * SEQ + s) * 192 + dim) = w; }
        else rw_chunk(l, m, first, lane, prow, mu_l, mu_v, ws);
#pragma unroll
        for (int j = 1; j < 4; ++j) rw_chunk(l, m, first, lane + 64 * j, prow, mu_l, mu_v, ws);
        if (lane < 24 || (l == 1 && lane < 28)) rw_chunk(l, m, first, lane + 256, prow, mu_l, mu_v, ws);
        else if (lane >= 32 && lane < 48 && (l == 0 || lane >= 36)) *(GAS v4u*)((bf16*)(ws + A_LA) + (size_t)m * KLORA + lane * 8) = (v4u){0u, 0u, 0u, 0u};
    }
}
__device__ __forceinline__ void onorm_phase(const float* g, unsigned char* ws, int gw, int NGW, int lane) {
    float gn[8];
#pragma unroll
    for (int e = 0; e < 8; ++e) gn[e] = g[lane * 8 + e];
    for (int m = gw; m < TOK; m += NGW) { GAS v4u* pp = (GAS v4u*)((bf16*)(ws + A_YCAT) + (size_t)m * DM + lane * 8); float p[8]; up8(*pp, p); float ss = 0.f;
#pragma unroll
        for (int e = 0; e < 8; ++e) ss += p[e] * p[e];
        const float rstd = 1.0f / sqrtf(wave_sum(ss) * (1.0f / 512.0f) + 1e-6f);
#pragma unroll
        for (int e = 0; e < 8; ++e) p[e] = p[e] * rstd * gn[e];
        *pp = pk8(p); }
}

__device__ __forceinline__ void route_scatter(unsigned char* ws, LAS unsigned char* lds, int vcu, int G, int wave, int lane, int tid) {
    LAS int* tot = (LAS int*)lds;
    LAS int* seg = tot + 16;
    LAS int* base = seg + 32;
    const GAS int* CNT = (const GAS int*)(ws + RT_CNT);
    if (tid < 16) { int s = 0; for (int w = 0; w < 256; ++w) s += CNT[w * 16 + tid]; tot[tid] = s; }
    __syncthreads();
    if (tid < 2) { int a = 0; for (int e = 0; e < 8; ++e) { seg[tid * 9 + e] = a; a += (tot[tid * 8 + e] + 255) & ~255; } seg[tid * 9 + 8] = a; }
    __syncthreads();
    GAS int* RIDX = (GAS int*)(ws + RT_RIDX); GAS float* RGW = (GAS float*)(ws + RT_RGW);
    if (vcu == 0 && tid < 2) { GAS int* TL = (GAS int*)(ws + RT_TILE) + tid * (PASS_TILES + 8); const int nt = seg[tid * 9 + 8] >> 8; TL[0] = nt;
        for (int e = 0; e < 8; ++e) for (int t = seg[tid * 9 + e] >> 8; t < (seg[tid * 9 + e + 1] >> 8); ++t) TL[8 + t] = e; }
    for (int pe = vcu; pe < 16; pe += G) { const int k = pe >> 3, e = pe & 7; const int s0 = seg[k * 9 + e] + tot[pe], s1 = seg[k * 9 + e + 1];
        for (int i = s0 + tid; i < s1; i += NTHR) { RIDX[k * PASS_ROWS + i] = -1; RGW[k * PASS_ROWS + i] = 0.f; } }
    for (int blk = vcu; blk < TOK / 128; blk += G) {
        __syncthreads();
        if (tid < 16) { int s = 0; for (int w = 0; w < blk; ++w) s += CNT[w * 16 + tid]; base[tid] = seg[(tid >> 3) * 9 + (tid & 7)] + s; }
        __syncthreads();
        if (wave < 2) { const int k = wave;
            int run[8];
#pragma unroll
            for (int e = 0; e < 8; ++e) run[e] = base[k * 8 + e];
            for (int r = 0; r < 2; ++r) { const int row = blk * 128 + r * 64 + lane; const int ex = *(const GAS int*)(ws + RT_SEL + (size_t)row * 8 + 4 * k); const float gwv = *(const GAS float*)(ws + RT_GW + (size_t)row * 8 + 4 * k);
                int mypos = 0;
#pragma unroll
                for (int e = 0; e < 8; ++e) { const unsigned long long mk = __ballot(ex == e); const int rank = __popcll(mk & ((1ull << lane) - 1ull)); if (ex == e) mypos = run[e] + rank; run[e] += __popcll(mk); }
                RIDX[k * PASS_ROWS + mypos] = row; RGW[k * PASS_ROWS + mypos] = gwv; } }
    }
}

namespace att {
constexpr int KVB = 64, KROW = 400, SHM_K = KVB * KROW, SHM_V = KVB * 128 * 2;
constexpr int OFF_V = 0, OFF_K = 2 * SHM_V, OFF_WS = OFF_K + 2 * SHM_K, LDS_BYTES = OFF_WS + NWAVES * 64 * 4;
static_assert(LDS_BYTES <= RING_BYTES, "attention LDS");
#define SBAR() __builtin_amdgcn_sched_barrier(0)
__device__ __forceinline__ int v_st(int k, int c) { const int kk = (k & ~0xC) | ((k & 4) << 1) | ((k & 8) >> 1); return ((kk >> 3) * 4 + (c >> 5)) * 512 + ((kk & 7) * 32 + (c & 31)) * 2; }
__device__ __forceinline__ int v_rd_base(int lane) { return ((lane & 3) << 3) | (((lane >> 2) & 3) << 6) | (((lane >> 4) & 1) << 5) | (((lane >> 5) & 1) << 8); }
constexpr int v_rd_off(int d0, int ks, int half) { return d0 * 512 + ks * 4096 + half * 2048; }
__device__ __forceinline__ int crow(int r, int hi) { return (r & 3) + 8 * (r >> 2) + 4 * hi; }
__device__ __forceinline__ unsigned cvtpk(float lo, float hi) { return cvt_pk_bf16(lo, hi); }
__device__ __forceinline__ void mask_tile(f32x16& p0, f32x16& p1, int dq) {
    const float NEG = -__builtin_inff();
#pragma unroll
    for (int r = 0; r < 16; ++r) { const int c = (r & 3) + 8 * (r >> 2);
        if (dq - c < 0) p0[r] = NEG;
        if (dq - c - 32 < 0) p1[r] = NEG; }
}
template <int VB>
__device__ __forceinline__ void pv_tile(f32x16* o, int vb0, bf16x8 pa0, bf16x8 pa1, bf16x8 pa2, bf16x8 pa3) {
#define TRRD(dst, off) asm volatile("ds_read_b64_tr_b16 %0, %1 offset:%2" : "=&v"(dst) : "v"(vb0), "i"(off) : "memory")
#define PV_D0(d0) do { s16x4 l0, l1, l2, l3, h0, h1, h2, h3; constexpr int b_ = VB * SHM_V + v_rd_off(d0, 0, 0); \
        TRRD(l0, b_); TRRD(h0, b_ + 2048); TRRD(l1, b_ + 4096); TRRD(h1, b_ + 6144); TRRD(l2, b_ + 8192); TRRD(h2, b_ + 10240); TRRD(l3, b_ + 12288); TRRD(h3, b_ + 14336); \
        asm volatile("s_waitcnt lgkmcnt(0)" ::: "memory"); SBAR(); \
        o[d0] = __builtin_amdgcn_mfma_f32_32x32x16_bf16(pa0, (bf16x8){l0[0], l0[1], l0[2], l0[3], h0[0], h0[1], h0[2], h0[3]}, o[d0], 0, 0, 0); \
        o[d0] = __builtin_amdgcn_mfma_f32_32x32x16_bf16(pa1, (bf16x8){l1[0], l1[1], l1[2], l1[3], h1[0], h1[1], h1[2], h1[3]}, o[d0], 0, 0, 0); \
        o[d0] = __builtin_amdgcn_mfma_f32_32x32x16_bf16(pa2, (bf16x8){l2[0], l2[1], l2[2], l2[3], h2[0], h2[1], h2[2], h2[3]}, o[d0], 0, 0, 0); \
        o[d0] = __builtin_amdgcn_mfma_f32_32x32x16_bf16(pa3, (bf16x8){l3[0], l3[1], l3[2], l3[3], h3[0], h3[1], h3[2], h3[3]}, o[d0], 0, 0, 0); } while (0)
    PV_D0(0); PV_D0(1); PV_D0(2); PV_D0(3);
#undef PV_D0
#undef TRRD
}
template <int KBUF>
__device__ __forceinline__ void qkt(f32x16& p0, f32x16& p1, LAS unsigned char* lds, int r32, int hi, const bf16x8* qr) {
    p0 = f32x16{}; p1 = f32x16{};
    const LAS unsigned char* a = lds + OFF_K + KBUF * SHM_K + r32 * KROW + hi * 16;
#pragma unroll
    for (int d0 = 0; d0 < 12; ++d0) {
        const bf16x8 b0 = *(const LAS bf16x8*)(a + d0 * 32);
        const bf16x8 b1 = *(const LAS bf16x8*)(a + 32 * KROW + d0 * 32);
        p0 = __builtin_amdgcn_mfma_f32_32x32x16_bf16(b0, qr[d0], p0, 0, 0, 0);
        p1 = __builtin_amdgcn_mfma_f32_32x32x16_bf16(b1, qr[d0], p1, 0, 0, 0); }
}
__device__ __forceinline__ void attn_unit(int b, int h, int qb, const bf16* Q, const bf16* K, const bf16* V, bf16* O, const int* pos, LAS unsigned char* lds) {
    int tid_ = threadIdx.x; asm volatile("" : "+v"(tid_));
    const int tid = tid_, wid = __builtin_amdgcn_readfirstlane(tid >> 6), lane = tid & 63, r32 = lane & 31, hi = lane >> 5;
    const int m0 = b * SEQ + qb * 256 + wid * 32;
    const int qpos = qb * 256 + wid * 32;
    bf16x8 qr[12];
    { const bf16* qp = Q + (size_t)(m0 + r32) * NQ + h * 192 + hi * 8; const float C2 = 0.07216878364870323f * 1.4426950408889634f;
      float f[12][8];
#pragma unroll
      for (int d0 = 0; d0 < 12; ++d0) up8(*(const GAS v4u*)(qp + d0 * 16), f[d0]);
      const float ps = (float)pos[m0 + r32];
#pragma unroll
      for (int g = 0; g < 2; ++g)
#pragma unroll
          for (int e = 0; e < 8; ++e) { const int i = 16 * g + 8 * hi + e; float rev = ps * (__builtin_amdgcn_exp2f(-(float)i * (13.287712379549449f / 32.0f)) * 0.15915494309189535f); rev -= rintf(rev);
              const float cs = __builtin_amdgcn_cosf(rev), sn = __builtin_amdgcn_sinf(rev); const float t1 = f[8 + g][e], t2 = f[10 + g][e];
              f[8 + g][e] = t1 * cs - t2 * sn; f[10 + g][e] = t2 * cs + t1 * sn; }
#pragma unroll
      for (int d0 = 0; d0 < 12; ++d0) { v4u w; w.x = cvtpk(f[d0][0] * C2, f[d0][1] * C2); w.y = cvtpk(f[d0][2] * C2, f[d0][3] * C2); w.z = cvtpk(f[d0][4] * C2, f[d0][5] * C2); w.w = cvtpk(f[d0][6] * C2, f[d0][7] * C2);
          qr[d0] = __builtin_bit_cast(bf16x8, w); } }
    const bf16* Kh = K + (size_t)(b * 4 + h) * SEQ * 192; const bf16* Vh = V + (size_t)(b * 4 + h) * SEQ * 128;
    const int NT = (qb + 1) * 4;
    LAS float* wsl = (LAS float*)(lds + OFF_WS) + wid * 64; LAS float* li_l = wsl; LAS float* al_l = wsl + 32;
    float m_reg = -1e30f, l_reg = 0.f; f32x16 o[4] = {};
    const int sr = tid >> 4, sc = (tid & 15) * 8, vst0 = v_st(sr, sc), vst1 = v_st(32 + sr, sc);
    const int vb0 = (int)(uintptr_t)(lds + OFF_V) + v_rd_base(lane);
    int kq[3], kl[3];
#pragma unroll
    for (int i = 0; i < 3; ++i) { const int q = tid + 512 * i; kq[i] = q * 8; kl[i] = (q / 24) * KROW + (q % 24) * 16; }
    v4u sk[3], sv[2];
#define ST_LOAD(t) do { const bf16* kp_ = Kh + (size_t)(t) * KVB * 192; const bf16* vp_ = Vh + (size_t)(t) * KVB * 128; \
        _Pragma("unroll") for (int i = 0; i < 3; ++i) sk[i] = *(const GAS v4u*)(kp_ + kq[i]); \
        sv[0] = *(const GAS v4u*)(vp_ + (size_t)sr * 128 + sc); sv[1] = *(const GAS v4u*)(vp_ + (size_t)(32 + sr) * 128 + sc); } while (0)
#define ST_WRITE(bf) do { _Pragma("unroll") for (int i = 0; i < 3; ++i) *(LAS v4u*)(lds + OFF_K + (bf) * SHM_K + kl[i]) = sk[i]; \
        *(LAS v4u*)(lds + OFF_V + (bf) * SHM_V + vst0) = sv[0]; *(LAS v4u*)(lds + OFF_V + (bf) * SHM_V + vst1) = sv[1]; } while (0)
#define TILE_STEP(t, BF) do { f32x16 p0, p1; \
        if ((t) + 1 < NT) ST_LOAD((t) + 1); \
        qkt<BF>(p0, p1, lds, r32, hi, qr); \
        { const int kb_ = (t) * KVB; if (kb_ + KVB - 1 > qpos) mask_tile(p0, p1, qpos + r32 - 4 * hi - kb_); } \
        float pmax = p0[0]; _Pragma("unroll") for (int r = 1; r < 16; ++r) pmax = fmaxf(pmax, p0[r]); _Pragma("unroll") for (int r = 0; r < 16; ++r) pmax = fmaxf(pmax, p1[r]); \
        { auto rr = __builtin_amdgcn_permlane32_swap(__float_as_uint(pmax), __float_as_uint(pmax), false, false); pmax = fmaxf(__uint_as_float(rr[0]), __uint_as_float(rr[1])); } \
        const float mn = fmaxf(m_reg, pmax), alpha = __builtin_amdgcn_exp2f(m_reg - mn); m_reg = mn; \
        float psum = 0.f; \
        _Pragma("unroll") for (int r = 0; r < 16; ++r) { p0[r] = __builtin_amdgcn_exp2f(p0[r] - mn); p1[r] = __builtin_amdgcn_exp2f(p1[r] - mn); psum += p0[r] + p1[r]; } \
        { auto rr = __builtin_amdgcn_permlane32_swap(__float_as_uint(psum), __float_as_uint(psum), false, false); psum = __uint_as_float(rr[0]) + __uint_as_float(rr[1]); } \
        l_reg = l_reg * alpha + psum; \
        bf16x8 pa0, pa1, pa2, pa3; \
        PK4(p0, 0, pa0); PK4(p0, 8, pa1); PK4(p1, 0, pa2); PK4(p1, 8, pa3); \
        if (__any(alpha < 1.f)) { if (hi == 0) al_l[r32] = alpha; asm volatile("s_waitcnt lgkmcnt(0)" ::: "memory"); \
            _Pragma("unroll") for (int d_ = 0; d_ < 4; ++d_) _Pragma("unroll") for (int r = 0; r < 16; ++r) o[d_][r] *= al_l[crow(r, hi)]; } \
        pv_tile<BF>(o, vb0, pa0, pa1, pa2, pa3); \
        if ((t) + 1 < NT) { VM_WAIT(); ST_WRITE(1 - (BF)); } \
        __syncthreads(); } while (0)
#define PK4(P, B_, OUT) do { unsigned a0 = cvtpk(P[B_+0], P[B_+1]), a1 = cvtpk(P[B_+2], P[B_+3]); \
        unsigned b0 = cvtpk(P[B_+4], P[B_+5]), b1 = cvtpk(P[B_+6], P[B_+7]); \
        auto r0 = __builtin_amdgcn_permlane32_swap(a0, b0, false, false); auto r1 = __builtin_amdgcn_permlane32_swap(a1, b1, false, false); \
        v4u w = {r0[0], r1[0], r0[1], r1[1]}; OUT = __builtin_bit_cast(bf16x8, w); } while (0)
    __syncthreads();
    ST_LOAD(0); VM_WAIT(); ST_WRITE(0);
    __syncthreads();
    for (int t = 0; t < NT; t += 2) { TILE_STEP(t, 0); TILE_STEP(t + 1, 1); }
#undef PK4
#undef TILE_STEP
#undef ST_LOAD
#undef ST_WRITE
    if (hi == 0) li_l[r32] = l_reg;
    asm volatile("s_waitcnt lgkmcnt(0)" ::: "memory");
    float rli[16];
#pragma unroll
    for (int r = 0; r < 16; ++r) rli[r] = __builtin_amdgcn_rcpf(li_l[crow(r, hi)]);
    bf16* Ow = O + (size_t)m0 * DM + h * 128;
#pragma unroll
    for (int r = 0; r < 16; ++r) { const int orow = crow(r, hi);
#pragma unroll
        for (int d0 = 0; d0 < 4; ++d0) { const float v = o[d0][r] * rli[r]; const float vn = lane_xor<1>(v);
            if ((r32 & 1) == 0) *(GAS unsigned*)(Ow + (size_t)orow * DM + d0 * 32 + r32) = cvtpk(v, vn); } }
}
}


namespace rk {
constexpr int RS1 = 144, RS2 = 80;
constexpr int O_AH = 0, O_BH = 4608, O_KH = 9216, O_RH = 13824;
constexpr int O_A2 = 0, O_A3 = 2560, O_A4 = 5120, O_PT = 7680, O_UT = 12800;
constexpr int O_BT = 18432, O_KT = 23552, O_VT = 28672, O_A1 = 33792, O_WC = 37888, UNIT_LDS = 38144;
static_assert(4 * UNIT_LDS <= RING_BYTES, "rwkv precompute LDS");
__device__ __forceinline__ int crow(int r, int hi) { return (r & 3) + 8 * (r >> 2) + 4 * hi; }
__device__ __forceinline__ float xsum32(float v) { const auto rr = __builtin_amdgcn_permlane32_swap(__float_as_uint(v), __float_as_uint(v), false, false); return __uint_as_float(rr[0]) + __uint_as_float(rr[1]); }
#define RK_FRAG(off, row, stride, q) (*(const LAS bf16x8*)(U + (off) + (row) * (stride) + (16 * (q) + 8 * hi) * 2))
#define RK_MFMA(a, b, c) __builtin_amdgcn_mfma_f32_32x32x16_bf16((a), (b), (c), 0, 0, 0)

__device__ __forceinline__ void pre_unit(int l, int b, int hd, int ck, unsigned char* ws, LAS unsigned char* U) {
    int lane_ = (int)__builtin_amdgcn_mbcnt_hi(~0u, __builtin_amdgcn_mbcnt_lo(~0u, 0u)); asm volatile("" : "+v"(lane_));
    const int lane = lane_, r32 = lane & 31, hi = lane >> 5;
    const int tok0 = b * SEQ + ck * 32;
    const size_t gofs = (size_t)tok0 * RW + hd * 64;
    bf16* Rg = (bf16*)(ws + A_R) + gofs; bf16* Kg = (bf16*)(ws + A_KRAW) + gofs; bf16* KKg = (bf16*)(ws + A_KK) + gofs; bf16* BVg = (bf16*)(ws + A_BV) + gofs;
    const bf16* Vg = (const bf16*)(ws + ((l == 0) ? WS_VFIRST : A_VRAW)) + gofs; float* LWg = (float*)(ws + A_LW) + gofs;
    { float L = 0.f, E3 = 1.f;
#pragma unroll 1
      for (int t8 = 0; t8 < 32; t8 += 8) {
          float lwv[8]; unsigned short rv[8], kv[8], kkv[8], bv[8], vv[8];
#pragma unroll
          for (int u = 0; u < 8; ++u) { const size_t o = (size_t)(t8 + u) * RW + lane; lwv[u] = LWg[o]; rv[u] = Rg[o]; kv[u] = Kg[o]; kkv[u] = KKg[o]; bv[u] = BVg[o]; vv[u] = Vg[o]; }
          float bh[8], kh[8];
#pragma unroll
          for (int u = 0; u < 8; ++u) { L += lwv[u]; const float E1 = __expf(L), E2 = __builtin_amdgcn_rcpf(E1);
              const float ah = -bf2f(kkv[u]) * E3, rh = bf2f(rv[u]) * E1; bh[u] = bf2f(bv[u]) * E2; kh[u] = bf2f(kv[u]) * E2; E3 = E1;
              const int t = t8 + u;
              *(LAS unsigned short*)(U + O_AH + t * RS1 + lane * 2) = (unsigned short)cvt_pk_bf16(ah, 0.f);
              *(LAS unsigned short*)(U + O_RH + t * RS1 + lane * 2) = (unsigned short)cvt_pk_bf16(rh, 0.f);
              *(LAS unsigned short*)(U + O_BH + t * RS1 + lane * 2) = (unsigned short)cvt_pk_bf16(bh[u], 0.f);
              *(LAS unsigned short*)(U + O_KH + t * RS1 + lane * 2) = (unsigned short)cvt_pk_bf16(kh[u], 0.f); }
          v4u w;
          w.x = cvt_pk_bf16(bh[0], bh[1]); w.y = cvt_pk_bf16(bh[2], bh[3]); w.z = cvt_pk_bf16(bh[4], bh[5]); w.w = cvt_pk_bf16(bh[6], bh[7]); *(LAS v4u*)(U + O_BT + lane * RS2 + t8 * 2) = w;
          w.x = cvt_pk_bf16(kh[0], kh[1]); w.y = cvt_pk_bf16(kh[2], kh[3]); w.z = cvt_pk_bf16(kh[4], kh[5]); w.w = cvt_pk_bf16(kh[6], kh[7]); *(LAS v4u*)(U + O_KT + lane * RS2 + t8 * 2) = w;
          w.x = (unsigned)vv[0] | ((unsigned)vv[1] << 16); w.y = (unsigned)vv[2] | ((unsigned)vv[3] << 16); w.z = (unsigned)vv[4] | ((unsigned)vv[5] << 16); w.w = (unsigned)vv[6] | ((unsigned)vv[7] << 16); *(LAS v4u*)(U + O_VT + lane * RS2 + t8 * 2) = w;
      }
      *(LAS float*)(U + O_WC + lane * 4) = E3; }
    LDS_WAIT(); asm volatile("" ::: "memory");
    f32x16 X[4];
    f32x16 rhc[2];
    { f32x16 d1 = {}, d2 = {}, d3 = {}, d4 = {};
#pragma unroll
      for (int q = 0; q < 4; ++q) { const bf16x8 fa = RK_FRAG(O_AH, r32, RS1, q), fb = RK_FRAG(O_BH, r32, RS1, q), fk = RK_FRAG(O_KH, r32, RS1, q), fr = RK_FRAG(O_RH, r32, RS1, q);
          d1 = RK_MFMA(fb, fa, d1); d2 = RK_MFMA(fk, fa, d2); d3 = RK_MFMA(fb, fr, d3); d4 = RK_MFMA(fk, fr, d4); }
#pragma unroll
      for (int jt = 0; jt < 2; ++jt)
#pragma unroll
          for (int r = 0; r < 16; ++r) { X[jt][r] = bf2f(*(const LAS unsigned short*)(U + O_AH + crow(r, hi) * RS1 + (r32 + 32 * jt) * 2)); rhc[jt][r] = bf2f(*(const LAS unsigned short*)(U + O_RH + crow(r, hi) * RS1 + (r32 + 32 * jt) * 2)); }
      LDS_WAIT(); asm volatile("" ::: "memory");
#pragma unroll
      for (int r = 0; r < 16; ++r) { const int s = crow(r, hi); const bool lt = s < r32, le = s <= r32; d1[r] = lt ? d1[r] : 0.f; d2[r] = lt ? d2[r] : 0.f; d3[r] = le ? d3[r] : 0.f; d4[r] = le ? d4[r] : 0.f; }
#pragma unroll
      for (int g = 0; g < 4; ++g) { const int so = 8 * g + 4 * hi;
          *(LAS f32x4*)(U + O_A1 + r32 * 128 + so * 4) = (f32x4){d1[4 * g], d1[4 * g + 1], d1[4 * g + 2], d1[4 * g + 3]};
          *(LAS v2u*)(U + O_A2 + r32 * RS2 + so * 2) = (v2u){cvt_pk_bf16(d2[4 * g], d2[4 * g + 1]), cvt_pk_bf16(d2[4 * g + 2], d2[4 * g + 3])};
          *(LAS v2u*)(U + O_A3 + r32 * RS2 + so * 2) = (v2u){cvt_pk_bf16(d3[4 * g], d3[4 * g + 1]), cvt_pk_bf16(d3[4 * g + 2], d3[4 * g + 3])};
          *(LAS v2u*)(U + O_A4 + r32 * RS2 + so * 2) = (v2u){cvt_pk_bf16(d4[4 * g], d4[4 * g + 1]), cvt_pk_bf16(d4[4 * g + 2], d4[4 * g + 3])}; } }
    LDS_WAIT(); asm volatile("" ::: "memory");
    X[2] = f32x16{}; X[3] = f32x16{};
#pragma unroll
    for (int q = 0; q < 2; ++q) { const bf16x8 fa = RK_FRAG(O_A2, r32, RS2, q);
        X[2] = RK_MFMA(fa, RK_FRAG(O_VT, r32, RS2, q), X[2]); X[3] = RK_MFMA(fa, RK_FRAG(O_VT, r32 + 32, RS2, q), X[3]); }
#ifndef RK_NOSOLVE
#pragma unroll
    for (int t = 1; t < 32; ++t) {
        float p0 = 0.f, p1 = 0.f, p2 = 0.f, p3 = 0.f;
#pragma unroll
        for (int g = 0; g < 4; ++g) if (8 * g < t) { const f32x4 cf = *(const LAS f32x4*)(U + O_A1 + t * 128 + (8 * g + 4 * hi) * 4);
#pragma unroll
            for (int e = 0; e < 4; ++e) { p0 += cf[e] * X[0][4 * g + e]; p1 += cf[e] * X[1][4 * g + e]; p2 += cf[e] * X[2][4 * g + e]; p3 += cf[e] * X[3][4 * g + e]; } }
        p0 = xsum32(p0); p1 = xsum32(p1); p2 = xsum32(p2); p3 = xsum32(p3);
        const bool own = hi == ((t >> 2) & 1); const int rt = (t & 3) + 4 * (t >> 3);
        X[0][rt] += own ? p0 : 0.f; X[1][rt] += own ? p1 : 0.f; X[2][rt] += own ? p2 : 0.f; X[3][rt] += own ? p3 : 0.f;
    }
#endif
#pragma unroll
    for (int tl = 0; tl < 4; ++tl)
#pragma unroll
        for (int g = 0; g < 4; ++g) *(LAS v2u*)(U + (tl < 2 ? O_PT : O_UT) + (r32 + 32 * (tl & 1)) * RS2 + (8 * g + 4 * hi) * 2) = (v2u){cvt_pk_bf16(X[tl][4 * g], X[tl][4 * g + 1]), cvt_pk_bf16(X[tl][4 * g + 2], X[tl][4 * g + 3])};
    LDS_WAIT(); asm volatile("" ::: "memory");
    const float wc0 = *(const LAS float*)(U + O_WC + r32 * 4), wc1 = *(const LAS float*)(U + O_WC + (r32 + 32) * 4);
    { f32x16 y0 = {}, y1 = {};
#pragma unroll
      for (int q = 0; q < 2; ++q) { const bf16x8 f3 = RK_FRAG(O_A3, r32, RS2, q), f4 = RK_FRAG(O_A4, r32, RS2, q);
          rhc[0] = RK_MFMA(f3, RK_FRAG(O_PT, r32, RS2, q), rhc[0]); rhc[1] = RK_MFMA(f3, RK_FRAG(O_PT, r32 + 32, RS2, q), rhc[1]);
          y0 = RK_MFMA(f3, RK_FRAG(O_UT, r32, RS2, q), y0); y1 = RK_MFMA(f3, RK_FRAG(O_UT, r32 + 32, RS2, q), y1);
          y0 = RK_MFMA(f4, RK_FRAG(O_VT, r32, RS2, q), y0); y1 = RK_MFMA(f4, RK_FRAG(O_VT, r32 + 32, RS2, q), y1); }
#pragma unroll
      for (int jt = 0; jt < 2; ++jt) { const int j = r32 + 32 * jt, pj = (j & ~0xC) | ((j & 4) << 1) | ((j & 8) >> 1);
#pragma unroll
          for (int r = 0; r < 16; ++r) Rg[(size_t)crow(r, hi) * RW + pj] = (unsigned short)cvt_pk_bf16(rhc[jt][r], 0.f); }
#pragma unroll
      for (int it = 0; it < 2; ++it)
#pragma unroll
          for (int hf = 0; hf < 2; ++hf) { const f32x16& y = it ? y1 : y0; const int off = ((it * 2 + hf) * 64 + lane) * 16;
              v4u w; w.x = cvt_pk_bf16(y[8 * hf], y[8 * hf + 1]); w.y = cvt_pk_bf16(y[8 * hf + 2], y[8 * hf + 3]); w.z = cvt_pk_bf16(y[8 * hf + 4], y[8 * hf + 5]); w.w = cvt_pk_bf16(y[8 * hf + 6], y[8 * hf + 7]);
              *(GAS v4u*)((unsigned char*)KKg + (size_t)(off >> 7) * (RW * 2) + (off & 127)) = w; } }
#pragma unroll
    for (int tj = 0; tj < 2; ++tj)
#pragma unroll
        for (int tp = 0; tp < 2; ++tp) { f32x16 z = {};
#pragma unroll
            for (int q = 0; q < 2; ++q) z = RK_MFMA(RK_FRAG(O_PT, r32 + 32 * tj, RS2, q), RK_FRAG(O_BT, r32 + 32 * tp, RS2, q), z);
            const float wc = tp ? wc1 : wc0;
#ifdef RK_SELFCHK
            if (ck == 3) { float num = 0.f, den = 0.f;
                for (int r = 0; r < 16; ++r) { const int jj = crow(r, hi) + 32 * tj, jp = r32 + 32 * tp; float ref = 0.f;
                    for (int t = 0; t < 32; ++t) ref += bf2f(*(const LAS unsigned short*)(U + O_PT + jj * RS2 + t * 2)) * bf2f(*(const LAS unsigned short*)(U + O_BT + jp * RS2 + t * 2));
                    const float d = z[r] - ref; num += d * d; den += ref * ref; }
                num = wave_sum(num); den = wave_sum(den); if (lane == 0) { atomicAdd((float*)(ws + WS_CTL) + 84, num); atomicAdd((float*)(ws + WS_CTL) + 85, den); } }
#endif
#pragma unroll
            for (int r = 0; r < 16; ++r) z[r] = (z[r] + ((tj == tp && crow(r, hi) == r32) ? 1.f : 0.f)) * wc;
#pragma unroll
            for (int hf = 0; hf < 2; ++hf) { const int off = (((tj * 2 + tp) * 2 + hf) * 64 + lane) * 16;
                v4u w; w.x = cvt_pk_bf16(z[8 * hf], z[8 * hf + 1]); w.y = cvt_pk_bf16(z[8 * hf + 2], z[8 * hf + 3]); w.z = cvt_pk_bf16(z[8 * hf + 4], z[8 * hf + 5]); w.w = cvt_pk_bf16(z[8 * hf + 6], z[8 * hf + 7]);
                *(GAS v4u*)((unsigned char*)LWg + (size_t)(off >> 8) * (RW * 4) + (off & 255)) = w; } }
#pragma unroll
    for (int tp = 0; tp < 2; ++tp)
#pragma unroll
        for (int ti = 0; ti < 2; ++ti) { f32x16 z = {};
#pragma unroll
            for (int q = 0; q < 2; ++q) { z = RK_MFMA(RK_FRAG(O_BT, r32 + 32 * tp, RS2, q), RK_FRAG(O_UT, r32 + 32 * ti, RS2, q), z); z = RK_MFMA(RK_FRAG(O_KT, r32 + 32 * tp, RS2, q), RK_FRAG(O_VT, r32 + 32 * ti, RS2, q), z); }
#pragma unroll
            for (int g = 0; g < 4; ++g) { const f32x4 wv = *(const LAS f32x4*)(U + O_WC + (32 * tp + 8 * g + 4 * hi) * 4);
#pragma unroll
                for (int e = 0; e < 4; ++e) z[4 * g + e] *= wv[e]; }
#ifdef RK_SELFCHK
            if (ck == 3) { float num = 0.f, den = 0.f;
                for (int r = 0; r < 16; ++r) { const int jp = crow(r, hi) + 32 * tp, ii = r32 + 32 * ti; float ref = 0.f;
                    for (int t = 0; t < 32; ++t) ref += bf2f(*(const LAS unsigned short*)(U + O_BT + jp * RS2 + t * 2)) * bf2f(*(const LAS unsigned short*)(U + O_UT + ii * RS2 + t * 2)) + bf2f(*(const LAS unsigned short*)(U + O_KT + jp * RS2 + t * 2)) * bf2f(*(const LAS unsigned short*)(U + O_VT + ii * RS2 + t * 2));
                    ref *= *(const LAS float*)(U + O_WC + jp * 4); const float d = z[r] - ref; num += d * d; den += ref * ref; }
                num = wave_sum(num); den = wave_sum(den); if (lane == 0) { atomicAdd((float*)(ws + WS_CTL) + 82, num); atomicAdd((float*)(ws + WS_CTL) + 83, den); } }
#endif
            unsigned char* dst = (unsigned char*)(tp ? BVg : Kg);
#pragma unroll
            for (int hf = 0; hf < 2; ++hf) { const int off = ((ti * 2 + hf) * 64 + lane) * 16;
                v4u w; w.x = cvt_pk_bf16(z[8 * hf], z[8 * hf + 1]); w.y = cvt_pk_bf16(z[8 * hf + 2], z[8 * hf + 3]); w.z = cvt_pk_bf16(z[8 * hf + 4], z[8 * hf + 5]); w.w = cvt_pk_bf16(z[8 * hf + 6], z[8 * hf + 7]);
                *(GAS v4u*)(dst + (size_t)(off >> 7) * (RW * 2) + (off & 127)) = w; } }
    LDS_WAIT(); asm volatile("" ::: "memory");
}

__device__ __forceinline__ void scan_unit(int q, int ih, unsigned char* ws) {
    const int lane = (int)__builtin_amdgcn_mbcnt_hi(~0u, __builtin_amdgcn_mbcnt_lo(~0u, 0u)), r32 = lane & 31, hi = lane >> 5;
    const int b = q >> 3, hd = q & 7;
    const size_t gofs0 = (size_t)b * SEQ * RW + hd * 64;
    const unsigned char* Rg = (const unsigned char*)((const bf16*)(ws + A_R) + gofs0); const unsigned char* Kg = (const unsigned char*)((const bf16*)(ws + A_KRAW) + gofs0);
    const unsigned char* KKg = (const unsigned char*)((const bf16*)(ws + A_KK) + gofs0); const unsigned char* BVg = (const unsigned char*)((const bf16*)(ws + A_BV) + gofs0);
    const unsigned char* LWg = (const unsigned char*)((const float*)(ws + A_LW) + gofs0);
    bf16* Yg = (bf16*)(ws + A_YCAT) + (size_t)b * SEQ * DM + 512 + hd * 64 + 32 * ih + r32;
    int oR[4], oY[2], oM[8], oG[4];
#pragma unroll
    for (int k = 0; k < 4; ++k) oR[k] = r32 * (RW * 2) + (16 * k + 8 * hi) * 2;
#pragma unroll
    for (int hf = 0; hf < 2; ++hf) { const int off = ((ih * 2 + hf) * 64 + lane) * 16; oY[hf] = (off >> 7) * (RW * 2) + (off & 127); }
#pragma unroll
    for (int m = 0; m < 8; ++m) { const int off = (m * 64 + lane) * 16; oM[m] = (off >> 8) * (RW * 4) + (off & 255); }
#pragma unroll
    for (int tp = 0; tp < 2; ++tp)
#pragma unroll
        for (int hf = 0; hf < 2; ++hf) { const int off = ((ih * 2 + hf) * 64 + lane) * 16; oG[tp * 2 + hf] = (off >> 7) * (RW * 2) + (off & 127); }
    f32x16 S0 = {}, S1 = {};
    v4u nR[4], nY[2], nM[8], nG[4];
#define RK_LOADS(ck) do { const size_t cb2 = (size_t)(ck) * 32 * (RW * 2), cb4 = (size_t)(ck) * 32 * (RW * 4); \
        _Pragma("unroll") for (int k = 0; k < 4; ++k) nR[k] = *(const GAS v4u*)(Rg + cb2 + oR[k]); \
        _Pragma("unroll") for (int k = 0; k < 2; ++k) nY[k] = *(const GAS v4u*)(KKg + cb2 + oY[k]); \
        _Pragma("unroll") for (int k = 0; k < 8; ++k) nM[k] = *(const GAS v4u*)(LWg + cb4 + oM[k]); \
        nG[0] = *(const GAS v4u*)(Kg + cb2 + oG[0]); nG[1] = *(const GAS v4u*)(Kg + cb2 + oG[1]); nG[2] = *(const GAS v4u*)(BVg + cb2 + oG[2]); nG[3] = *(const GAS v4u*)(BVg + cb2 + oG[3]); } while (0)
    RK_LOADS(0);
#pragma unroll 1
    for (int ck = 0; ck < SEQ / 32; ++ck) {
        v4u cR[4], cY[2], cM[8], cG[4];
#pragma unroll
        for (int k = 0; k < 4; ++k) cR[k] = nR[k];
#pragma unroll
        for (int k = 0; k < 2; ++k) cY[k] = nY[k];
#pragma unroll
        for (int k = 0; k < 8; ++k) cM[k] = nM[k];
#pragma unroll
        for (int k = 0; k < 4; ++k) cG[k] = nG[k];
        if (ck + 1 < SEQ / 32) RK_LOADS(ck + 1);
        bf16x8 sb[4];
#pragma unroll
        for (int kq = 0; kq < 4; ++kq) { const f32x16& s = (kq >> 1) ? S1 : S0; const int o = 8 * (kq & 1);
            v4u w; w.x = cvt_pk_bf16(s[o], s[o + 1]); w.y = cvt_pk_bf16(s[o + 2], s[o + 3]); w.z = cvt_pk_bf16(s[o + 4], s[o + 5]); w.w = cvt_pk_bf16(s[o + 6], s[o + 7]); sb[kq] = __builtin_bit_cast(bf16x8, w); }
        f32x16 y, n0, n1;
#pragma unroll
        for (int hf = 0; hf < 2; ++hf) { const v4u w = cY[hf]; y[8 * hf] = bflo(w.x); y[8 * hf + 1] = bfhi(w.x); y[8 * hf + 2] = bflo(w.y); y[8 * hf + 3] = bfhi(w.y); y[8 * hf + 4] = bflo(w.z); y[8 * hf + 5] = bfhi(w.z); y[8 * hf + 6] = bflo(w.w); y[8 * hf + 7] = bfhi(w.w); }
#pragma unroll
        for (int hf = 0; hf < 2; ++hf) { const v4u w = cG[hf], x = cG[2 + hf];
            n0[8 * hf] = bflo(w.x); n0[8 * hf + 1] = bfhi(w.x); n0[8 * hf + 2] = bflo(w.y); n0[8 * hf + 3] = bfhi(w.y); n0[8 * hf + 4] = bflo(w.z); n0[8 * hf + 5] = bfhi(w.z); n0[8 * hf + 6] = bflo(w.w); n0[8 * hf + 7] = bfhi(w.w);
            n1[8 * hf] = bflo(x.x); n1[8 * hf + 1] = bfhi(x.x); n1[8 * hf + 2] = bflo(x.y); n1[8 * hf + 3] = bfhi(x.y); n1[8 * hf + 4] = bflo(x.z); n1[8 * hf + 5] = bfhi(x.z); n1[8 * hf + 6] = bflo(x.w); n1[8 * hf + 7] = bfhi(x.w); }
#pragma unroll
        for (int kq = 0; kq < 4; ++kq) {
            y = RK_MFMA(__builtin_bit_cast(bf16x8, cR[kq]), sb[kq], y);
            n0 = RK_MFMA(__builtin_bit_cast(bf16x8, cM[((kq >> 1) * 2 + 0) * 2 + (kq & 1)]), sb[kq], n0);
            n1 = RK_MFMA(__builtin_bit_cast(bf16x8, cM[((kq >> 1) * 2 + 1) * 2 + (kq & 1)]), sb[kq], n1); }
        S0 = n0; S1 = n1;
        bf16* yp = Yg + (size_t)ck * 32 * DM;
#pragma unroll
        for (int r = 0; r < 16; ++r) yp[(size_t)crow(r, hi) * DM] = (unsigned short)cvt_pk_bf16(y[r], 0.f);
    }
#undef RK_LOADS
}
#undef RK_FRAG
#undef RK_MFMA
}

__device__ __forceinline__ void post_phase(int l, const float* gao, const float* lnwp, const float* lnbp, unsigned char* ws, int gw, int NGW, int lane) {
    float gn[8], lw8[8], lb8[8];
#pragma unroll
    for (int e = 0; e < 8; ++e) { gn[e] = gao[lane * 8 + e]; lw8[e] = lnwp[lane * 8 + e]; lb8[e] = lnbp[lane * 8 + e]; }
    const bf16* Vv = (const bf16*)(ws + ((l == 0) ? WS_VFIRST : A_VRAW)); const bf16* Gg = (const bf16*)(ws + A_G); const float* BON = (const float*)(ws + A_BON);
    for (int m = gw; m < TOK; m += NGW) {
        GAS v4u* pp = (GAS v4u*)((bf16*)(ws + A_YCAT) + (size_t)m * DM + lane * 8); float p[8]; up8(*pp, p); float ss = 0.f;
        GAS v4u* py = (GAS v4u*)((bf16*)(ws + A_YCAT) + (size_t)m * DM + 512 + lane * 8); float y[8], v[8], g[8]; up8(*py, y);
        up8(*(const GAS v4u*)(Vv + (size_t)m * RW + lane * 8), v); up8(*(const GAS v4u*)(Gg + (size_t)m * RW + lane * 8), g);
        const float bon = BON[(size_t)m * 8 + (lane >> 3)];
#pragma unroll
        for (int e = 0; e < 8; ++e) ss += p[e] * p[e];
        const float rstd = 1.0f / sqrtf(wave_sum(ss) * (1.0f / 512.0f) + 1e-6f);
#pragma unroll
        for (int e = 0; e < 8; ++e) p[e] = p[e] * rstd * gn[e];
        *pp = pk8(p);
        float s1 = 0.f;
#pragma unroll
        for (int e = 0; e < 8; ++e) s1 += y[e];
        s1 += lane_xor<1>(s1); s1 += lane_xor<2>(s1); s1 += lane_xor<4>(s1);
        const float mean = s1 * (1.0f / 64.0f); float s2 = 0.f;
#pragma unroll
        for (int e = 0; e < 8; ++e) { y[e] -= mean; s2 += y[e] * y[e]; }
        s2 += lane_xor<1>(s2); s2 += lane_xor<2>(s2); s2 += lane_xor<4>(s2);
        const float rs = 1.0f / sqrtf(s2 * (1.0f / 64.0f) + 64e-5f);
#pragma unroll
        for (int e = 0; e < 8; ++e) y[e] = (y[e] * rs * lw8[e] + lb8[e] + bon * v[e]) * g[e];
        *py = pk8(y);
    }
}
#ifdef RK_PROBE
__device__ __forceinline__ void rwkv_seq_raw(int l, int b, int hd, unsigned char* ws, LAS unsigned char* ldsw  , int lane, bf16* T1) {
    constexpr int CH = 8;
    LAS float* buf = (LAS float*)ldsw;
    const bf16* R = (const bf16*)(ws + A_R); const bf16* Kp = (const bf16*)(ws + A_KRAW); const bf16* KK = (const bf16*)(ws + A_KK); const bf16* BV = (const bf16*)(ws + A_BV);
    const bf16* Vv = (const bf16*)(ws + ((l == 0) ? WS_VFIRST : A_VRAW)); const bf16* Gg = (const bf16*)(ws + A_G); const float* LW = (const float*)(ws + A_LW);
    const int c = hd * 64 + lane;
    float S[64];
#pragma unroll
    for (int j = 0; j < 64; ++j) S[j] = 0.f;
    for (int t0 = 0; t0 < SEQ; t0 += CH) {
        float vv[CH], gg[CH], bon[CH];
#pragma unroll
        for (int s = 0; s < CH; ++s) { const size_t o = (size_t)(b * SEQ + t0 + s) * RW + c;
            const float r = bf2f(R[o]), k = bf2f(Kp[o]), kk = bf2f(KK[o]), bb = bf2f(BV[o]), w = __expf(LW[o]);
            buf[(s * 5 + 0) * 64 + lane] = r; buf[(s * 5 + 1) * 64 + lane] = w; buf[(s * 5 + 2) * 64 + lane] = k; buf[(s * 5 + 3) * 64 + lane] = -kk; buf[(s * 5 + 4) * 64 + lane] = bb;
            vv[s] = bf2f(Vv[o]); gg[s] = 0.f; bon[s] = 0.f; }
        LDS_WAIT(); asm volatile("" ::: "memory");
#pragma unroll 1
        for (int s = 0; s < CH; ++s) {
            const LAS f32x4* pr = (const LAS f32x4*)(buf + (s * 5 + 0) * 64); const LAS f32x4* pw = (const LAS f32x4*)(buf + (s * 5 + 1) * 64);
            const LAS f32x4* pk = (const LAS f32x4*)(buf + (s * 5 + 2) * 64); const LAS f32x4* pa = (const LAS f32x4*)(buf + (s * 5 + 3) * 64); const LAS f32x4* pb = (const LAS f32x4*)(buf + (s * 5 + 4) * 64);
            float sa = 0.f;
#pragma unroll
            for (int j4 = 0; j4 < 16; ++j4) { const f32x4 a = pa[j4]; sa += S[4 * j4] * a.x + S[4 * j4 + 1] * a.y + S[4 * j4 + 2] * a.z + S[4 * j4 + 3] * a.w; }
            float v_s = vv[0], g_s = gg[0], bo_s = bon[0];
#pragma unroll
            for (int q = 1; q < CH; ++q) if (s == q) { v_s = vv[q]; g_s = gg[q]; bo_s = bon[q]; }
            float y = 0.f;
#pragma unroll
            for (int j4 = 0; j4 < 16; ++j4) { const f32x4 w = pw[j4], bb = pb[j4], k = pk[j4], r = pr[j4];
                S[4 * j4]     = S[4 * j4]     * w.x + sa * bb.x + v_s * k.x; y += S[4 * j4] * r.x;
                S[4 * j4 + 1] = S[4 * j4 + 1] * w.y + sa * bb.y + v_s * k.y; y += S[4 * j4 + 1] * r.y;
                S[4 * j4 + 2] = S[4 * j4 + 2] * w.z + sa * bb.z + v_s * k.z; y += S[4 * j4 + 2] * r.z;
                S[4 * j4 + 3] = S[4 * j4 + 3] * w.w + sa * bb.w + v_s * k.w; y += S[4 * j4 + 3] * r.w; }
            T1[(size_t)(b * SEQ + t0 + s) * RW + c] = (bf16)(cvt_pk_bf16(y, 0.f) & 0xffffu); (void)g_s; (void)bo_s;
        }
        LDS_WAIT(); asm volatile("" ::: "memory");
    }
}

#endif

constexpr int N_PHASES = 27;
struct Args { In in; float* out; unsigned char* ws; int ph_lo, ph_hi; };
static_assert(sizeof(Args) == 38 * 8 + 8 + 8 + 8, "Args has padding");

__global__ void __launch_bounds__(NTHR, 2) mega_fwd(Args args) {
    extern __shared__ __attribute__((aligned(16))) unsigned char lds_raw[];
    LAS unsigned char* lds = (LAS unsigned char*)lds_raw;
#define OPAQUE_IDS(TID0, BX0) int tid = (TID0); asm volatile("" : "+v"(tid)); int bx = (BX0); asm volatile("" : "+s"(bx)); \
    const int lane = tid & 63, wave = __builtin_amdgcn_readfirstlane(tid >> 6); const int G = gridDim.x; \
    const int vcu = (G % 8 == 0) ? (bx % 8) * (G / 8) + bx / 8 : bx; \
    const int gw = vcu * NWAVES + wave, NGW = G * NWAVES, gtid = vcu * NTHR + tid, NGT = G * NTHR; (void)gw; (void)NGW; (void)gtid; (void)NGT; (void)lane
    OPAQUE_IDS(threadIdx.x, blockIdx.x);
    for (int u = tid; u < (LDS_BYTES - LDSCTL_OFF) / 4; u += NTHR) ((LAS unsigned*)(lds + LDSCTL_OFF))[u] = 0u;
    __syncthreads();
    if (tid < 40) { const unsigned long long v = (tid < 38) ? (unsigned long long)args.in.p[tid] : (tid == 38 ? (unsigned long long)args.ws : (unsigned long long)args.out);
        ((LAS unsigned*)(lds + PTAB_OFF))[2 * tid] = (unsigned)v; ((LAS unsigned*)(lds + PTAB_OFF))[2 * tid + 1] = (unsigned)(v >> 32); }
    __syncthreads();
    const InT in{(volatile LAS unsigned*)(lds + PTAB_OFF)};
    gu32* ctl = (gu32*)(args.ws + WS_CTL);
    XcdBarrier bar; bar.bar = (unsigned*)(ctl + CW_BAR); bar.x = 0; bar.st = nullptr;
    if (!MK_SPLIT) bar = xcd_barrier_post((unsigned*)(ctl + CW_BAR), (volatile LAS unsigned*)(lds + MISC_OFF) + 8);
    const int lo = args.ph_lo, hi = args.ph_hi;
#ifndef PH_MASK
#define PH_MASK 0xffffffffu
#endif
#define IN_PH(bit, k) (((PH_MASK >> (bit)) & 1u) && lo <= (k) && (k) < hi)
#define BAR_AFTER(k) do { if ((k) + 1 < hi) { if (!MK_SPLIT) xcd_barrier(bar); } } while (0)
#define PH_PTRS unsigned char* ws = (unsigned char*)in[38]; float* out = (float*)in[39]; const float* modl = (const float*)(ws + WS_MOD) + (size_t)l * NB * MODLD; (void)out; (void)modl

    if (IN_PH(0, 0)) { const int l = 0; PH_PTRS; p0_mod(in, ws, lds, vcu, G, wave, lane, tid); __syncthreads(); p0_weights(in, ws, lds, gw, NGW, wave, lane, gtid, NGT); BAR_AFTER(0); }

    {
        constexpr int l = 0;
        const int pb = 1 + 11 * l;
        OPAQUE_IDS(threadIdx.x, blockIdx.x);
        if (IN_PH(1, pb + 0)) { PH_PTRS; const float* xres = (l == 0) ? in[0] : out; norm_phase<false>(xres, in[5] + (size_t)l * DM, modl, 0, (bf16*)(ws + A_H), nullptr, nullptr, ws, lds, vcu, G, wave, lane, tid); BAR_AFTER(pb + 0); }
        if (IN_PH(2, pb + 1)) { PH_PTRS;
            pg8::Gemm g{(const bf16*)(ws + A_H), (const bf16*)(ws + WS_WIN) + (size_t)l * NPROJ * DM, TOK, NPROJ, DM, nullptr, nullptr, 0};
            pg8::StaticOrder S; S.init(TOK, NPROJ, G, bx);
            pg8::EpiBf16<0> E{(bf16*)(ws + A_PROJ), NPROJ, nullptr, 0, 0, 1.f};
            pg8::gemm_phase<pg8::EpiBf16<0>, pg8::StaticOrder, true, true, 0>(lds, g, S, E);
            BAR_AFTER(pb + 1); }
        if (IN_PH(3, pb + 2)) { PH_PTRS; prep_phase(l, in, ws, gw, NGW, lane); BAR_AFTER(pb + 2); }
        if (IN_PH(4, pb + 3)) { PH_PTRS;
#ifndef P4_MASK
#define P4_MASK 7
#endif
            if (P4_MASK & 1) { pg8::Gemm g{(const bf16*)(ws + A_CQ), (const bf16*)(ws + WS_WUQ) + (size_t)l * NQ * 256, TOK, NQ, 256, nullptr, nullptr, 0};
              pg8::StaticOrder S; S.init(TOK, NQ, G, (bx + G / 2) % G);
              pg8::EpiBf16<0> E{(bf16*)(ws + A_Q), NQ, nullptr, 0, 0, 1.f};
              pg8::gemm_phase<pg8::EpiBf16<0>, pg8::StaticOrder, true, true, 0>(lds, g, S, E); }
            __syncthreads();
            if (P4_MASK & 2) { pg8::Gemm g{(const bf16*)(ws + A_CKV), (const bf16*)(ws + WS_WUKV) + (size_t)l * NKV * 128, TOK, NKV, 128, nullptr, nullptr, 0};
              pg8::StaticOrder S; S.init(TOK, NKV, G, bx);
              pg8::EpiKV E{(bf16*)(ws + A_KB), (bf16*)(ws + A_VB)};
              pg8::gemm_phase<pg8::EpiKV, pg8::StaticOrder, true, true, 0>(lds, g, S, E); }
            __syncthreads();
            if (P4_MASK & 4) { const int nl = (l == 0) ? 1536 : NLORA;
              pg8::Gemm g{(const bf16*)(ws + A_LA), (const bf16*)(ws + WS_WLORA) + (size_t)l * NLORA * KLORA, TOK, nl, KLORA, nullptr, nullptr, 0};
              pg8::StaticOrder S; S.init(TOK, nl, G, bx);
              pg8::EpiLora E{in[16] + (size_t)l * RW, in[18] + (size_t)l * RW, in[21], in[23] + (size_t)l * RW, in[24] + (size_t)l * RW,
                             (float*)(ws + A_LW), (bf16*)(ws + A_KRAW), (bf16*)(ws + A_KK), (bf16*)(ws + A_BV), (bf16*)(ws + A_G), (bf16*)(ws + A_VRAW), (const bf16*)(ws + WS_VFIRST), (const bf16*)(ws + A_R), in[25] + (size_t)l * RW, (float*)(ws + A_BON)};
              pg8::gemm_phase<pg8::EpiLora, pg8::StaticOrder, true, true, 0>(lds, g, S, E); }
            BAR_AFTER(pb + 3); }
        if (IN_PH(5, pb + 4)) { PH_PTRS;
#ifdef RK_PROBE
            if (l == RK_PROBE) { if (vcu < 16 && wave < 4) { const int unit = vcu * 4 + wave; rwkv_seq_raw(l, unit >> 3, unit & 7, ws, lds + wave * 10240, lane, (bf16*)(ws + WS_ARENA + 224 * MiB)); } xcd_barrier(bar); }
#endif
            if (wave < 4) { for (int u = vcu * 4 + wave; u < 64 * (SEQ / 32); u += G * 4) { const int q = u & 63, ck = u >> 6; rk::pre_unit(l, q >> 3, q & 7, ck, ws, lds + wave * rk::UNIT_LDS); } }
            BAR_AFTER(pb + 4); }
        if (IN_PH(6, pb + 5)) { PH_PTRS;
            if (vcu < 32) { if (wave < 4) { const int si = vcu * 4 + wave; rk::scan_unit(si >> 1, si & 1, ws); } __syncthreads(); }
            volatile LAS unsigned* qslot = (volatile LAS unsigned*)(lds + MISC_OFF) + 16;
            for (;;) {
                __syncthreads();
                if (tid == 0) qslot[0] = __hip_atomic_fetch_add(ctl + CW_QCTR + 64 * l, 1u, RLX_AGENT);
                __syncthreads();
                const int u = (int)qslot[0];
                if (u >= 512) break;
                const int qb = 15 - (u >> 5), bh = u & 31;
                att::attn_unit(bh >> 2, bh & 3, qb, (const bf16*)(ws + A_Q), (const bf16*)(ws + A_KB), (const bf16*)(ws + A_VB), (bf16*)(ws + A_YCAT), (const int*)in[2], lds);
            }
            BAR_AFTER(pb + 5); }
        if (IN_PH(7, pb + 6)) { PH_PTRS;
#ifdef RK_PROBE
            if (l == RK_PROBE) { float num = 0.f, den = 0.f; const bf16* T1 = (const bf16*)(ws + WS_ARENA + 224 * MiB);
                for (int m = gw; m < TOK; m += NGW) { if (((m & (SEQ - 1)) >> 5) < 1 || (m & 31) != RK_PROBE_POS) continue; float a[8], b8[8]; up8(*(const GAS v4u*)((const bf16*)(ws + A_YCAT) + (size_t)m * DM + 512 + lane * 8), a); up8(*(const GAS v4u*)(T1 + (size_t)m * RW + lane * 8), b8);
#pragma unroll
                    for (int e = 0; e < 8; ++e) { const float d = a[e] - b8[e]; num += d * d; den += b8[e] * b8[e]; } }
                num = wave_sum(num); den = wave_sum(den);
                if (lane == 0) { atomicAdd((float*)(ctl + 80), num); atomicAdd((float*)(ctl + 81), den); } }
#endif
            post_phase(l, in[13] + (size_t)l * 512, in[26] + (size_t)l * RW, in[27] + (size_t)l * RW, ws, gw, NGW, lane); BAR_AFTER(pb + 6); }
        if (IN_PH(8, pb + 7)) { PH_PTRS; const float* xres = (l == 0) ? in[0] : out;
            pg8::Gemm g{(const bf16*)(ws + A_YCAT), (const bf16*)(ws + WS_WOUT) + (size_t)l * DM * DM, TOK, DM, DM, nullptr, nullptr, 0};
            pg8::StaticOrder S; S.init(TOK, DM, G, bx);
            pg8::EpiResid E{xres, out, modl + 2048};
            pg8::gemm_phase<pg8::EpiResid, pg8::StaticOrder, true, true, 0>(lds, g, S, E);
            BAR_AFTER(pb + 7); }
        if (IN_PH(9, pb + 8)) { PH_PTRS;
            if (l == 0) norm_phase<false>(out, in[6] + (size_t)l * DM, modl, 3072, (bf16*)(ws + A_H), nullptr, nullptr, ws, lds, vcu, G, wave, lane, tid);
            else norm_phase<true>(out, in[6] + (size_t)l * DM, modl, 3072, (bf16*)(ws + A_H), in[32], in[33], ws, lds, vcu, G, wave, lane, tid);
            if (l == 1) { __syncthreads(); p_expert_weights(in, ws, lds, gw, NGW, wave, lane); }
            BAR_AFTER(pb + 8); }
        if (l == 0) {
            if (IN_PH(10, 10)) { PH_PTRS;
                pg8::Gemm g{(const bf16*)(ws + A_H), (const bf16*)(ws + WS_WF1), TOK, 2 * FFD, DM, nullptr, nullptr, 0};
                pg8::StaticOrder S; S.init(TOK, 2 * FFD, G, bx);
                pg8::EpiSwiGLU E{(bf16*)(ws + A_HID), FFD};
                pg8::gemm_phase<pg8::EpiSwiGLU, pg8::StaticOrder, true, true, 0>(lds, g, S, E);
                BAR_AFTER(10); }
            if (IN_PH(11, 11)) { PH_PTRS;
                pg8::Gemm g{(const bf16*)(ws + A_HID), (const bf16*)(ws + WS_WF2), TOK, DM, FFD, nullptr, nullptr, 0};
                pg8::StaticOrder S; S.init(TOK, DM, G, bx);
                pg8::EpiResid E{out, out, modl + 5120};
                pg8::gemm_phase<pg8::EpiResid, pg8::StaticOrder, true, true, 0>(lds, g, S, E);
                BAR_AFTER(11); }
        } else {
            if (IN_PH(12, 21)) { PH_PTRS; route_scatter(ws, lds, vcu, G, wave, lane, tid); BAR_AFTER(21); }
#pragma unroll
            for (int k = 0; k < 2; ++k) {
                if (IN_PH(13, 22 + 2 * k)) { PH_PTRS; const int* TL = (const int*)(ws + RT_TILE) + k * (PASS_TILES + 8); const int* ridx = (const int*)(ws + RT_RIDX) + (size_t)k * PASS_ROWS;
                    const int nt = __builtin_amdgcn_readfirstlane(TL[0]);
                    pg8::Gemm g{(const bf16*)(ws + A_H), (const bf16*)(ws + A_WE1), nt * 256, 2 * FFE, DM, ridx, TL + 8, (size_t)2 * FFE * DM * 2};
                    pg8::StaticOrder S; S.init(nt * 256, 2 * FFE, G, bx);
                    pg8::EpiSwiGLU E{(bf16*)(ws + A_HID), FFE};
                    pg8::gemm_phase<pg8::EpiSwiGLU, pg8::StaticOrder, true, true, 1>(lds, g, S, E);
                    BAR_AFTER(22 + 2 * k); }
                if (IN_PH(14, 23 + 2 * k)) { PH_PTRS; const int* TL = (const int*)(ws + RT_TILE) + k * (PASS_TILES + 8); const int* ridx = (const int*)(ws + RT_RIDX) + (size_t)k * PASS_ROWS; const float* rgw = (const float*)(ws + RT_RGW) + (size_t)k * PASS_ROWS;
                    const int nt = __builtin_amdgcn_readfirstlane(TL[0]);
                    pg8::Gemm g{(const bf16*)(ws + A_HID), (const bf16*)(ws + A_WE2), nt * 256, DM, FFE, nullptr, TL + 8, (size_t)DM * FFE * 2};
                    pg8::StaticOrder S; S.init(nt * 256, DM, G, bx);
                    pg8::EpiMoE2 E{out, modl + 5120, ridx, rgw};
                    pg8::gemm_phase<pg8::EpiMoE2, pg8::StaticOrder, true, true, 2>(lds, g, S, E);
                    BAR_AFTER(23 + 2 * k); }
            }
        }
    }
    {
        constexpr int l = 1;
        const int pb = 1 + 11 * l;
        OPAQUE_IDS(threadIdx.x, blockIdx.x);
        if (IN_PH(1, pb + 0)) { PH_PTRS; const float* xres = (l == 0) ? in[0] : out; norm_phase<false>(xres, in[5] + (size_t)l * DM, modl, 0, (bf16*)(ws + A_H), nullptr, nullptr, ws, lds, vcu, G, wave, lane, tid); BAR_AFTER(pb + 0); }
        if (IN_PH(2, pb + 1)) { PH_PTRS;
            pg8::Gemm g{(const bf16*)(ws + A_H), (const bf16*)(ws + WS_WIN) + (size_t)l * NPROJ * DM, TOK, NPROJ, DM, nullptr, nullptr, 0};
            pg8::StaticOrder S; S.init(TOK, NPROJ, G, bx);
            pg8::EpiBf16<0> E{(bf16*)(ws + A_PROJ), NPROJ, nullptr, 0, 0, 1.f};
            pg8::gemm_phase<pg8::EpiBf16<0>, pg8::StaticOrder, true, true, 0>(lds, g, S, E);
            BAR_AFTER(pb + 1); }
        if (IN_PH(3, pb + 2)) { PH_PTRS; prep_phase(l, in, ws, gw, NGW, lane); BAR_AFTER(pb + 2); }
        if (IN_PH(4, pb + 3)) { PH_PTRS;
#ifndef P4_MASK
#define P4_MASK 7
#endif
            if (P4_MASK & 1) { pg8::Gemm g{(const bf16*)(ws + A_CQ), (const bf16*)(ws + WS_WUQ) + (size_t)l * NQ * 256, TOK, NQ, 256, nullptr, nullptr, 0};
              pg8::StaticOrder S; S.init(TOK, NQ, G, (bx + G / 2) % G);
              pg8::EpiBf16<0> E{(bf16*)(ws + A_Q), NQ, nullptr, 0, 0, 1.f};
              pg8::gemm_phase<pg8::EpiBf16<0>, pg8::StaticOrder, true, true, 0>(lds, g, S, E); }
            __syncthreads();
            if (P4_MASK & 2) { pg8::Gemm g{(const bf16*)(ws + A_CKV), (const bf16*)(ws + WS_WUKV) + (size_t)l * NKV * 128, TOK, NKV, 128, nullptr, nullptr, 0};
              pg8::StaticOrder S; S.init(TOK, NKV, G, bx);
              pg8::EpiKV E{(bf16*)(ws + A_KB), (bf16*)(ws + A_VB)};
              pg8::gemm_phase<pg8::EpiKV, pg8::StaticOrder, true, true, 0>(lds, g, S, E); }
            __syncthreads();
            if (P4_MASK & 4) { const int nl = (l == 0) ? 1536 : NLORA;
              pg8::Gemm g{(const bf16*)(ws + A_LA), (const bf16*)(ws + WS_WLORA) + (size_t)l * NLORA * KLORA, TOK, nl, KLORA, nullptr, nullptr, 0};
              pg8::StaticOrder S; S.init(TOK, nl, G, bx);
              pg8::EpiLora E{in[16] + (size_t)l * RW, in[18] + (size_t)l * RW, in[21], in[23] + (size_t)l * RW, in[24] + (size_t)l * RW,
                             (float*)(ws + A_LW), (bf16*)(ws + A_KRAW), (bf16*)(ws + A_KK), (bf16*)(ws + A_BV), (bf16*)(ws + A_G), (bf16*)(ws + A_VRAW), (const bf16*)(ws + WS_VFIRST), (const bf16*)(ws + A_R), in[25] + (size_t)l * RW, (float*)(ws + A_BON)};
              pg8::gemm_phase<pg8::EpiLora, pg8::StaticOrder, true, true, 0>(lds, g, S, E); }
            BAR_AFTER(pb + 3); }
        if (IN_PH(5, pb + 4)) { PH_PTRS;
#ifdef RK_PROBE
            if (l == RK_PROBE) { if (vcu < 16 && wave < 4) { const int unit = vcu * 4 + wave; rwkv_seq_raw(l, unit >> 3, unit & 7, ws, lds + wave * 10240, lane, (bf16*)(ws + WS_ARENA + 224 * MiB)); } xcd_barrier(bar); }
#endif
            if (wave < 4) { for (int u = vcu * 4 + wave; u < 64 * (SEQ / 32); u += G * 4) { const int q = u & 63, ck = u >> 6; rk::pre_unit(l, q >> 3, q & 7, ck, ws, lds + wave * rk::UNIT_LDS); } }
            BAR_AFTER(pb + 4); }
        if (IN_PH(6, pb + 5)) { PH_PTRS;
            if (vcu < 32) { if (wave < 4) { const int si = vcu * 4 + wave; rk::scan_unit(si >> 1, si & 1, ws); } __syncthreads(); }
            volatile LAS unsigned* qslot = (volatile LAS unsigned*)(lds + MISC_OFF) + 16;
            for (;;) {
                __syncthreads();
                if (tid == 0) qslot[0] = __hip_atomic_fetch_add(ctl + CW_QCTR + 64 * l, 1u, RLX_AGENT);
                __syncthreads();
                const int u = (int)qslot[0];
                if (u >= 512) break;
                const int qb = 15 - (u >> 5), bh = u & 31;
                att::attn_unit(bh >> 2, bh & 3, qb, (const bf16*)(ws + A_Q), (const bf16*)(ws + A_KB), (const bf16*)(ws + A_VB), (bf16*)(ws + A_YCAT), (const int*)in[2], lds);
            }
            BAR_AFTER(pb + 5); }
        if (IN_PH(7, pb + 6)) { PH_PTRS;
#ifdef RK_PROBE
            if (l == RK_PROBE) { float num = 0.f, den = 0.f; const bf16* T1 = (const bf16*)(ws + WS_ARENA + 224 * MiB);
                for (int m = gw; m < TOK; m += NGW) { if (((m & (SEQ - 1)) >> 5) < 1 || (m & 31) != RK_PROBE_POS) continue; float a[8], b8[8]; up8(*(const GAS v4u*)((const bf16*)(ws + A_YCAT) + (size_t)m * DM + 512 + lane * 8), a); up8(*(const GAS v4u*)(T1 + (size_t)m * RW + lane * 8), b8);
#pragma unroll
                    for (int e = 0; e < 8; ++e) { const float d = a[e] - b8[e]; num += d * d; den += b8[e] * b8[e]; } }
                num = wave_sum(num); den = wave_sum(den);
                if (lane == 0) { atomicAdd((float*)(ctl + 80), num); atomicAdd((float*)(ctl + 81), den); } }
#endif
            post_phase(l, in[13] + (size_t)l * 512, in[26] + (size_t)l * RW, in[27] + (size_t)l * RW, ws, gw, NGW, lane); BAR_AFTER(pb + 6); }
        if (IN_PH(8, pb + 7)) { PH_PTRS; const float* xres = (l == 0) ? in[0] : out;
            pg8::Gemm g{(const bf16*)(ws + A_YCAT), (const bf16*)(ws + WS_WOUT) + (size_t)l * DM * DM, TOK, DM, DM, nullptr, nullptr, 0};
            pg8::StaticOrder S; S.init(TOK, DM, G, bx);
            pg8::EpiResid E{xres, out, modl + 2048};
            pg8::gemm_phase<pg8::EpiResid, pg8::StaticOrder, true, true, 0>(lds, g, S, E);
            BAR_AFTER(pb + 7); }
        if (IN_PH(9, pb + 8)) { PH_PTRS;
            if (l == 0) norm_phase<false>(out, in[6] + (size_t)l * DM, modl, 3072, (bf16*)(ws + A_H), nullptr, nullptr, ws, lds, vcu, G, wave, lane, tid);
            else norm_phase<true>(out, in[6] + (size_t)l * DM, modl, 3072, (bf16*)(ws + A_H), in[32], in[33], ws, lds, vcu, G, wave, lane, tid);
            if (l == 1) { __syncthreads(); p_expert_weights(in, ws, lds, gw, NGW, wave, lane); }
            BAR_AFTER(pb + 8); }
        if (l == 0) {
            if (IN_PH(10, 10)) { PH_PTRS;
                pg8::Gemm g{(const bf16*)(ws + A_H), (const bf16*)(ws + WS_WF1), TOK, 2 * FFD, DM, nullptr, nullptr, 0};
                pg8::StaticOrder S; S.init(TOK, 2 * FFD, G, bx);
                pg8::EpiSwiGLU E{(bf16*)(ws + A_HID), FFD};
                pg8::gemm_phase<pg8::EpiSwiGLU, pg8::StaticOrder, true, true, 0>(lds, g, S, E);
                BAR_AFTER(10); }
            if (IN_PH(11, 11)) { PH_PTRS;
                pg8::Gemm g{(const bf16*)(ws + A_HID), (const bf16*)(ws + WS_WF2), TOK, DM, FFD, nullptr, nullptr, 0};
                pg8::StaticOrder S; S.init(TOK, DM, G, bx);
                pg8::EpiResid E{out, out, modl + 5120};
                pg8::gemm_phase<pg8::EpiResid, pg8::StaticOrder, true, true, 0>(lds, g, S, E);
                BAR_AFTER(11); }
        } else {
            if (IN_PH(12, 21)) { PH_PTRS; route_scatter(ws, lds, vcu, G, wave, lane, tid); BAR_AFTER(21); }
#pragma unroll
            for (int k = 0; k < 2; ++k) {
                if (IN_PH(13, 22 + 2 * k)) { PH_PTRS; const int* TL = (const int*)(ws + RT_TILE) + k * (PASS_TILES + 8); const int* ridx = (const int*)(ws + RT_RIDX) + (size_t)k * PASS_ROWS;
                    const int nt = __builtin_amdgcn_readfirstlane(TL[0]);
                    pg8::Gemm g{(const bf16*)(ws + A_H), (const bf16*)(ws + A_WE1), nt * 256, 2 * FFE, DM, ridx, TL + 8, (size_t)2 * FFE * DM * 2};
                    pg8::StaticOrder S; S.init(nt * 256, 2 * FFE, G, bx);
                    pg8::EpiSwiGLU E{(bf16*)(ws + A_HID), FFE};
                    pg8::gemm_phase<pg8::EpiSwiGLU, pg8::StaticOrder, true, true, 1>(lds, g, S, E);
                    BAR_AFTER(22 + 2 * k); }
                if (IN_PH(14, 23 + 2 * k)) { PH_PTRS; const int* TL = (const int*)(ws + RT_TILE) + k * (PASS_TILES + 8); const int* ridx = (const int*)(ws + RT_RIDX) + (size_t)k * PASS_ROWS; const float* rgw = (const float*)(ws + RT_RGW) + (size_t)k * PASS_ROWS;
                    const int nt = __builtin_amdgcn_readfirstlane(TL[0]);
                    pg8::Gemm g{(const bf16*)(ws + A_HID), (const bf16*)(ws + A_WE2), nt * 256, DM, FFE, nullptr, TL + 8, (size_t)DM * FFE * 2};
                    pg8::StaticOrder S; S.init(nt * 256, DM, G, bx);
                    pg8::EpiMoE2 E{out, modl + 5120, ridx, rgw};
                    pg8::gemm_phase<pg8::EpiMoE2, pg8::StaticOrder, true, true, 2>(lds, g, S, E);
                    BAR_AFTER(23 + 2 * k); }
            }
        }
    }
    if (IN_PH(15, 26)) { const int l = 1; PH_PTRS; OPAQUE_IDS(threadIdx.x, blockIdx.x); final_norm(out, in[37], gw, NGW, lane);
#ifdef RK_PROBE
        { VM_WAIT(); const float num = __hip_atomic_load((float*)(ctl + 80), RLX_AGENT), den = __hip_atomic_load((float*)(ctl + 81), RLX_AGENT);
#ifdef RK_SELFCHK
          const float n2 = __hip_atomic_load((float*)(ctl + RK_SELFCHK), RLX_AGENT), d2 = __hip_atomic_load((float*)(ctl + RK_SELFCHK + 1), RLX_AGENT); const float sc = 1.0f + sqrtf(n2 / d2) + 0.f * num * den;
#else
          const float sc = 1.0f + sqrtf(num / den);
#endif

          for (int row = gw; row < TOK; row += NGW) { GAS f32x4* xr = (GAS f32x4*)(out + (size_t)row * DM) + lane;
#pragma unroll
              for (int j = 0; j < 4; ++j) xr[64 * j] = xr[64 * j] * sc; } }
#endif
    }
#undef IN_PH
#undef BAR_AFTER
}

extern "C" void kernel_launch(void* const* d_in, const int* in_sizes, int n_in, void* d_out, int out_size, void* d_ws, size_t ws_size, hipStream_t stream) {
    static int grid = 0;
    if (grid == 0) {
        if (n_in != 38 || in_sizes[0] != TOK * DM || out_size != TOK * DM || ws_size < WS_END) {
            fprintf(stderr, "kernel_launch: unexpected problem (n_in %d, in0 %d, out %d, ws %zu, need %zu); nothing launched\n", n_in, n_in > 0 ? in_sizes[0] : -1, out_size, ws_size, (size_t)WS_END); grid = -1; return; }
        int dev = 0, cus = 0, per_cu = 0;
        if (hipGetDevice(&dev) != hipSuccess || hipDeviceGetAttribute(&cus, hipDeviceAttributeMultiprocessorCount, dev) != hipSuccess) { grid = -1; return; }
        if (hipFuncSetAttribute((const void*)mega_fwd, hipFuncAttributeMaxDynamicSharedMemorySize, LDS_BYTES) != hipSuccess) { fprintf(stderr, "kernel_launch: hipFuncSetAttribute failed\n"); grid = -1; return; }
        if (hipOccupancyMaxActiveBlocksPerMultiprocessor(&per_cu, (const void*)mega_fwd, NTHR, LDS_BYTES) != hipSuccess || per_cu < 1) { fprintf(stderr, "kernel_launch: occupancy query says %d\n", per_cu); }
        (void)hipGetLastError();
        grid = cus;
    }
    if (grid < 0) return;
    (void)hipMemsetAsync((char*)d_ws + WS_CTL, 0, CTL_ZERO_BYTES, stream);
    Args a{};
    for (int i = 0; i < 38; ++i) a.in.p[i] = (const float*)d_in[i];
    a.out = (float*)d_out; a.ws = (unsigned char*)d_ws;
#if MK_SPLIT
    for (int p = 0; p < N_PHASES; ++p) { a.ph_lo = p; a.ph_hi = p + 1; hipLaunchKernelGGL(mega_fwd, dim3(grid), dim3(NTHR), LDS_BYTES, stream, a); }
#else
    a.ph_lo = 0; a.ph_hi = N_PHASES;
    hipLaunchKernelGGL(mega_fwd, dim3(grid), dim3(NTHR), LDS_BYTES, stream, a);
#endif
    const hipError_t le = hipPeekAtLastError();
    if (le != hipSuccess) fprintf(stderr, "kernel_launch: launch failed: %s\n", hipGetErrorName(le));
}
```

```cpp
#include <hip/hip_runtime.h>
#include <cstdio>
#include <cstdint>
namespace pg8 {
#define PG8_LAS __attribute__((address_space(3)))
typedef unsigned short bf16_t;
typedef short bf16x8 __attribute__((ext_vector_type(8)));
typedef float f32x4 __attribute__((ext_vector_type(4)));
typedef unsigned u32x4 __attribute__((ext_vector_type(4)));
constexpr int BM = 256, BK = 64, HALF = 128, HTB = HALF * BK * 2  , STAGE_BYTES = 8 * HTB, NXCD = 8, WGM = 8;

__host__ __device__ __forceinline__ int lds_byte(int r, int c) { const int st = (r >> 4) * 2 + (c >> 5), rr = r & 15, cc = c & 31, ob = rr * 64 + cc * 2; return st * 1024 + (ob ^ (((ob >> 9) & 1) << 5)); }
__host__ __device__ __forceinline__ void stage_rc(int b, int& R, int& C) { const int st = b / 1024, sb = b % 1024, swz = sb ^ (((sb >> 9) & 1) << 5); R = (st >> 1) * 16 + swz / 64; C = (st & 1) * 32 + (swz % 64) / 2; }
__host__ __device__ __forceinline__ int perm32(int rho) { const int n = rho >> 4, i = rho & 15; return 8 * (i >> 2) + 4 * n + (i & 3); }

struct Unit { int pm, pn; };
struct Gemm { const bf16_t* A; const bf16_t* Bt; int M, N, K; const int* ridx; const int* tile_e; size_t e_stride; };

struct StaticOrder {
    int nM, nN, nwg, G, c;
    __host__ __device__ void init(int M, int N, int G_, int c_) { nM = M / BM; nN = N / BM; nwg = nM * nN; G = G_; c = c_; }
    __host__ __device__ bool next(int i, Unit& u) const {
        const long L = (long)i * G + c; if (L >= nwg) return false;
        int wgid = (int)L; { const int q = nwg / NXCD, r = nwg % NXCD, xcd = wgid % NXCD, off = wgid / NXCD; wgid = (xcd < r ? xcd * (q + 1) : r * (q + 1) + (xcd - r) * q) + off; }
        const int nig = WGM * nN, gid = wgid / nig, fm = gid * WGM, gsz = (nM - fm) < WGM ? (nM - fm) : WGM;
        u.pm = fm + ((wgid % nig) % gsz); u.pn = (wgid % nig) / gsz; return true;
    }
    __device__ __forceinline__ void a_ready(const Unit&) const {}
    __device__ __forceinline__ void done(const Unit&) const {}
};

typedef float f32x2_cv __attribute__((ext_vector_type(2))); typedef __bf16 bf16x2_cv __attribute__((ext_vector_type(2)));
__device__ __forceinline__ unsigned cvt_pk_bf16(float lo, float hi) { const f32x2_cv v = {lo, hi}; const bf16x2_cv b = __builtin_convertvector(v, bf16x2_cv); return __builtin_bit_cast(unsigned, b); }
typedef float f32x2 __attribute__((ext_vector_type(2)));
__device__ __forceinline__ f32x2 gelu_pk(f32x2 v) {
    const f32x2 av = __builtin_elementwise_abs(v), d = av * 0.2316418882f + 1.0f;
    f32x2 t; t.x = __builtin_amdgcn_rcpf(d.x); t.y = __builtin_amdgcn_rcpf(d.y);
    f32x2 q = t * 0.5307027145f + (-0.7265760135f); q = q * t + 0.7107068705f; q = q * t + (-0.142248368f); q = q * t + 0.127414796f; q = q * t;
    const f32x2 s = (v * v) * (-0.72134752044f);
    f32x2 e; e.x = __builtin_amdgcn_exp2f(s.x); e.y = __builtin_amdgcn_exp2f(s.y);
    const f32x2 m = v * (q * e), r = v - m;
    f32x2 o; o.x = v.x < 0.f ? m.x : r.x; o.y = v.y < 0.f ? m.y : r.y; return o;
}

template <int ACT  > struct EpiBf16 {
    static constexpr bool PERM = true, AFTER_DRAIN = false; static_assert(ACT == 0 || ACT == 1, "EpiBf16: ACT is 0 (none) or 1 (gelu_pk)");
    bf16_t* O; int ldc; const float* bias; int split_cols; size_t split_stride; float scale0;
    __device__ __forceinline__ void operator()(const f32x4 (&acc)[2][2][4][2], const Unit& u, int wr, int wc, int fr, int fq) const {
        const int row0 = u.pm * BM + wr * 64 + fr; int colt = u.pn * BM; bf16_t* base = O;
        float sc = 1.f; if (split_cols) { const int t = colt / split_cols; base += (size_t)t * split_stride; colt -= t * split_cols; if (t == 0) sc = scale0; }
        const int col0 = colt + wc * 32 + 8 * fq, bcol0 = u.pn * BM + wc * 32 + 8 * fq;
        f32x4 bv[2][2];
#pragma unroll
        for (int bj = 0; bj < 2; ++bj)
#pragma unroll
            for (int n = 0; n < 2; ++n) bv[bj][n] = bias ? *(const f32x4*)(bias + bcol0 + bj * HALF + 4 * n) : (f32x4){0.f, 0.f, 0.f, 0.f};
#pragma unroll
        for (int ai = 0; ai < 2; ++ai)
#pragma unroll
            for (int m = 0; m < 4; ++m) { bf16_t* rowp = base + (size_t)(row0 + ai * HALF + m * 16) * ldc + col0;
#pragma unroll
                for (int bj = 0; bj < 2; ++bj) { f32x4 v0 = acc[ai][bj][m][0] + bv[bj][0], v1 = acc[ai][bj][m][1] + bv[bj][1];
                    if (ACT == 1) { f32x2 a = gelu_pk((f32x2){v0[0], v0[1]}), b = gelu_pk((f32x2){v0[2], v0[3]}), c = gelu_pk((f32x2){v1[0], v1[1]}), d = gelu_pk((f32x2){v1[2], v1[3]});
                        v0 = (f32x4){a.x, a.y, b.x, b.y}; v1 = (f32x4){c.x, c.y, d.x, d.y}; }
                    v0 = v0 * sc; v1 = v1 * sc; u32x4 w; w.x = cvt_pk_bf16(v0[0], v0[1]); w.y = cvt_pk_bf16(v0[2], v0[3]); w.z = cvt_pk_bf16(v1[0], v1[1]); w.w = cvt_pk_bf16(v1[2], v1[3]);
                    *(u32x4*)(rowp + bj * HALF) = w; } }
    }
};

__device__ __forceinline__ float bf2f(unsigned short v) { return __uint_as_float(((unsigned)v) << 16); }
__device__ __forceinline__ float bflo(unsigned w) { return __uint_as_float(w << 16); }
__device__ __forceinline__ float bfhi(unsigned w) { return __uint_as_float(w & 0xffff0000u); }
__device__ __forceinline__ float fsigmoid(float x) { return __builtin_amdgcn_rcpf(1.0f + __builtin_amdgcn_exp2f(-1.4426950408889634f * x)); }
__device__ __forceinline__ u32x4 pack8f(const f32x4 a, const f32x4 b) { u32x4 w; w.x = cvt_pk_bf16(a[0], a[1]); w.y = cvt_pk_bf16(a[2], a[3]); w.z = cvt_pk_bf16(b[0], b[1]); w.w = cvt_pk_bf16(b[2], b[3]); return w; }
__device__ __forceinline__ void unpack8(const u32x4 w, f32x4& a, f32x4& b) { a = (f32x4){bflo(w.x), bfhi(w.x), bflo(w.y), bfhi(w.y)}; b = (f32x4){bflo(w.z), bfhi(w.z), bflo(w.w), bfhi(w.w)}; }

struct EpiKV { static constexpr bool PERM = true, AFTER_DRAIN = false;
    bf16_t* Kb; bf16_t* Vb;
    __device__ __forceinline__ void operator()(const f32x4 (&acc)[2][2][4][2], const Unit& u, int wr, int wc, int fr, int fq) const {
        const int row0 = u.pm * BM + wr * 64 + fr, h = u.pn, col = wc * 32 + 8 * fq;
#pragma unroll
        for (int ai = 0; ai < 2; ++ai)
#pragma unroll
            for (int m = 0; m < 4; ++m) { const int row = row0 + ai * HALF + m * 16; const int b = row >> 12, s = row & 4095;
                const size_t tok = (size_t)(b * 4 + h) * 4096 + s;
                *(u32x4*)(Kb + tok * 192 + col) = pack8f(acc[ai][0][m][0], acc[ai][0][m][1]);
                *(u32x4*)(Vb + tok * 128 + col) = pack8f(acc[ai][1][m][0], acc[ai][1][m][1]); }
    }
};

struct EpiResid { static constexpr bool PERM = false, AFTER_DRAIN = false;
    const float* base; float* out; const float* gate;
    __device__ __forceinline__ void operator()(const f32x4 (&acc)[2][2][4][2], const Unit& u, int wr, int wc, int fr, int fq) const {
        const int row0 = u.pm * BM + wr * 64 + fr, col0 = u.pn * BM + wc * 32 + 4 * fq, b = (u.pm * BM) >> 12;
        f32x4 gv[2][2];
#pragma unroll
        for (int bj = 0; bj < 2; ++bj)
#pragma unroll
            for (int n = 0; n < 2; ++n) gv[bj][n] = *(const f32x4*)(gate + b * 6144 + col0 + bj * HALF + n * 16);
#pragma unroll
        for (int ai = 0; ai < 2; ++ai)
#pragma unroll
            for (int m = 0; m < 4; ++m) { const size_t off = (size_t)(row0 + ai * HALF + m * 16) * 1024 + col0;
#pragma unroll
                for (int bj = 0; bj < 2; ++bj)
#pragma unroll
                    for (int n = 0; n < 2; ++n) { const f32x4 bs = *(const f32x4*)(base + off + bj * HALF + n * 16); *(f32x4*)(out + off + bj * HALF + n * 16) = bs + gv[bj][n] * acc[ai][bj][m][n]; } }
    }
};

struct EpiSwiGLU { static constexpr bool PERM = true, AFTER_DRAIN = false;
    bf16_t* Hd; int ldh;
    __device__ __forceinline__ void operator()(const f32x4 (&acc)[2][2][4][2], const Unit& u, int wr, int wc, int fr, int fq) const {
        const int row0 = u.pm * BM + wr * 64 + fr, col = u.pn * HALF + wc * 32 + 8 * fq;
#pragma unroll
        for (int ai = 0; ai < 2; ++ai)
#pragma unroll
            for (int m = 0; m < 4; ++m) { f32x4 r[2];
#pragma unroll
                for (int n = 0; n < 2; ++n) { const f32x4 g = acc[ai][0][m][n], up = acc[ai][1][m][n];
#pragma unroll
                    for (int e = 0; e < 4; ++e) r[n][e] = g[e] * fsigmoid(g[e]) * up[e]; }
                *(u32x4*)(Hd + (size_t)(row0 + ai * HALF + m * 16) * ldh + col) = pack8f(r[0], r[1]); }
    }
};

struct EpiMoE2 { static constexpr bool PERM = false, AFTER_DRAIN = false;
    float* out; const float* gate; const int* ridx; const float* rgw;
    __device__ __forceinline__ void operator()(const f32x4 (&acc)[2][2][4][2], const Unit& u, int wr, int wc, int fr, int fq) const {
        const int row0 = u.pm * BM + wr * 64 + fr, col0 = u.pn * BM + wc * 32 + 4 * fq;
#pragma unroll
        for (int ai = 0; ai < 2; ++ai)
#pragma unroll
            for (int m = 0; m < 4; ++m) { const int srow = row0 + ai * HALF + m * 16; const int tok = ridx[srow];
                if (tok >= 0) { const float gw = rgw[srow]; const float* gp = gate + (tok >> 12) * 6144 + col0; float* op = out + (size_t)tok * 1024 + col0;
#pragma unroll
                    for (int bj = 0; bj < 2; ++bj)
#pragma unroll
                        for (int n = 0; n < 2; ++n) { const f32x4 gv = *(const f32x4*)(gp + bj * HALF + n * 16); const f32x4 bs = *(const f32x4*)(op + bj * HALF + n * 16);
                            *(f32x4*)(op + bj * HALF + n * 16) = bs + (gv * gw) * acc[ai][bj][m][n]; } } }
    }
};

struct EpiLora { static constexpr bool PERM = true, AFTER_DRAIN = false;
    const float *w0, *a0, *v0, *k_k, *k_a;
    float* LW; bf16_t* Kraw; bf16_t* KK; bf16_t* BV; bf16_t* G; bf16_t* Vraw; const bf16_t* VF; const bf16_t* Rr; const float* r_k; float* BON;
    __device__ __forceinline__ void operator()(const f32x4 (&acc)[2][2][4][2], const Unit& u, int wr, int wc, int fr, int fq) const {
        const int row0 = u.pm * BM + wr * 64 + fr, seg = u.pn >> 1, cb = 256 * (u.pn & 1) + 64 * wc + 8 * fq;
        if (seg == 0) {
            f32x4 p[2][2];
#pragma unroll
            for (int bj = 0; bj < 2; ++bj) { p[bj][0] = *(const f32x4*)(w0 + cb + 32 * bj); p[bj][1] = *(const f32x4*)(w0 + cb + 32 * bj + 4); }
#pragma unroll
            for (int ai = 0; ai < 2; ++ai)
#pragma unroll
                for (int m = 0; m < 4; ++m) { float* rp = LW + (size_t)(row0 + ai * HALF + m * 16) * 512 + cb;
#pragma unroll
                    for (int bj = 0; bj < 2; ++bj)
#pragma unroll
                        for (int n = 0; n < 2; ++n) { f32x4 o;
#pragma unroll
                            for (int e = 0; e < 4; ++e) o[e] = -0.6065306597126334f * fsigmoid(p[bj][n][e] + acc[ai][bj][m][n][e]);
                            *(f32x4*)(rp + 32 * bj + 4 * n) = o; } }
        } else if (seg == 1) {
#pragma unroll
            for (int ai = 0; ai < 2; ++ai)
#pragma unroll
                for (int m = 0; m < 4; ++m) { const size_t ro = (size_t)(row0 + ai * HALF + m * 16) * 512 + cb;
                    float ss = 0.f;
#pragma unroll
                    for (int bj = 0; bj < 2; ++bj) { f32x4 kv[2]; unpack8(*(const u32x4*)(Kraw + ro + 32 * bj), kv[0], kv[1]);
#pragma unroll
                        for (int n = 0; n < 2; ++n) { const f32x4 pk = *(const f32x4*)(k_k + cb + 32 * bj + 4 * n); const f32x4 t = kv[n] * pk; ss += (t[0] * t[0] + t[1] * t[1]) + (t[2] * t[2] + t[3] * t[3]); } }
                    ss += __uint_as_float((unsigned)__builtin_amdgcn_ds_swizzle((int)__float_as_uint(ss), 0x1f | (16 << 10)));
                    { const auto rr = __builtin_amdgcn_permlane32_swap(__float_as_uint(ss), __float_as_uint(ss), false, false); ss = __uint_as_float(rr[0]) + __uint_as_float(rr[1]); }
                    const float inv = 1.0f / fmaxf(sqrtf(ss), 1e-12f);
                    asm volatile("" ::: "memory");
                    float bsum = 0.f;
#pragma unroll
                    for (int bj = 0; bj < 2; ++bj) { f32x4 kv[2], rv[2], k2[2], kk2[2], b2[2]; unpack8(*(const u32x4*)(Kraw + ro + 32 * bj), kv[0], kv[1]); unpack8(*(const u32x4*)(Rr + ro + 32 * bj), rv[0], rv[1]);
#pragma unroll
                        for (int n = 0; n < 2; ++n) { const f32x4 pa = *(const f32x4*)(a0 + cb + 32 * bj + 4 * n), pk = *(const f32x4*)(k_k + cb + 32 * bj + 4 * n), pq = *(const f32x4*)(k_a + cb + 32 * bj + 4 * n), pr = *(const f32x4*)(r_k + cb + 32 * bj + 4 * n);
#pragma unroll
                            for (int e = 0; e < 4; ++e) { const float a = fsigmoid(pa[e] + acc[ai][bj][m][n][e]), kkn = kv[n][e] * pk[e] * inv; kk2[n][e] = kkn; b2[n][e] = kkn * a; k2[n][e] = kv[n][e] * (1.0f + (a - 1.0f) * pq[e]);
                                bsum += rv[n][e] * bflo(cvt_pk_bf16(k2[n][e], 0.f)) * pr[e]; } }
                        *(u32x4*)(Kraw + ro + 32 * bj) = pack8f(k2[0], k2[1]); *(u32x4*)(KK + ro + 32 * bj) = pack8f(kk2[0], kk2[1]); *(u32x4*)(BV + ro + 32 * bj) = pack8f(b2[0], b2[1]); }
                    bsum += __uint_as_float((unsigned)__builtin_amdgcn_ds_swizzle((int)__float_as_uint(bsum), 0x1f | (16 << 10)));
                    { const auto rr = __builtin_amdgcn_permlane32_swap(__float_as_uint(bsum), __float_as_uint(bsum), false, false); bsum = __uint_as_float(rr[0]) + __uint_as_float(rr[1]); }
                    if (fq == 0) BON[(size_t)(row0 + ai * HALF + m * 16) * 8 + 4 * (u.pn & 1) + wc] = bsum;
                    asm volatile("" ::: "memory"); }
        } else if (seg == 2) {
#pragma unroll
            for (int ai = 0; ai < 2; ++ai)
#pragma unroll
                for (int m = 0; m < 4; ++m) { bf16_t* rp = G + (size_t)(row0 + ai * HALF + m * 16) * 512 + cb;
#pragma unroll
                    for (int bj = 0; bj < 2; ++bj) *(u32x4*)(rp + 32 * bj) = pack8f(acc[ai][bj][m][0], acc[ai][bj][m][1]); }
        } else {
            f32x4 p[2][2];
#pragma unroll
            for (int bj = 0; bj < 2; ++bj) { p[bj][0] = *(const f32x4*)(v0 + cb + 32 * bj); p[bj][1] = *(const f32x4*)(v0 + cb + 32 * bj + 4); }
#pragma unroll
            for (int ai = 0; ai < 2; ++ai)
#pragma unroll
                for (int m = 0; m < 4; ++m) { const size_t ro = (size_t)(row0 + ai * HALF + m * 16) * 512 + cb;
#pragma unroll
                    for (int bj = 0; bj < 2; ++bj) { f32x4 vv[2], vf[2], o[2]; unpack8(*(const u32x4*)(Vraw + ro + 32 * bj), vv[0], vv[1]); unpack8(*(const u32x4*)(VF + ro + 32 * bj), vf[0], vf[1]);
#pragma unroll
                        for (int n = 0; n < 2; ++n)
#pragma unroll
                            for (int e = 0; e < 4; ++e) o[n][e] = vv[n][e] + (vf[n][e] - vv[n][e]) * fsigmoid(p[bj][n][e] + acc[ai][bj][m][n][e]);
                        *(u32x4*)(Vraw + ro + 32 * bj) = pack8f(o[0], o[1]); } }
        }
    }
};
template <class Epi, class Sched, bool ALIGN_EPI = false, bool SP2 = false, int MODE = 0>
__device__ __forceinline__ void gemm_phase(PG8_LAS unsigned char* lds, const Gemm g, const Sched& S, const Epi& E) {
    int tid_ = threadIdx.x; asm volatile("" : "+v"(tid_));
    const int tid = tid_, wid = __builtin_amdgcn_readfirstlane(tid >> 6), lane = tid & 63, wr = wid >> 2, wc = wid & 3, fr = lane & 15, fq = lane >> 4;
    int K_ = g.K; asm volatile("" : "+s"(K_));
    const int K = K_, nt = K / BK;
    unsigned voffA[2], voffB[2]; int gR[2], gC[2]; unsigned vAc[2][2], vAn[2][2];
    static_assert(SP2 || MODE == 0, "MODE != 0 needs SP2");
#pragma unroll
    for (int i = 0; i < 2; ++i) { int R, C; stage_rc(tid * 16 + i * 8192, R, C); const int Rb = Epi::PERM ? ((R & ~31) + perm32(R & 31)) : R;
        voffA[i] = (unsigned)(R * K + C) * 2u; voffB[i] = (unsigned)(Rb * K + C) * 2u; gR[i] = R; gC[i] = C; }
    const size_t kstep = (size_t)(BK * 2);
    const size_t hstep = (size_t)HALF * K * 2;
    const size_t tstep = 2 * hstep;
    const unsigned ldsw = (unsigned)wid * 1024u;
    const int aoff = lds_byte(wr * 64 + fr, fq * 8), boff = lds_byte(wc * 32 + fr, fq * 8);
#define PG8_SA(b, h) (((b) * 2 + (h)) * HTB)
#define PG8_SB(b, h) ((4 + (b) * 2 + (h)) * HTB)
#define PG8_STAGE(bufoff, gbase, voff) do { _Pragma("unroll") for (int _i = 0; _i < 2; ++_i) \
        __builtin_amdgcn_global_load_lds((const unsigned*)((const char*)(gbase) + (voff)[_i]), (PG8_LAS unsigned*)(lds + (bufoff) + ldsw + _i * 8192), 16, 0, 0); } while (0)
#define PG8_GATHER(dst, U) do { _Pragma("unroll") for (int _h = 0; _h < 2; ++_h) _Pragma("unroll") for (int _i = 0; _i < 2; ++_i) { \
        int _r = g.ridx[(U).pm * BM + _h * HALF + gR[_i]]; _r = _r < 0 ? 0 : _r; dst[_h][_i] = (unsigned)(_r * K + gC[_i]) * 2u; } } while (0)
#define PG8_STAGE_A(bufoff, kptr, h, NXT) do { if constexpr (MODE == 1) { _Pragma("unroll") for (int _i = 0; _i < 2; ++_i) \
        __builtin_amdgcn_global_load_lds((const unsigned*)((const char*)(kptr) + ((NXT) ? vAn[h][_i] : vAc[h][_i])), (PG8_LAS unsigned*)(lds + (bufoff) + ldsw + _i * 8192), 16, 0, 0); } \
    else { PG8_STAGE(bufoff, (kptr) + (h) * hstep, voffA); } } while (0)
#define PG8_APTR(U) ((MODE == 1) ? (const char*)g.A : (const char*)g.A + (size_t)(U).pm * tstep)
#define PG8_BPTR(U) ((MODE != 0) ? (const char*)g.Bt + (size_t)g.tile_e[(U).pm] * g.e_stride + (size_t)(U).pn * tstep : (const char*)g.Bt + (size_t)(U).pn * tstep)
#define PG8_LDA(dst, b, h) do { _Pragma("unroll") for (int m = 0; m < 4; ++m) _Pragma("unroll") for (int k = 0; k < 2; ++k) dst[m][k] = *(const PG8_LAS bf16x8*)(lds + PG8_SA(b, h) + aoff + m * 2048 + k * 1024); } while (0)
#define PG8_LDB(dst, b, h) do { _Pragma("unroll") for (int n = 0; n < 2; ++n) _Pragma("unroll") for (int k = 0; k < 2; ++k) dst[n][k] = *(const PG8_LAS bf16x8*)(lds + PG8_SB(b, h) + boff + n * 2048 + k * 1024); } while (0)
#define PG8_MMA(ai, bj, At, Bt) do { __builtin_amdgcn_s_setprio(1); _Pragma("unroll") for (int m = 0; m < 4; ++m) _Pragma("unroll") for (int n = 0; n < 2; ++n) _Pragma("unroll") for (int k = 0; k < 2; ++k) \
        acc[ai][bj][m][n] = __builtin_amdgcn_mfma_f32_16x16x32_bf16(Bt[n][k], At[m][k], acc[ai][bj][m][n], 0, 0, 0); __builtin_amdgcn_s_setprio(0); } while (0)
#define PG8_WAIT_V(n) asm volatile("s_waitcnt vmcnt(" #n ")" ::: "memory")
#define PG8_WAIT_L(n) asm volatile("s_waitcnt lgkmcnt(" #n ")" ::: "memory")
#define PG8_BAR __builtin_amdgcn_s_barrier()
#define PG8_SCHED __builtin_amdgcn_sched_barrier(0)
    Unit cur, nxt; int ui = 0;
    if (!S.next(0, cur)) return;
    f32x4 acc[2][2][4][2];
#pragma unroll
    for (int a = 0; a < 2; ++a)
#pragma unroll
        for (int b = 0; b < 2; ++b)
#pragma unroll
            for (int m = 0; m < 4; ++m)
#pragma unroll
                for (int n = 0; n < 2; ++n) acc[a][b][m][n] = (f32x4){0.f, 0.f, 0.f, 0.f};
    bf16x8 At[4][2], B0[2][2], B1[2][2];
    const char* cA = PG8_APTR(cur); const char* cB = PG8_BPTR(cur);
    if constexpr (MODE == 1) { PG8_GATHER(vAc, cur); }
    S.a_ready(cur);
    if constexpr (SP2) {
        PG8_STAGE(PG8_SB(0, 0), cB, voffB); PG8_STAGE(PG8_SB(0, 1), cB + hstep, voffB); PG8_STAGE_A(PG8_SA(0, 0), cA, 0, false); PG8_STAGE_A(PG8_SA(0, 1), cA, 1, false);
        if (wr == 1) PG8_BAR;
        PG8_WAIT_V(2); PG8_BAR;
        PG8_STAGE(PG8_SB(1, 0), cB + kstep, voffB); PG8_STAGE_A(PG8_SA(1, 0), cA + kstep, 0, false); PG8_STAGE(PG8_SB(1, 1), cB + hstep + kstep, voffB);
        PG8_WAIT_V(6); PG8_BAR;
    } else {
        PG8_STAGE(PG8_SB(0, 0), cB, voffB); PG8_STAGE(PG8_SA(0, 0), cA, voffA); PG8_STAGE(PG8_SB(0, 1), cB + hstep, voffB); PG8_STAGE(PG8_SA(0, 1), cA + hstep, voffA);
        if (wr == 1) PG8_BAR;
        PG8_WAIT_V(4); PG8_BAR;
        PG8_STAGE(PG8_SB(1, 0), cB + kstep, voffB); PG8_STAGE(PG8_SA(1, 0), cA + kstep, voffA); PG8_STAGE(PG8_SB(1, 1), cB + hstep + kstep, voffB);
        PG8_WAIT_V(6); PG8_BAR;
    }
    for (;;) {
        const bool has_next = S.next(ui + 1, nxt);
        const char* nA = has_next ? PG8_APTR(nxt) : cA; const char* nB = has_next ? PG8_BPTR(nxt) : cB;
        if constexpr (MODE == 1) { if (has_next) { PG8_GATHER(vAn, nxt); asm volatile("s_waitcnt vmcnt(0)" ::: "memory"); } else { vAn[0][0] = vAc[0][0]; vAn[0][1] = vAc[0][1]; vAn[1][0] = vAc[1][0]; vAn[1][1] = vAc[1][1]; } }
        for (int t = 0; t < nt; t += 2) {
            const bool last = (t == nt - 2);
            const char* a1 = cA + (size_t)(t + 1) * kstep;
            const char* a2 = last ? nA : cA + (size_t)(t + 2) * kstep; const char* b2 = last ? nB : cB + (size_t)(t + 2) * kstep;
            const char* a3 = a2 + kstep; const char* b3 = b2 + kstep;
            if (last && has_next) S.a_ready(nxt);
            if constexpr (SP2) {
            PG8_LDB(B0, 0, 0); PG8_LDB(B1, 0, 1); PG8_SCHED; PG8_LDA(At, 0, 0); PG8_STAGE_A(PG8_SA(1, 1), a1, 1, false);
            PG8_WAIT_V(8); PG8_WAIT_L(0); PG8_BAR; PG8_MMA(0, 0, At, B0); PG8_MMA(0, 1, At, B1); PG8_BAR; PG8_SCHED;
            PG8_LDA(At, 0, 1); PG8_STAGE(PG8_SB(0, 0), b2, voffB); PG8_STAGE(PG8_SB(0, 1), b2 + hstep, voffB); PG8_STAGE_A(PG8_SA(0, 0), a2, 0, last);
            PG8_WAIT_V(8); PG8_WAIT_L(0); PG8_BAR; PG8_MMA(1, 0, At, B0); PG8_MMA(1, 1, At, B1); PG8_BAR; PG8_SCHED;
            PG8_LDB(B0, 1, 0); PG8_LDB(B1, 1, 1); PG8_SCHED; PG8_LDA(At, 1, 0); PG8_STAGE_A(PG8_SA(0, 1), a2, 1, last);
            PG8_WAIT_V(8); PG8_WAIT_L(0); PG8_BAR; PG8_MMA(0, 0, At, B0); PG8_MMA(0, 1, At, B1); PG8_BAR; PG8_SCHED;
            PG8_LDA(At, 1, 1); PG8_STAGE(PG8_SB(1, 0), b3, voffB); PG8_STAGE(PG8_SB(1, 1), b3 + hstep, voffB); PG8_STAGE_A(PG8_SA(1, 0), a3, 0, last);
            PG8_WAIT_V(8); PG8_WAIT_L(0); PG8_BAR; PG8_MMA(1, 0, At, B0); PG8_MMA(1, 1, At, B1); PG8_BAR; PG8_SCHED;
            } else {
            PG8_LDB(B0, 0, 0); PG8_SCHED; PG8_LDA(At, 0, 0); PG8_STAGE(PG8_SA(1, 1), a1 + hstep, voffA);
            PG8_WAIT_L(8); PG8_BAR; PG8_WAIT_L(0); PG8_MMA(0, 0, At, B0); PG8_BAR; PG8_SCHED;
            PG8_LDB(B1, 0, 1); PG8_STAGE(PG8_SB(0, 0), b2, voffB);
            PG8_BAR; PG8_WAIT_L(0); PG8_MMA(0, 1, At, B1); PG8_BAR;
            PG8_LDA(At, 0, 1); PG8_STAGE(PG8_SA(0, 0), a2, voffA);
            PG8_BAR; PG8_WAIT_L(0); PG8_MMA(1, 0, At, B0); PG8_BAR; PG8_SCHED;
            PG8_STAGE(PG8_SB(0, 1), b2 + hstep, voffB);
            PG8_WAIT_V(6); PG8_BAR; PG8_MMA(1, 1, At, B1); PG8_BAR;
            PG8_LDB(B0, 1, 0); PG8_SCHED; PG8_LDA(At, 1, 0); PG8_STAGE(PG8_SA(0, 1), a2 + hstep, voffA);
            PG8_WAIT_L(8); PG8_BAR; PG8_WAIT_L(0); PG8_MMA(0, 0, At, B0); PG8_BAR; PG8_SCHED;
            PG8_LDB(B1, 1, 1); PG8_STAGE(PG8_SB(1, 0), b3, voffB);
            PG8_BAR; PG8_WAIT_L(0); PG8_MMA(0, 1, At, B1); PG8_BAR;
            PG8_LDA(At, 1, 1); PG8_STAGE(PG8_SA(1, 0), a3, voffA);
            PG8_BAR; PG8_WAIT_L(0); PG8_MMA(1, 0, At, B0); PG8_BAR; PG8_SCHED;
            PG8_STAGE(PG8_SB(1, 1), b3 + hstep, voffB);
            PG8_WAIT_V(6); PG8_BAR; PG8_MMA(1, 1, At, B1); PG8_BAR;
            }
        }
        if constexpr (ALIGN_EPI) { if (wr == 0) PG8_BAR; }
        if constexpr (!Epi::AFTER_DRAIN) { E(acc, cur, wr, wc, fr, fq); S.done(cur); }
        if (!has_next) break;
#pragma unroll
        for (int a = 0; a < 2; ++a)
#pragma unroll
            for (int b = 0; b < 2; ++b)
#pragma unroll
                for (int m = 0; m < 4; ++m)
#pragma unroll
                    for (int n = 0; n < 2; ++n) acc[a][b][m][n] = (f32x4){0.f, 0.f, 0.f, 0.f};
        cur = nxt; cA = nA; cB = nB; ++ui;
        if constexpr (MODE == 1) { vAc[0][0] = vAn[0][0]; vAc[0][1] = vAn[0][1]; vAc[1][0] = vAn[1][0]; vAc[1][1] = vAn[1][1]; }
        if constexpr (ALIGN_EPI) { if (wr == 1) PG8_BAR; }
    }
    PG8_WAIT_V(0);
    if constexpr (!ALIGN_EPI) { if (wr == 0) PG8_BAR; }
    PG8_BAR;
    if constexpr (Epi::AFTER_DRAIN) { E.fused(acc, cur, wr, wc, fr, fq, lds, wid, lane); S.done(cur); }
#undef PG8_SA
#undef PG8_SB
#undef PG8_STAGE
#undef PG8_STAGE_A
#undef PG8_GATHER
#undef PG8_APTR
#undef PG8_BPTR
#undef PG8_LDA
#undef PG8_LDB
#undef PG8_MMA
#undef PG8_WAIT_V
#undef PG8_WAIT_L
#undef PG8_BAR
#undef PG8_SCHED
}
}

#define GAS __attribute__((address_space(1)))
#define LAS __attribute__((address_space(3)))
typedef unsigned short bf16;
typedef unsigned v4u __attribute__((ext_vector_type(4)));
typedef unsigned v2u __attribute__((ext_vector_type(2)));
typedef float f32x4 __attribute__((ext_vector_type(4)));
typedef float f32x16 __attribute__((ext_vector_type(16)));
typedef short bf16x8 __attribute__((ext_vector_type(8)));
typedef short s16x4 __attribute__((ext_vector_type(4)));
typedef GAS unsigned gu32;
#define RLX_AGENT __ATOMIC_RELAXED, __HIP_MEMORY_SCOPE_AGENT
#define LDS_WAIT() asm volatile("s_waitcnt lgkmcnt(0)" ::: "memory")
#define VM_WAIT() asm volatile("s_waitcnt vmcnt(0)" ::: "memory")
using pg8::bf2f; using pg8::bflo; using pg8::bfhi; using pg8::fsigmoid; using pg8::cvt_pk_bf16;

#ifndef MK_SPLIT
#define MK_SPLIT 0
#endif

constexpr int NWAVES = 8, NTHR = 512;
constexpr int NB = 8, SEQ = 4096, TOK = NB * SEQ, DM = 1024;
constexpr int NPROJ = 2304;
constexpr int NQ = 768, NKV = 1024, KLORA = 384, NLORA = 2048, RW = 512;
constexpr int FFD = 2816, FFE = 3584, NEXP = 8;
constexpr int MODLD = 6144;
constexpr int PASS_TILES = 136;
constexpr int PASS_ROWS = PASS_TILES * 256;

constexpr size_t MiB = 1u << 20;
constexpr size_t WS_CTL = 0, CTL_ZERO_BYTES = 64 * 1024;
constexpr size_t WS_MOD = 1 * MiB;
constexpr size_t WS_ROUTE = 2 * MiB;
constexpr size_t WS_WIN = 4 * MiB;
constexpr size_t WS_WUQ = WS_WIN + 2ull * NPROJ * DM * 2;
constexpr size_t WS_WUKV = WS_WUQ + 2ull * NQ * 256 * 2;
constexpr size_t WS_WLORA = WS_WUKV + 2ull * NKV * 128 * 2;
constexpr size_t WS_WOUT = WS_WLORA + 2ull * NLORA * KLORA * 2;
constexpr size_t WS_WF1 = WS_WOUT + 2ull * DM * DM * 2;
constexpr size_t WS_WF2 = WS_WF1 + 2ull * FFD * DM * 2;
constexpr size_t WS_WEND = WS_WF2 + (size_t)DM * FFD * 2;
constexpr size_t WS_VFIRST = 38 * MiB;
constexpr size_t WS_ARENA = 70 * MiB;
static_assert(WS_WEND <= WS_VFIRST, "weights overflow");
constexpr size_t A_H = WS_ARENA + 0 * MiB;
constexpr size_t A_PROJ = WS_ARENA + 64 * MiB;
constexpr size_t A_CQ = WS_ARENA + 208 * MiB;
constexpr size_t A_CKV = WS_ARENA + 224 * MiB;
constexpr size_t A_LA = WS_ARENA + 232 * MiB;
constexpr size_t A_KB = WS_ARENA + 256 * MiB;
constexpr size_t A_R = WS_ARENA + 304 * MiB;
constexpr size_t A_KRAW = WS_ARENA + 336 * MiB;
constexpr size_t A_VRAW = WS_ARENA + 368 * MiB;
constexpr size_t A_VB = WS_ARENA + 400 * MiB;
constexpr size_t A_KK = WS_ARENA + 432 * MiB;
constexpr size_t A_BV = WS_ARENA + 464 * MiB;
constexpr size_t A_BON = WS_ARENA + 496 * MiB;
constexpr size_t A_Q = WS_ARENA + 0 * MiB;
constexpr size_t A_LW = WS_ARENA + 64 * MiB;
constexpr size_t A_G = WS_ARENA + 128 * MiB;
constexpr size_t A_YCAT = WS_ARENA + 160 * MiB;
constexpr size_t A_HID = WS_ARENA + 64 * MiB;
constexpr size_t A_WE1 = WS_ARENA + 304 * MiB;
constexpr size_t A_WE2 = WS_ARENA + 416 * MiB;
constexpr size_t WS_END = WS_ARENA + 504 * MiB;
static_assert(A_HID + (size_t)PASS_ROWS * FFE * 2 <= A_WE1, "moe hidden overflow");
constexpr size_t RT_SEL = WS_ROUTE;
constexpr size_t RT_GW = RT_SEL + (size_t)TOK * 8;
constexpr size_t RT_CNT = RT_GW + (size_t)TOK * 8;
constexpr size_t RT_RIDX = RT_CNT + 256 * 16 * 4;
constexpr size_t RT_RGW = RT_RIDX + 2ull * PASS_ROWS * 4;
constexpr size_t RT_TILE = RT_RGW + 2ull * PASS_ROWS * 4;
static_assert(RT_TILE + 2 * (PASS_TILES + 8) * 4 <= WS_WIN, "route tables overflow");
constexpr int CW_QCTR = 64;
constexpr int CW_BAR = 4096;

constexpr int RING_BYTES = 155648;
constexpr int LDSCTL_OFF = RING_BYTES, MISC_OFF = LDSCTL_OFF + 320, PTAB_OFF = LDSCTL_OFF + 1024;
constexpr int LDS_BYTES = 163840;

#define XB_TMO      128
#define XB_XCNT(j)  (256  + 64 * (j))
#define XB_XSUB(j)  (1280 + 64 * (j))
#define XB_XGEN(j)  (2304 + 64 * (j))
#define XB_TOP      3328
#define XB_TOPGEN   3392
#define XCD_BAR_WORDS 3456
#define XB_SPIN_CAP (1u << 18)

__device__ __forceinline__ unsigned xb_ld(unsigned* p)              { return __hip_atomic_load(p, __ATOMIC_RELAXED, __HIP_MEMORY_SCOPE_AGENT); }
__device__ __forceinline__ unsigned xb_add(unsigned* p, unsigned v) { return __hip_atomic_fetch_add(p, v, __ATOMIC_RELAXED, __HIP_MEMORY_SCOPE_AGENT); }
__device__ __forceinline__ unsigned xb_xcc_id() { return (unsigned)__builtin_amdgcn_s_getreg((3 << 11) | 20) & 0xFu; }
#define XB_SPIN(cond, bar) do { unsigned _sp = 0; while (cond) { __builtin_amdgcn_s_sleep(1); \
    if ((++_sp & 255u) == 0u) { if (xb_ld(&(bar)[XB_TMO])) break; if (_sp > XB_SPIN_CAP) { atomicAdd(&(bar)[XB_TMO], 1u); break; } } } } while (0)

struct XcdBarrier {
    unsigned* bar; unsigned x;
    volatile LAS unsigned* st;
};

__device__ __forceinline__ XcdBarrier xcd_barrier_post(unsigned* bar, volatile LAS unsigned* st) {
    XcdBarrier b; b.bar = bar; b.x = xb_xcc_id(); b.st = st;
    if (threadIdx.x == 0) (void)xb_add(&bar[XB_XCNT(b.x)], 1u);
    return b;
}
__device__ __forceinline__ void xcd_barrier_complete(unsigned* bar, unsigned x, unsigned& nloc, unsigned& nx) {
    const unsigned G = gridDim.x * gridDim.y * gridDim.z;
    unsigned sum, cnt, mine, sp = 0u;
    for (;;) {
        sum = 0u; cnt = 0u; mine = 0u;
#pragma unroll
        for (unsigned j = 0; j < 16; ++j) { const unsigned c = xb_ld(&bar[XB_XCNT(j)]); sum += c; cnt += (c > 0u) ? 1u : 0u; mine = (j == x) ? c : mine; }
        if (sum == G) break;
        __builtin_amdgcn_s_sleep(1);
        if ((++sp & 255u) == 0u) { if (xb_ld(&bar[XB_TMO])) break; if (sp > XB_SPIN_CAP) { atomicAdd(&bar[XB_TMO], 1u); break; } }
    }
    nloc = mine > 0u ? mine : 1u; nx = cnt > 0u ? cnt : 1u;
}

__device__ __forceinline__ void xcd_barrier(const XcdBarrier& b) {
    asm volatile("s_waitcnt vmcnt(0)" ::: "memory");
    __syncthreads();
    if (threadIdx.x == 0) {
        unsigned* bar = b.bar;
        __builtin_amdgcn_s_waitcnt(0);
        unsigned nloc = b.st[0], nx = b.st[1];
        if (nloc == 0u) { xcd_barrier_complete(bar, b.x, nloc, nx); b.st[0] = nloc; b.st[1] = nx; }
        const unsigned old = xb_add(&bar[XB_XSUB(b.x)], 1u);
        const unsigned gen = old / nloc;
        if (old + 1u == (gen + 1u) * nloc) {
            __builtin_amdgcn_fence(__ATOMIC_RELEASE, "agent");
            asm volatile("s_waitcnt vmcnt(0)" ::: "memory");
            const unsigned og = xb_add(&bar[XB_TOP], 1u);
            const unsigned tg = og / nx;
            if (og + 1u == (tg + 1u) * nx) xb_add(&bar[XB_TOPGEN], 1u);
            else XB_SPIN(xb_ld(&bar[XB_TOPGEN]) == tg, bar);
            __builtin_amdgcn_fence(__ATOMIC_ACQUIRE, "agent");
            xb_add(&bar[XB_XGEN(b.x)], 1u);
            asm volatile("s_waitcnt vmcnt(0)" ::: "memory");
        } else {
            XB_SPIN(xb_ld(&bar[XB_XGEN(b.x)]) == gen, bar);
            __builtin_amdgcn_fence(__ATOMIC_ACQUIRE, "agent");
            asm volatile("s_waitcnt vmcnt(0)" ::: "memory");
        }
    }
    __syncthreads();
}


template <int X> __device__ __forceinline__ float lane_xor(float v) {
    if constexpr (X == 32) { const auto rr = __builtin_amdgcn_permlane32_swap(__float_as_uint(v), __float_as_uint(v), false, false); return __uint_as_float((threadIdx.x & 32) ? rr[0] : rr[1]); }
    else return __uint_as_float((unsigned)__builtin_amdgcn_ds_swizzle((int)__float_as_uint(v), 0x1f | (X << 10)));
}
__device__ __forceinline__ float wave_sum(float v) {
    v += lane_xor<1>(v); v += lane_xor<2>(v); v += lane_xor<4>(v); v += lane_xor<8>(v); v += lane_xor<16>(v);
    { const auto rr = __builtin_amdgcn_permlane32_swap(__float_as_uint(v), __float_as_uint(v), false, false); v = __uint_as_float(rr[0]) + __uint_as_float(rr[1]); }
    return v;
}
__device__ __forceinline__ v4u pk8(const float* f) { v4u w; w.x = cvt_pk_bf16(f[0], f[1]); w.y = cvt_pk_bf16(f[2], f[3]); w.z = cvt_pk_bf16(f[4], f[5]); w.w = cvt_pk_bf16(f[6], f[7]); return w; }
__device__ __forceinline__ void up8(const v4u w, float* f) { f[0] = bflo(w.x); f[1] = bfhi(w.x); f[2] = bflo(w.y); f[3] = bfhi(w.y); f[4] = bflo(w.z); f[5] = bfhi(w.z); f[6] = bflo(w.w); f[7] = bfhi(w.w); }

__device__ __forceinline__ void tr_block64(const float* W, int ldw, bf16* WT, int ldk, int k0, int n0, int drow0, int nv, int lane) {
    const bool ok = lane < nv;
    const float* src = W + (size_t)k0 * ldw + n0 + (ok ? lane : 0);
    float v[64];
#pragma unroll
    for (int k = 0; k < 64; ++k) v[k] = src[(size_t)k * ldw];
    if (ok) { GAS v4u* dst = (GAS v4u*)(WT + (size_t)(drow0 + lane) * ldk + k0);
#pragma unroll
        for (int c = 0; c < 8; ++c) { v4u o; o.x = cvt_pk_bf16(v[8 * c], v[8 * c + 1]); o.y = cvt_pk_bf16(v[8 * c + 2], v[8 * c + 3]); o.z = cvt_pk_bf16(v[8 * c + 4], v[8 * c + 5]); o.w = cvt_pk_bf16(v[8 * c + 6], v[8 * c + 7]); dst[c] = o; } }
}
__device__ __forceinline__ void conv_item(const float* W, int K, int N, bf16* WT, int ldk, int mode, int row_off, int item, int lane) {
    const int nblk = (N + 63) / 64, kb = item / nblk, nb = item % nblk, n0 = 64 * nb;
    int drow = n0 + row_off;
    if (mode != 0) drow = 256 * (n0 >> 7) + (n0 & 127) + (mode == 2 ? 128 : 0);
    tr_block64(W, N, WT, ldk, 64 * kb, n0, drow, (N - n0) < 64 ? (N - n0) : 64, lane);
}
struct In { const float* p[38]; };
struct InT { volatile LAS unsigned* t;
    __device__ __forceinline__ const float* operator[](int i) const { const unsigned lo = __builtin_amdgcn_readfirstlane(t[2 * i]), hi = __builtin_amdgcn_readfirstlane(t[2 * i + 1]);
        return (const float*)(((unsigned long long)hi << 32) | (unsigned long long)lo); } };

__device__ __forceinline__ void p0_weights(const InT in, unsigned char* ws, LAS unsigned char* lds, int gw, int NGW, int wave, int lane, int gtid, int NGT) {
    constexpr int I_IN = 16 * 35, I_VR = 16, I_UQ = 4 * 12, I_UKV = 2 * 16, I_OUT = 16 * 16, I_G = 16 * 44, I_D = 44 * 16;
    constexpr int PER_L = I_IN + I_UQ + I_UKV + I_OUT;
    constexpr int NITEMS = 2 * PER_L + I_VR + 2 * I_G + I_D;
    for (int it = gw; it < NITEMS; it += NGW) {
        int r = it;
        if (r < 2 * PER_L) { const int l = r / PER_L; r -= l * PER_L;
            if (r < I_IN) { conv_item(in[7] + (size_t)l * DM * 2240, DM, 2240, (bf16*)(ws + WS_WIN) + (size_t)l * NPROJ * DM, DM, 0, 0, r, lane); continue; } r -= I_IN;
            if (r < I_UQ) { conv_item(in[10] + (size_t)l * 256 * NQ, 256, NQ, (bf16*)(ws + WS_WUQ) + (size_t)l * NQ * 256, 256, 0, 0, r, lane); continue; } r -= I_UQ;
            if (r < I_UKV) { conv_item(in[12] + (size_t)l * 128 * NKV, 128, NKV, (bf16*)(ws + WS_WUKV) + (size_t)l * NKV * 128, 128, 0, 0, r, lane); continue; } r -= I_UKV;
            conv_item(in[28] + (size_t)l * DM * DM, DM, DM, (bf16*)(ws + WS_WOUT) + (size_t)l * DM * DM, DM, 0, 0, r, lane); continue; }
        r -= 2 * PER_L;
        if (r < I_VR) { conv_item(in[8], DM, 32, (bf16*)(ws + WS_WIN) + (size_t)NPROJ * DM, DM, 0, 2240, r, lane); continue; } r -= I_VR;
        if (r < I_G) { conv_item(in[29], DM, FFD, (bf16*)(ws + WS_WF1), DM, 1, 0, r, lane); continue; } r -= I_G;
        if (r < I_G) { conv_item(in[30], DM, FFD, (bf16*)(ws + WS_WF1), DM, 2, 0, r, lane); continue; } r -= I_G;
        conv_item(in[31], FFD, DM, (bf16*)(ws + WS_WF2), FFD, 0, 0, r, lane);
    }
    { const int n0 = 64 * 128, n1 = 32 * 128;
      for (int i = gtid; i < n0 + n1; i += NGT) { const bool l1 = i >= n0; const int j = l1 ? i - n0 : i; const int row = (l1 ? 2272 : 2240) + j / 128, ch = j % 128;
          *(GAS v4u*)((bf16*)(ws + WS_WIN) + ((size_t)(l1 ? NPROJ : 0) + row) * DM + ch * 8) = (v4u){0u, 0u, 0u, 0u}; } }
    const float* pw2 = in[17]; const float* pa2 = in[19]; const float* pg2 = in[20]; const float* pv2 = in[22];
    for (int i = gtid; i < 2 * NLORA * (KLORA / 8); i += NGT) {
        const int l = i / (NLORA * 48), rem = i % (NLORA * 48), k8 = rem / NLORA, pos = rem % NLORA;
        const int seg = pos >> 9, p9 = pos & 511, ct = p9 >> 8, p8 = p9 & 255, bj = p8 >> 7, wc = (p8 >> 5) & 3, x = p8 & 31;
        const int oc = 256 * ct + 64 * wc + 32 * bj + x;
        const int k0 = k8 * 8;
        const float* src = nullptr; int kr = 0;
        if (seg == 0 && k0 < 64) { src = pw2 + (size_t)l * 64 * RW; kr = k0; }
        else if (seg == 1 && k0 >= 64 && k0 < 128) { src = pa2 + (size_t)l * 64 * RW; kr = k0 - 64; }
        else if (seg == 2 && k0 >= 128 && k0 < 256) { src = pg2 + (size_t)l * 128 * RW; kr = k0 - 128; }
        else if (seg == 3 && l == 1 && k0 >= 256 && k0 < 288) { src = pv2; kr = k0 - 256; }
        float f[8];
#pragma unroll
        for (int e = 0; e < 8; ++e) f[e] = src ? src[(size_t)(kr + e) * RW + oc] : 0.f;
        *(GAS v4u*)((bf16*)(ws + WS_WLORA) + ((size_t)l * NLORA + pos) * KLORA + k0) = pk8(f);
    }
}
__device__ __forceinline__ void p_expert_weights(const InT in, unsigned char* ws, LAS unsigned char* lds, int gw, int NGW, int wave, int lane) {
    constexpr int IPJ = 896;
    const float* pg = in[34]; const float* pu = in[35]; const float* pd = in[36];
    for (int it = gw; it < 24 * IPJ; it += NGW) { const int job = it / IPJ, r = it % IPJ, e = job / 3, kind = job % 3;
        if (kind == 0) conv_item(pg + (size_t)e * DM * FFE, DM, FFE, (bf16*)(ws + A_WE1) + (size_t)e * 2 * FFE * DM, DM, 1, 0, r, lane);
        else if (kind == 1) conv_item(pu + (size_t)e * DM * FFE, DM, FFE, (bf16*)(ws + A_WE1) + (size_t)e * 2 * FFE * DM, DM, 2, 0, r, lane);
        else conv_item(pd + (size_t)e * FFE * DM, FFE, DM, (bf16*)(ws + A_WE2) + (size_t)e * DM * FFE, FFE, 0, 0, r, lane); }
}
__device__ __forceinline__ void p0_mod(const InT in, unsigned char* ws, LAS unsigned char* lds, int vcu, int G, int wave, int lane, int tid) {
    LAS float* cond = (LAS float*)lds;
    LAS float* red = (LAS float*)(lds + 32768);
    const float* cin = in[1]; const float* wada = in[3]; const float* bada = in[4];
    for (int i = tid; i < NB * DM; i += NTHR) { const float c = cin[i]; cond[i] = c * fsigmoid(c); }
    __syncthreads();
    float* MOD = (float*)(ws + WS_MOD);
    for (int it = vcu; it < 2 * (MODLD / 64); it += G) { const int l = it / (MODLD / 64), n0 = (it % (MODLD / 64)) * 64;
        const float* W = wada + (size_t)l * DM * MODLD + n0 + lane;
        float a[8] = {0.f, 0.f, 0.f, 0.f, 0.f, 0.f, 0.f, 0.f};
#pragma unroll 16
        for (int k = wave * 128; k < wave * 128 + 128; ++k) { const float w = W[(size_t)k * MODLD];
#pragma unroll
            for (int b = 0; b < 8; ++b) a[b] += cond[b * DM + k] * w; }
#pragma unroll
        for (int b = 0; b < 8; ++b) red[(wave * 8 + b) * 64 + lane] = a[b];
        __syncthreads();
        { const int b = tid >> 6, n = tid & 63; float s = bada[(size_t)l * MODLD + n0 + n];
#pragma unroll
          for (int w = 0; w < 8; ++w) s += red[(w * 8 + b) * 64 + n];
          MOD[((size_t)l * NB + b) * MODLD + n0 + n] = s; }
        __syncthreads();
    }
}

template <bool ROUTER>
__device__ __forceinline__ void norm_phase(const float* xin, const float* g, const float* modl, int sh_off, bf16* H, const float* wr, const float* br, unsigned char* ws,
                                           LAS unsigned char* lds, int vcu, int G, int wave, int lane, int tid) {
    LAS int* cntl = (LAS int*)lds;
    for (int blk = vcu; blk < TOK / 128; blk += G) {
        if (ROUTER) { if (tid < 16) cntl[tid] = 0; __syncthreads(); }
        const int row0 = blk * 128 + wave * 16, b = row0 >> 12;
        const float* shp = modl + (size_t)b * MODLD + sh_off; const float* scp = shp + 1024;
        f32x4 gs[4], sh[4];
#pragma unroll
        for (int j = 0; j < 4; ++j) { const int c = 4 * lane + 256 * j; const f32x4 gg = *(const f32x4*)(g + c), sc = *(const f32x4*)(scp + c); gs[j] = gg * (sc + 1.0f); sh[j] = *(const f32x4*)(shp + c); }
        for (int r = 0; r < 16; ++r) { const int row = row0 + r;
            const GAS f32x4* xr = (const GAS f32x4*)(xin + (size_t)row * DM) + lane;
            f32x4 v[4]; float s = 0.f;
#pragma unroll
            for (int j = 0; j < 4; ++j) { v[j] = xr[64 * j]; s += (v[j].x * v[j].x + v[j].y * v[j].y) + (v[j].z * v[j].z + v[j].w * v[j].w); }
            const float rstd = 1.0f / sqrtf(wave_sum(s) * (1.0f / DM) + 1e-6f);
            GAS unsigned long long* o8 = (GAS unsigned long long*)(H + (size_t)row * DM) + lane;
#pragma unroll
            for (int j = 0; j < 4; ++j) { v[j] = v[j] * rstd * gs[j] + sh[j]; o8[64 * j] = (unsigned long long)cvt_pk_bf16(v[j].x, v[j].y) | ((unsigned long long)cvt_pk_bf16(v[j].z, v[j].w) << 32); }
            if (ROUTER) {
                float lg[8];
#pragma unroll
                for (int e = 0; e < 8; ++e) lg[e] = 0.f;
#pragma unroll
                for (int j = 0; j < 4; ++j)
#pragma unroll
                    for (int i = 0; i < 4; ++i) { const f32x4 w0 = *(const f32x4*)(wr + (size_t)(4 * lane + 256 * j + i) * 8), w1 = *(const f32x4*)(wr + (size_t)(4 * lane + 256 * j + i) * 8 + 4); const float hv = v[j][i];
                        lg[0] += hv * w0.x; lg[1] += hv * w0.y; lg[2] += hv * w0.z; lg[3] += hv * w0.w; lg[4] += hv * w1.x; lg[5] += hv * w1.y; lg[6] += hv * w1.z; lg[7] += hv * w1.w; }
#pragma unroll
                for (int e = 0; e < 8; ++e) lg[e] = wave_sum(lg[e]) + br[e];
                unsigned key[8];
#pragma unroll
                for (int e = 0; e < 8; ++e) { const unsigned u = __float_as_uint(lg[e]); const unsigned kx = (u & 0x80000000u) ? ~u : (u | 0x80000000u); key[e] = (kx & ~7u) | (unsigned)(7 - e); }
                unsigned k1 = key[0];
#pragma unroll
                for (int e = 1; e < 8; ++e) k1 = key[e] > k1 ? key[e] : k1;
                unsigned k2 = 0u;
#pragma unroll
                for (int e = 0; e < 8; ++e) { const unsigned t = (key[e] == k1) ? 0u : key[e]; k2 = t > k2 ? t : k2; }
                k1 = (unsigned)__builtin_amdgcn_readfirstlane((int)k1); k2 = (unsigned)__builtin_amdgcn_readfirstlane((int)k2);
                const int i1 = 7 - (int)(k1 & 7u), i2 = 7 - (int)(k2 & 7u);
                const float v1 = __uint_as_float((k1 & 0x80000000u) ? (k1 & 0x7fffffffu) : ~k1), v2 = __uint_as_float((k2 & 0x80000000u) ? (k2 & 0x7fffffffu) : ~k2);
                const float w2 = 1.0f / (1.0f + __expf(v1 - v2)), w1 = 1.0f - w2;
                if (lane == 0) { *(GAS int*)(ws + RT_SEL + (size_t)row * 8) = i1; *(GAS int*)(ws + RT_SEL + (size_t)row * 8 + 4) = i2; *(GAS float*)(ws + RT_GW + (size_t)row * 8) = w1; *(GAS float*)(ws + RT_GW + (size_t)row * 8 + 4) = w2;
                    atomicAdd((int*)&cntl[i1], 1); atomicAdd((int*)&cntl[8 + i2], 1); }
            }
        }
        if (ROUTER) {
            __syncthreads();
            if (tid < 16) *(GAS int*)(ws + RT_CNT + ((size_t)blk * 16 + tid) * 4) = cntl[tid];
            __syncthreads();
        }
    }
}
__device__ __forceinline__ void final_norm(float* x, const float* g, int gw, int NGW, int lane) {
    f32x4 gs[4];
#pragma unroll
    for (int j = 0; j < 4; ++j) gs[j] = *(const f32x4*)(g + 4 * lane + 256 * j);
    for (int row = gw; row < TOK; row += NGW) { GAS f32x4* xr = (GAS f32x4*)(x + (size_t)row * DM) + lane; f32x4 v[4]; float s = 0.f;
#pragma unroll
        for (int j = 0; j < 4; ++j) { v[j] = xr[64 * j]; s += (v[j].x * v[j].x + v[j].y * v[j].y) + (v[j].z * v[j].z + v[j].w * v[j].w); }
        const float rstd = 1.0f / sqrtf(wave_sum(s) * (1.0f / DM) + 1e-6f);
#pragma unroll
        for (int j = 0; j < 4; ++j) xr[64 * j] = v[j] * rstd * gs[j]; }
}

__device__ __forceinline__ void rw_chunk(int l, int m, bool first, int ci, const bf16* prow, const float* mu_l, const float* mu_v, unsigned char* ws) {
    const int cr = ci * 8 - 448;
    float p[8], q[8], mu[8];
    up8(*(const GAS v4u*)(prow + ci * 8), p);
    if (first) {
#pragma unroll
        for (int e = 0; e < 8; ++e) q[e] = 0.f; }
    else up8(*(const GAS v4u*)(prow - NPROJ + ci * 8), q);
    const float* mup = (cr < 1792) ? mu_l + cr : mu_v + (cr - 1792);
    *(f32x4*)mu = *(const f32x4*)mup; *(f32x4*)(mu + 4) = *(const f32x4*)(mup + 4);
    float xs[8];
#pragma unroll
    for (int e = 0; e < 8; ++e) xs[e] = p[e] + (q[e] - p[e]) * mu[e];
    bf16* dst;
    if (cr < 512) dst = (bf16*)(ws + A_R) + (size_t)m * RW + cr;
    else if (cr < 1024) dst = (bf16*)(ws + A_KRAW) + (size_t)m * RW + (cr - 512);
    else if (cr < 1536) dst = (bf16*)(ws + (l == 0 ? WS_VFIRST : A_VRAW)) + (size_t)m * RW + (cr - 1024);
    else if (cr < 1600) { dst = (bf16*)(ws + A_LA) + (size_t)m * KLORA + (cr - 1536);
#pragma unroll
        for (int e = 0; e < 8; ++e) xs[e] = 1.0f - 2.0f * __builtin_amdgcn_rcpf(1.0f + __builtin_amdgcn_exp2f(2.885390081777927f * xs[e])); }
    else if (cr < 1664) dst = (bf16*)(ws + A_LA) + (size_t)m * KLORA + 64 + (cr - 1600);
    else if (cr < 1792) { dst = (bf16*)(ws + A_LA) + (size_t)m * KLORA + 128 + (cr - 1664);
#pragma unroll
        for (int e = 0; e < 8; ++e) xs[e] = fsigmoid(xs[e]); }
    else dst = (bf16*)(ws + A_LA) + (size_t)m * KLORA + 256 + (cr - 1792);
    *(GAS v4u*)dst = pk8(xs);
}
__device__ __forceinline__ void prep_phase(int l, const InT in, unsigned char* ws, int gw, int NGW, int lane) {
    const bf16* PROJ = (const bf16*)(ws + A_PROJ);
    const int* pos = (const int*)in[2]; const float* mu_l = in[14] + (size_t)l * 1792; const float* mu_v = in[15];
    float gn[8];
    { const float* gp = (lane < 32) ? in[9] + (size_t)l * 256 + lane * 8 : in[11] + (size_t)l * 128 + ((lane - 32) & 15) * 8;
#pragma unroll
      for (int e = 0; e < 8; ++e) gn[e] = gp[e]; }
    float frq[8];
#pragma unroll
    for (int e = 0; e < 8; ++e) { const int i = 8 * (lane & 3) + e; frq[e] = __builtin_amdgcn_exp2f(-(float)i * (13.287712379549449f / 32.0f)) * 0.15915494309189535f; }
    for (int m = gw; m < TOK; m += NGW) {
        const bf16* prow = PROJ + (size_t)m * NPROJ; const bool first = (m & (SEQ - 1)) == 0;
        float p[8]; up8(*(const GAS v4u*)(prow + lane * 8), p);
        float ss = 0.f;
#pragma unroll
        for (int e = 0; e < 8; ++e) ss += p[e] * p[e];
        const float sq = wave_sum(lane < 32 ? ss : 0.f), skv = wave_sum((lane >= 32 && lane < 48) ? ss : 0.f);
        float oth[8];
#pragma unroll
        for (int e = 0; e < 8; ++e) oth[e] = lane_xor<4>(p[e]);
        if (lane < 32) { const float rstd = 1.0f / sqrtf(sq * (1.0f / 256.0f) + 1e-6f); float o[8];
#pragma unroll
            for (int e = 0; e < 8; ++e) o[e] = p[e] * rstd * gn[e];
            *(GAS v4u*)((bf16*)(ws + A_CQ) + (size_t)m * 256 + lane * 8) = pk8(o); }
        else if (lane < 48) { const float rstd = 1.0f / sqrtf(skv * (1.0f / 128.0f) + 1e-6f); float o[8];
#pragma unroll
            for (int e = 0; e < 8; ++e) o[e] = p[e] * rstd * gn[e];
            *(GAS v4u*)((bf16*)(ws + A_CKV) + (size_t)m * 128 + (lane - 32) * 8) = pk8(o); }
        else if (lane < 56) { const float ps = (float)pos[m]; const bool hi = lane >= 52; float o[8];
#pragma unroll
            for (int e = 0; e < 8; ++e) { float rev = ps * frq[e]; rev -= rintf(rev); const float cs = __builtin_amdgcn_cosf(rev), sn = __builtin_amdgcn_sinf(rev);
                o[e] = hi ? (p[e] * cs + oth[e] * sn) : (p[e] * cs - oth[e] * sn); }
            const v4u w = pk8(o); const int b = m >> 12, s = m & (SEQ - 1); const int dim = 128 + (hi ? 32 : 0) + 8 * (lane & 3);
#pragma unroll
            for (int h = 0; h < 4; ++h) *(GAS v4u*)((bf16*)(ws + A_KB) + ((size_t)(b * 4 + h) * SEQ + s) * 192 + dim) = w; }
        else rw_chunk(l, m, first, lane, prow, mu_l, mu_v, ws);
#pragma unroll
        for (int j = 1; j < 4; ++j) rw_chunk(l, m, first, lane + 64 * j, prow, mu_l, mu_v, ws);
        if (lane < 24 || (l == 1 && lane < 28)) rw_chunk(l, m, first, lane + 256, prow, mu_l, mu_v, ws);
        else if (lane >= 32 && lane < 48 && (l == 0 || lane >= 36)) *(GAS v4u*)((bf16*)(ws + A_LA) + (size_t)m * KLORA + lane * 8) = (v4u){0u, 0u, 0u, 0u};
    }
}
__device__ __forceinline__ void onorm_phase(const float* g, unsigned char* ws, int gw, int NGW, int lane) {
    float gn[8];
#pragma unroll
    for (int e = 0; e < 8; ++e) gn[e] = g[lane * 8 + e];
    for (int m = gw; m < TOK; m += NGW) { GAS v4u* pp = (GAS v4u*)((bf16*)(ws + A_YCAT) + (size_t)m * DM + lane * 8); float p[8]; up8(*pp, p); float ss = 0.f;
#pragma unroll
        for (int e = 0; e < 8; ++e) ss += p[e] * p[e];
        const float rstd = 1.0f / sqrtf(wave_sum(ss) * (1.0f / 512.0f) + 1e-6f);
#pragma unroll
        for (int e = 0; e < 8; ++e) p[e] = p[e] * rstd * gn[e];
        *pp = pk8(p); }
}

__device__ __forceinline__ void route_scatter(unsigned char* ws, LAS unsigned char* lds, int vcu, int G, int wave, int lane, int tid) {
    LAS int* tot = (LAS int*)lds;
    LAS int* seg = tot + 16;
    LAS int* base = seg + 32;
    const GAS int* CNT = (const GAS int*)(ws + RT_CNT);
    if (tid < 16) { int s = 0; for (int w = 0; w < 256; ++w) s += CNT[w * 16 + tid]; tot[tid] = s; }
    __syncthreads();
    if (tid < 2) { int a = 0; for (int e = 0; e < 8; ++e) { seg[tid * 9 + e] = a; a += (tot[tid * 8 + e] + 255) & ~255; } seg[tid * 9 + 8] = a; }
    __syncthreads();
    GAS int* RIDX = (GAS int*)(ws + RT_RIDX); GAS float* RGW = (GAS float*)(ws + RT_RGW);
    if (vcu == 0 && tid < 2) { GAS int* TL = (GAS int*)(ws + RT_TILE) + tid * (PASS_TILES + 8); const int nt = seg[tid * 9 + 8] >> 8; TL[0] = nt;
        for (int e = 0; e < 8; ++e) for (int t = seg[tid * 9 + e] >> 8; t < (seg[tid * 9 + e + 1] >> 8); ++t) TL[8 + t] = e; }
    for (int pe = vcu; pe < 16; pe += G) { const int k = pe >> 3, e = pe & 7; const int s0 = seg[k * 9 + e] + tot[pe], s1 = seg[k * 9 + e + 1];
        for (int i = s0 + tid; i < s1; i += NTHR) { RIDX[k * PASS_ROWS + i] = -1; RGW[k * PASS_ROWS + i] = 0.f; } }
    for (int blk = vcu; blk < TOK / 128; blk += G) {
        __syncthreads();
        if (tid < 16) { int s = 0; for (int w = 0; w < blk; ++w) s += CNT[w * 16 + tid]; base[tid] = seg[(tid >> 3) * 9 + (tid & 7)] + s; }
        __syncthreads();
        if (wave < 2) { const int k = wave;
            int run[8];
#pragma unroll
            for (int e = 0; e < 8; ++e) run[e] = base[k * 8 + e];
            for (int r = 0; r < 2; ++r) { const int row = blk * 128 + r * 64 + lane; const int ex = *(const GAS int*)(ws + RT_SEL + (size_t)row * 8 + 4 * k); const float gwv = *(const GAS float*)(ws + RT_GW + (size_t)row * 8 + 4 * k);
                int mypos = 0;
#pragma unroll
                for (int e = 0; e < 8; ++e) { const unsigned long long mk = __ballot(ex == e); const int rank = __popcll(mk & ((1ull << lane) - 1ull)); if (ex == e) mypos = run[e] + rank; run[e] += __popcll(mk); }
                RIDX[k * PASS_ROWS + mypos] = row; RGW[k * PASS_ROWS + mypos] = gwv; } }
    }
}

namespace att {
constexpr int KVB = 64, KROW = 400, SHM_K = KVB * KROW, SHM_V = KVB * 128 * 2;
constexpr int OFF_V = 0, OFF_K = 2 * SHM_V, OFF_WS = OFF_K + 2 * SHM_K, LDS_BYTES = OFF_WS + NWAVES * 64 * 4;
static_assert(LDS_BYTES <= RING_BYTES, "attention LDS");
#define SBAR() __builtin_amdgcn_sched_barrier(0)
__device__ __forceinline__ int v_st(int k, int c) { const int kk = (k & ~0xC) | ((k & 4) << 1) | ((k & 8) >> 1); return ((kk >> 3) * 4 + (c >> 5)) * 512 + ((kk & 7) * 32 + (c & 31)) * 2; }
__device__ __forceinline__ int v_rd_base(int lane) { return ((lane & 3) << 3) | (((lane >> 2) & 3) << 6) | (((lane >> 4) & 1) << 5) | (((lane >> 5) & 1) << 8); }
constexpr int v_rd_off(int d0, int ks, int half) { return d0 * 512 + ks * 4096 + half * 2048; }
__device__ __forceinline__ int crow(int r, int hi) { return (r & 3) + 8 * (r >> 2) + 4 * hi; }
__device__ __forceinline__ unsigned cvtpk(float lo, float hi) { return cvt_pk_bf16(lo, hi); }
__device__ __forceinline__ void mask_tile(f32x16& p0, f32x16& p1, int dq) {
    const float NEG = -__builtin_inff();
#pragma unroll
    for (int r = 0; r < 16; ++r) { const int c = (r & 3) + 8 * (r >> 2);
        if (dq - c < 0) p0[r] = NEG;
        if (dq - c - 32 < 0) p1[r] = NEG; }
}
template <int VB>
__device__ __forceinline__ void pv_tile(f32x16* o, int vb0, bf16x8 pa0, bf16x8 pa1, bf16x8 pa2, bf16x8 pa3) {
#define TRRD(dst, off) asm volatile("ds_read_b64_tr_b16 %0, %1 offset:%2" : "=&v"(dst) : "v"(vb0), "i"(off) : "memory")
#define PV_D0(d0) do { s16x4 l0, l1, l2, l3, h0, h1, h2, h3; constexpr int b_ = VB * SHM_V + v_rd_off(d0, 0, 0); \
        TRRD(l0, b_); TRRD(h0, b_ + 2048); TRRD(l1, b_ + 4096); TRRD(h1, b_ + 6144); TRRD(l2, b_ + 8192); TRRD(h2, b_ + 10240); TRRD(l3, b_ + 12288); TRRD(h3, b_ + 14336); \
        asm volatile("s_waitcnt lgkmcnt(0)" ::: "memory"); SBAR(); \
        o[d0] = __builtin_amdgcn_mfma_f32_32x32x16_bf16(pa0, (bf16x8){l0[0], l0[1], l0[2], l0[3], h0[0], h0[1], h0[2], h0[3]}, o[d0], 0, 0, 0); \
        o[d0] = __builtin_amdgcn_mfma_f32_32x32x16_bf16(pa1, (bf16x8){l1[0], l1[1], l1[2], l1[3], h1[0], h1[1], h1[2], h1[3]}, o[d0], 0, 0, 0); \
        o[d0] = __builtin_amdgcn_mfma_f32_32x32x16_bf16(pa2, (bf16x8){l2[0], l2[1], l2[2], l2[3], h2[0], h2[1], h2[2], h2[3]}, o[d0], 0, 0, 0); \
        o[d0] = __builtin_amdgcn_mfma_f32_32x32x16_bf16(pa3, (bf16x8){l3[0], l3[1], l3[2], l3[3], h3[0], h3[1], h3[2], h3[3]}, o[d0], 0, 0, 0); } while (0)
    PV_D0(0); PV_D0(1); PV_D0(2); PV_D0(3);
#undef PV_D0
#undef TRRD
}
template <int KBUF>
__device__ __forceinline__ void qkt(f32x16& p0, f32x16& p1, LAS unsigned char* lds, int r32, int hi, const bf16x8* qr) {
    p0 = f32x16{}; p1 = f32x16{};
    const LAS unsigned char* a = lds + OFF_K + KBUF * SHM_K + r32 * KROW + hi * 16;
#pragma unroll
    for (int d0 = 0; d0 < 12; ++d0) {
        const bf16x8 b0 = *(const LAS bf16x8*)(a + d0 * 32);
        const bf16x8 b1 = *(const LAS bf16x8*)(a + 32 * KROW + d0 * 32);
        p0 = __builtin_amdgcn_mfma_f32_32x32x16_bf16(b0, qr[d0], p0, 0, 0, 0);
        p1 = __builtin_amdgcn_mfma_f32_32x32x16_bf16(b1, qr[d0], p1, 0, 0, 0); }
}
__device__ __forceinline__ void attn_unit(int b, int h, int qb, const bf16* Q, const bf16* K, const bf16* V, bf16* O, const int* pos, LAS unsigned char* lds) {
    int tid_ = threadIdx.x; asm volatile("" : "+v"(tid_));
    const int tid = tid_, wid = __builtin_amdgcn_readfirstlane(tid >> 6), lane = tid & 63, r32 = lane & 31, hi = lane >> 5;
    const int m0 = b * SEQ + qb * 256 + wid * 32;
    const int qpos = qb * 256 + wid * 32;
    bf16x8 qr[12];
    { const bf16* qp = Q + (size_t)(m0 + r32) * NQ + h * 192 + hi * 8; const float C2 = 0.07216878364870323f * 1.4426950408889634f;
      float f[12][8];
#pragma unroll
      for (int d0 = 0; d0 < 12; ++d0) up8(*(const GAS v4u*)(qp + d0 * 16), f[d0]);
      const float ps = (float)pos[m0 + r32];
#pragma unroll
      for (int g = 0; g < 2; ++g)
#pragma unroll
          for (int e = 0; e < 8; ++e) { const int i = 16 * g + 8 * hi + e; float rev = ps * (__builtin_amdgcn_exp2f(-(float)i * (13.287712379549449f / 32.0f)) * 0.15915494309189535f); rev -= rintf(rev);
              const float cs = __builtin_amdgcn_cosf(rev), sn = __builtin_amdgcn_sinf(rev); const float t1 = f[8 + g][e], t2 = f[10 + g][e];
              f[8 + g][e] = t1 * cs - t2 * sn; f[10 + g][e] = t2 * cs + t1 * sn; }
#pragma unroll
      for (int d0 = 0; d0 < 12; ++d0) { v4u w; w.x = cvtpk(f[d0][0] * C2, f[d0][1] * C2); w.y = cvtpk(f[d0][2] * C2, f[d0][3] * C2); w.z = cvtpk(f[d0][4] * C2, f[d0][5] * C2); w.w = cvtpk(f[d0][6] * C2, f[d0][7] * C2);
          qr[d0] = __builtin_bit_cast(bf16x8, w); } }
    const bf16* Kh = K + (size_t)(b * 4 + h) * SEQ * 192; const bf16* Vh = V + (size_t)(b * 4 + h) * SEQ * 128;
    const int NT = (qb + 1) * 4;
    LAS float* wsl = (LAS float*)(lds + OFF_WS) + wid * 64; LAS float* li_l = wsl; LAS float* al_l = wsl + 32;
    float m_reg = -1e30f, l_reg = 0.f; f32x16 o[4] = {};
    const int sr = tid >> 4, sc = (tid & 15) * 8, vst0 = v_st(sr, sc), vst1 = v_st(32 + sr, sc);
    const int vb0 = (int)(uintptr_t)(lds + OFF_V) + v_rd_base(lane);
    int kq[3], kl[3];
#pragma unroll
    for (int i = 0; i < 3; ++i) { const int q = tid + 512 * i; kq[i] = q * 8; kl[i] = (q / 24) * KROW + (q % 24) * 16; }
    v4u sk[3], sv[2];
#define ST_LOAD(t) do { const bf16* kp_ = Kh + (size_t)(t) * KVB * 192; const bf16* vp_ = Vh + (size_t)(t) * KVB * 128; \
        _Pragma("unroll") for (int i = 0; i < 3; ++i) sk[i] = *(const GAS v4u*)(kp_ + kq[i]); \
        sv[0] = *(const GAS v4u*)(vp_ + (size_t)sr * 128 + sc); sv[1] = *(const GAS v4u*)(vp_ + (size_t)(32 + sr) * 128 + sc); } while (0)
#define ST_WRITE(bf) do { _Pragma("unroll") for (int i = 0; i < 3; ++i) *(LAS v4u*)(lds + OFF_K + (bf) * SHM_K + kl[i]) = sk[i]; \
        *(LAS v4u*)(lds + OFF_V + (bf) * SHM_V + vst0) = sv[0]; *(LAS v4u*)(lds + OFF_V + (bf) * SHM_V + vst1) = sv[1]; } while (0)
#define TILE_STEP(t, BF) do { f32x16 p0, p1; \
        if ((t) + 1 < NT) ST_LOAD((t) + 1); \
        qkt<BF>(p0, p1, lds, r32, hi, qr); \
        { const int kb_ = (t) * KVB; if (kb_ + KVB - 1 > qpos) mask_tile(p0, p1, qpos + r32 - 4 * hi - kb_); } \
        float pmax = p0[0]; _Pragma("unroll") for (int r = 1; r < 16; ++r) pmax = fmaxf(pmax, p0[r]); _Pragma("unroll") for (int r = 0; r < 16; ++r) pmax = fmaxf(pmax, p1[r]); \
        { auto rr = __builtin_amdgcn_permlane32_swap(__float_as_uint(pmax), __float_as_uint(pmax), false, false); pmax = fmaxf(__uint_as_float(rr[0]), __uint_as_float(rr[1])); } \
        const float mn = fmaxf(m_reg, pmax), alpha = __builtin_amdgcn_exp2f(m_reg - mn); m_reg = mn; \
        float psum = 0.f; \
        _Pragma("unroll") for (int r = 0; r < 16; ++r) { p0[r] = __builtin_amdgcn_exp2f(p0[r] - mn); p1[r] = __builtin_amdgcn_exp2f(p1[r] - mn); psum += p0[r] + p1[r]; } \
        { auto rr = __builtin_amdgcn_permlane32_swap(__float_as_uint(psum), __float_as_uint(psum), false, false); psum = __uint_as_float(rr[0]) + __uint_as_float(rr[1]); } \
        l_reg = l_reg * alpha + psum; \
        bf16x8 pa0, pa1, pa2, pa3; \
        PK4(p0, 0, pa0); PK4(p0, 8, pa1); PK4(p1, 0, pa2); PK4(p1, 8, pa3); \
        if (__any(alpha < 1.f)) { if (hi == 0) al_l[r32] = alpha; asm volatile("s_waitcnt lgkmcnt(0)" ::: "memory"); \
            _Pragma("unroll") for (int d_ = 0; d_ < 4; ++d_) _Pragma("unroll") for (int r = 0; r < 16; ++r) o[d_][r] *= al_l[crow(r, hi)]; } \
        pv_tile<BF>(o, vb0, pa0, pa1, pa2, pa3); \
        if ((t) + 1 < NT) { VM_WAIT(); ST_WRITE(1 - (BF)); } \
        __syncthreads(); } while (0)
#define PK4(P, B_, OUT) do { unsigned a0 = cvtpk(P[B_+0], P[B_+1]), a1 = cvtpk(P[B_+2], P[B_+3]); \
        unsigned b0 = cvtpk(P[B_+4], P[B_+5]), b1 = cvtpk(P[B_+6], P[B_+7]); \
        auto r0 = __builtin_amdgcn_permlane32_swap(a0, b0, false, false); auto r1 = __builtin_amdgcn_permlane32_swap(a1, b1, false, false); \
        v4u w = {r0[0], r1[0], r0[1], r1[1]}; OUT = __builtin_bit_cast(bf16x8, w); } while (0)
    __syncthreads();
    ST_LOAD(0); VM_WAIT(); ST_WRITE(0);
    __syncthreads();
    for (int t = 0; t < NT; t += 2) { TILE_STEP(t, 0); TILE_STEP(t + 1, 1); }
#undef PK4
#undef TILE_STEP
#undef ST_LOAD
#undef ST_WRITE
    if (hi == 0) li_l[r32] = l_reg;
    asm volatile("s_waitcnt lgkmcnt(0)" ::: "memory");
    float rli[16];
#pragma unroll
    for (int r = 0; r < 16; ++r) rli[r] = __builtin_amdgcn_rcpf(li_l[crow(r, hi)]);
    bf16* Ow = O + (size_t)m0 * DM + h * 128;
#pragma unroll
    for (int r = 0; r < 16; ++r) { const int orow = crow(r, hi);
#pragma unroll
        for (int d0 = 0; d0 < 4; ++d0) { const float v = o[d0][r] * rli[r]; const float vn = lane_xor<1>(v);
            if ((r32 & 1) == 0) *(GAS unsigned*)(Ow + (size_t)orow * DM + d0 * 32 + r32) = cvtpk(v, vn); } }
}
}


namespace rk {
constexpr int RS1 = 144, RS2 = 80;
constexpr int O_AH = 0, O_BH = 4608, O_KH = 9216, O_RH = 13824;
constexpr int O_A2 = 0, O_A3 = 2560, O_A4 = 5120, O_PT = 7680, O_UT = 12800;
constexpr int O_BT = 18432, O_KT = 23552, O_VT = 28672, O_A1 = 33792, O_WC = 37888, UNIT_LDS = 38144;
static_assert(4 * UNIT_LDS <= RING_BYTES, "rwkv precompute LDS");
__device__ __forceinline__ int crow(int r, int hi) { return (r & 3) + 8 * (r >> 2) + 4 * hi; }
__device__ __forceinline__ float xsum32(float v) { const auto rr = __builtin_amdgcn_permlane32_swap(__float_as_uint(v), __float_as_uint(v), false, false); return __uint_as_float(rr[0]) + __uint_as_float(rr[1]); }
#define RK_FRAG(off, row, stride, q) (*(const LAS bf16x8*)(U + (off) + (row) * (stride) + (16 * (q) + 8 * hi) * 2))
#define RK_MFMA(a, b, c) __builtin_amdgcn_mfma_f32_32x32x16_bf16((a), (b), (c), 0, 0, 0)

__device__ __forceinline__ void pre_unit(int l, int b, int hd, int ck, unsigned char* ws, LAS unsigned char* U) {
    int lane_ = (int)__builtin_amdgcn_mbcnt_hi(~0u, __builtin_amdgcn_mbcnt_lo(~0u, 0u)); asm volatile("" : "+v"(lane_));
    const int lane = lane_, r32 = lane & 31, hi = lane >> 5;
    const int tok0 = b * SEQ + ck * 32;
    const size_t gofs = (size_t)tok0 * RW + hd * 64;
    bf16* Rg = (bf16*)(ws + A_R) + gofs; bf16* Kg = (bf16*)(ws + A_KRAW) + gofs; bf16* KKg = (bf16*)(ws + A_KK) + gofs; bf16* BVg = (bf16*)(ws + A_BV) + gofs;
    const bf16* Vg = (const bf16*)(ws + ((l == 0) ? WS_VFIRST : A_VRAW)) + gofs; float* LWg = (float*)(ws + A_LW) + gofs;
    { float L = 0.f, E3 = 1.f;
#pragma unroll 1
      for (int t8 = 0; t8 < 32; t8 += 8) {
          float lwv[8]; unsigned short rv[8], kv[8], kkv[8], bv[8], vv[8];
#pragma unroll
          for (int u = 0; u < 8; ++u) { const size_t o = (size_t)(t8 + u) * RW + lane; lwv[u] = LWg[o]; rv[u] = Rg[o]; kv[u] = Kg[o]; kkv[u] = KKg[o]; bv[u] = BVg[o]; vv[u] = Vg[o]; }
          float bh[8], kh[8];
#pragma unroll
          for (int u = 0; u < 8; ++u) { L += lwv[u]; const float E1 = __expf(L), E2 = __builtin_amdgcn_rcpf(E1);
              const float ah = -bf2f(kkv[u]) * E3, rh = bf2f(rv[u]) * E1; bh[u] = bf2f(bv[u]) * E2; kh[u] = bf2f(kv[u]) * E2; E3 = E1;
              const int t = t8 + u;
              *(LAS unsigned short*)(U + O_AH + t * RS1 + lane * 2) = (unsigned short)cvt_pk_bf16(ah, 0.f);
              *(LAS unsigned short*)(U + O_RH + t * RS1 + lane * 2) = (unsigned short)cvt_pk_bf16(rh, 0.f);
              *(LAS unsigned short*)(U + O_BH + t * RS1 + lane * 2) = (unsigned short)cvt_pk_bf16(bh[u], 0.f);
              *(LAS unsigned short*)(U + O_KH + t * RS1 + lane * 2) = (unsigned short)cvt_pk_bf16(kh[u], 0.f); }
          v4u w;
          w.x = cvt_pk_bf16(bh[0], bh[1]); w.y = cvt_pk_bf16(bh[2], bh[3]); w.z = cvt_pk_bf16(bh[4], bh[5]); w.w = cvt_pk_bf16(bh[6], bh[7]); *(LAS v4u*)(U + O_BT + lane * RS2 + t8 * 2) = w;
          w.x = cvt_pk_bf16(kh[0], kh[1]); w.y = cvt_pk_bf16(kh[2], kh[3]); w.z = cvt_pk_bf16(kh[4], kh[5]); w.w = cvt_pk_bf16(kh[6], kh[7]); *(LAS v4u*)(U + O_KT + lane * RS2 + t8 * 2) = w;
          w.x = (unsigned)vv[0] | ((unsigned)vv[1] << 16); w.y = (unsigned)vv[2] | ((unsigned)vv[3] << 16); w.z = (unsigned)vv[4] | ((unsigned)vv[5] << 16); w.w = (unsigned)vv[6] | ((unsigned)vv[7] << 16); *(LAS v4u*)(U + O_VT + lane * RS2 + t8 * 2) = w;
      }
      *(LAS float*)(U + O_WC + lane * 4) = E3; }
    LDS_WAIT(); asm volatile("" ::: "memory");
    f32x16 X[4];
    f32x16 rhc[2];
    { f32x16 d1 = {}, d2 = {}, d3 = {}, d4 = {};
#pragma unroll
      for (int q = 0; q < 4; ++q) { const bf16x8 fa = RK_FRAG(O_AH, r32, RS1, q), fb = RK_FRAG(O_BH, r32, RS1, q), fk = RK_FRAG(O_KH, r32, RS1, q), fr = RK_FRAG(O_RH, r32, RS1, q);
          d1 = RK_MFMA(fb, fa, d1); d2 = RK_MFMA(fk, fa, d2); d3 = RK_MFMA(fb, fr, d3); d4 = RK_MFMA(fk, fr, d4); }
#pragma unroll
      for (int jt = 0; jt < 2; ++jt)
#pragma unroll
          for (int r = 0; r < 16; ++r) { X[jt][r] = bf2f(*(const LAS unsigned short*)(U + O_AH + crow(r, hi) * RS1 + (r32 + 32 * jt) * 2)); rhc[jt][r] = bf2f(*(const LAS unsigned short*)(U + O_RH + crow(r, hi) * RS1 + (r32 + 32 * jt) * 2)); }
      LDS_WAIT(); asm volatile("" ::: "memory");
#pragma unroll
      for (int r = 0; r < 16; ++r) { const int s = crow(r, hi); const bool lt = s < r32, le = s <= r32; d1[r] = lt ? d1[r] : 0.f; d2[r] = lt ? d2[r] : 0.f; d3[r] = le ? d3[r] : 0.f; d4[r] = le ? d4[r] : 0.f; }
#pragma unroll
      for (int g = 0; g < 4; ++g) { const int so = 8 * g + 4 * hi;
          *(LAS f32x4*)(U + O_A1 + r32 * 128 + so * 4) = (f32x4){d1[4 * g], d1[4 * g + 1], d1[4 * g + 2], d1[4 * g + 3]};
          *(LAS v2u*)(U + O_A2 + r32 * RS2 + so * 2) = (v2u){cvt_pk_bf16(d2[4 * g], d2[4 * g + 1]), cvt_pk_bf16(d2[4 * g + 2], d2[4 * g + 3])};
          *(LAS v2u*)(U + O_A3 + r32 * RS2 + so * 2) = (v2u){cvt_pk_bf16(d3[4 * g], d3[4 * g + 1]), cvt_pk_bf16(d3[4 * g + 2], d3[4 * g + 3])};
          *(LAS v2u*)(U + O_A4 + r32 * RS2 + so * 2) = (v2u){cvt_pk_bf16(d4[4 * g], d4[4 * g + 1]), cvt_pk_bf16(d4[4 * g + 2], d4[4 * g + 3])}; } }
    LDS_WAIT(); asm volatile("" ::: "memory");
    X[2] = f32x16{}; X[3] = f32x16{};
#pragma unroll
    for (int q = 0; q < 2; ++q) { const bf16x8 fa = RK_FRAG(O_A2, r32, RS2, q);
        X[2] = RK_MFMA(fa, RK_FRAG(O_VT, r32, RS2, q), X[2]); X[3] = RK_MFMA(fa, RK_FRAG(O_VT, r32 + 32, RS2, q), X[3]); }
#ifndef RK_NOSOLVE
#pragma unroll
    for (int t = 1; t < 32; ++t) {
        float p0 = 0.f, p1 = 0.f, p2 = 0.f, p3 = 0.f;
#pragma unroll
        for (int g = 0; g < 4; ++g) if (8 * g < t) { const f32x4 cf = *(const LAS f32x4*)(U + O_A1 + t * 128 + (8 * g + 4 * hi) * 4);
#pragma unroll
            for (int e = 0; e < 4; ++e) { p0 += cf[e] * X[0][4 * g + e]; p1 += cf[e] * X[1][4 * g + e]; p2 += cf[e] * X[2][4 * g + e]; p3 += cf[e] * X[3][4 * g + e]; } }
        p0 = xsum32(p0); p1 = xsum32(p1); p2 = xsum32(p2); p3 = xsum32(p3);
        const bool own = hi == ((t >> 2) & 1); const int rt = (t & 3) + 4 * (t >> 3);
        X[0][rt] += own ? p0 : 0.f; X[1][rt] += own ? p1 : 0.f; X[2][rt] += own ? p2 : 0.f; X[3][rt] += own ? p3 : 0.f;
    }
#endif
#pragma unroll
    for (int tl = 0; tl < 4; ++tl)
#pragma unroll
        for (int g = 0; g < 4; ++g) *(LAS v2u*)(U + (tl < 2 ? O_PT : O_UT) + (r32 + 32 * (tl & 1)) * RS2 + (8 * g + 4 * hi) * 2) = (v2u){cvt_pk_bf16(X[tl][4 * g], X[tl][4 * g + 1]), cvt_pk_bf16(X[tl][4 * g + 2], X[tl][4 * g + 3])};
    LDS_WAIT(); asm volatile("" ::: "memory");
    const float wc0 = *(const LAS float*)(U + O_WC + r32 * 4), wc1 = *(const LAS float*)(U + O_WC + (r32 + 32) * 4);
    { f32x16 y0 = {}, y1 = {};
#pragma unroll
      for (int q = 0; q < 2; ++q) { const bf16x8 f3 = RK_FRAG(O_A3, r32, RS2, q), f4 = RK_FRAG(O_A4, r32, RS2, q);
          rhc[0] = RK_MFMA(f3, RK_FRAG(O_PT, r32, RS2, q), rhc[0]); rhc[1] = RK_MFMA(f3, RK_FRAG(O_PT, r32 + 32, RS2, q), rhc[1]);
          y0 = RK_MFMA(f3, RK_FRAG(O_UT, r32, RS2, q), y0); y1 = RK_MFMA(f3, RK_FRAG(O_UT, r32 + 32, RS2, q), y1);
          y0 = RK_MFMA(f4, RK_FRAG(O_VT, r32, RS2, q), y0); y1 = RK_MFMA(f4, RK_FRAG(O_VT, r32 + 32, RS2, q), y1); }
#pragma unroll
      for (int jt = 0; jt < 2; ++jt) { const int j = r32 + 32 * jt, pj = (j & ~0xC) | ((j & 4) << 1) | ((j & 8) >> 1);
#pragma unroll
          for (int r = 0; r < 16; ++r) Rg[(size_t)crow(r, hi) * RW + pj] = (unsigned short)cvt_pk_bf16(rhc[jt][r], 0.f); }
#pragma unroll
      for (int it = 0; it < 2; ++it)
#pragma unroll
          for (int hf = 0; hf < 2; ++hf) { const f32x16& y = it ? y1 : y0; const int off = ((it * 2 + hf) * 64 + lane) * 16;
              v4u w; w.x = cvt_pk_bf16(y[8 * hf], y[8 * hf + 1]); w.y = cvt_pk_bf16(y[8 * hf + 2], y[8 * hf + 3]); w.z = cvt_pk_bf16(y[8 * hf + 4], y[8 * hf + 5]); w.w = cvt_pk_bf16(y[8 * hf + 6], y[8 * hf + 7]);
              *(GAS v4u*)((unsigned char*)KKg + (size_t)(off >> 7) * (RW * 2) + (off & 127)) = w; } }
#pragma unroll
    for (int tj = 0; tj < 2; ++tj)
#pragma unroll
        for (int tp = 0; tp < 2; ++tp) { f32x16 z = {};
#pragma unroll
            for (int q = 0; q < 2; ++q) z = RK_MFMA(RK_FRAG(O_PT, r32 + 32 * tj, RS2, q), RK_FRAG(O_BT, r32 + 32 * tp, RS2, q), z);
            const float wc = tp ? wc1 : wc0;
#ifdef RK_SELFCHK
            if (ck == 3) { float num = 0.f, den = 0.f;
                for (int r = 0; r < 16; ++r) { const int jj = crow(r, hi) + 32 * tj, jp = r32 + 32 * tp; float ref = 0.f;
                    for (int t = 0; t < 32; ++t) ref += bf2f(*(const LAS unsigned short*)(U + O_PT + jj * RS2 + t * 2)) * bf2f(*(const LAS unsigned short*)(U + O_BT + jp * RS2 + t * 2));
                    const float d = z[r] - ref; num += d * d; den += ref * ref; }
                num = wave_sum(num); den = wave_sum(den); if (lane == 0) { atomicAdd((float*)(ws + WS_CTL) + 84, num); atomicAdd((float*)(ws + WS_CTL) + 85, den); } }
#endif
#pragma unroll
            for (int r = 0; r < 16; ++r) z[r] = (z[r] + ((tj == tp && crow(r, hi) == r32) ? 1.f : 0.f)) * wc;
#pragma unroll
            for (int hf = 0; hf < 2; ++hf) { const int off = (((tj * 2 + tp) * 2 + hf) * 64 + lane) * 16;
                v4u w; w.x = cvt_pk_bf16(z[8 * hf], z[8 * hf + 1]); w.y = cvt_pk_bf16(z[8 * hf + 2], z[8 * hf + 3]); w.z = cvt_pk_bf16(z[8 * hf + 4], z[8 * hf + 5]); w.w = cvt_pk_bf16(z[8 * hf + 6], z[8 * hf + 7]);
                *(GAS v4u*)((unsigned char*)LWg + (size_t)(off >> 8) * (RW * 4) + (off & 255)) = w; } }
#pragma unroll
    for (int tp = 0; tp < 2; ++tp)
#pragma unroll
        for (int ti = 0; ti < 2; ++ti) { f32x16 z = {};
#pragma unroll
            for (int q = 0; q < 2; ++q) { z = RK_MFMA(RK_FRAG(O_BT, r32 + 32 * tp, RS2, q), RK_FRAG(O_UT, r32 + 32 * ti, RS2, q), z); z = RK_MFMA(RK_FRAG(O_KT, r32 + 32 * tp, RS2, q), RK_FRAG(O_VT, r32 + 32 * ti, RS2, q), z); }
#pragma unroll
            for (int g = 0; g < 4; ++g) { const f32x4 wv = *(const LAS f32x4*)(U + O_WC + (32 * tp + 8 * g + 4 * hi) * 4);
#pragma unroll
                for (int e = 0; e < 4; ++e) z[4 * g + e] *= wv[e]; }
#ifdef RK_SELFCHK
            if (ck == 3) { float num = 0.f, den = 0.f;
                for (int r = 0; r < 16; ++r) { const int jp = crow(r, hi) + 32 * tp, ii = r32 + 32 * ti; float ref = 0.f;
                    for (int t = 0; t < 32; ++t) ref += bf2f(*(const LAS unsigned short*)(U + O_BT + jp * RS2 + t * 2)) * bf2f(*(const LAS unsigned short*)(U + O_UT + ii * RS2 + t * 2)) + bf2f(*(const LAS unsigned short*)(U + O_KT + jp * RS2 + t * 2)) * bf2f(*(const LAS unsigned short*)(U + O_VT + ii * RS2 + t * 2));
                    ref *= *(const LAS float*)(U + O_WC + jp * 4); const float d = z[r] - ref; num += d * d; den += ref * ref; }
                num = wave_sum(num); den = wave_sum(den); if (lane == 0) { atomicAdd((float*)(ws + WS_CTL) + 82, num); atomicAdd((float*)(ws + WS_CTL) + 83, den); } }
#endif
            unsigned char* dst = (unsigned char*)(tp ? BVg : Kg);
#pragma unroll
            for (int hf = 0; hf < 2; ++hf) { const int off = ((ti * 2 + hf) * 64 + lane) * 16;
                v4u w; w.x = cvt_pk_bf16(z[8 * hf], z[8 * hf + 1]); w.y = cvt_pk_bf16(z[8 * hf + 2], z[8 * hf + 3]); w.z = cvt_pk_bf16(z[8 * hf + 4], z[8 * hf + 5]); w.w = cvt_pk_bf16(z[8 * hf + 6], z[8 * hf + 7]);
                *(GAS v4u*)(dst + (size_t)(off >> 7) * (RW * 2) + (off & 127)) = w; } }
    LDS_WAIT(); asm volatile("" ::: "memory");
}

__device__ __forceinline__ void scan_unit(int q, int ih, unsigned char* ws) {
    const int lane = (int)__builtin_amdgcn_mbcnt_hi(~0u, __builtin_amdgcn_mbcnt_lo(~0u, 0u)), r32 = lane & 31, hi = lane >> 5;
    const int b = q >> 3, hd = q & 7;
    const size_t gofs0 = (size_t)b * SEQ * RW + hd * 64;
    const unsigned char* Rg = (const unsigned char*)((const bf16*)(ws + A_R) + gofs0); const unsigned char* Kg = (const unsigned char*)((const bf16*)(ws + A_KRAW) + gofs0);
    const unsigned char* KKg = (const unsigned char*)((const bf16*)(ws + A_KK) + gofs0); const unsigned char* BVg = (const unsigned char*)((const bf16*)(ws + A_BV) + gofs0);
    const unsigned char* LWg = (const unsigned char*)((const float*)(ws + A_LW) + gofs0);
    bf16* Yg = (bf16*)(ws + A_YCAT) + (size_t)b * SEQ * DM + 512 + hd * 64 + 32 * ih + r32;
    int oR[4], oY[2], oM[8], oG[4];
#pragma unroll
    for (int k = 0; k < 4; ++k) oR[k] = r32 * (RW * 2) + (16 * k + 8 * hi) * 2;
#pragma unroll
    for (int hf = 0; hf < 2; ++hf) { const int off = ((ih * 2 + hf) * 64 + lane) * 16; oY[hf] = (off >> 7) * (RW * 2) + (off & 127); }
#pragma unroll
    for (int m = 0; m < 8; ++m) { const int off = (m * 64 + lane) * 16; oM[m] = (off >> 8) * (RW * 4) + (off & 255); }
#pragma unroll
    for (int tp = 0; tp < 2; ++tp)
#pragma unroll
        for (int hf = 0; hf < 2; ++hf) { const int off = ((ih * 2 + hf) * 64 + lane) * 16; oG[tp * 2 + hf] = (off >> 7) * (RW * 2) + (off & 127); }
    f32x16 S0 = {}, S1 = {};
    v4u nR[4], nY[2], nM[8], nG[4];
#define RK_LOADS(ck) do { const size_t cb2 = (size_t)(ck) * 32 * (RW * 2), cb4 = (size_t)(ck) * 32 * (RW * 4); \
        _Pragma("unroll") for (int k = 0; k < 4; ++k) nR[k] = *(const GAS v4u*)(Rg + cb2 + oR[k]); \
        _Pragma("unroll") for (int k = 0; k < 2; ++k) nY[k] = *(const GAS v4u*)(KKg + cb2 + oY[k]); \
        _Pragma("unroll") for (int k = 0; k < 8; ++k) nM[k] = *(const GAS v4u*)(LWg + cb4 + oM[k]); \
        nG[0] = *(const GAS v4u*)(Kg + cb2 + oG[0]); nG[1] = *(const GAS v4u*)(Kg + cb2 + oG[1]); nG[2] = *(const GAS v4u*)(BVg + cb2 + oG[2]); nG[3] = *(const GAS v4u*)(BVg + cb2 + oG[3]); } while (0)
    RK_LOADS(0);
#pragma unroll 1
    for (int ck = 0; ck < SEQ / 32; ++ck) {
        v4u cR[4], cY[2], cM[8], cG[4];
#pragma unroll
        for (int k = 0; k < 4; ++k) cR[k] = nR[k];
#pragma unroll
        for (int k = 0; k < 2; ++k) cY[k] = nY[k];
#pragma unroll
        for (int k = 0; k < 8; ++k) cM[k] = nM[k];
#pragma unroll
        for (int k = 0; k < 4; ++k) cG[k] = nG[k];
        if (ck + 1 < SEQ / 32) RK_LOADS(ck + 1);
        bf16x8 sb[4];
#pragma unroll
        for (int kq = 0; kq < 4; ++kq) { const f32x16& s = (kq >> 1) ? S1 : S0; const int o = 8 * (kq & 1);
            v4u w; w.x = cvt_pk_bf16(s[o], s[o + 1]); w.y = cvt_pk_bf16(s[o + 2], s[o + 3]); w.z = cvt_pk_bf16(s[o + 4], s[o + 5]); w.w = cvt_pk_bf16(s[o + 6], s[o + 7]); sb[kq] = __builtin_bit_cast(bf16x8, w); }
        f32x16 y, n0, n1;
#pragma unroll
        for (int hf = 0; hf < 2; ++hf) { const v4u w = cY[hf]; y[8 * hf] = bflo(w.x); y[8 * hf + 1] = bfhi(w.x); y[8 * hf + 2] = bflo(w.y); y[8 * hf + 3] = bfhi(w.y); y[8 * hf + 4] = bflo(w.z); y[8 * hf + 5] = bfhi(w.z); y[8 * hf + 6] = bflo(w.w); y[8 * hf + 7] = bfhi(w.w); }
#pragma unroll
        for (int hf = 0; hf < 2; ++hf) { const v4u w = cG[hf], x = cG[2 + hf];
            n0[8 * hf] = bflo(w.x); n0[8 * hf + 1] = bfhi(w.x); n0[8 * hf + 2] = bflo(w.y); n0[8 * hf + 3] = bfhi(w.y); n0[8 * hf + 4] = bflo(w.z); n0[8 * hf + 5] = bfhi(w.z); n0[8 * hf + 6] = bflo(w.w); n0[8 * hf + 7] = bfhi(w.w);
            n1[8 * hf] = bflo(x.x); n1[8 * hf + 1] = bfhi(x.x); n1[8 * hf + 2] = bflo(x.y); n1[8 * hf + 3] = bfhi(x.y); n1[8 * hf + 4] = bflo(x.z); n1[8 * hf + 5] = bfhi(x.z); n1[8 * hf + 6] = bflo(x.w); n1[8 * hf + 7] = bfhi(x.w); }
#pragma unroll
        for (int kq = 0; kq < 4; ++kq) {
            y = RK_MFMA(__builtin_bit_cast(bf16x8, cR[kq]), sb[kq], y);
            n0 = RK_MFMA(__builtin_bit_cast(bf16x8, cM[((kq >> 1) * 2 + 0) * 2 + (kq & 1)]), sb[kq], n0);
            n1 = RK_MFMA(__builtin_bit_cast(bf16x8, cM[((kq >> 1) * 2 + 1) * 2 + (kq & 1)]), sb[kq], n1); }
        S0 = n0; S1 = n1;
        bf16* yp = Yg + (size_t)ck * 32 * DM;
#pragma unroll
        for (int r = 0; r < 16; ++r) yp[(size_t)crow(r, hi) * DM] = (unsigned short)cvt_pk_bf16(y[r], 0.f);
    }
#undef RK_LOADS
}
#undef RK_FRAG
#undef RK_MFMA
}

__device__ __forceinline__ void post_phase(int l, const float* gao, const float* lnwp, const float* lnbp, unsigned char* ws, int gw, int NGW, int lane) {
    float gn[8], lw8[8], lb8[8];
#pragma unroll
    for (int e = 0; e < 8; ++e) { gn[e] = gao[lane * 8 + e]; lw8[e] = lnwp[lane * 8 + e]; lb8[e] = lnbp[lane * 8 + e]; }
    const bf16* Vv = (const bf16*)(ws + ((l == 0) ? WS_VFIRST : A_VRAW)); const bf16* Gg = (const bf16*)(ws + A_G); const float* BON = (const float*)(ws + A_BON);
    for (int m = gw; m < TOK; m += NGW) {
        GAS v4u* pp = (GAS v4u*)((bf16*)(ws + A_YCAT) + (size_t)m * DM + lane * 8); float p[8]; up8(*pp, p); float ss = 0.f;
        GAS v4u* py = (GAS v4u*)((bf16*)(ws + A_YCAT) + (size_t)m * DM + 512 + lane * 8); float y[8], v[8], g[8]; up8(*py, y);
        up8(*(const GAS v4u*)(Vv + (size_t)m * RW + lane * 8), v); up8(*(const GAS v4u*)(Gg + (size_t)m * RW + lane * 8), g);
        const float bon = BON[(size_t)m * 8 + (lane >> 3)];
#pragma unroll
        for (int e = 0; e < 8; ++e) ss += p[e] * p[e];
        const float rstd = 1.0f / sqrtf(wave_sum(ss) * (1.0f / 512.0f) + 1e-6f);
#pragma unroll
        for (int e = 0; e < 8; ++e) p[e] = p[e] * rstd * gn[e];
        *pp = pk8(p);
        float s1 = 0.f;
#pragma unroll
        for (int e = 0; e < 8; ++e) s1 += y[e];
        s1 += lane_xor<1>(s1); s1 += lane_xor<2>(s1); s1 += lane_xor<4>(s1);
        const float mean = s1 * (1.0f / 64.0f); float s2 = 0.f;
#pragma unroll
        for (int e = 0; e < 8; ++e) { y[e] -= mean; s2 += y[e] * y[e]; }
        s2 += lane_xor<1>(s2); s2 += lane_xor<2>(s2); s2 += lane_xor<4>(s2);
        const float rs = 1.0f / sqrtf(s2 * (1.0f / 64.0f) + 64e-5f);
#pragma unroll
        for (int e = 0; e < 8; ++e) y[e] = (y[e] * rs * lw8[e] + lb8[e] + bon * v[e]) * g[e];
        *py = pk8(y);
    }
}
#ifdef RK_PROBE
__device__ __forceinline__ void rwkv_seq_raw(int l, int b, int hd, unsigned char* ws, LAS unsigned char* ldsw  , int lane, bf16* T1) {
    constexpr int CH = 8;
    LAS float* buf = (LAS float*)ldsw;
    const bf16* R = (const bf16*)(ws + A_R); const bf16* Kp = (const bf16*)(ws + A_KRAW); const bf16* KK = (const bf16*)(ws + A_KK); const bf16* BV = (const bf16*)(ws + A_BV);
    const bf16* Vv = (const bf16*)(ws + ((l == 0) ? WS_VFIRST : A_VRAW)); const bf16* Gg = (const bf16*)(ws + A_G); const float* LW = (const float*)(ws + A_LW);
    const int c = hd * 64 + lane;
    float S[64];
#pragma unroll
    for (int j = 0; j < 64; ++j) S[j] = 0.f;
    for (int t0 = 0; t0 < SEQ; t0 += CH) {
        float vv[CH], gg[CH], bon[CH];
#pragma unroll
        for (int s = 0; s < CH; ++s) { const size_t o = (size_t)(b * SEQ + t0 + s) * RW + c;
            const float r = bf2f(R[o]), k = bf2f(Kp[o]), kk = bf2f(KK[o]), bb = bf2f(BV[o]), w = __expf(LW[o]);
            buf[(s * 5 + 0) * 64 + lane] = r; buf[(s * 5 + 1) * 64 + lane] = w; buf[(s * 5 + 2) * 64 + lane] = k; buf[(s * 5 + 3) * 64 + lane] = -kk; buf[(s * 5 + 4) * 64 + lane] = bb;
            vv[s] = bf2f(Vv[o]); gg[s] = 0.f; bon[s] = 0.f; }
        LDS_WAIT(); asm volatile("" ::: "memory");
#pragma unroll 1
        for (int s = 0; s < CH; ++s) {
            const LAS f32x4* pr = (const LAS f32x4*)(buf + (s * 5 + 0) * 64); const LAS f32x4* pw = (const LAS f32x4*)(buf + (s * 5 + 1) * 64);
            const LAS f32x4* pk = (const LAS f32x4*)(buf + (s * 5 + 2) * 64); const LAS f32x4* pa = (const LAS f32x4*)(buf + (s * 5 + 3) * 64); const LAS f32x4* pb = (const LAS f32x4*)(buf + (s * 5 + 4) * 64);
            float sa = 0.f;
#pragma unroll
            for (int j4 = 0; j4 < 16; ++j4) { const f32x4 a = pa[j4]; sa += S[4 * j4] * a.x + S[4 * j4 + 1] * a.y + S[4 * j4 + 2] * a.z + S[4 * j4 + 3] * a.w; }
            float v_s = vv[0], g_s = gg[0], bo_s = bon[0];
#pragma unroll
            for (int q = 1; q < CH; ++q) if (s == q) { v_s = vv[q]; g_s = gg[q]; bo_s = bon[q]; }
            float y = 0.f;
#pragma unroll
            for (int j4 = 0; j4 < 16; ++j4) { const f32x4 w = pw[j4], bb = pb[j4], k = pk[j4], r = pr[j4];
                S[4 * j4]     = S[4 * j4]     * w.x + sa * bb.x + v_s * k.x; y += S[4 * j4] * r.x;
                S[4 * j4 + 1] = S[4 * j4 + 1] * w.y + sa * bb.y + v_s * k.y; y += S[4 * j4 + 1] * r.y;
                S[4 * j4 + 2] = S[4 * j4 + 2] * w.z + sa * bb.z + v_s * k.z; y += S[4 * j4 + 2] * r.z;
                S[4 * j4 + 3] = S[4 * j4 + 3] * w.w + sa * bb.w + v_s * k.w; y += S[4 * j4 + 3] * r.w; }
            T1[(size_t)(b * SEQ + t0 + s) * RW + c] = (bf16)(cvt_pk_bf16(y, 0.f) & 0xffffu); (void)g_s; (void)bo_s;
        }
        LDS_WAIT(); asm volatile("" ::: "memory");
    }
}

#endif

constexpr int N_PHASES = 27;
struct Args { In in; float* out; unsigned char* ws; int ph_lo, ph_hi; };
static_assert(sizeof(Args) == 38 * 8 + 8 + 8 + 8, "Args has padding");

__global__ void __launch_bounds__(NTHR, 2) mega_fwd(Args args) {
    extern __shared__ __attribute__((aligned(16))) unsigned char lds_raw[];
    LAS unsigned char* lds = (LAS unsigned char*)lds_raw;
#define OPAQUE_IDS(TID0, BX0) int tid = (TID0); asm volatile("" : "+v"(tid)); int bx = (BX0); asm volatile("" : "+s"(bx)); \
    const int lane = tid & 63, wave = __builtin_amdgcn_readfirstlane(tid >> 6); const int G = gridDim.x; \
    const int vcu = (G % 8 == 0) ? (bx % 8) * (G / 8) + bx / 8 : bx; \
    const int gw = vcu * NWAVES + wave, NGW = G * NWAVES, gtid = vcu * NTHR + tid, NGT = G * NTHR; (void)gw; (void)NGW; (void)gtid; (void)NGT; (void)lane
    OPAQUE_IDS(threadIdx.x, blockIdx.x);
    for (int u = tid; u < (LDS_BYTES - LDSCTL_OFF) / 4; u += NTHR) ((LAS unsigned*)(lds + LDSCTL_OFF))[u] = 0u;
    __syncthreads();
    if (tid < 40) { const unsigned long long v = (tid < 38) ? (unsigned long long)args.in.p[tid] : (tid == 38 ? (unsigned long long)args.ws : (unsigned long long)args.out);
        ((LAS unsigned*)(lds + PTAB_OFF))[2 * tid] = (unsigned)v; ((LAS unsigned*)(lds + PTAB_OFF))[2 * tid + 1] = (unsigned)(v >> 32); }
    __syncthreads();
    const InT in{(volatile LAS unsigned*)(lds + PTAB_OFF)};
    gu32* ctl = (gu32*)(args.ws + WS_CTL);
    XcdBarrier bar; bar.bar = (unsigned*)(ctl + CW_BAR); bar.x = 0; bar.st = nullptr;
    if (!MK_SPLIT) bar = xcd_barrier_post((unsigned*)(ctl + CW_BAR), (volatile LAS unsigned*)(lds + MISC_OFF) + 8);
    const int lo = args.ph_lo, hi = args.ph_hi;
#ifndef PH_MASK
#define PH_MASK 0xffffffffu
#endif
#define IN_PH(bit, k) (((PH_MASK >> (bit)) & 1u) && lo <= (k) && (k) < hi)
#ifndef DUPMASK
#define DUPMASK 0u
#endif
#define DUP(bit) for (int rep_ = 0; rep_ < (int)((DUPMASK >> (bit)) & 1u) + 1; ++rep_)
#define BAR_AFTER(k) do { if ((k) + 1 < hi) { if (!MK_SPLIT) xcd_barrier(bar); } } while (0)
#define PH_PTRS unsigned char* ws = (unsigned char*)in[38]; float* out = (float*)in[39]; const float* modl = (const float*)(ws + WS_MOD) + (size_t)l * NB * MODLD; (void)out; (void)modl

    if (IN_PH(0, 0)) { const int l = 0; PH_PTRS; DUP(0) { __syncthreads(); p0_mod(in, ws, lds, vcu, G, wave, lane, tid); __syncthreads(); p0_weights(in, ws, lds, gw, NGW, wave, lane, gtid, NGT); } BAR_AFTER(0); }

    {
        constexpr int l = 0;
        const int pb = 1 + 11 * l;
        OPAQUE_IDS(threadIdx.x, blockIdx.x);
        if (IN_PH(1, pb + 0)) { PH_PTRS; const float* xres = (l == 0) ? in[0] : out; DUP(1) { __syncthreads(); norm_phase<false>(xres, in[5] + (size_t)l * DM, modl, 0, (bf16*)(ws + A_H), nullptr, nullptr, ws, lds, vcu, G, wave, lane, tid); } BAR_AFTER(pb + 0); }
        if (IN_PH(2, pb + 1)) { PH_PTRS;
            pg8::Gemm g{(const bf16*)(ws + A_H), (const bf16*)(ws + WS_WIN) + (size_t)l * NPROJ * DM, TOK, NPROJ, DM, nullptr, nullptr, 0};
            pg8::StaticOrder S; S.init(TOK, NPROJ, G, bx);
            pg8::EpiBf16<0> E{(bf16*)(ws + A_PROJ), NPROJ, nullptr, 0, 0, 1.f};
            DUP(2) { __syncthreads(); pg8::gemm_phase<pg8::EpiBf16<0>, pg8::StaticOrder, true, true, 0>(lds, g, S, E); }
            BAR_AFTER(pb + 1); }
        if (IN_PH(3, pb + 2)) { PH_PTRS; DUP(3) { __syncthreads(); prep_phase(l, in, ws, gw, NGW, lane); } BAR_AFTER(pb + 2); }
        if (IN_PH(4, pb + 3)) { PH_PTRS;
#ifndef P4_MASK
#define P4_MASK 7
#endif
            if (P4_MASK & 1) { pg8::Gemm g{(const bf16*)(ws + A_CQ), (const bf16*)(ws + WS_WUQ) + (size_t)l * NQ * 256, TOK, NQ, 256, nullptr, nullptr, 0};
              pg8::StaticOrder S; S.init(TOK, NQ, G, (bx + G / 2) % G);
              pg8::EpiBf16<0> E{(bf16*)(ws + A_Q), NQ, nullptr, 0, 0, 1.f};
              DUP(4) { __syncthreads(); pg8::gemm_phase<pg8::EpiBf16<0>, pg8::StaticOrder, true, true, 0>(lds, g, S, E); } }
            __syncthreads();
            if (P4_MASK & 2) { pg8::Gemm g{(const bf16*)(ws + A_CKV), (const bf16*)(ws + WS_WUKV) + (size_t)l * NKV * 128, TOK, NKV, 128, nullptr, nullptr, 0};
              pg8::StaticOrder S; S.init(TOK, NKV, G, bx);
              pg8::EpiKV E{(bf16*)(ws + A_KB), (bf16*)(ws + A_VB)};
              DUP(4) { __syncthreads(); pg8::gemm_phase<pg8::EpiKV, pg8::StaticOrder, true, true, 0>(lds, g, S, E); } }
            __syncthreads();
            if (P4_MASK & 4) { const int nl = (l == 0) ? 1536 : NLORA;
              pg8::Gemm g{(const bf16*)(ws + A_LA), (const bf16*)(ws + WS_WLORA) + (size_t)l * NLORA * KLORA, TOK, nl, KLORA, nullptr, nullptr, 0};
              pg8::StaticOrder S; S.init(TOK, nl, G, bx);
              pg8::EpiLora E{in[16] + (size_t)l * RW, in[18] + (size_t)l * RW, in[21], in[23] + (size_t)l * RW, in[24] + (size_t)l * RW,
                             (float*)(ws + A_LW), (bf16*)(ws + A_KRAW), (bf16*)(ws + A_KK), (bf16*)(ws + A_BV), (bf16*)(ws + A_G), (bf16*)(ws + A_VRAW), (const bf16*)(ws + WS_VFIRST), (const bf16*)(ws + A_R), in[25] + (size_t)l * RW, (float*)(ws + A_BON)};
              pg8::gemm_phase<pg8::EpiLora, pg8::StaticOrder, true, true, 0>(lds, g, S, E); }
            BAR_AFTER(pb + 3); }
        if (IN_PH(5, pb + 4)) { PH_PTRS;
#ifdef RK_PROBE
            if (l == RK_PROBE) { if (vcu < 16 && wave < 4) { const int unit = vcu * 4 + wave; rwkv_seq_raw(l, unit >> 3, unit & 7, ws, lds + wave * 10240, lane, (bf16*)(ws + WS_ARENA + 224 * MiB)); } xcd_barrier(bar); }
#endif
            if (wave < 4) { for (int u = vcu * 4 + wave; u < 64 * (SEQ / 32); u += G * 4) { const int q = u & 63, ck = u >> 6; rk::pre_unit(l, q >> 3, q & 7, ck, ws, lds + wave * rk::UNIT_LDS); } }
            BAR_AFTER(pb + 4); }
        if (IN_PH(6, pb + 5)) { PH_PTRS;
            if (vcu < 32) { if (wave < 4) { const int si = vcu * 4 + wave; rk::scan_unit(si >> 1, si & 1, ws); } __syncthreads(); }
            volatile LAS unsigned* qslot = (volatile LAS unsigned*)(lds + MISC_OFF) + 16;
#ifdef DUP_ATT
            for (int rep = 0; rep < 2; ++rep)
#else
            const int rep = 0;
#endif
            for (;;) {
                __syncthreads();
                if (tid == 0) qslot[0] = __hip_atomic_fetch_add(ctl + CW_QCTR + 64 * l + 16 * rep, 1u, RLX_AGENT);
                __syncthreads();
                const int u = (int)qslot[0];
                if (u >= 512) break;
                const int qb = 15 - (u >> 5), bh = u & 31;
                att::attn_unit(bh >> 2, bh & 3, qb, (const bf16*)(ws + A_Q), (const bf16*)(ws + A_KB), (const bf16*)(ws + A_VB), (bf16*)(ws + A_YCAT), (const int*)in[2], lds);
            }
            BAR_AFTER(pb + 5); }
        if (IN_PH(7, pb + 6)) { PH_PTRS;
#ifdef RK_PROBE
            if (l == RK_PROBE) { float num = 0.f, den = 0.f; const bf16* T1 = (const bf16*)(ws + WS_ARENA + 224 * MiB);
                for (int m = gw; m < TOK; m += NGW) { if (((m & (SEQ - 1)) >> 5) < 1 || (m & 31) != RK_PROBE_POS) continue; float a[8], b8[8]; up8(*(const GAS v4u*)((const bf16*)(ws + A_YCAT) + (size_t)m * DM + 512 + lane * 8), a); up8(*(const GAS v4u*)(T1 + (size_t)m * RW + lane * 8), b8);
#pragma unroll
                    for (int e = 0; e < 8; ++e) { const float d = a[e] - b8[e]; num += d * d; den += b8[e] * b8[e]; } }
                num = wave_sum(num); den = wave_sum(den);
                if (lane == 0) { atomicAdd((float*)(ctl + 80), num); atomicAdd((float*)(ctl + 81), den); } }
#endif
            post_phase(l, in[13] + (size_t)l * 512, in[26] + (size_t)l * RW, in[27] + (size_t)l * RW, ws, gw, NGW, lane); BAR_AFTER(pb + 6); }
        if (IN_PH(8, pb + 7)) { PH_PTRS; const float* xres = (l == 0) ? in[0] : out;
            pg8::Gemm g{(const bf16*)(ws + A_YCAT), (const bf16*)(ws + WS_WOUT) + (size_t)l * DM * DM, TOK, DM, DM, nullptr, nullptr, 0};
            pg8::StaticOrder S; S.init(TOK, DM, G, bx);
            pg8::EpiResid E{xres, out, modl + 2048};
            pg8::gemm_phase<pg8::EpiResid, pg8::StaticOrder, true, true, 0>(lds, g, S, E);
            BAR_AFTER(pb + 7); }
        if (IN_PH(9, pb + 8)) { PH_PTRS;
            DUP(9) { __syncthreads();
            if (l == 0) norm_phase<false>(out, in[6] + (size_t)l * DM, modl, 3072, (bf16*)(ws + A_H), nullptr, nullptr, ws, lds, vcu, G, wave, lane, tid);
            else norm_phase<true>(out, in[6] + (size_t)l * DM, modl, 3072, (bf16*)(ws + A_H), in[32], in[33], ws, lds, vcu, G, wave, lane, tid);
            if (l == 1) { __syncthreads(); p_expert_weights(in, ws, lds, gw, NGW, wave, lane); } }
            BAR_AFTER(pb + 8); }
        if (l == 0) {
            if (IN_PH(10, 10)) { PH_PTRS;
                pg8::Gemm g{(const bf16*)(ws + A_H), (const bf16*)(ws + WS_WF1), TOK, 2 * FFD, DM, nullptr, nullptr, 0};
                pg8::StaticOrder S; S.init(TOK, 2 * FFD, G, bx);
                pg8::EpiSwiGLU E{(bf16*)(ws + A_HID), FFD};
                DUP(10) { __syncthreads(); pg8::gemm_phase<pg8::EpiSwiGLU, pg8::StaticOrder, true, true, 0>(lds, g, S, E); }
                BAR_AFTER(10); }
            if (IN_PH(11, 11)) { PH_PTRS;
                pg8::Gemm g{(const bf16*)(ws + A_HID), (const bf16*)(ws + WS_WF2), TOK, DM, FFD, nullptr, nullptr, 0};
                pg8::StaticOrder S; S.init(TOK, DM, G, bx);
                pg8::EpiResid E{out, out, modl + 5120};
                pg8::gemm_phase<pg8::EpiResid, pg8::StaticOrder, true, true, 0>(lds, g, S, E);
                BAR_AFTER(11); }
        } else {
            if (IN_PH(12, 21)) { PH_PTRS; DUP(12) { __syncthreads(); route_scatter(ws, lds, vcu, G, wave, lane, tid); } BAR_AFTER(21); }
#pragma unroll
            for (int k = 0; k < 2; ++k) {
                if (IN_PH(13, 22 + 2 * k)) { PH_PTRS; const int* TL = (const int*)(ws + RT_TILE) + k * (PASS_TILES + 8); const int* ridx = (const int*)(ws + RT_RIDX) + (size_t)k * PASS_ROWS;
                    const int nt = __builtin_amdgcn_readfirstlane(TL[0]);
                    pg8::Gemm g{(const bf16*)(ws + A_H), (const bf16*)(ws + A_WE1), nt * 256, 2 * FFE, DM, ridx, TL + 8, (size_t)2 * FFE * DM * 2};
                    pg8::StaticOrder S; S.init(nt * 256, 2 * FFE, G, bx);
                    pg8::EpiSwiGLU E{(bf16*)(ws + A_HID), FFE};
                    DUP(13) { __syncthreads(); pg8::gemm_phase<pg8::EpiSwiGLU, pg8::StaticOrder, true, true, 1>(lds, g, S, E); }
                    BAR_AFTER(22 + 2 * k); }
                if (IN_PH(14, 23 + 2 * k)) { PH_PTRS; const int* TL = (const int*)(ws + RT_TILE) + k * (PASS_TILES + 8); const int* ridx = (const int*)(ws + RT_RIDX) + (size_t)k * PASS_ROWS; const float* rgw = (const float*)(ws + RT_RGW) + (size_t)k * PASS_ROWS;
                    const int nt = __builtin_amdgcn_readfirstlane(TL[0]);
                    pg8::Gemm g{(const bf16*)(ws + A_HID), (const bf16*)(ws + A_WE2), nt * 256, DM, FFE, nullptr, TL + 8, (size_t)DM * FFE * 2};
                    pg8::StaticOrder S; S.init(nt * 256, DM, G, bx);
                    pg8::EpiMoE2 E{out, modl + 5120, ridx, rgw};
                    pg8::gemm_phase<pg8::EpiMoE2, pg8::StaticOrder, true, true, 2>(lds, g, S, E);
                    BAR_AFTER(23 + 2 * k); }
            }
        }
    }
    {
        constexpr int l = 1;
        const int pb = 1 + 11 * l;
        OPAQUE_IDS(threadIdx.x, blockIdx.x);
        if (IN_PH(1, pb + 0)) { PH_PTRS; const float* xres = (l == 0) ? in[0] : out; DUP(1) { __syncthreads(); norm_phase<false>(xres, in[5] + (size_t)l * DM, modl, 0, (bf16*)(ws + A_H), nullptr, nullptr, ws, lds, vcu, G, wave, lane, tid); } BAR_AFTER(pb + 0); }
        if (IN_PH(2, pb + 1)) { PH_PTRS;
            pg8::Gemm g{(const bf16*)(ws + A_H), (const bf16*)(ws + WS_WIN) + (size_t)l * NPROJ * DM, TOK, NPROJ, DM, nullptr, nullptr, 0};
            pg8::StaticOrder S; S.init(TOK, NPROJ, G, bx);
            pg8::EpiBf16<0> E{(bf16*)(ws + A_PROJ), NPROJ, nullptr, 0, 0, 1.f};
            DUP(2) { __syncthreads(); pg8::gemm_phase<pg8::EpiBf16<0>, pg8::StaticOrder, true, true, 0>(lds, g, S, E); }
            BAR_AFTER(pb + 1); }
        if (IN_PH(3, pb + 2)) { PH_PTRS; DUP(3) { __syncthreads(); prep_phase(l, in, ws, gw, NGW, lane); } BAR_AFTER(pb + 2); }
        if (IN_PH(4, pb + 3)) { PH_PTRS;
#ifndef P4_MASK
#define P4_MASK 7
#endif
            if (P4_MASK & 1) { pg8::Gemm g{(const bf16*)(ws + A_CQ), (const bf16*)(ws + WS_WUQ) + (size_t)l * NQ * 256, TOK, NQ, 256, nullptr, nullptr, 0};
              pg8::StaticOrder S; S.init(TOK, NQ, G, (bx + G / 2) % G);
              pg8::EpiBf16<0> E{(bf16*)(ws + A_Q), NQ, nullptr, 0, 0, 1.f};
              DUP(4) { __syncthreads(); pg8::gemm_phase<pg8::EpiBf16<0>, pg8::StaticOrder, true, true, 0>(lds, g, S, E); } }
            __syncthreads();
            if (P4_MASK & 2) { pg8::Gemm g{(const bf16*)(ws + A_CKV), (const bf16*)(ws + WS_WUKV) + (size_t)l * NKV * 128, TOK, NKV, 128, nullptr, nullptr, 0};
              pg8::StaticOrder S; S.init(TOK, NKV, G, bx);
              pg8::EpiKV E{(bf16*)(ws + A_KB), (bf16*)(ws + A_VB)};
              DUP(4) { __syncthreads(); pg8::gemm_phase<pg8::EpiKV, pg8::StaticOrder, true, true, 0>(lds, g, S, E); } }
            __syncthreads();
            if (P4_MASK & 4) { const int nl = (l == 0) ? 1536 : NLORA;
              pg8::Gemm g{(const bf16*)(ws + A_LA), (const bf16*)(ws + WS_WLORA) + (size_t)l * NLORA * KLORA, TOK, nl, KLORA, nullptr, nullptr, 0};
              pg8::StaticOrder S; S.init(TOK, nl, G, bx);
              pg8::EpiLora E{in[16] + (size_t)l * RW, in[18] + (size_t)l * RW, in[21], in[23] + (size_t)l * RW, in[24] + (size_t)l * RW,
                             (float*)(ws + A_LW), (bf16*)(ws + A_KRAW), (bf16*)(ws + A_KK), (bf16*)(ws + A_BV), (bf16*)(ws + A_G), (bf16*)(ws + A_VRAW), (const bf16*)(ws + WS_VFIRST), (const bf16*)(ws + A_R), in[25] + (size_t)l * RW, (float*)(ws + A_BON)};
              pg8::gemm_phase<pg8::EpiLora, pg8::StaticOrder, true, true, 0>(lds, g, S, E); }
            BAR_AFTER(pb + 3); }
        if (IN_PH(5, pb + 4)) { PH_PTRS;
#ifdef RK_PROBE
            if (l == RK_PROBE) { if (vcu < 16 && wave < 4) { const int unit = vcu * 4 + wave; rwkv_seq_raw(l, unit >> 3, unit & 7, ws, lds + wave * 10240, lane, (bf16*)(ws + WS_ARENA + 224 * MiB)); } xcd_barrier(bar); }
#endif
            if (wave < 4) { for (int u = vcu * 4 + wave; u < 64 * (SEQ / 32); u += G * 4) { const int q = u & 63, ck = u >> 6; rk::pre_unit(l, q >> 3, q & 7, ck, ws, lds + wave * rk::UNIT_LDS); } }
            BAR_AFTER(pb + 4); }
        if (IN_PH(6, pb + 5)) { PH_PTRS;
            if (vcu < 32) { if (wave < 4) { const int si = vcu * 4 + wave; rk::scan_unit(si >> 1, si & 1, ws); } __syncthreads(); }
            volatile LAS unsigned* qslot = (volatile LAS unsigned*)(lds + MISC_OFF) + 16;
#ifdef DUP_ATT
            for (int rep = 0; rep < 2; ++rep)
#else
            const int rep = 0;
#endif
            for (;;) {
                __syncthreads();
                if (tid == 0) qslot[0] = __hip_atomic_fetch_add(ctl + CW_QCTR + 64 * l + 16 * rep, 1u, RLX_AGENT);
                __syncthreads();
                const int u = (int)qslot[0];
                if (u >= 512) break;
                const int qb = 15 - (u >> 5), bh = u & 31;
                att::attn_unit(bh >> 2, bh & 3, qb, (const bf16*)(ws + A_Q), (const bf16*)(ws + A_KB), (const bf16*)(ws + A_VB), (bf16*)(ws + A_YCAT), (const int*)in[2], lds);
            }
            BAR_AFTER(pb + 5); }
        if (IN_PH(7, pb + 6)) { PH_PTRS;
#ifdef RK_PROBE
            if (l == RK_PROBE) { float num = 0.f, den = 0.f; const bf16* T1 = (const bf16*)(ws + WS_ARENA + 224 * MiB);
                for (int m = gw; m < TOK; m += NGW) { if (((m & (SEQ - 1)) >> 5) < 1 || (m & 31) != RK_PROBE_POS) continue; float a[8], b8[8]; up8(*(const GAS v4u*)((const bf16*)(ws + A_YCAT) + (size_t)m * DM + 512 + lane * 8), a); up8(*(const GAS v4u*)(T1 + (size_t)m * RW + lane * 8), b8);
#pragma unroll
                    for (int e = 0; e < 8; ++e) { const float d = a[e] - b8[e]; num += d * d; den += b8[e] * b8[e]; } }
                num = wave_sum(num); den = wave_sum(den);
                if (lane == 0) { atomicAdd((float*)(ctl + 80), num); atomicAdd((float*)(ctl + 81), den); } }
#endif
            post_phase(l, in[13] + (size_t)l * 512, in[26] + (size_t)l * RW, in[27] + (size_t)l * RW, ws, gw, NGW, lane); BAR_AFTER(pb + 6); }
        if (IN_PH(8, pb + 7)) { PH_PTRS; const float* xres = (l == 0) ? in[0] : out;
            pg8::Gemm g{(const bf16*)(ws + A_YCAT), (const bf16*)(ws + WS_WOUT) + (size_t)l * DM * DM, TOK, DM, DM, nullptr, nullptr, 0};
            pg8::StaticOrder S; S.init(TOK, DM, G, bx);
            pg8::EpiResid E{xres, out, modl + 2048};
            pg8::gemm_phase<pg8::EpiResid, pg8::StaticOrder, true, true, 0>(lds, g, S, E);
            BAR_AFTER(pb + 7); }
        if (IN_PH(9, pb + 8)) { PH_PTRS;
            DUP(9) { __syncthreads();
            if (l == 0) norm_phase<false>(out, in[6] + (size_t)l * DM, modl, 3072, (bf16*)(ws + A_H), nullptr, nullptr, ws, lds, vcu, G, wave, lane, tid);
            else norm_phase<true>(out, in[6] + (size_t)l * DM, modl, 3072, (bf16*)(ws + A_H), in[32], in[33], ws, lds, vcu, G, wave, lane, tid);
            if (l == 1) { __syncthreads(); p_expert_weights(in, ws, lds, gw, NGW, wave, lane); } }
            BAR_AFTER(pb + 8); }
        if (l == 0) {
            if (IN_PH(10, 10)) { PH_PTRS;
                pg8::Gemm g{(const bf16*)(ws + A_H), (const bf16*)(ws + WS_WF1), TOK, 2 * FFD, DM, nullptr, nullptr, 0};
                pg8::StaticOrder S; S.init(TOK, 2 * FFD, G, bx);
                pg8::EpiSwiGLU E{(bf16*)(ws + A_HID), FFD};
                DUP(10) { __syncthreads(); pg8::gemm_phase<pg8::EpiSwiGLU, pg8::StaticOrder, true, true, 0>(lds, g, S, E); }
                BAR_AFTER(10); }
            if (IN_PH(11, 11)) { PH_PTRS;
                pg8::Gemm g{(const bf16*)(ws + A_HID), (const bf16*)(ws + WS_WF2), TOK, DM, FFD, nullptr, nullptr, 0};
                pg8::StaticOrder S; S.init(TOK, DM, G, bx);
                pg8::EpiResid E{out, out, modl + 5120};
                pg8::gemm_phase<pg8::EpiResid, pg8::StaticOrder, true, true, 0>(lds, g, S, E);
                BAR_AFTER(11); }
        } else {
            if (IN_PH(12, 21)) { PH_PTRS; DUP(12) { __syncthreads(); route_scatter(ws, lds, vcu, G, wave, lane, tid); } BAR_AFTER(21); }
#pragma unroll
            for (int k = 0; k < 2; ++k) {
                if (IN_PH(13, 22 + 2 * k)) { PH_PTRS; const int* TL = (const int*)(ws + RT_TILE) + k * (PASS_TILES + 8); const int* ridx = (const int*)(ws + RT_RIDX) + (size_t)k * PASS_ROWS;
                    const int nt = __builtin_amdgcn_readfirstlane(TL[0]);
                    pg8::Gemm g{(const bf16*)(ws + A_H), (const bf16*)(ws + A_WE1), nt * 256, 2 * FFE, DM, ridx, TL + 8, (size_t)2 * FFE * DM * 2};
                    pg8::StaticOrder S; S.init(nt * 256, 2 * FFE, G, bx);
                    pg8::EpiSwiGLU E{(bf16*)(ws + A_HID), FFE};
                    DUP(13) { __syncthreads(); pg8::gemm_phase<pg8::EpiSwiGLU, pg8::StaticOrder, true, true, 1>(lds, g, S, E); }
                    BAR_AFTER(22 + 2 * k); }
                if (IN_PH(14, 23 + 2 * k)) { PH_PTRS; const int* TL = (const int*)(ws + RT_TILE) + k * (PASS_TILES + 8); const int* ridx = (const int*)(ws + RT_RIDX) + (size_t)k * PASS_ROWS; const float* rgw = (const float*)(ws + RT_RGW) + (size_t)k * PASS_ROWS;
                    const int nt = __builtin_amdgcn_readfirstlane(TL[0]);
                    pg8::Gemm g{(const bf16*)(ws + A_HID), (const bf16*)(ws + A_WE2), nt * 256, DM, FFE, nullptr, TL + 8, (size_t)DM * FFE * 2};
                    pg8::StaticOrder S; S.init(nt * 256, DM, G, bx);
                    pg8::EpiMoE2 E{out, modl + 5120, ridx, rgw};
                    pg8::gemm_phase<pg8::EpiMoE2, pg8::StaticOrder, true, true, 2>(lds, g, S, E);
                    BAR_AFTER(23 + 2 * k); }
            }
        }
    }
    if (IN_PH(15, 26)) { const int l = 1; PH_PTRS; OPAQUE_IDS(threadIdx.x, blockIdx.x); final_norm(out, in[37], gw, NGW, lane);
#ifdef RK_PROBE
        { VM_WAIT(); const float num = __hip_atomic_load((float*)(ctl + 80), RLX_AGENT), den = __hip_atomic_load((float*)(ctl + 81), RLX_AGENT);
#ifdef RK_SELFCHK
          const float n2 = __hip_atomic_load((float*)(ctl + RK_SELFCHK), RLX_AGENT), d2 = __hip_atomic_load((float*)(ctl + RK_SELFCHK + 1), RLX_AGENT); const float sc = 1.0f + sqrtf(n2 / d2) + 0.f * num * den;
#else
          const float sc = 1.0f + sqrtf(num / den);
#endif

          for (int row = gw; row < TOK; row += NGW) { GAS f32x4* xr = (GAS f32x4*)(out + (size_t)row * DM) + lane;
#pragma unroll
              for (int j = 0; j < 4; ++j) xr[64 * j] = xr[64 * j] * sc; } }
#endif
    }
#undef IN_PH
#undef BAR_AFTER
}

extern "C" void kernel_launch(void* const* d_in, const int* in_sizes, int n_in, void* d_out, int out_size, void* d_ws, size_t ws_size, hipStream_t stream) {
    static int grid = 0;
    if (grid == 0) {
        if (n_in != 38 || in_sizes[0] != TOK * DM || out_size != TOK * DM || ws_size < WS_END) {
            fprintf(stderr, "kernel_launch: unexpected problem (n_in %d, in0 %d, out %d, ws %zu, need %zu); nothing launched\n", n_in, n_in > 0 ? in_sizes[0] : -1, out_size, ws_size, (size_t)WS_END); grid = -1; return; }
        int dev = 0, cus = 0, per_cu = 0;
        if (hipGetDevice(&dev) != hipSuccess || hipDeviceGetAttribute(&cus, hipDeviceAttributeMultiprocessorCount, dev) != hipSuccess) { grid = -1; return; }
        if (hipFuncSetAttribute((const void*)mega_fwd, hipFuncAttributeMaxDynamicSharedMemorySize, LDS_BYTES) != hipSuccess) { fprintf(stderr, "kernel_launch: hipFuncSetAttribute failed\n"); grid = -1; return; }
        if (hipOccupancyMaxActiveBlocksPerMultiprocessor(&per_cu, (const void*)mega_fwd, NTHR, LDS_BYTES) != hipSuccess || per_cu < 1) { fprintf(stderr, "kernel_launch: occupancy query says %d\n", per_cu); }
        (void)hipGetLastError();
        grid = cus;
    }
    if (grid < 0) return;
    (void)hipMemsetAsync((char*)d_ws + WS_CTL, 0, CTL_ZERO_BYTES, stream);
    Args a{};
    for (int i = 0; i < 38; ++i) a.in.p[i] = (const float*)d_in[i];
    a.out = (float*)d_out; a.ws = (unsigned char*)d_ws;
#if MK_SPLIT
    for (int p = 0; p < N_PHASES; ++p) { a.ph_lo = p; a.ph_hi = p + 1; hipLaunchKernelGGL(mega_fwd, dim3(grid), dim3(NTHR), LDS_BYTES, stream, a); }
#else
    a.ph_lo = 0; a.ph_hi = N_PHASES;
    hipLaunchKernelGGL(mega_fwd, dim3(grid), dim3(NTHR), LDS_BYTES, stream, a);
#endif
    const hipError_t le = hipPeekAtLastError();
    if (le != hipSuccess) fprintf(stderr, "kernel_launch: launch failed: %s\n", hipGetErrorName(le));
}
```

```cpp
#include <hip/hip_runtime.h>
#include <cstdio>
#include <cstdint>
namespace pg8 {
constexpr int WAVETAB_OFF = 155648 + 1536;
__device__ __forceinline__ int lane_now() { return (int)__builtin_amdgcn_mbcnt_hi(~0u, __builtin_amdgcn_mbcnt_lo(~0u, 0u)); }
__device__ __forceinline__ int wave_now() { const unsigned h = (unsigned)__builtin_amdgcn_s_getreg((5 << 11) | 4) & 63u;
    return __builtin_amdgcn_readfirstlane((int)*((volatile __attribute__((address_space(3))) unsigned*)(WAVETAB_OFF) + h)); }
__device__ __forceinline__ int tid_now() { return wave_now() * 64 + lane_now(); }
#define PG8_LAS __attribute__((address_space(3)))
typedef unsigned short bf16_t;
typedef short bf16x8 __attribute__((ext_vector_type(8)));
typedef float f32x4 __attribute__((ext_vector_type(4)));
typedef unsigned u32x4 __attribute__((ext_vector_type(4)));
constexpr int BM = 256, BK = 64, HALF = 128, HTB = HALF * BK * 2  , STAGE_BYTES = 8 * HTB, NXCD = 8, WGM = 8;

__host__ __device__ __forceinline__ int lds_byte(int r, int c) { const int st = (r >> 4) * 2 + (c >> 5), rr = r & 15, cc = c & 31, ob = rr * 64 + cc * 2; return st * 1024 + (ob ^ (((ob >> 9) & 1) << 5)); }
__host__ __device__ __forceinline__ void stage_rc(int b, int& R, int& C) { const int st = b / 1024, sb = b % 1024, swz = sb ^ (((sb >> 9) & 1) << 5); R = (st >> 1) * 16 + swz / 64; C = (st & 1) * 32 + (swz % 64) / 2; }
__host__ __device__ __forceinline__ int perm32(int rho) { const int n = rho >> 4, i = rho & 15; return 8 * (i >> 2) + 4 * n + (i & 3); }

struct Unit { int pm, pn; };
struct Gemm { const bf16_t* A; const bf16_t* Bt; int M, N, K; const int* ridx; const int* tile_e; size_t e_stride; int pitch; int pitch_b; };

struct StaticOrder {
    int nM, nN, nwg, G, c, lim, wgm;
    __host__ __device__ __forceinline__ void init(int M, int N, int G_, int c_) { nM = M / BM; nN = N / BM; nwg = nM * nN; G = G_; c = c_; lim = nwg; wgm = (nN >= 9) ? 16 : WGM; }
    __host__ __device__ __forceinline__ bool next(int i, Unit& u) const {
        const long L = (long)i * G + c; if (L >= lim) return false;
        int wgid = (int)L; { const int q = nwg / NXCD, r = nwg % NXCD, xcd = wgid % NXCD, off = wgid / NXCD; wgid = (xcd < r ? xcd * (q + 1) : r * (q + 1) + (xcd - r) * q) + off; }
        const int nig = wgm * nN, gid = wgid / nig, fm = gid * wgm, gsz = (nM - fm) < wgm ? (nM - fm) : wgm;
        u.pm = fm + ((wgid % nig) % gsz); u.pn = (wgid % nig) / gsz; return true;
    }
    __device__ __forceinline__ void a_ready(const Unit&) const {}
    __device__ __forceinline__ void done(const Unit&) const {}
};
struct OneUnit { Unit u; bool have;
    __device__ __forceinline__ bool next(int i, Unit& o) const { if (i || !have) return false; o = u; return true; }
    __device__ __forceinline__ void a_ready(const Unit&) const {}
    __device__ __forceinline__ void done(const Unit&) const {}
};

typedef float f32x2_cv __attribute__((ext_vector_type(2))); typedef __bf16 bf16x2_cv __attribute__((ext_vector_type(2)));
__device__ __forceinline__ unsigned cvt_pk_bf16(float lo, float hi) { const f32x2_cv v = {lo, hi}; const bf16x2_cv b = __builtin_convertvector(v, bf16x2_cv); return __builtin_bit_cast(unsigned, b); }
typedef float f32x2 __attribute__((ext_vector_type(2)));
__device__ __forceinline__ f32x2 gelu_pk(f32x2 v) {
    const f32x2 av = __builtin_elementwise_abs(v), d = av * 0.2316418882f + 1.0f;
    f32x2 t; t.x = __builtin_amdgcn_rcpf(d.x); t.y = __builtin_amdgcn_rcpf(d.y);
    f32x2 q = t * 0.5307027145f + (-0.7265760135f); q = q * t + 0.7107068705f; q = q * t + (-0.142248368f); q = q * t + 0.127414796f; q = q * t;
    const f32x2 s = (v * v) * (-0.72134752044f);
    f32x2 e; e.x = __builtin_amdgcn_exp2f(s.x); e.y = __builtin_amdgcn_exp2f(s.y);
    const f32x2 m = v * (q * e), r = v - m;
    f32x2 o; o.x = v.x < 0.f ? m.x : r.x; o.y = v.y < 0.f ? m.y : r.y; return o;
}

template <int ACT  > struct EpiBf16 {
    static constexpr bool PERM = true, AFTER_DRAIN = false; static_assert(ACT == 0 || ACT == 1, "EpiBf16: ACT is 0 (none) or 1 (gelu_pk)");
    bf16_t* O; int ldc; const float* bias; int split_cols; size_t split_stride; float scale0;
    __device__ __forceinline__ void operator()(const f32x4 (&acc)[2][2][4][2], const Unit& u, int wr, int wc, int fr, int fq) const {
        const int row0 = u.pm * BM + wr * 64 + fr; int colt = u.pn * BM; bf16_t* base = O;
        float sc = 1.f; if (split_cols) { const int t = colt / split_cols; base += (size_t)t * split_stride; colt -= t * split_cols; if (t == 0) sc = scale0; }
        const int col0 = colt + wc * 32 + 8 * fq, bcol0 = u.pn * BM + wc * 32 + 8 * fq;
        f32x4 bv[2][2];
#pragma unroll
        for (int bj = 0; bj < 2; ++bj)
#pragma unroll
            for (int n = 0; n < 2; ++n) bv[bj][n] = bias ? *(const f32x4*)(bias + bcol0 + bj * HALF + 4 * n) : (f32x4){0.f, 0.f, 0.f, 0.f};
#pragma unroll
        for (int ai = 0; ai < 2; ++ai)
#pragma unroll
            for (int m = 0; m < 4; ++m) { bf16_t* rowp = base + (size_t)(row0 + ai * HALF + m * 16) * ldc + col0;
#pragma unroll
                for (int bj = 0; bj < 2; ++bj) { f32x4 v0 = acc[ai][bj][m][0] + bv[bj][0], v1 = acc[ai][bj][m][1] + bv[bj][1];
                    if (ACT == 1) { f32x2 a = gelu_pk((f32x2){v0[0], v0[1]}), b = gelu_pk((f32x2){v0[2], v0[3]}), c = gelu_pk((f32x2){v1[0], v1[1]}), d = gelu_pk((f32x2){v1[2], v1[3]});
                        v0 = (f32x4){a.x, a.y, b.x, b.y}; v1 = (f32x4){c.x, c.y, d.x, d.y}; }
                    v0 = v0 * sc; v1 = v1 * sc; u32x4 w; w.x = cvt_pk_bf16(v0[0], v0[1]); w.y = cvt_pk_bf16(v0[2], v0[3]); w.z = cvt_pk_bf16(v1[0], v1[1]); w.w = cvt_pk_bf16(v1[2], v1[3]);
                    *(u32x4*)(rowp + bj * HALF) = w; } }
    }
};

__device__ __forceinline__ float bf2f(unsigned short v) { return __uint_as_float(((unsigned)v) << 16); }
__device__ __forceinline__ float bflo(unsigned w) { return __uint_as_float(w << 16); }
__device__ __forceinline__ float bfhi(unsigned w) { return __uint_as_float(w & 0xffff0000u); }
__device__ __forceinline__ float fsigmoid(float x) { return __builtin_amdgcn_rcpf(1.0f + __builtin_amdgcn_exp2f(-1.4426950408889634f * x)); }
__device__ __forceinline__ u32x4 pack8f(const f32x4 a, const f32x4 b) { u32x4 w; w.x = cvt_pk_bf16(a[0], a[1]); w.y = cvt_pk_bf16(a[2], a[3]); w.z = cvt_pk_bf16(b[0], b[1]); w.w = cvt_pk_bf16(b[2], b[3]); return w; }
__device__ __forceinline__ void unpack8(const u32x4 w, f32x4& a, f32x4& b) { a = (f32x4){bflo(w.x), bfhi(w.x), bflo(w.y), bfhi(w.y)}; b = (f32x4){bflo(w.z), bfhi(w.z), bflo(w.w), bfhi(w.w)}; }

struct EpiKV { static constexpr bool PERM = true, AFTER_DRAIN = false;
    bf16_t* Kb; bf16_t* Vb;
    __device__ __forceinline__ void operator()(const f32x4 (&acc)[2][2][4][2], const Unit& u, int wr, int wc, int fr, int fq) const {
        const int row0 = u.pm * BM + wr * 64 + fr, h = u.pn, col = wc * 32 + 8 * fq;
#pragma unroll
        for (int ai = 0; ai < 2; ++ai)
#pragma unroll
            for (int m = 0; m < 4; ++m) { const int row = row0 + ai * HALF + m * 16; const int b = row >> 12, s = row & 4095;
                const size_t tok = (size_t)(b * 4 + h) * 4096 + s;
                *(u32x4*)(Kb + tok * 192 + col) = pack8f(acc[ai][0][m][0], acc[ai][0][m][1]);
                *(u32x4*)(Vb + tok * 128 + col) = pack8f(acc[ai][1][m][0], acc[ai][1][m][1]); }
    }
};

template <bool NRM, bool BIN> struct EpiResidT { static constexpr bool PERM = true, AFTER_DRAIN = false;
    const void* base; bf16_t* out; const float* gate; const float* gn; const float* scn; bf16_t* An; float* rowsq;
    __device__ __forceinline__ void operator()(const f32x4 (&acc)[2][2][4][2], const Unit& u, int wr, int wc, int fr, int fq) const {
        const int row0 = u.pm * BM + wr * 64 + fr, col0 = u.pn * BM + wc * 32 + 8 * fq, b = (u.pm * BM) >> 12;
        f32x4 gv[2][2], gs[2][2];
#pragma unroll
        for (int bj = 0; bj < 2; ++bj)
#pragma unroll
            for (int n = 0; n < 2; ++n) { gv[bj][n] = *(const f32x4*)(gate + b * 6144 + col0 + bj * HALF + n * 4);
                if (NRM) gs[bj][n] = *(const f32x4*)(gn + col0 + bj * HALF + n * 4) * (*(const f32x4*)(scn + b * 6144 + col0 + bj * HALF + n * 4) + 1.0f); }
        u32x4 nb16[2]; f32x4 nb32[2][2];
#define RESID_LOAD(offq) do { _Pragma("unroll") for (int bj = 0; bj < 2; ++bj) { if (BIN) nb16[bj] = *(const u32x4*)((const bf16_t*)base + (offq) + bj * HALF); \
            else { nb32[bj][0] = *(const f32x4*)((const float*)base + (offq) + bj * HALF); nb32[bj][1] = *(const f32x4*)((const float*)base + (offq) + bj * HALF + 4); } } } while (0)
        RESID_LOAD((size_t)row0 * 1024 + col0);
#pragma unroll
        for (int ai = 0; ai < 2; ++ai)
#pragma unroll
            for (int m = 0; m < 4; ++m) { const int row = row0 + ai * HALF + m * 16; const size_t off = (size_t)row * 1024 + col0; float ss = 0.f;
                f32x4 cx[2][2];
#pragma unroll
                for (int bj = 0; bj < 2; ++bj) { if (BIN) unpack8(nb16[bj], cx[bj][0], cx[bj][1]); else { cx[bj][0] = nb32[bj][0]; cx[bj][1] = nb32[bj][1]; } }
                asm volatile("" : "+v"(cx[0][0]), "+v"(cx[0][1]), "+v"(cx[1][0]), "+v"(cx[1][1]));
                if (ai * 4 + m < 7) { const int i2 = ai * 4 + m + 1; RESID_LOAD((size_t)(row0 + (i2 >> 2) * HALF + (i2 & 3) * 16) * 1024 + col0); }
#pragma unroll
                for (int bj = 0; bj < 2; ++bj) { f32x4 x[2]; x[0] = cx[bj][0]; x[1] = cx[bj][1];
#pragma unroll
                    for (int n = 0; n < 2; ++n) { x[n] = x[n] + gv[bj][n] * acc[ai][bj][m][n];
                        if (NRM) ss += (x[n][0] * x[n][0] + x[n][1] * x[n][1]) + (x[n][2] * x[n][2] + x[n][3] * x[n][3]); }
                    *(u32x4*)(out + off + bj * HALF) = pack8f(x[0], x[1]);
                    if (NRM) *(u32x4*)(An + off + bj * HALF) = pack8f(x[0] * gs[bj][0], x[1] * gs[bj][1]); }
                if (NRM) { ss += __uint_as_float((unsigned)__builtin_amdgcn_ds_swizzle((int)__float_as_uint(ss), 0x1f | (16 << 10)));
                    { const auto rr = __builtin_amdgcn_permlane32_swap(__float_as_uint(ss), __float_as_uint(ss), false, false); ss = __uint_as_float(rr[0]) + __uint_as_float(rr[1]); }
                    if (fq == 0) rowsq[(size_t)row * 16 + u.pn * 4 + wc] = ss; } }
    }
};

#undef RESID_LOAD
__device__ __forceinline__ void row_rstd8(const float* rowsq, int row0, int fq, float (&rs)[8]) {
    f32x4 q[8];
#pragma unroll
    for (int i = 0; i < 8; ++i) q[i] = *(const f32x4*)(rowsq + (size_t)(row0 + (i >> 2) * HALF + (i & 3) * 16) * 16 + 4 * fq);
#pragma unroll
    for (int i = 0; i < 8; ++i) { float t = (q[i][0] + q[i][1]) + (q[i][2] + q[i][3]);
        t += __uint_as_float((unsigned)__builtin_amdgcn_ds_swizzle((int)__float_as_uint(t), 0x1f | (16 << 10)));
        { const auto rr = __builtin_amdgcn_permlane32_swap(__float_as_uint(t), __float_as_uint(t), false, false); t = __uint_as_float(rr[0]) + __uint_as_float(rr[1]); }
        rs[i] = 1.0f / sqrtf(t * (1.0f / 1024.0f) + 1e-6f); }
}
template <bool NRM> struct EpiSwiGLUT { static constexpr bool PERM = true, AFTER_DRAIN = false;
    bf16_t* Hd; int ldh; const float* rowsq; const float* bias; int ldb;
    __device__ __forceinline__ void operator()(const f32x4 (&acc)[2][2][4][2], const Unit& u, int wr, int wc, int fr, int fq) const {
        const int row0 = u.pm * BM + wr * 64 + fr, col = u.pn * HALF + wc * 32 + 8 * fq;
        f32x4 bg[2], bu[2];
        if (NRM) { const float* bp = bias + (size_t)((u.pm * BM) >> 12) * ldb + u.pn * BM + wc * 32 + 8 * fq;
#pragma unroll
            for (int n = 0; n < 2; ++n) { bg[n] = *(const f32x4*)(bp + 4 * n); bu[n] = *(const f32x4*)(bp + HALF + 4 * n); } }
        float rs[8]; if (NRM) row_rstd8(rowsq, row0, fq, rs);
#pragma unroll
        for (int ai = 0; ai < 2; ++ai)
#pragma unroll
            for (int m = 0; m < 4; ++m) { f32x4 r[2]; const int row = row0 + ai * HALF + m * 16;
                const float rstd = NRM ? rs[ai * 4 + m] : 1.0f;
#pragma unroll
                for (int n = 0; n < 2; ++n) { f32x4 g = acc[ai][0][m][n], up = acc[ai][1][m][n];
                    if (NRM) { g = g * rstd + bg[n]; up = up * rstd + bu[n]; }
#pragma unroll
                    for (int e = 0; e < 4; ++e) r[n][e] = g[e] * fsigmoid(g[e]) * up[e]; }
                *(u32x4*)(Hd + (size_t)row * ldh + col) = pack8f(r[0], r[1]); }
    }
};
typedef EpiSwiGLUT<false> EpiSwiGLU;

struct EpiProjN { static constexpr bool PERM = true, AFTER_DRAIN = false;
    bf16_t* O; int ldc; const float* rowsq; const float* bias; int ldb;
    __device__ __forceinline__ void operator()(const f32x4 (&acc)[2][2][4][2], const Unit& u, int wr, int wc, int fr, int fq) const {
        const int row0 = u.pm * BM + wr * 64 + fr, col0 = u.pn * BM + wc * 32 + 8 * fq;
        const float* bp = bias + (size_t)((u.pm * BM) >> 12) * ldb + col0;
        f32x4 bv[2][2];
#pragma unroll
        for (int bj = 0; bj < 2; ++bj)
#pragma unroll
            for (int n = 0; n < 2; ++n) bv[bj][n] = *(const f32x4*)(bp + bj * HALF + 4 * n);
        float rs[8]; row_rstd8(rowsq, row0, fq, rs);
#pragma unroll
        for (int ai = 0; ai < 2; ++ai)
#pragma unroll
            for (int m = 0; m < 4; ++m) { const int row = row0 + ai * HALF + m * 16; const float rstd = rs[ai * 4 + m];
#pragma unroll
                for (int bj = 0; bj < 2; ++bj) *(u32x4*)(O + (size_t)row * ldc + col0 + bj * HALF) = pack8f(acc[ai][bj][m][0] * rstd + bv[bj][0], acc[ai][bj][m][1] * rstd + bv[bj][1]); }
    }
};

struct EpiLora { static constexpr bool PERM = true, AFTER_DRAIN = false;
    const float *w0, *a0, *v0, *k_k, *k_a;
    bf16_t* LW; bf16_t* Kraw; bf16_t* KK; bf16_t* BV; bf16_t* G; bf16_t* Vraw; const bf16_t* VF; const bf16_t* Rr; const float* r_k; float* BON;
    __device__ __forceinline__ void operator()(const f32x4 (&acc)[2][2][4][2], const Unit& u, int wr, int wc, int fr, int fq) const {
        const int row0 = u.pm * BM + wr * 64 + fr, seg = u.pn >> 1, cb = 256 * (u.pn & 1) + 64 * wc + 8 * fq;
        if (seg == 0) {
            f32x4 p[2][2];
#pragma unroll
            for (int bj = 0; bj < 2; ++bj) { p[bj][0] = *(const f32x4*)(w0 + cb + 32 * bj); p[bj][1] = *(const f32x4*)(w0 + cb + 32 * bj + 4); }
#pragma unroll
            for (int ai = 0; ai < 2; ++ai)
#pragma unroll
                for (int m = 0; m < 4; ++m) { bf16_t* rp = LW + (size_t)(row0 + ai * HALF + m * 16) * 512 + cb;
#pragma unroll
                    for (int bj = 0; bj < 2; ++bj) { f32x4 o[2];
#pragma unroll
                        for (int n = 0; n < 2; ++n)
#pragma unroll
                            for (int e = 0; e < 4; ++e) o[n][e] = -0.6065306597126334f * fsigmoid(p[bj][n][e] + acc[ai][bj][m][n][e]);
                        *(u32x4*)(rp + 32 * bj) = pack8f(o[0], o[1]); } }
        } else if (seg == 1) {
            u32x4 nk[2], nr[2];
            { const size_t ro = (size_t)row0 * 512 + cb;
#pragma unroll
              for (int bj = 0; bj < 2; ++bj) { nk[bj] = *(const u32x4*)(Kraw + ro + 32 * bj); nr[bj] = *(const u32x4*)(Rr + ro + 32 * bj); } }
#pragma unroll
            for (int ai = 0; ai < 2; ++ai)
#pragma unroll
                for (int m = 0; m < 4; ++m) { const size_t ro = (size_t)(row0 + ai * HALF + m * 16) * 512 + cb;
                    u32x4 ck[2], cr[2];
#pragma unroll
                    for (int bj = 0; bj < 2; ++bj) { ck[bj] = nk[bj]; cr[bj] = nr[bj]; }
                    if (ai * 4 + m < 7) { const int i2 = ai * 4 + m + 1; const size_t rn = (size_t)(row0 + (i2 >> 2) * HALF + (i2 & 3) * 16) * 512 + cb;
#pragma unroll
                        for (int bj = 0; bj < 2; ++bj) { nk[bj] = *(const u32x4*)(Kraw + rn + 32 * bj); nr[bj] = *(const u32x4*)(Rr + rn + 32 * bj); } }
                    float ss = 0.f;
#pragma unroll
                    for (int bj = 0; bj < 2; ++bj) { f32x4 kv[2]; unpack8(ck[bj], kv[0], kv[1]);
#pragma unroll
                        for (int n = 0; n < 2; ++n) { const f32x4 pk = *(const f32x4*)(k_k + cb + 32 * bj + 4 * n); const f32x4 t = kv[n] * pk; ss += (t[0] * t[0] + t[1] * t[1]) + (t[2] * t[2] + t[3] * t[3]); } }
                    ss += __uint_as_float((unsigned)__builtin_amdgcn_ds_swizzle((int)__float_as_uint(ss), 0x1f | (16 << 10)));
                    { const auto rr = __builtin_amdgcn_permlane32_swap(__float_as_uint(ss), __float_as_uint(ss), false, false); ss = __uint_as_float(rr[0]) + __uint_as_float(rr[1]); }
                    const float inv = 1.0f / fmaxf(sqrtf(ss), 1e-12f);
                    float bsum = 0.f;
#pragma unroll
                    for (int bj = 0; bj < 2; ++bj) { f32x4 kv[2], rv[2], k2[2], kk2[2], b2[2]; unpack8(ck[bj], kv[0], kv[1]); unpack8(cr[bj], rv[0], rv[1]);
#pragma unroll
                        for (int n = 0; n < 2; ++n) { const f32x4 pa = *(const f32x4*)(a0 + cb + 32 * bj + 4 * n), pk = *(const f32x4*)(k_k + cb + 32 * bj + 4 * n), pq = *(const f32x4*)(k_a + cb + 32 * bj + 4 * n), pr = *(const f32x4*)(r_k + cb + 32 * bj + 4 * n);
#pragma unroll
                            for (int e = 0; e < 4; ++e) { const float a = fsigmoid(pa[e] + acc[ai][bj][m][n][e]), kkn = kv[n][e] * pk[e] * inv; kk2[n][e] = kkn; b2[n][e] = kkn * a; k2[n][e] = kv[n][e] * (1.0f + (a - 1.0f) * pq[e]);
                                bsum += rv[n][e] * bflo(cvt_pk_bf16(k2[n][e], 0.f)) * pr[e]; } }
                        *(u32x4*)(Kraw + ro + 32 * bj) = pack8f(k2[0], k2[1]); *(u32x4*)(KK + ro + 32 * bj) = pack8f(kk2[0], kk2[1]); *(u32x4*)(BV + ro + 32 * bj) = pack8f(b2[0], b2[1]); }
                    bsum += __uint_as_float((unsigned)__builtin_amdgcn_ds_swizzle((int)__float_as_uint(bsum), 0x1f | (16 << 10)));
                    { const auto rr = __builtin_amdgcn_permlane32_swap(__float_as_uint(bsum), __float_as_uint(bsum), false, false); bsum = __uint_as_float(rr[0]) + __uint_as_float(rr[1]); }
                    if (fq == 0) BON[(size_t)(row0 + ai * HALF + m * 16) * 8 + 4 * (u.pn & 1) + wc] = bsum;
                    asm volatile("" ::: "memory"); }
        } else if (seg == 2) {
#pragma unroll
            for (int ai = 0; ai < 2; ++ai)
#pragma unroll
                for (int m = 0; m < 4; ++m) { bf16_t* rp = G + (size_t)(row0 + ai * HALF + m * 16) * 512 + cb;
#pragma unroll
                    for (int bj = 0; bj < 2; ++bj) *(u32x4*)(rp + 32 * bj) = pack8f(acc[ai][bj][m][0], acc[ai][bj][m][1]); }
        } else {
            f32x4 p[2][2];
#pragma unroll
            for (int bj = 0; bj < 2; ++bj) { p[bj][0] = *(const f32x4*)(v0 + cb + 32 * bj); p[bj][1] = *(const f32x4*)(v0 + cb + 32 * bj + 4); }
#pragma unroll
            for (int r0 = 0; r0 < 8; r0 += 2) { u32x4 hv[2][2], hf[2][2];
#pragma unroll
                for (int i = 0; i < 2; ++i) { const size_t ro = (size_t)(row0 + ((r0 + i) >> 2) * HALF + ((r0 + i) & 3) * 16) * 512 + cb;
#pragma unroll
                    for (int bj = 0; bj < 2; ++bj) { hv[i][bj] = *(const u32x4*)(Vraw + ro + 32 * bj); hf[i][bj] = *(const u32x4*)(VF + ro + 32 * bj); } }
#pragma unroll
                for (int i = 0; i < 2; ++i) { const int ai = (r0 + i) >> 2, m = (r0 + i) & 3; const size_t ro = (size_t)(row0 + ai * HALF + m * 16) * 512 + cb;
#pragma unroll
                    for (int bj = 0; bj < 2; ++bj) { f32x4 vv[2], vf[2], o[2]; unpack8(hv[i][bj], vv[0], vv[1]); unpack8(hf[i][bj], vf[0], vf[1]);
#pragma unroll
                        for (int n = 0; n < 2; ++n)
#pragma unroll
                            for (int e = 0; e < 4; ++e) o[n][e] = vv[n][e] + (vf[n][e] - vv[n][e]) * fsigmoid(p[bj][n][e] + acc[ai][bj][m][n][e]);
                        *(u32x4*)(Vraw + ro + 32 * bj) = pack8f(o[0], o[1]); } } }
        }
    }
};

struct EpiSlab { static constexpr bool PERM = false, AFTER_DRAIN = false;
    float* slab;
    __device__ __forceinline__ void operator()(const f32x4 (&acc)[2][2][4][2], const Unit& u, int wr, int wc, int fr, int fq) const {
        const int tid = (wr * 4 + wc) * 64 + fq * 16 + fr;
#pragma unroll
        for (int ai = 0; ai < 2; ++ai)
#pragma unroll
            for (int bj = 0; bj < 2; ++bj)
#pragma unroll
                for (int m = 0; m < 4; ++m)
#pragma unroll
                    for (int n = 0; n < 2; ++n) *(f32x4*)(slab + ((size_t)((((ai * 2 + bj) * 4 + m) * 2 + n) * 512 + tid)) * 4) = acc[ai][bj][m][n];
    }
};
struct G2Plan { int full, tail, spl; };
__device__ __forceinline__ G2Plan g2_plan(int nt, int G, int cap) { G2Plan p; const int nunits = nt * 4; p.full = (nunits / G) * G; p.tail = nunits - p.full; if (cap > G) cap = G;
    p.spl = (p.tail * 7 <= cap) ? 7 : ((p.tail * 4 <= cap) ? 4 : ((p.tail * 2 <= cap) ? 2 : 1)); if (p.tail == 0 || p.spl == 1) { p.full = nunits; p.tail = 0; p.spl = 1; } return p; }
template <class Epi, class Sched, bool ALIGN_EPI = false, bool SP2 = false, int MODE = 0>
__device__ __forceinline__ void gemm_phase(PG8_LAS unsigned char* lds, const Gemm g, const Sched& S, const Epi& E) {
    int tid_ = tid_now(); asm volatile("" : "+v"(tid_));
    const int tid = tid_, wid = __builtin_amdgcn_readfirstlane(tid >> 6), lane = tid & 63, wr = wid >> 2, wc = wid & 3, fr = lane & 15, fq = lane >> 4;
    int K_ = __builtin_amdgcn_readfirstlane(g.K); asm volatile("" : "+s"(K_));
    const int K = K_, nt = K / BK;
    int P_ = __builtin_amdgcn_readfirstlane(g.pitch ? g.pitch : K_); asm volatile("" : "+s"(P_)); const int P = P_;
    int PB_ = __builtin_amdgcn_readfirstlane(g.pitch_b ? g.pitch_b : P_); asm volatile("" : "+s"(PB_)); const int PB = PB_;
    unsigned voffA[2], voffB[2]; int gR[2], gC[2]; unsigned vAc[2][2], vAn[2][2]; int rawN[2][2];
    static_assert(SP2 || MODE == 0, "MODE != 0 needs SP2");
#pragma unroll
    for (int i = 0; i < 2; ++i) { int R, C; stage_rc(tid * 16 + i * 8192, R, C); const int Rb = Epi::PERM ? ((R & ~31) + perm32(R & 31)) : R;
        voffA[i] = (unsigned)(R * P + C) * 2u; voffB[i] = (unsigned)(Rb * PB + C) * 2u; gR[i] = R; gC[i] = C; }
    const size_t kstep = (size_t)(BK * 2);
    const size_t hstep = (size_t)HALF * P * 2;
    const size_t tstep = 2 * hstep;
    const size_t hstepB = (size_t)HALF * PB * 2, tstepB = 2 * hstepB;
    const unsigned ldsw = (unsigned)wid * 1024u;
    const int aoff = lds_byte(wr * 64 + fr, fq * 8), boff = lds_byte(wc * 32 + fr, fq * 8);
#define PG8_SA(b, h) (((b) * 2 + (h)) * HTB)
#define PG8_SB(b, h) ((4 + (b) * 2 + (h)) * HTB)
#define PG8_STAGE(bufoff, gbase, voff) do { _Pragma("unroll") for (int _i = 0; _i < 2; ++_i) \
        __builtin_amdgcn_global_load_lds((const unsigned*)((const char*)(gbase) + (voff)[_i]), (PG8_LAS unsigned*)(lds + (bufoff) + ldsw + _i * 8192), 16, 0, 0); } while (0)
#define PG8_GATHER(dst, U) do { _Pragma("unroll") for (int _h = 0; _h < 2; ++_h) _Pragma("unroll") for (int _i = 0; _i < 2; ++_i) { \
        int _r = g.ridx[(U).pm * BM + _h * HALF + gR[_i]]; _r = _r < 0 ? 0 : _r; dst[_h][_i] = (unsigned)(_r * P + gC[_i]) * 2u; } } while (0)
#define PG8_GATHER_RAW(U) do { _Pragma("unroll") for (int _h = 0; _h < 2; ++_h) _Pragma("unroll") for (int _i = 0; _i < 2; ++_i) { \
        const __attribute__((address_space(1))) int* _p = (const __attribute__((address_space(1))) int*)(g.ridx + ((U).pm * BM + _h * HALF + gR[_i])); \
        asm volatile("global_load_dword %0, %1, off" : "=v"(rawN[_h][_i]) : "v"(_p) : "memory"); } } while (0)
#define PG8_GATHER_FIN() do { _Pragma("unroll") for (int _h = 0; _h < 2; ++_h) _Pragma("unroll") for (int _i = 0; _i < 2; ++_i) { \
        int _r = rawN[_h][_i]; asm volatile("" : "+v"(_r));     \
        _r = _r < 0 ? 0 : _r; vAn[_h][_i] = (unsigned)(_r * P + gC[_i]) * 2u; } } while (0)
#define PG8_STAGE_A(bufoff, kptr, h, NXT) do { if constexpr (MODE == 1) { _Pragma("unroll") for (int _i = 0; _i < 2; ++_i) \
        __builtin_amdgcn_global_load_lds((const unsigned*)((const char*)(kptr) + ((NXT) ? vAn[h][_i] : vAc[h][_i])), (PG8_LAS unsigned*)(lds + (bufoff) + ldsw + _i * 8192), 16, 0, 0); } \
    else { PG8_STAGE(bufoff, (kptr) + (h) * hstep, voffA); } } while (0)
#define PG8_APTR(U) ((MODE == 1) ? (const char*)g.A : (MODE == 3) ? (const char*)g.A + (size_t)(U).pm * tstep + (((U).pn >> 1) < 2 ? 0 : (((U).pn >> 1) - 1) * 256) : (const char*)g.A + (size_t)(U).pm * tstep)
#define PG8_BPTR(U) ((MODE == 1 || MODE == 2) ? (const char*)g.Bt + (size_t)g.tile_e[(U).pm] * g.e_stride + (size_t)(U).pn * tstepB : (const char*)g.Bt + (size_t)(U).pn * tstepB)
#define PG8_LDA(dst, b, h) do { _Pragma("unroll") for (int m = 0; m < 4; ++m) _Pragma("unroll") for (int k = 0; k < 2; ++k) dst[m][k] = *(const PG8_LAS bf16x8*)(lds + PG8_SA(b, h) + aoff + m * 2048 + k * 1024); } while (0)
#define PG8_LDB(dst, b, h) do { _Pragma("unroll") for (int n = 0; n < 2; ++n) _Pragma("unroll") for (int k = 0; k < 2; ++k) dst[n][k] = *(const PG8_LAS bf16x8*)(lds + PG8_SB(b, h) + boff + n * 2048 + k * 1024); } while (0)
#define PG8_MMA(ai, bj, At, Bt) do { __builtin_amdgcn_s_setprio(1); _Pragma("unroll") for (int m = 0; m < 4; ++m) _Pragma("unroll") for (int n = 0; n < 2; ++n) _Pragma("unroll") for (int k = 0; k < 2; ++k) \
        acc[ai][bj][m][n] = __builtin_amdgcn_mfma_f32_16x16x32_bf16(Bt[n][k], At[m][k], acc[ai][bj][m][n], 0, 0, 0); __builtin_amdgcn_s_setprio(0); } while (0)
#define PG8_WAIT_V(n) asm volatile("s_waitcnt vmcnt(" #n ")" ::: "memory")
#define PG8_WAIT_L(n) asm volatile("s_waitcnt lgkmcnt(" #n ")" ::: "memory")
#define PG8_BAR __builtin_amdgcn_s_barrier()
#define PG8_SCHED __builtin_amdgcn_sched_barrier(0)
    Unit cur, nxt; int ui = 0;
    if (!S.next(0, cur)) return;
    f32x4 acc[2][2][4][2];
#pragma unroll
    for (int a = 0; a < 2; ++a)
#pragma unroll
        for (int b = 0; b < 2; ++b)
#pragma unroll
            for (int m = 0; m < 4; ++m)
#pragma unroll
                for (int n = 0; n < 2; ++n) acc[a][b][m][n] = (f32x4){0.f, 0.f, 0.f, 0.f};
    bf16x8 At[4][2], B0[2][2], B1[2][2];
    const char* cA = PG8_APTR(cur); const char* cB = PG8_BPTR(cur);
    if constexpr (MODE == 1) { PG8_GATHER(vAc, cur); }
    S.a_ready(cur);
    if constexpr (SP2) {
        PG8_STAGE(PG8_SB(0, 0), cB, voffB); PG8_STAGE(PG8_SB(0, 1), cB + hstepB, voffB); PG8_STAGE_A(PG8_SA(0, 0), cA, 0, false); PG8_STAGE_A(PG8_SA(0, 1), cA, 1, false);
        if (wr == 1) PG8_BAR;
        PG8_WAIT_V(2); PG8_BAR;
        PG8_STAGE(PG8_SB(1, 0), cB + kstep, voffB); PG8_STAGE_A(PG8_SA(1, 0), cA + kstep, 0, false); PG8_STAGE(PG8_SB(1, 1), cB + hstepB + kstep, voffB);
        PG8_WAIT_V(6); PG8_BAR;
    } else {
        PG8_STAGE(PG8_SB(0, 0), cB, voffB); PG8_STAGE(PG8_SA(0, 0), cA, voffA); PG8_STAGE(PG8_SB(0, 1), cB + hstepB, voffB); PG8_STAGE(PG8_SA(0, 1), cA + hstep, voffA);
        if (wr == 1) PG8_BAR;
        PG8_WAIT_V(4); PG8_BAR;
        PG8_STAGE(PG8_SB(1, 0), cB + kstep, voffB); PG8_STAGE(PG8_SA(1, 0), cA + kstep, voffA); PG8_STAGE(PG8_SB(1, 1), cB + hstepB + kstep, voffB);
        PG8_WAIT_V(6); PG8_BAR;
    }
    for (;;) {
        const bool has_next = S.next(ui + 1, nxt);
        const char* nA = has_next ? PG8_APTR(nxt) : cA; const char* nB = has_next ? PG8_BPTR(nxt) : cB;
        if constexpr (MODE == 1) { if (has_next) { PG8_GATHER_RAW(nxt); } else { vAn[0][0] = vAc[0][0]; vAn[0][1] = vAc[0][1]; vAn[1][0] = vAc[1][0]; vAn[1][1] = vAc[1][1]; } }
        for (int t = 0; t < nt; t += 2) {
            const bool last = (t == nt - 2);
            const char* a1 = cA + (size_t)(t + 1) * kstep;
            const char* a2 = last ? nA : cA + (size_t)(t + 2) * kstep; const char* b2 = last ? nB : cB + (size_t)(t + 2) * kstep;
            const char* a3 = a2 + kstep; const char* b3 = b2 + kstep;
            if (last && has_next) S.a_ready(nxt);
            if constexpr (MODE == 1) { if (last && has_next) { PG8_GATHER_FIN(); } }
            if constexpr (SP2) {
            PG8_LDB(B0, 0, 0); PG8_LDB(B1, 0, 1); PG8_SCHED; PG8_LDA(At, 0, 0); PG8_STAGE_A(PG8_SA(1, 1), a1, 1, false);
            PG8_WAIT_V(8); PG8_WAIT_L(0); PG8_BAR; PG8_MMA(0, 0, At, B0); PG8_MMA(0, 1, At, B1); PG8_BAR; PG8_SCHED;
            PG8_LDA(At, 0, 1); PG8_STAGE(PG8_SB(0, 0), b2, voffB); PG8_STAGE(PG8_SB(0, 1), b2 + hstepB, voffB); PG8_STAGE_A(PG8_SA(0, 0), a2, 0, last);
            PG8_WAIT_V(8); PG8_WAIT_L(0); PG8_BAR; PG8_MMA(1, 0, At, B0); PG8_MMA(1, 1, At, B1); PG8_BAR; PG8_SCHED;
            PG8_LDB(B0, 1, 0); PG8_LDB(B1, 1, 1); PG8_SCHED; PG8_LDA(At, 1, 0); PG8_STAGE_A(PG8_SA(0, 1), a2, 1, last);
            PG8_WAIT_V(8); PG8_WAIT_L(0); PG8_BAR; PG8_MMA(0, 0, At, B0); PG8_MMA(0, 1, At, B1); PG8_BAR; PG8_SCHED;
            PG8_LDA(At, 1, 1); PG8_STAGE(PG8_SB(1, 0), b3, voffB); PG8_STAGE(PG8_SB(1, 1), b3 + hstepB, voffB); PG8_STAGE_A(PG8_SA(1, 0), a3, 0, last);
            PG8_WAIT_V(8); PG8_WAIT_L(0); PG8_BAR; PG8_MMA(1, 0, At, B0); PG8_MMA(1, 1, At, B1); PG8_BAR; PG8_SCHED;
            } else {
            PG8_LDB(B0, 0, 0); PG8_SCHED; PG8_LDA(At, 0, 0); PG8_STAGE(PG8_SA(1, 1), a1 + hstep, voffA);
            PG8_WAIT_L(8); PG8_BAR; PG8_WAIT_L(0); PG8_MMA(0, 0, At, B0); PG8_BAR; PG8_SCHED;
            PG8_LDB(B1, 0, 1); PG8_STAGE(PG8_SB(0, 0), b2, voffB);
            PG8_BAR; PG8_WAIT_L(0); PG8_MMA(0, 1, At, B1); PG8_BAR;
            PG8_LDA(At, 0, 1); PG8_STAGE(PG8_SA(0, 0), a2, voffA);
            PG8_BAR; PG8_WAIT_L(0); PG8_MMA(1, 0, At, B0); PG8_BAR; PG8_SCHED;
            PG8_STAGE(PG8_SB(0, 1), b2 + hstepB, voffB);
            PG8_WAIT_V(6); PG8_BAR; PG8_MMA(1, 1, At, B1); PG8_BAR;
            PG8_LDB(B0, 1, 0); PG8_SCHED; PG8_LDA(At, 1, 0); PG8_STAGE(PG8_SA(0, 1), a2 + hstep, voffA);
            PG8_WAIT_L(8); PG8_BAR; PG8_WAIT_L(0); PG8_MMA(0, 0, At, B0); PG8_BAR; PG8_SCHED;
            PG8_LDB(B1, 1, 1); PG8_STAGE(PG8_SB(1, 0), b3, voffB);
            PG8_BAR; PG8_WAIT_L(0); PG8_MMA(0, 1, At, B1); PG8_BAR;
            PG8_LDA(At, 1, 1); PG8_STAGE(PG8_SA(1, 0), a3, voffA);
            PG8_BAR; PG8_WAIT_L(0); PG8_MMA(1, 0, At, B0); PG8_BAR; PG8_SCHED;
            PG8_STAGE(PG8_SB(1, 1), b3 + hstepB, voffB);
            PG8_WAIT_V(6); PG8_BAR; PG8_MMA(1, 1, At, B1); PG8_BAR;
            }
        }
        if constexpr (ALIGN_EPI) { if (wr == 0) PG8_BAR; }
        if constexpr (!Epi::AFTER_DRAIN) { E(acc, cur, wr, wc, fr, fq); S.done(cur); }
        if (!has_next) break;
#pragma unroll
        for (int a = 0; a < 2; ++a)
#pragma unroll
            for (int b = 0; b < 2; ++b)
#pragma unroll
                for (int m = 0; m < 4; ++m)
#pragma unroll
                    for (int n = 0; n < 2; ++n) acc[a][b][m][n] = (f32x4){0.f, 0.f, 0.f, 0.f};
        cur = nxt; cA = nA; cB = nB; ++ui;
        if constexpr (MODE == 1) { vAc[0][0] = vAn[0][0]; vAc[0][1] = vAn[0][1]; vAc[1][0] = vAn[1][0]; vAc[1][1] = vAn[1][1]; }
        if constexpr (ALIGN_EPI) { if (wr == 1) PG8_BAR; }
    }
    PG8_WAIT_V(0);
    if constexpr (!ALIGN_EPI) { if (wr == 0) PG8_BAR; }
    PG8_BAR;
    if constexpr (Epi::AFTER_DRAIN) { E.fused(acc, cur, wr, wc, fr, fq, lds, wid, lane); S.done(cur); }
#undef PG8_SA
#undef PG8_SB
#undef PG8_STAGE
#undef PG8_STAGE_A
#undef PG8_GATHER
#undef PG8_GATHER_RAW
#undef PG8_GATHER_FIN
#undef PG8_APTR
#undef PG8_BPTR
#undef PG8_LDA
#undef PG8_LDB
#undef PG8_MMA
#undef PG8_WAIT_V
#undef PG8_WAIT_L
#undef PG8_BAR
#undef PG8_SCHED
}
}

#define GAS __attribute__((address_space(1)))
#define LAS __attribute__((address_space(3)))
typedef unsigned short bf16;
typedef unsigned v4u __attribute__((ext_vector_type(4)));
typedef unsigned v2u __attribute__((ext_vector_type(2)));
typedef float f32x4 __attribute__((ext_vector_type(4)));
typedef float f32x16 __attribute__((ext_vector_type(16)));
typedef short bf16x8 __attribute__((ext_vector_type(8)));
typedef short s16x4 __attribute__((ext_vector_type(4)));
typedef GAS unsigned gu32;
#define RLX_AGENT __ATOMIC_RELAXED, __HIP_MEMORY_SCOPE_AGENT
#define LDS_WAIT() asm volatile("s_waitcnt lgkmcnt(0)" ::: "memory")
#define VM_WAIT() asm volatile("s_waitcnt vmcnt(0)" ::: "memory")
using pg8::bf2f; using pg8::bflo; using pg8::bfhi; using pg8::fsigmoid; using pg8::cvt_pk_bf16;

#ifndef MK_SPLIT
#define MK_SPLIT 0
#endif

constexpr int NWAVES = 8, NTHR = 512;
constexpr int NB = 8, SEQ = 4096, TOK = NB * SEQ, DM = 1024;
constexpr int NPROJ = 2304;
constexpr int NQ = 768, NKV = 1024, KLORA = 384, NLORA = 2048, RW = 512, KLW = 128;
constexpr int FFD = 2816, FFE = 3584, NEXP = 8;
constexpr int MODLD = 6144;
constexpr int CONV_WGS = 80;
constexpr int PASS_TILES = 136;
constexpr int PASS_ROWS = PASS_TILES * 256;

constexpr size_t MiB = 1u << 20;
constexpr size_t WS_CTL = 0, CTL_ZERO_BYTES = 64 * 1024;
constexpr size_t WS_MOD = 1 * MiB;
constexpr size_t WS_BIAS2 = WS_MOD + 512 * 1024;
constexpr size_t WS_BIAS1 = WS_MOD + 768 * 1024;
constexpr size_t WS_ROUTE = 2 * MiB;
constexpr size_t WS_WIN = 4 * MiB;
constexpr size_t WS_WUQ = WS_WIN + 2ull * NPROJ * DM * 2;
constexpr size_t WS_WUKV = WS_WUQ + 2ull * NQ * 256 * 2;
constexpr size_t WS_WLORA = WS_WUKV + 2ull * NKV * 128 * 2;
constexpr size_t WS_WOUT = WS_WLORA + 2ull * NLORA * KLORA * 2;
constexpr size_t WS_WF1 = WS_WOUT + 2ull * DM * DM * 2;
constexpr size_t WS_WF2 = WS_WF1 + 2ull * FFD * DM * 2;
constexpr size_t WS_WEND = WS_WF2 + (size_t)DM * FFD * 2;
constexpr size_t WS_VFIRST = 38 * MiB;
constexpr size_t WS_ARENA = 70 * MiB;
static_assert(WS_WEND <= WS_VFIRST, "weights overflow");
constexpr size_t A_H = WS_ARENA + 0 * MiB;
constexpr size_t A_PROJ = WS_ARENA + 64 * MiB;
constexpr size_t A_CQ = WS_ARENA + 208 * MiB;
constexpr size_t A_CKV = WS_ARENA + 224 * MiB;
constexpr size_t A_LA = WS_ARENA + 232 * MiB;
constexpr size_t A_KB = WS_ARENA + 256 * MiB;
constexpr size_t A_R = WS_ARENA + 304 * MiB;
constexpr size_t A_KRAW = WS_ARENA + 336 * MiB;
constexpr size_t A_VRAW = WS_ARENA + 368 * MiB;
constexpr size_t A_VB = WS_ARENA + 400 * MiB;
constexpr size_t A_KK = WS_ARENA + 432 * MiB;
constexpr size_t A_BV = WS_ARENA + 464 * MiB;
constexpr size_t A_BON = WS_ARENA + 496 * MiB;
constexpr size_t A_RSQ = WS_ARENA + 498 * MiB;
constexpr size_t A_Q = WS_ARENA + 0 * MiB;
constexpr size_t A_LW = WS_ARENA + 64 * MiB;
constexpr size_t A_LWH = WS_ARENA + 160 * MiB;
constexpr size_t A_G = WS_ARENA + 128 * MiB;
constexpr size_t A_YCAT = WS_ARENA + 160 * MiB;
constexpr size_t A_HID = WS_ARENA + 64 * MiB;
constexpr size_t A_X16B = 4 * MiB;
constexpr size_t A_HIDM = WS_ARENA + 0 * MiB;
constexpr size_t A_WE1 = WS_ARENA + 238 * MiB;
constexpr size_t A_WE2 = WS_ARENA + 350 * MiB;
constexpr size_t A_Y0 = WS_ARENA + 406 * MiB;
constexpr size_t A_Y1 = A_WE1;
constexpr size_t WS_WOUT1 = WS_ARENA + 500 * MiB;
constexpr size_t DO_H2 = 0;
constexpr size_t DO_X16A = 64 * MiB;
constexpr size_t DO_SLAB = 64 * MiB;
constexpr int SLAB0_CAP = 256;
constexpr size_t WS_END = WS_ARENA + 504 * MiB;
static_assert(A_HIDM + (size_t)PASS_ROWS * FFE * 2 <= A_WE1, "moe hidden overflow");
static_assert(A_Y0 + (size_t)PASS_ROWS * DM * 2 <= A_BON, "Y0 overflow");
constexpr size_t RT_SEL = WS_ROUTE;
constexpr size_t RT_GW = RT_SEL + (size_t)TOK * 8;
constexpr size_t RT_CNT = RT_GW + (size_t)TOK * 8;
constexpr size_t RT_RIDX = RT_CNT + 256 * 16 * 4;
constexpr size_t RT_RGW = RT_RIDX + 2ull * PASS_ROWS * 4;
constexpr size_t RT_TILE = RT_RGW + 2ull * PASS_ROWS * 4;
constexpr size_t RT_TPOS = WS_ROUTE + 1280 * 1024;
static_assert(RT_TILE + 2 * (PASS_TILES + 8) * 4 <= RT_TPOS && RT_TPOS + 2ull * TOK * 4 <= WS_WIN, "route tables overflow");

constexpr int CW_QCTR = 64;
constexpr int CW_BAR = 4096;
constexpr size_t WS_PADST = 32 * 1024;
#define PAD_STORES(ws_, gw_, n_) do { GAS unsigned* ps_ = (GAS unsigned*)((ws_) + WS_CTL + WS_PADST); _Pragma("unroll") for (int i_ = 0; i_ < (n_); ++i_) __builtin_nontemporal_store(0u, ps_ + 64 * i_); } while (0)

constexpr int RING_BYTES = 155648;
constexpr int LDSCTL_OFF = RING_BYTES, MISC_OFF = LDSCTL_OFF + 320, PTAB_OFF = LDSCTL_OFF + 1024, TS_OFF = LDSCTL_OFF + 2048;
constexpr int LDS_BYTES = 163840;

#define XB_TMO      128
#define XB_XCNT(j)  (256  + 64 * (j))
#define XB_XSUB(j)  (1280 + 64 * (j))
#define XB_XGEN(j)  (2304 + 64 * (j))
#define XB_TOP      3328
#define XB_TOPGEN   3392
#define XCD_BAR_WORDS 3456
#define XB_SPIN_CAP (1u << 18)

__device__ __forceinline__ unsigned xb_ld(unsigned* p)              { return __hip_atomic_load(p, __ATOMIC_RELAXED, __HIP_MEMORY_SCOPE_AGENT); }
__device__ __forceinline__ unsigned xb_add(unsigned* p, unsigned v) { return __hip_atomic_fetch_add(p, v, __ATOMIC_RELAXED, __HIP_MEMORY_SCOPE_AGENT); }
__device__ __forceinline__ unsigned xb_xcc_id() { return (unsigned)__builtin_amdgcn_s_getreg((3 << 11) | 20) & 0xFu; }
#define XB_SPIN(cond, bar) do { unsigned _sp = 0; while (cond) { __builtin_amdgcn_s_sleep(1); \
    if ((++_sp & 255u) == 0u) { if (xb_ld(&(bar)[XB_TMO])) break; if (_sp > XB_SPIN_CAP) { atomicAdd(&(bar)[XB_TMO], 1u); break; } } } } while (0)

struct XcdBarrier {
    unsigned* bar; unsigned x;
    volatile LAS unsigned* st;
};

__device__ __forceinline__ XcdBarrier xcd_barrier_post(unsigned* bar, volatile LAS unsigned* st) {
    XcdBarrier b; b.bar = bar; b.x = xb_xcc_id(); b.st = st;
    if (pg8::tid_now() == 0) (void)xb_add(&bar[XB_XCNT(b.x)], 1u);
    return b;
}
__device__ __forceinline__ void xcd_barrier_complete(unsigned* bar, unsigned x, unsigned& nloc, unsigned& nx) {
    const unsigned G = gridDim.x * gridDim.y * gridDim.z;
    unsigned sum, cnt, mine, sp = 0u;
    for (;;) {
        sum = 0u; cnt = 0u; mine = 0u;
#pragma unroll
        for (unsigned j = 0; j < 16; ++j) { const unsigned c = xb_ld(&bar[XB_XCNT(j)]); sum += c; cnt += (c > 0u) ? 1u : 0u; mine = (j == x) ? c : mine; }
        if (sum == G) break;
        __builtin_amdgcn_s_sleep(1);
        if ((++sp & 255u) == 0u) { if (xb_ld(&bar[XB_TMO])) break; if (sp > XB_SPIN_CAP) { atomicAdd(&bar[XB_TMO], 1u); break; } }
    }
    nloc = mine > 0u ? mine : 1u; nx = cnt > 0u ? cnt : 1u;
}

__device__ __forceinline__ void xcd_barrier(const XcdBarrier& b) {
    asm volatile("s_waitcnt vmcnt(0)" ::: "memory");
    __syncthreads();
    if (pg8::tid_now() == 0) {
        unsigned* bar = b.bar;
        __builtin_amdgcn_s_waitcnt(0);
        unsigned nloc = b.st[0], nx = b.st[1];
        if (nloc == 0u) { xcd_barrier_complete(bar, b.x, nloc, nx); b.st[0] = nloc; b.st[1] = nx; }
        const unsigned old = xb_add(&bar[XB_XSUB(b.x)], 1u);
        const unsigned gen = old / nloc;
        if (old + 1u == (gen + 1u) * nloc) {
            __builtin_amdgcn_fence(__ATOMIC_RELEASE, "agent");
            asm volatile("s_waitcnt vmcnt(0)" ::: "memory");
            const unsigned og = xb_add(&bar[XB_TOP], 1u);
            const unsigned tg = og / nx;
            if (og + 1u == (tg + 1u) * nx) xb_add(&bar[XB_TOPGEN], 1u);
            else XB_SPIN(xb_ld(&bar[XB_TOPGEN]) == tg, bar);
            __builtin_amdgcn_fence(__ATOMIC_ACQUIRE, "agent");
            xb_add(&bar[XB_XGEN(b.x)], 1u);
            asm volatile("s_waitcnt vmcnt(0)" ::: "memory");
        } else {
            XB_SPIN(xb_ld(&bar[XB_XGEN(b.x)]) == gen, bar);
            __builtin_amdgcn_fence(__ATOMIC_ACQUIRE, "agent");
            asm volatile("s_waitcnt vmcnt(0)" ::: "memory");
        }
    }
    __syncthreads();
}


template <int X> __device__ __forceinline__ float lane_xor(float v) {
    if constexpr (X == 32) { const auto rr = __builtin_amdgcn_permlane32_swap(__float_as_uint(v), __float_as_uint(v), false, false); return __uint_as_float((__builtin_amdgcn_mbcnt_lo(~0u, 0u) == 32u) ? rr[0] : rr[1]); }
    else return __uint_as_float((unsigned)__builtin_amdgcn_ds_swizzle((int)__float_as_uint(v), 0x1f | (X << 10)));
}
__device__ __forceinline__ float wave_sum(float v) {
    v += lane_xor<1>(v); v += lane_xor<2>(v); v += lane_xor<4>(v); v += lane_xor<8>(v); v += lane_xor<16>(v);
    { const auto rr = __builtin_amdgcn_permlane32_swap(__float_as_uint(v), __float_as_uint(v), false, false); v = __uint_as_float(rr[0]) + __uint_as_float(rr[1]); }
    return v;
}
__device__ __forceinline__ v4u pk8(const float* f) { v4u w; w.x = cvt_pk_bf16(f[0], f[1]); w.y = cvt_pk_bf16(f[2], f[3]); w.z = cvt_pk_bf16(f[4], f[5]); w.w = cvt_pk_bf16(f[6], f[7]); return w; }
__device__ __forceinline__ void up8(const v4u w, float* f) { f[0] = bflo(w.x); f[1] = bfhi(w.x); f[2] = bflo(w.y); f[3] = bfhi(w.y); f[4] = bflo(w.z); f[5] = bfhi(w.z); f[6] = bflo(w.w); f[7] = bfhi(w.w); }

__device__ __forceinline__ void tr_block64(const float* W, int ldw, bf16* WT, int ldk, int k0, int n0, int drow0, int nv, int lane, LAS float* scr  ) {
    const bool ok = lane < nv;
    const float* src = W + (size_t)k0 * ldw + n0 + (ok ? lane : 0);
    float v[64];
#pragma unroll
    for (int k = 0; k < 64; ++k) v[k] = src[(size_t)k * ldw];
#pragma unroll
    for (int k = 0; k < 64; ++k) scr[k * 65 + lane] = v[k];
    LDS_WAIT(); asm volatile("" ::: "memory");
    const int c = lane & 7;
#pragma unroll
    for (int j = 0; j < 8; ++j) { const int n = (lane >> 3) + 8 * j; const LAS float* sp = scr + (8 * c) * 65 + n;
        v4u o; o.x = cvt_pk_bf16(sp[0 * 65], sp[1 * 65]); o.y = cvt_pk_bf16(sp[2 * 65], sp[3 * 65]); o.z = cvt_pk_bf16(sp[4 * 65], sp[5 * 65]); o.w = cvt_pk_bf16(sp[6 * 65], sp[7 * 65]);
        if (n < nv) *(GAS v4u*)(WT + (size_t)(drow0 + n) * ldk + k0 + 8 * c) = o; }
    LDS_WAIT(); asm volatile("" ::: "memory");
}
__device__ __forceinline__ void conv_item(const float* W, int K, int N, bf16* WT, int ldk, int mode, int row_off, int item, int lane, LAS float* scr) {
    const int nblk = (N + 63) / 64, kb = item / nblk, nb = item % nblk, n0 = 64 * nb;
    int drow = n0 + row_off;
    if (mode != 0) drow = 256 * (n0 >> 7) + (n0 & 127) + (mode == 2 ? 128 : 0);
    tr_block64(W, N, WT, ldk, 64 * kb, n0, drow, (N - n0) < 64 ? (N - n0) : 64, lane, scr);
}
struct In { const float* p[38]; };
struct InT { volatile LAS unsigned* t;
    __device__ __forceinline__ const float* operator[](int i) const { const unsigned lo = __builtin_amdgcn_readfirstlane(t[2 * i]), hi = __builtin_amdgcn_readfirstlane(t[2 * i + 1]);
        return (const float*)(const GAS float*)(((unsigned long long)hi << 32) | (unsigned long long)lo); } };

__device__ __forceinline__ void p0_weights(const InT in, unsigned char* ws, LAS unsigned char* lds, int gw, int NGW, int wave, int lane, int gtid, int NGT) {
    LAS float* scr = (LAS float*)(lds + wave * 16896);
    constexpr int I_IN = 16 * 35, I_VR = 16, I_UQ = 4 * 12, I_UKV = 2 * 16, I_OUT = 16 * 16, I_G = 16 * 44, I_D = 44 * 16;
    constexpr int PER_L = I_IN + I_UQ + I_UKV + I_OUT;
    constexpr int NITEMS = 2 * PER_L + I_VR + 2 * I_G + I_D;
    for (int it = gw; it < NITEMS; it += NGW) {
        int r = it;
        if (r < 2 * PER_L) { const int l = r / PER_L; r -= l * PER_L;
            if (r < I_IN) { conv_item(in[7] + (size_t)l * DM * 2240, DM, 2240, (bf16*)(ws + WS_WIN) + (size_t)l * NPROJ * DM, DM, 0, 0, r, lane, scr); continue; } r -= I_IN;
            if (r < I_UQ) { conv_item(in[10] + (size_t)l * 256 * NQ, 256, NQ, (bf16*)(ws + WS_WUQ) + (size_t)l * NQ * 256, 256, 0, 0, r, lane, scr); continue; } r -= I_UQ;
            if (r < I_UKV) { conv_item(in[12] + (size_t)l * 128 * NKV, 128, NKV, (bf16*)(ws + WS_WUKV) + (size_t)l * NKV * 128, 128, 0, 0, r, lane, scr); continue; } r -= I_UKV;
            conv_item(in[28] + (size_t)l * DM * DM, DM, DM, (bf16*)(ws + (l == 0 ? WS_WOUT : WS_WOUT1)), DM, 0, 0, r, lane, scr); continue; }
        r -= 2 * PER_L;
        if (r < I_VR) { conv_item(in[8], DM, 32, (bf16*)(ws + WS_WIN) + (size_t)NPROJ * DM, DM, 0, 2240, r, lane, scr); continue; } r -= I_VR;
        if (r < I_G) { conv_item(in[29], DM, FFD, (bf16*)(ws + WS_WF1), DM, 1, 0, r, lane, scr); continue; } r -= I_G;
        if (r < I_G) { conv_item(in[30], DM, FFD, (bf16*)(ws + WS_WF1), DM, 2, 0, r, lane, scr); continue; } r -= I_G;
        conv_item(in[31], FFD, DM, (bf16*)(ws + WS_WF2), FFD, 0, 0, r, lane, scr);
    }
    { const int n0 = 64 * 128, n1 = 32 * 128;
      for (int i = gtid; i < n0 + n1; i += NGT) { const bool l1 = i >= n0; const int j = l1 ? i - n0 : i; const int row = (l1 ? 2272 : 2240) + j / 128, ch = j % 128;
          *(GAS v4u*)((bf16*)(ws + WS_WIN) + ((size_t)(l1 ? NPROJ : 0) + row) * DM + ch * 8) = (v4u){0u, 0u, 0u, 0u}; } }
    const float* pw2 = in[17]; const float* pa2 = in[19]; const float* pg2 = in[20]; const float* pv2 = in[22];
    for (int i = gtid; i < 2 * NLORA * (KLW / 8); i += NGT) {
        const int l = i / (NLORA * (KLW / 8)), rem = i % (NLORA * (KLW / 8)), k8 = rem / NLORA, pos = rem % NLORA;
        const int seg = pos >> 9, p9 = pos & 511, ct = p9 >> 8, p8 = p9 & 255, bj = p8 >> 7, wc = (p8 >> 5) & 3, x = p8 & 31;
        const int oc = 256 * ct + 64 * wc + 32 * bj + x;
        const int k0 = k8 * 8;
        const float* src = nullptr; int kr = 0;
        if (seg == 0 && k0 < 64) { src = pw2 + (size_t)l * 64 * RW; kr = k0; }
        else if (seg == 1 && k0 >= 64) { src = pa2 + (size_t)l * 64 * RW; kr = k0 - 64; }
        else if (seg == 2) { src = pg2 + (size_t)l * 128 * RW; kr = k0; }
        else if (seg == 3 && l == 1 && k0 < 32) { src = pv2; kr = k0; }
        float f[8];
#pragma unroll
        for (int e = 0; e < 8; ++e) f[e] = src ? src[(size_t)(kr + e) * RW + oc] : 0.f;
        *(GAS v4u*)((bf16*)(ws + WS_WLORA) + ((size_t)l * NLORA + pos) * KLW + k0) = pk8(f);
    }
}
struct TrBlk { const GAS float* src; GAS bf16* dst; int ldw, ldk; };
__device__ __forceinline__ TrBlk expert_block(const float* pg, const float* pu, const float* pd, unsigned char* ws, int it) {
    constexpr int IPJ = 896;
    const int job = it / IPJ, r = it % IPJ, e = job / 3, kind = job % 3; TrBlk t;
    if (kind < 2) { const int kb = r / 56, n0 = 64 * (r % 56), drow = 256 * (n0 >> 7) + (n0 & 127) + (kind == 1 ? 128 : 0);
        t.src = (const GAS float*)((kind == 0 ? pg : pu) + (size_t)e * DM * FFE + (size_t)(64 * kb) * FFE + n0); t.ldw = FFE; t.dst = (GAS bf16*)((bf16*)(ws + A_WE1) + (size_t)e * 2 * FFE * DM + (size_t)drow * DM + 64 * kb); t.ldk = DM; }
    else { const int kb = r / 16, n0 = 64 * (r % 16);
        t.src = (const GAS float*)(pd + (size_t)e * FFE * DM + (size_t)(64 * kb) * DM + n0); t.ldw = DM; t.dst = (GAS bf16*)((bf16*)(ws + A_WE2) + (size_t)e * DM * FFE + (size_t)n0 * FFE + 64 * kb); t.ldk = FFE; }
    return t;
}
__device__ __forceinline__ void p_expert_weights(const InT in, unsigned char* ws, LAS unsigned char* lds, int gw, int NGW, int wave, int lane) {
    constexpr int NIT = 24 * 896;
    LAS float* scr = (LAS float*)(lds + wave * 16896);
    const float* pg = in[34]; const float* pu = in[35]; const float* pd = in[36];
    float v[64];
    TrBlk cur; cur.src = (const GAS float*)pg; cur.dst = nullptr; cur.ldw = 0; cur.ldk = 0;
    if (gw < NIT) { cur = expert_block(pg, pu, pd, ws, gw);
#pragma unroll
        for (int k = 0; k < 64; ++k) v[k] = cur.src[(size_t)k * cur.ldw + lane]; }
    for (int it = gw; it < NIT; it += NGW) {
#pragma unroll
        for (int k = 0; k < 64; ++k) scr[k * 65 + lane] = v[k];
        TrBlk nxt = cur;
        if (it + NGW < NIT) { nxt = expert_block(pg, pu, pd, ws, it + NGW);
#pragma unroll
            for (int k = 0; k < 64; ++k) v[k] = nxt.src[(size_t)k * nxt.ldw + lane]; }
        LDS_WAIT(); asm volatile("" ::: "memory");
        const int c = lane & 7;
#pragma unroll
        for (int j = 0; j < 8; ++j) { const int n = (lane >> 3) + 8 * j; const LAS float* sp = scr + (8 * c) * 65 + n;
            v4u o; o.x = cvt_pk_bf16(sp[0 * 65], sp[1 * 65]); o.y = cvt_pk_bf16(sp[2 * 65], sp[3 * 65]); o.z = cvt_pk_bf16(sp[4 * 65], sp[5 * 65]); o.w = cvt_pk_bf16(sp[6 * 65], sp[7 * 65]);
            *(GAS v4u*)(cur.dst + (size_t)n * cur.ldk + 8 * c) = o; }
        LDS_WAIT(); asm volatile("" ::: "memory");
        cur = nxt;
    }
}
__device__ __forceinline__ void p0_mod(const InT in, unsigned char* ws, LAS unsigned char* lds, int vcu, int G, int wave, int lane, int tid) {
    LAS float* cond = (LAS float*)lds;
    LAS float* red = (LAS float*)(lds + 32768);
    const float* cin = in[1]; const float* wada = in[3]; const float* bada = in[4];
    for (int i = tid; i < NB * DM; i += NTHR) { const float c = cin[i]; cond[i] = c * fsigmoid(c); }
    __syncthreads();
    float* MOD = (float*)(ws + WS_MOD);
    for (int it = vcu; it < 2 * (MODLD / 64); it += G) { const int l = it / (MODLD / 64), n0 = (it % (MODLD / 64)) * 64;
        const float* W = wada + (size_t)l * DM * MODLD + n0 + lane;
        float a[8] = {0.f, 0.f, 0.f, 0.f, 0.f, 0.f, 0.f, 0.f};
#pragma unroll 16
        for (int k = wave * 128; k < wave * 128 + 128; ++k) { const float w = W[(size_t)k * MODLD];
#pragma unroll
            for (int b = 0; b < 8; ++b) a[b] += cond[b * DM + k] * w; }
#pragma unroll
        for (int b = 0; b < 8; ++b) red[(wave * 8 + b) * 64 + lane] = a[b];
        __syncthreads();
        { const int b = tid >> 6, n = tid & 63; float s = bada[(size_t)l * MODLD + n0 + n];
#pragma unroll
          for (int w = 0; w < 8; ++w) s += red[(w * 8 + b) * 64 + n];
          MOD[((size_t)l * NB + b) * MODLD + n0 + n] = s; }
        __syncthreads();
    }
}

template <bool ROUTER, bool XIN16>
__device__ __forceinline__ void norm_phase(const void* xin_, const float* g, const float* modl, int sh_off, bf16* H, const float* wr, const float* br, unsigned char* ws,
                                           LAS unsigned char* lds, int vcu, int G, int wave, int lane, int tid) {
    LAS int* cntl = (LAS int*)lds;
    const LAS f32x4* wl = (const LAS f32x4*)(lds + 1024);
    if (ROUTER) { __syncthreads();
        for (int q = tid; q < 2048; q += NTHR) { const int c = q >> 1, h = q & 1, ln = (c & 511) >> 3, j = 2 * (c >> 9) + ((c >> 2) & 1), i = c & 3; ((LAS f32x4*)(lds + 1024))[((j * 4 + i) * 2 + h) * 64 + ln] = *(const f32x4*)(wr + (size_t)c * 8 + 4 * h); }
        __syncthreads(); }
    float brv[8];
#pragma unroll
    for (int e = 0; e < 8; ++e) brv[e] = ROUTER ? br[e] : 0.f;
    for (int blk = vcu; blk < TOK / 128; blk += G) {
        if (ROUTER) { if (tid < 16) cntl[tid] = 0; __syncthreads(); }
        const int row0 = blk * 128 + wave * 16, b = row0 >> 12;
        const float* shp = modl + (size_t)b * MODLD + sh_off; const float* scp = shp + 1024;
        f32x4 gs[4], sh[4];
#pragma unroll
        for (int j = 0; j < 4; ++j) { const int c = 8 * lane + 512 * (j >> 1) + 4 * (j & 1);
            const f32x4 gg = *(const f32x4*)(g + c), sc = *(const f32x4*)(scp + c); gs[j] = gg * (sc + 1.0f); sh[j] = *(const f32x4*)(shp + c); }
        f32x4 nx[4]; v4u nh[2];
#define NORM_LOAD(rr) do { if (XIN16) { _Pragma("unroll") for (int jj = 0; jj < 2; ++jj) nh[jj] = ((const GAS v4u*)((const bf16*)xin_ + (size_t)(rr) * DM) + lane)[64 * jj]; } \
            else { _Pragma("unroll") for (int j = 0; j < 4; ++j) nx[j] = ((const GAS f32x4*)((const float*)xin_ + (size_t)(rr) * DM) + 2 * lane)[128 * (j >> 1) + (j & 1)]; } } while (0)
        NORM_LOAD(row0);
        if (lane == 0) PAD_STORES(ws, vcu * NWAVES + wave, ROUTER ? 3 : 2);
        for (int r = 0; r < 16; ++r) { const int row = row0 + r;
            f32x4 v[4]; float s = 0.f;
#pragma unroll
            for (int j = 0; j < 4; ++j) { const unsigned lo = (j & 1) ? nh[j >> 1].z : nh[j >> 1].x, hi2 = (j & 1) ? nh[j >> 1].w : nh[j >> 1].y; v[j] = XIN16 ? (f32x4){bflo(lo), bfhi(lo), bflo(hi2), bfhi(hi2)} : nx[j]; }
            if (r < 15) NORM_LOAD(row + 1);
#pragma unroll
            for (int j = 0; j < 4; ++j) s += (v[j].x * v[j].x + v[j].y * v[j].y) + (v[j].z * v[j].z + v[j].w * v[j].w);
            const float rstd = 1.0f / sqrtf(wave_sum(s) * (1.0f / DM) + 1e-6f);
            GAS v4u* o16 = (GAS v4u*)(H + (size_t)row * DM) + lane;
#pragma unroll
            for (int j = 0; j < 4; ++j) v[j] = v[j] * rstd * gs[j] + sh[j];
#pragma unroll
            for (int jj = 0; jj < 2; ++jj) o16[64 * jj] = (v4u){cvt_pk_bf16(v[2 * jj].x, v[2 * jj].y), cvt_pk_bf16(v[2 * jj].z, v[2 * jj].w), cvt_pk_bf16(v[2 * jj + 1].x, v[2 * jj + 1].y), cvt_pk_bf16(v[2 * jj + 1].z, v[2 * jj + 1].w)};
            if (ROUTER) {
                float lg[8];
#pragma unroll
                for (int e = 0; e < 8; ++e) lg[e] = 0.f;
#pragma unroll
                for (int j = 0; j < 4; ++j)
#pragma unroll
                    for (int i = 0; i < 4; ++i) { const f32x4 w0 = wl[((j * 4 + i) * 2) * 64 + lane], w1 = wl[((j * 4 + i) * 2 + 1) * 64 + lane]; const float hv = v[j][i];
                        lg[0] += hv * w0.x; lg[1] += hv * w0.y; lg[2] += hv * w0.z; lg[3] += hv * w0.w; lg[4] += hv * w1.x; lg[5] += hv * w1.y; lg[6] += hv * w1.z; lg[7] += hv * w1.w; }
#pragma unroll
                for (int e = 0; e < 8; ++e) lg[e] = wave_sum(lg[e]) + brv[e];
                unsigned key[8];
#pragma unroll
                for (int e = 0; e < 8; ++e) { const unsigned u = __float_as_uint(lg[e]); const unsigned kx = (u & 0x80000000u) ? ~u : (u | 0x80000000u); key[e] = (kx & ~7u) | (unsigned)(7 - e); }
                unsigned k1 = key[0];
#pragma unroll
                for (int e = 1; e < 8; ++e) k1 = key[e] > k1 ? key[e] : k1;
                unsigned k2 = 0u;
#pragma unroll
                for (int e = 0; e < 8; ++e) { const unsigned t = (key[e] == k1) ? 0u : key[e]; k2 = t > k2 ? t : k2; }
                k1 = (unsigned)__builtin_amdgcn_readfirstlane((int)k1); k2 = (unsigned)__builtin_amdgcn_readfirstlane((int)k2);
                const int i1 = 7 - (int)(k1 & 7u), i2 = 7 - (int)(k2 & 7u);
                const float v1 = __uint_as_float((k1 & 0x80000000u) ? (k1 & 0x7fffffffu) : ~k1), v2 = __uint_as_float((k2 & 0x80000000u) ? (k2 & 0x7fffffffu) : ~k2);
                const float w2 = 1.0f / (1.0f + __expf(v1 - v2)), w1 = 1.0f - w2;
                if (lane < 2) *(GAS v2u*)(ws + (lane == 0 ? RT_SEL : RT_GW) + (size_t)row * 8) = lane == 0 ? (v2u){(unsigned)i1, (unsigned)i2} : (v2u){__float_as_uint(w1), __float_as_uint(w2)};
                if (lane == 0) { atomicAdd((int*)&cntl[i1], 1); atomicAdd((int*)&cntl[8 + i2], 1); }
            }
        }
        if (ROUTER) {
            __syncthreads();
            if (tid < 16) *(GAS int*)(ws + RT_CNT + ((size_t)blk * 16 + tid) * 4) = cntl[tid];
            __syncthreads();
        }
    }
}
#undef NORM_LOAD
__device__ __forceinline__ void final_norm(float* x, const float* g, int gw, int NGW, int lane) {
    f32x4 gs[4];
#pragma unroll
    for (int j = 0; j < 4; ++j) gs[j] = *(const f32x4*)(g + 4 * lane + 256 * j);
    f32x4 nx[4];
#pragma unroll
    for (int j = 0; j < 4; ++j) nx[j] = (gw < TOK) ? ((const GAS f32x4*)(x + (size_t)gw * DM) + lane)[64 * j] : (f32x4){0.f, 0.f, 0.f, 0.f};
    for (int row = gw; row < TOK; row += NGW) { GAS f32x4* xr = (GAS f32x4*)(x + (size_t)row * DM) + lane; f32x4 v[4]; float s = 0.f;
#pragma unroll
        for (int j = 0; j < 4; ++j) v[j] = nx[j];
        if (row + NGW < TOK) {
#pragma unroll
            for (int j = 0; j < 4; ++j) nx[j] = ((const GAS f32x4*)(x + (size_t)(row + NGW) * DM) + lane)[64 * j]; }
#pragma unroll
        for (int j = 0; j < 4; ++j) s += (v[j].x * v[j].x + v[j].y * v[j].y) + (v[j].z * v[j].z + v[j].w * v[j].w);
        const float rstd = 1.0f / sqrtf(wave_sum(s) * (1.0f / DM) + 1e-6f);
#pragma unroll
        for (int j = 0; j < 4; ++j) xr[64 * j] = v[j] * rstd * gs[j]; }
}

__device__ __forceinline__ void final_moe_norm(unsigned char* ws, const bf16* xs, float* x, const float* g, const float* gate, const bf16* Y0, const bf16* Y1, const int* tpos, const float* tgw, int gw, int NGW, int lane) {
    f32x4 gs[4];
#pragma unroll
    for (int j = 0; j < 4; ++j) gs[j] = *(const f32x4*)(g + 4 * lane + 256 * j);
    v2u nx[4]; f32x4 ng[4]; v2u ny0[4], ny1[4]; float nwa = 0.f, nwb = 0.f;
    int pa = 0, pb = 0; float wa = 0.f, wb = 0.f;
    if (gw < TOK) { pa = tpos[gw]; pb = tpos[TOK + gw]; wa = tgw[2 * gw]; wb = tgw[2 * gw + 1]; }
#pragma unroll
    for (int j = 0; j < 4; ++j) { nx[j] = (v2u){0u, 0u}; ng[j] = (f32x4){0.f, 0.f, 0.f, 0.f}; ny0[j] = (v2u){0u, 0u}; ny1[j] = (v2u){0u, 0u}; }
    if (gw < TOK) {
#pragma unroll
        for (int j = 0; j < 4; ++j) { nx[j] = ((const GAS v2u*)(xs + (size_t)gw * DM) + lane)[64 * j]; ny0[j] = ((const GAS v2u*)(Y0 + (size_t)pa * DM) + lane)[64 * j]; ny1[j] = ((const GAS v2u*)(Y1 + (size_t)pb * DM) + lane)[64 * j];
            ng[j] = *(const f32x4*)(gate + (size_t)(gw >> 12) * MODLD + 4 * lane + 256 * j); }
        nwa = wa; nwb = wb;
        if (gw + NGW < TOK) { const int r2 = gw + NGW; pa = tpos[r2]; pb = tpos[TOK + r2]; wa = tgw[2 * r2]; wb = tgw[2 * r2 + 1]; } }
    if (lane == 0) PAD_STORES(ws, gw, 4);
    for (int row = gw; row < TOK; row += NGW) { GAS f32x4* xr = (GAS f32x4*)(x + (size_t)row * DM) + lane; f32x4 v[4]; v2u y0[4], y1[4]; f32x4 gtv[4]; float s = 0.f; const float cwa = nwa, cwb = nwb;
#pragma unroll
        for (int j = 0; j < 4; ++j) { v[j] = (f32x4){bflo(nx[j].x), bfhi(nx[j].x), bflo(nx[j].y), bfhi(nx[j].y)}; y0[j] = ny0[j]; y1[j] = ny1[j]; gtv[j] = ng[j]; }
        if (row + NGW < TOK) { const int r1 = row + NGW;
#pragma unroll
            for (int j = 0; j < 4; ++j) { nx[j] = ((const GAS v2u*)(xs + (size_t)r1 * DM) + lane)[64 * j]; ny0[j] = ((const GAS v2u*)(Y0 + (size_t)pa * DM) + lane)[64 * j]; ny1[j] = ((const GAS v2u*)(Y1 + (size_t)pb * DM) + lane)[64 * j];
                ng[j] = *(const f32x4*)(gate + (size_t)(r1 >> 12) * MODLD + 4 * lane + 256 * j); }
            nwa = wa; nwb = wb;
            if (r1 + NGW < TOK) { const int r2 = r1 + NGW; pa = tpos[r2]; pb = tpos[TOK + r2]; wa = tgw[2 * r2]; wb = tgw[2 * r2 + 1]; } }
#pragma unroll
        for (int j = 0; j < 4; ++j) { const f32x4 gt = gtv[j];
            const f32x4 mo = (f32x4){cwa * bflo(y0[j].x) + cwb * bflo(y1[j].x), cwa * bfhi(y0[j].x) + cwb * bfhi(y1[j].x), cwa * bflo(y0[j].y) + cwb * bflo(y1[j].y), cwa * bfhi(y0[j].y) + cwb * bfhi(y1[j].y)};
            v[j] = v[j] + gt * mo; s += (v[j].x * v[j].x + v[j].y * v[j].y) + (v[j].z * v[j].z + v[j].w * v[j].w); }
        const float rstd = 1.0f / sqrtf(wave_sum(s) * (1.0f / DM) + 1e-6f);
#pragma unroll
        for (int j = 0; j < 4; ++j) xr[64 * j] = v[j] * rstd * gs[j]; }
}

struct RwRoute { bf16* base[5]; int pitch[5]; float mu[5][8]; };
__device__ __forceinline__ void rw_route(int l, int lane, const float* mu_l, const float* mu_v, unsigned char* ws, RwRoute& R) {
#pragma unroll
    for (int j = 0; j < 5; ++j) { const int ci = lane + 64 * j, cr = ci * 8 - 448; const bool valid = ci >= 56 && (cr < 1792 || (l == 1 && cr < 1824));
        bf16* d; int st = RW;
        if (cr < 512) d = (bf16*)(ws + A_R) + cr;
        else if (cr < 1024) d = (bf16*)(ws + A_KRAW) + (cr - 512);
        else if (cr < 1536) d = (bf16*)(ws + (l == 0 ? WS_VFIRST : A_VRAW)) + (cr - 1024);
        else { st = KLORA; d = (bf16*)(ws + A_LA) + (cr < 1600 ? cr - 1536 : (cr < 1664 ? 64 + (cr - 1600) : (cr < 1792 ? 128 + (cr - 1664) : 256 + (cr - 1792)))); }
        R.base[j] = d; R.pitch[j] = st;
        const float* mup = (cr < 1792) ? mu_l + cr : mu_v + (cr - 1792);
#pragma unroll
        for (int e = 0; e < 8; ++e) R.mu[j][e] = valid ? mup[e] : 0.f; }
}
template <int J> __device__ __forceinline__ v4u rw_val(int lane, const v4u cur, const v4u prv, const RwRoute& R) {
    float p[8], q[8], xs[8];
    up8(cur, p); up8(prv, q);
#pragma unroll
    for (int e = 0; e < 8; ++e) xs[e] = p[e] + (q[e] - p[e]) * R.mu[J][e];
    if (J == 3) { if (lane >= 56) {
#pragma unroll
        for (int e = 0; e < 8; ++e) xs[e] = 1.0f - 2.0f * __builtin_amdgcn_rcpf(1.0f + __builtin_amdgcn_exp2f(2.885390081777927f * xs[e])); } }
    if (J == 4) { if (lane >= 8 && lane < 24) {
#pragma unroll
        for (int e = 0; e < 8; ++e) xs[e] = fsigmoid(xs[e]); } }
    return pk8(xs);
}
template <int J> __device__ __forceinline__ void rw_chunk(int m, int lane, const v4u cur, const v4u prv, const RwRoute& R) {
    float p[8], q[8], xs[8];
    up8(cur, p); up8(prv, q);
#pragma unroll
    for (int e = 0; e < 8; ++e) xs[e] = p[e] + (q[e] - p[e]) * R.mu[J][e];
    if (J == 3) { if (lane >= 56) {
#pragma unroll
        for (int e = 0; e < 8; ++e) xs[e] = 1.0f - 2.0f * __builtin_amdgcn_rcpf(1.0f + __builtin_amdgcn_exp2f(2.885390081777927f * xs[e])); } }
    if (J == 4) { if (lane >= 8 && lane < 24) {
#pragma unroll
        for (int e = 0; e < 8; ++e) xs[e] = fsigmoid(xs[e]); } }
    *(GAS v4u*)(R.base[J] + (size_t)m * R.pitch[J]) = pk8(xs);
}
__device__ __forceinline__ void prep_phase(int l, const InT in, unsigned char* ws, int gw, int NGW, int lane) {
    const bf16* PROJ = (const bf16*)(ws + A_PROJ);
    const int* pos = (const int*)in[2]; const float* mu_l = in[14] + (size_t)l * 1792; const float* mu_v = in[15];
    float gn[8];
    { const float* gp = (lane < 32) ? in[9] + (size_t)l * 256 + lane * 8 : in[11] + (size_t)l * 128 + ((lane - 32) & 15) * 8;
#pragma unroll
      for (int e = 0; e < 8; ++e) gn[e] = gp[e]; }
    float frq[8];
#pragma unroll
    for (int e = 0; e < 8; ++e) { const int i = 8 * (lane & 3) + e; frq[e] = __builtin_amdgcn_exp2f(-(float)i * (13.287712379549449f / 32.0f)) * 0.15915494309189535f; }
    RwRoute R; rw_route(l, lane, mu_l, mu_v, ws, R);
    for (int m0 = gw * 16; m0 < TOK; m0 += NGW * 16) {
        const int b0 = m0 >> 12;
        GAS unsigned char* d0b; int d0p;
        if (lane < 32) { d0b = (GAS unsigned char*)(ws + A_CQ) + lane * 16; d0p = 512; }
        else if (lane < 48) { d0b = (GAS unsigned char*)(ws + A_CKV) + (lane - 32) * 16; d0p = 256; }
        else if (lane < 56) { const int dim = 128 + (lane >= 52 ? 32 : 0) + 8 * (lane & 3); d0b = (GAS unsigned char*)(ws + A_KB) + ((size_t)(3 * b0) * SEQ * 192 + dim) * 2; d0p = 384; }
        else { d0b = (GAS unsigned char*)R.base[0]; d0p = R.pitch[0] * 2; }
        const int l7 = lane & 7, h7 = 1 + ((lane - 40) >> 3);
        GAS unsigned char* dkb = (GAS unsigned char*)(ws + A_KB) + ((size_t)(3 * b0 + h7) * SEQ * 192 + 128 + (l7 >= 4 ? 32 : 0) + 8 * (l7 & 3)) * 2;
        const int kpsrc = (48 + l7) * 4;
        const bool rw4 = lane < 24 || (l == 1 && lane < 28), act4 = rw4 || (lane >= 32 && lane < 48 && (l == 0 || lane >= 36));
        GAS unsigned char* d4b = rw4 ? (GAS unsigned char*)R.base[4] : (GAS unsigned char*)(ws + A_LA) + lane * 16; const int d4p = rw4 ? R.pitch[4] * 2 : KLORA * 2;
        v4u pv[5];
#pragma unroll
        for (int j = 0; j < 5; ++j) pv[j] = (v4u){0u, 0u, 0u, 0u};
        if ((m0 & (SEQ - 1)) != 0) {
#pragma unroll
            for (int j = 0; j < 5; ++j) if (j < 4 || lane < 32) pv[j] = *(const GAS v4u*)(PROJ + (size_t)(m0 - 1) * NPROJ + (lane + 64 * j) * 8); }
        v4u nc[5];
#pragma unroll
        for (int j = 0; j < 5; ++j) nc[j] = (j < 4 || lane < 32) ? *(const GAS v4u*)(PROJ + (size_t)m0 * NPROJ + (lane + 64 * j) * 8) : (v4u){0u, 0u, 0u, 0u};
        int posn = pos[m0];
        for (int r = 0; r < 16; ++r) { const int m = m0 + r; const int posc = posn; if (r < 15) posn = pos[m + 1];
        v4u cu[5];
#pragma unroll
        for (int j = 0; j < 5; ++j) cu[j] = nc[j];
        if (r < 15) {
#pragma unroll
            for (int j = 0; j < 5; ++j) nc[j] = (j < 4 || lane < 32) ? *(const GAS v4u*)(PROJ + (size_t)(m + 1) * NPROJ + (lane + 64 * j) * 8) : (v4u){0u, 0u, 0u, 0u}; }
        float p[8]; up8(cu[0], p);
        float ss = 0.f;
#pragma unroll
        for (int e = 0; e < 8; ++e) ss += p[e] * p[e];
        const float sq = wave_sum(lane < 32 ? ss : 0.f), skv = wave_sum((lane >= 32 && lane < 48) ? ss : 0.f);
        float oth[8];
#pragma unroll
        for (int e = 0; e < 8; ++e) oth[e] = lane_xor<4>(p[e]);
        v4u out0;
        if (lane < 32) { const float rstd = 1.0f / sqrtf(sq * (1.0f / 256.0f) + 1e-6f); float o[8];
#pragma unroll
            for (int e = 0; e < 8; ++e) o[e] = p[e] * rstd * gn[e];
            out0 = pk8(o); }
        else if (lane < 48) { const float rstd = 1.0f / sqrtf(skv * (1.0f / 128.0f) + 1e-6f); float o[8];
#pragma unroll
            for (int e = 0; e < 8; ++e) o[e] = p[e] * rstd * gn[e];
            out0 = pk8(o); }
        else if (lane < 56) { const float ps = (float)posc; const bool hi = lane >= 52; float o[8];
#pragma unroll
            for (int e = 0; e < 8; ++e) { float rev = ps * frq[e]; rev -= rintf(rev); const float cs = __builtin_amdgcn_cosf(rev), sn = __builtin_amdgcn_sinf(rev);
                o[e] = hi ? (p[e] * cs + oth[e] * sn) : (p[e] * cs - oth[e] * sn); }
            out0 = pk8(o); }
        else out0 = rw_val<0>(lane, cu[0], pv[0], R);
        *(GAS v4u*)(d0b + (size_t)m * d0p) = out0;
        { v4u kp; kp.x = (unsigned)__builtin_amdgcn_ds_bpermute(kpsrc, (int)out0.x); kp.y = (unsigned)__builtin_amdgcn_ds_bpermute(kpsrc, (int)out0.y);
          kp.z = (unsigned)__builtin_amdgcn_ds_bpermute(kpsrc, (int)out0.z); kp.w = (unsigned)__builtin_amdgcn_ds_bpermute(kpsrc, (int)out0.w);
          if (lane >= 40) *(GAS v4u*)(dkb + (size_t)m * 384) = kp; }
        rw_chunk<1>(m, lane, cu[1], pv[1], R); rw_chunk<2>(m, lane, cu[2], pv[2], R); rw_chunk<3>(m, lane, cu[3], pv[3], R);
        { v4u o4 = (v4u){0u, 0u, 0u, 0u}; if (rw4) o4 = rw_val<4>(lane, cu[4], pv[4], R);
          if (act4) *(GAS v4u*)(d4b + (size_t)m * d4p) = o4; }
#pragma unroll
        for (int j = 0; j < 5; ++j) pv[j] = ((m + 1) & (SEQ - 1)) ? cu[j] : (v4u){0u, 0u, 0u, 0u};
        }
    }
}
__device__ __forceinline__ void onorm_phase(const float* g, unsigned char* ws, int gw, int NGW, int lane) {
    float gn[8];
#pragma unroll
    for (int e = 0; e < 8; ++e) gn[e] = g[lane * 8 + e];
    for (int m = gw; m < TOK; m += NGW) { GAS v4u* pp = (GAS v4u*)((bf16*)(ws + A_YCAT) + (size_t)m * DM + lane * 8); float p[8]; up8(*pp, p); float ss = 0.f;
#pragma unroll
        for (int e = 0; e < 8; ++e) ss += p[e] * p[e];
        const float rstd = 1.0f / sqrtf(wave_sum(ss) * (1.0f / 512.0f) + 1e-6f);
#pragma unroll
        for (int e = 0; e < 8; ++e) p[e] = p[e] * rstd * gn[e];
        *pp = pk8(p); }
}

__device__ __forceinline__ void bias_rows(const bf16* W, int rows, const float* sh, float* ob, int ldb, int gw, int NGW, int lane) {
    for (int r0 = gw; r0 < rows; r0 += 4 * NGW) {
        v4u wv[4][2];
#pragma unroll
        for (int i = 0; i < 4; ++i) { const int r = r0 + i * NGW; const bool ok = r < rows; const bf16* wp = W + (size_t)(ok ? r : r0) * DM + lane * 8; wv[i][0] = *(const GAS v4u*)wp; wv[i][1] = *(const GAS v4u*)(wp + 512); }
        f32x4 ns[4];
#pragma unroll
        for (int j = 0; j < 4; ++j) ns[j] = *(const f32x4*)(sh + lane * 8 + 512 * (j >> 1) + 4 * (j & 1));
#pragma unroll
        for (int b = 0; b < NB; ++b) { f32x4 s4[4];
#pragma unroll
            for (int j = 0; j < 4; ++j) s4[j] = ns[j];
            if (b + 1 < NB) {
#pragma unroll
                for (int j = 0; j < 4; ++j) ns[j] = *(const f32x4*)(sh + (size_t)(b + 1) * MODLD + lane * 8 + 512 * (j >> 1) + 4 * (j & 1)); }
            float a[4];
#pragma unroll
            for (int i = 0; i < 4; ++i) { float w[16]; up8(wv[i][0], w); up8(wv[i][1], w + 8);
                a[i] = (w[0] * s4[0].x + w[1] * s4[0].y) + (w[2] * s4[0].z + w[3] * s4[0].w) + (w[4] * s4[1].x + w[5] * s4[1].y) + (w[6] * s4[1].z + w[7] * s4[1].w)
                     + (w[8] * s4[2].x + w[9] * s4[2].y) + (w[10] * s4[2].z + w[11] * s4[2].w) + (w[12] * s4[3].x + w[13] * s4[3].y) + (w[14] * s4[3].z + w[15] * s4[3].w); }
#pragma unroll
            for (int i = 0; i < 4; ++i) { a[i] = wave_sum(a[i]); const int r = r0 + i * NGW; if (lane == 0 && r < rows) ob[(size_t)b * ldb + r] = a[i]; } }
    }
}

__device__ __forceinline__ void route_scatter(unsigned char* ws, LAS unsigned char* lds, int vcu, int G, int wave, int lane, int tid) {
    LAS int* tot = (LAS int*)lds;
    LAS int* seg = tot + 16;
    LAS int* base = seg + 32;
    const GAS int* CNT = (const GAS int*)(ws + RT_CNT);
    LAS int* part = base + 16;
    { const int e = tid & 15, pr = tid >> 4; int s = 0;
#pragma unroll
      for (int w = 0; w < 8; ++w) s += CNT[(pr * 8 + w) * 16 + e];
      part[pr * 16 + e] = s; }
    __syncthreads();
    if (tid < 16) { int s = 0;
#pragma unroll
        for (int pr = 0; pr < 32; ++pr) s += part[pr * 16 + tid];
        tot[tid] = s; }
    __syncthreads();
    if (tid < 2) { int a = 0; for (int e = 0; e < 8; ++e) { seg[tid * 9 + e] = a; a += (tot[tid * 8 + e] + 255) & ~255; } seg[tid * 9 + 8] = a; }
    __syncthreads();
    GAS int* RIDX = (GAS int*)(ws + RT_RIDX); GAS float* RGW = (GAS float*)(ws + RT_RGW);
    if (vcu == 0 && tid < 2) { GAS int* TL = (GAS int*)(ws + RT_TILE) + tid * (PASS_TILES + 8); const int nt = seg[tid * 9 + 8] >> 8; TL[0] = nt;
        for (int e = 0; e < 8; ++e) for (int t = seg[tid * 9 + e] >> 8; t < (seg[tid * 9 + e + 1] >> 8); ++t) TL[8 + t] = e; }
    for (int pe = vcu; pe < 16; pe += G) { const int k = pe >> 3, e = pe & 7; const int s0 = seg[k * 9 + e] + tot[pe], s1 = seg[k * 9 + e + 1];
        for (int i = s0 + tid; i < s1; i += NTHR) { RIDX[k * PASS_ROWS + i] = -1; RGW[k * PASS_ROWS + i] = 0.f; } }
    for (int blk = vcu; blk < TOK / 128; blk += G) {
        __syncthreads();
        if (tid < 16) { int s = 0; const int fb = blk >> 3;
            for (int pr = 0; pr < fb; ++pr) s += part[pr * 16 + tid];
            for (int w = fb * 8; w < blk; ++w) s += CNT[w * 16 + tid];
            base[tid] = seg[(tid >> 3) * 9 + (tid & 7)] + s; }
        __syncthreads();
        if (wave < 2) { const int k = wave;
            int run[8];
#pragma unroll
            for (int e = 0; e < 8; ++e) run[e] = base[k * 8 + e];
            for (int r = 0; r < 2; ++r) { const int row = blk * 128 + r * 64 + lane; const int ex = *(const GAS int*)(ws + RT_SEL + (size_t)row * 8 + 4 * k); const float gwv = *(const GAS float*)(ws + RT_GW + (size_t)row * 8 + 4 * k);
                int mypos = 0;
#pragma unroll
                for (int e = 0; e < 8; ++e) { const unsigned long long mk = __ballot(ex == e); const int rank = __popcll(mk & ((1ull << lane) - 1ull)); if (ex == e) mypos = run[e] + rank; run[e] += __popcll(mk); }
                RIDX[k * PASS_ROWS + mypos] = row; RGW[k * PASS_ROWS + mypos] = gwv; *(GAS int*)(ws + RT_TPOS + ((size_t)k * TOK + row) * 4) = mypos; } }
    }
}

__device__ __forceinline__ void moe_combine(int nt, int G, int cap, int vcu, const float* slab, bf16* Y, int tid) {
    const pg8::G2Plan pl = pg8::g2_plan(nt, G, cap);
    if (pl.tail == 0) return;
    pg8::StaticOrder T; T.init(nt * 256, DM, 1, 0);
    const int wid = tid >> 6, lane = tid & 63, wr = wid >> 2, wc = wid & 3, fr = lane & 15, fq = lane >> 4;
    for (int it = vcu; it < pl.tail * 4; it += G) { const int tu = it >> 2, ai = (it >> 1) & 1, bj = it & 1;
        pg8::Unit u; T.next(pl.full + tu, u);
        f32x4 sm[4][2];
#pragma unroll
        for (int m = 0; m < 4; ++m)
#pragma unroll
            for (int n = 0; n < 2; ++n) sm[m][n] = (f32x4){0.f, 0.f, 0.f, 0.f};
        for (int kp = 0; kp < pl.spl; ++kp) { const float* sl = slab + (size_t)(tu * pl.spl + kp) * 65536;
#pragma unroll
            for (int m = 0; m < 4; ++m)
#pragma unroll
                for (int n = 0; n < 2; ++n) sm[m][n] += *(const f32x4*)(sl + ((size_t)((((ai * 2 + bj) * 4 + m) * 2 + n) * 512 + tid)) * 4); }
#pragma unroll
        for (int m = 0; m < 4; ++m) { const int srow = u.pm * 256 + ai * 128 + wr * 64 + m * 16 + fr;
#pragma unroll
            for (int n = 0; n < 2; ++n) { const int col = u.pn * 256 + wc * 32 + 4 * fq + bj * 128 + n * 16;
                *(v2u*)(Y + (size_t)srow * DM + col) = (v2u){cvt_pk_bf16(sm[m][n][0], sm[m][n][1]), cvt_pk_bf16(sm[m][n][2], sm[m][n][3])}; } }
    }
}

namespace att {
constexpr int KVB = 64, KROW = 400, SHM_K = KVB * KROW, SHM_V = KVB * 128 * 2;
constexpr int OFF_V = 0, OFF_K = 2 * SHM_V, OFF_WS = OFF_K + 2 * SHM_K, LDS_BYTES = OFF_WS + NWAVES * 64 * 4;
static_assert(LDS_BYTES <= RING_BYTES, "attention LDS");
#define SBAR() __builtin_amdgcn_sched_barrier(0)
__device__ __forceinline__ int v_st(int k, int c) { const int kk = (k & ~0xC) | ((k & 4) << 1) | ((k & 8) >> 1); return ((kk >> 3) * 4 + (c >> 5)) * 512 + ((kk & 7) * 32 + (c & 31)) * 2; }
__device__ __forceinline__ int v_rd_base(int lane) { return ((lane & 3) << 3) | (((lane >> 2) & 3) << 6) | (((lane >> 4) & 1) << 5) | (((lane >> 5) & 1) << 8); }
constexpr int v_rd_off(int d0, int ks, int half) { return d0 * 512 + ks * 4096 + half * 2048; }
__device__ __forceinline__ int crow(int r, int hi) { return (r & 3) + 8 * (r >> 2) + 4 * hi; }
__device__ __forceinline__ unsigned cvtpk(float lo, float hi) { return cvt_pk_bf16(lo, hi); }
__device__ __forceinline__ void mask_tile(f32x16& p0, f32x16& p1, int dq) {
    const float NEG = -__builtin_inff();
#pragma unroll
    for (int r = 0; r < 16; ++r) { const int c = (r & 3) + 8 * (r >> 2);
        if (dq - c < 0) p0[r] = NEG;
        if (dq - c - 32 < 0) p1[r] = NEG; }
}
template <int VB>
__device__ __forceinline__ void pv_tile(f32x16* o, int vb0, bf16x8 pa0, bf16x8 pa1, bf16x8 pa2, bf16x8 pa3) {
#define TRRD(dst, off) asm volatile("ds_read_b64_tr_b16 %0, %1 offset:%2" : "=&v"(dst) : "v"(vb0), "i"(off) : "memory")
#define PV_D0(d0) do { s16x4 l0, l1, l2, l3, h0, h1, h2, h3; constexpr int b_ = VB * SHM_V + v_rd_off(d0, 0, 0); \
        TRRD(l0, b_); TRRD(h0, b_ + 2048); TRRD(l1, b_ + 4096); TRRD(h1, b_ + 6144); TRRD(l2, b_ + 8192); TRRD(h2, b_ + 10240); TRRD(l3, b_ + 12288); TRRD(h3, b_ + 14336); \
        asm volatile("s_waitcnt lgkmcnt(0)" ::: "memory"); SBAR(); \
        o[d0] = __builtin_amdgcn_mfma_f32_32x32x16_bf16(pa0, (bf16x8){l0[0], l0[1], l0[2], l0[3], h0[0], h0[1], h0[2], h0[3]}, o[d0], 0, 0, 0); \
        o[d0] = __builtin_amdgcn_mfma_f32_32x32x16_bf16(pa1, (bf16x8){l1[0], l1[1], l1[2], l1[3], h1[0], h1[1], h1[2], h1[3]}, o[d0], 0, 0, 0); \
        o[d0] = __builtin_amdgcn_mfma_f32_32x32x16_bf16(pa2, (bf16x8){l2[0], l2[1], l2[2], l2[3], h2[0], h2[1], h2[2], h2[3]}, o[d0], 0, 0, 0); \
        o[d0] = __builtin_amdgcn_mfma_f32_32x32x16_bf16(pa3, (bf16x8){l3[0], l3[1], l3[2], l3[3], h3[0], h3[1], h3[2], h3[3]}, o[d0], 0, 0, 0); } while (0)
    PV_D0(0); PV_D0(1); PV_D0(2); PV_D0(3);
#undef PV_D0
#undef TRRD
}
template <int KBUF>
__device__ __forceinline__ void qkt(f32x16& p0, f32x16& p1, LAS unsigned char* lds, int r32, int hi, const bf16x8* qr, float negm) {
#pragma unroll
    for (int r = 0; r < 16; ++r) { p0[r] = negm; p1[r] = negm; }
    const LAS unsigned char* a = lds + OFF_K + KBUF * SHM_K + r32 * KROW + hi * 16;
#pragma unroll
    for (int d0 = 0; d0 < 12; ++d0) {
        const bf16x8 b0 = *(const LAS bf16x8*)(a + d0 * 32);
        const bf16x8 b1 = *(const LAS bf16x8*)(a + 32 * KROW + d0 * 32);
        p0 = __builtin_amdgcn_mfma_f32_32x32x16_bf16(b0, qr[d0], p0, 0, 0, 0);
        p1 = __builtin_amdgcn_mfma_f32_32x32x16_bf16(b1, qr[d0], p1, 0, 0, 0); }
}
__device__ __forceinline__ void attn_unit(int b, int h, int qb, const bf16* Q, const bf16* K, const bf16* V, bf16* O, const int* pos, LAS unsigned char* lds) {
    int tid_ = pg8::tid_now(); asm volatile("" : "+v"(tid_));
    const int tid = tid_, wid = __builtin_amdgcn_readfirstlane(tid >> 6), lane = tid & 63, r32 = lane & 31, hi = lane >> 5;
    const int m0 = b * SEQ + qb * 256 + wid * 32;
    const int qpos = qb * 256 + wid * 32;
    bf16x8 qr[12];
    { const bf16* qp = Q + (size_t)(m0 + r32) * NQ + h * 192 + hi * 8; const float C2 = 0.07216878364870323f * 1.4426950408889634f;
      float f[12][8];
#pragma unroll
      for (int d0 = 0; d0 < 12; ++d0) up8(*(const GAS v4u*)(qp + d0 * 16), f[d0]);
      const float ps = (float)pos[m0 + r32];
#pragma unroll
      for (int g = 0; g < 2; ++g)
#pragma unroll
          for (int e = 0; e < 8; ++e) { const int i = 16 * g + 8 * hi + e; float rev = ps * (__builtin_amdgcn_exp2f(-(float)i * (13.287712379549449f / 32.0f)) * 0.15915494309189535f); rev -= rintf(rev);
              const float cs = __builtin_amdgcn_cosf(rev), sn = __builtin_amdgcn_sinf(rev); const float t1 = f[8 + g][e], t2 = f[10 + g][e];
              f[8 + g][e] = t1 * cs - t2 * sn; f[10 + g][e] = t2 * cs + t1 * sn; }
#pragma unroll
      for (int d0 = 0; d0 < 12; ++d0) { v4u w; w.x = cvtpk(f[d0][0] * C2, f[d0][1] * C2); w.y = cvtpk(f[d0][2] * C2, f[d0][3] * C2); w.z = cvtpk(f[d0][4] * C2, f[d0][5] * C2); w.w = cvtpk(f[d0][6] * C2, f[d0][7] * C2);
          qr[d0] = __builtin_bit_cast(bf16x8, w); } }
    const bf16* Kh = K + (size_t)(b * 4 + h) * SEQ * 192; const bf16* Vh = V + (size_t)(b * 4 + h) * SEQ * 128;
    const int NT = (qb + 1) * 4;
    LAS float* wsl = (LAS float*)(lds + OFF_WS) + wid * 64; LAS float* li_l = wsl; LAS float* al_l = wsl + 32;
    float m_reg = 0.f, l_reg = 0.f; f32x16 o[4] = {};
    const int sr = tid >> 4, sc = (tid & 15) * 8, vst0 = v_st(sr, sc), vst1 = v_st(32 + sr, sc);
    const int vb0 = (int)(uintptr_t)(lds + OFF_V) + v_rd_base(lane);
    int kq[3], kl[3];
#pragma unroll
    for (int i = 0; i < 3; ++i) { const int q = tid + 512 * i; kq[i] = q * 8; kl[i] = (q / 24) * KROW + (q % 24) * 16; }
    v4u sk[3], sv[2];
#define ST_LOAD(t) do { const bf16* kp_ = Kh + (size_t)(t) * KVB * 192; const bf16* vp_ = Vh + (size_t)(t) * KVB * 128; \
        _Pragma("unroll") for (int i = 0; i < 3; ++i) sk[i] = *(const GAS v4u*)(kp_ + kq[i]); \
        sv[0] = *(const GAS v4u*)(vp_ + (size_t)sr * 128 + sc); sv[1] = *(const GAS v4u*)(vp_ + (size_t)(32 + sr) * 128 + sc); } while (0)
#define ST_WRITE(bf) do { _Pragma("unroll") for (int i = 0; i < 3; ++i) *(LAS v4u*)(lds + OFF_K + (bf) * SHM_K + kl[i]) = sk[i]; \
        *(LAS v4u*)(lds + OFF_V + (bf) * SHM_V + vst0) = sv[0]; *(LAS v4u*)(lds + OFF_V + (bf) * SHM_V + vst1) = sv[1]; } while (0)
#define TILE_STEP(t, BF) do { f32x16 p0, p1; \
        if ((t) + 1 < NT) ST_LOAD((t) + 1); \
        qkt<BF>(p0, p1, lds, r32, hi, qr, -m_reg); \
        { const int kb_ = (t) * KVB; if (kb_ + KVB - 1 > qpos) mask_tile(p0, p1, qpos + r32 - 4 * hi - kb_); } \
        float pmax; { float t_[16]; _Pragma("unroll") for (int r = 0; r < 16; ++r) t_[r] = fmaxf(p0[r], p1[r]);            \
            _Pragma("unroll") for (int r = 0; r < 8; ++r) t_[r] = fmaxf(t_[r], t_[r + 8]); _Pragma("unroll") for (int r = 0; r < 4; ++r) t_[r] = fmaxf(t_[r], t_[r + 4]); \
            pmax = fmaxf(fmaxf(t_[0], t_[1]), fmaxf(t_[2], t_[3])); } \
        { auto rr = __builtin_amdgcn_permlane32_swap(__float_as_uint(pmax), __float_as_uint(pmax), false, false); pmax = fmaxf(__uint_as_float(rr[0]), __uint_as_float(rr[1])); } \
        float alpha = 1.f; \
          \
        if (!__builtin_expect((t) > 0 && __all(pmax <= 11.5f), 1)) { const float sh = (t) > 0 ? fmaxf(pmax, 0.f) : pmax; alpha = (t) > 0 ? __builtin_amdgcn_exp2f(-sh) : 1.f; m_reg += sh; \
            _Pragma("unroll") for (int r = 0; r < 16; ++r) { p0[r] -= sh; p1[r] -= sh; } } \
        float psum; { float t_[16]; _Pragma("unroll") for (int r = 0; r < 16; ++r) { p0[r] = __builtin_amdgcn_exp2f(p0[r]); p1[r] = __builtin_amdgcn_exp2f(p1[r]); t_[r] = p0[r] + p1[r]; } \
            _Pragma("unroll") for (int r = 0; r < 8; ++r) t_[r] += t_[r + 8]; _Pragma("unroll") for (int r = 0; r < 4; ++r) t_[r] += t_[r + 4]; psum = (t_[0] + t_[1]) + (t_[2] + t_[3]); } \
        { auto rr = __builtin_amdgcn_permlane32_swap(__float_as_uint(psum), __float_as_uint(psum), false, false); psum = __uint_as_float(rr[0]) + __uint_as_float(rr[1]); } \
        l_reg = l_reg * alpha + psum; \
        bf16x8 pa0, pa1, pa2, pa3; \
        PK4(p0, 0, pa0); PK4(p0, 8, pa1); PK4(p1, 0, pa2); PK4(p1, 8, pa3); \
        if (__any(alpha < 1.f)) { if (hi == 0) al_l[r32] = alpha; asm volatile("s_waitcnt lgkmcnt(0)" ::: "memory"); \
            _Pragma("unroll") for (int d_ = 0; d_ < 4; ++d_) _Pragma("unroll") for (int r = 0; r < 16; ++r) o[d_][r] *= al_l[crow(r, hi)]; } \
        pv_tile<BF>(o, vb0, pa0, pa1, pa2, pa3); \
        if ((t) + 1 < NT) { VM_WAIT(); ST_WRITE(1 - (BF)); } \
        __syncthreads(); } while (0)
#define PK4(P, B_, OUT) do { unsigned a0 = cvtpk(P[B_+0], P[B_+1]), a1 = cvtpk(P[B_+2], P[B_+3]); \
        unsigned b0 = cvtpk(P[B_+4], P[B_+5]), b1 = cvtpk(P[B_+6], P[B_+7]); \
        auto r0 = __builtin_amdgcn_permlane32_swap(a0, b0, false, false); auto r1 = __builtin_amdgcn_permlane32_swap(a1, b1, false, false); \
        v4u w = {r0[0], r1[0], r0[1], r1[1]}; OUT = __builtin_bit_cast(bf16x8, w); } while (0)
    __syncthreads();
    ST_LOAD(0); VM_WAIT(); ST_WRITE(0);
    __syncthreads();
    for (int t = 0; t < NT; t += 2) { TILE_STEP(t, 0); TILE_STEP(t + 1, 1); }
#undef PK4
#undef TILE_STEP
#undef ST_LOAD
#undef ST_WRITE
    if (hi == 0) li_l[r32] = l_reg;
    asm volatile("s_waitcnt lgkmcnt(0)" ::: "memory");
    float rli[16];
#pragma unroll
    for (int r = 0; r < 16; ++r) rli[r] = __builtin_amdgcn_rcpf(li_l[crow(r, hi)]);
    bf16* Ow = O + (size_t)m0 * DM + h * 128;
#pragma unroll
    for (int r = 0; r < 16; ++r) { const int orow = crow(r, hi);
#pragma unroll
        for (int d0 = 0; d0 < 4; ++d0) { const float v = o[d0][r] * rli[r]; const float vn = lane_xor<1>(v);
            if ((r32 & 1) == 0) *(GAS unsigned*)(Ow + (size_t)orow * DM + d0 * 32 + r32) = cvtpk(v, vn); } }
}
}


namespace rk {
constexpr int RS1 = 144, RS2 = 80;
constexpr int O_AH = 0, O_BH = 4608, O_KH = 9216, O_RH = 13824;
constexpr int O_A2 = 0, O_A3 = 2560, O_A4 = 5120, O_PT = 7680, O_UT = 12800;
constexpr int O_BT = 18432, O_KT = 23552, O_VT = 28672, O_A1 = 33792, O_WC = 37888, UNIT_LDS = 38144;
static_assert(4 * UNIT_LDS <= RING_BYTES, "rwkv precompute LDS");
__device__ __forceinline__ int crow(int r, int hi) { return (r & 3) + 8 * (r >> 2) + 4 * hi; }
__device__ __forceinline__ float xsum32(float v) { const auto rr = __builtin_amdgcn_permlane32_swap(__float_as_uint(v), __float_as_uint(v), false, false); return __uint_as_float(rr[0]) + __uint_as_float(rr[1]); }
#define RK_FRAG(off, row, stride, q) (*(const LAS bf16x8*)(U + (off) + (row) * (stride) + (16 * (q) + 8 * hi) * 2))
#define RK_MFMA(a, b, c) __builtin_amdgcn_mfma_f32_32x32x16_bf16((a), (b), (c), 0, 0, 0)

__device__ __forceinline__ void pre_unit(int l, int b, int hd, int ck, unsigned char* ws, LAS unsigned char* U, unsigned char* dummy = nullptr  ) {
    int lane_ = (int)__builtin_amdgcn_mbcnt_hi(~0u, __builtin_amdgcn_mbcnt_lo(~0u, 0u)); asm volatile("" : "+v"(lane_));
    const int lane = lane_, r32 = lane & 31, hi = lane >> 5;
    const int tok0 = b * SEQ + ck * 32;
    const size_t gofs = (size_t)tok0 * RW + hd * 64;
    bf16* Rg = (bf16*)(ws + A_R) + gofs; bf16* Kg = (bf16*)(ws + A_KRAW) + gofs; bf16* KKg = (bf16*)(ws + A_KK) + gofs; bf16* BVg = (bf16*)(ws + A_BV) + gofs;
    const bf16* Vg = (const bf16*)(ws + ((l == 0) ? WS_VFIRST : A_VRAW)) + gofs; float* LWg = (float*)(ws + A_LW) + gofs; const bf16* LHg = (const bf16*)(ws + A_LWH) + gofs;
    bf16* Rd = dummy ? (bf16*)dummy + gofs : Rg; bf16* Kd = dummy ? (bf16*)dummy + gofs : Kg; bf16* KKd = dummy ? (bf16*)dummy + gofs : KKg; bf16* BVd = dummy ? (bf16*)dummy + gofs : BVg; float* LWd = dummy ? (float*)dummy + (gofs & ((1u << 22) - 1)) : LWg;
    { v4u ld[5][4]; v4u lq[4];
#pragma unroll
      for (int i = 0; i < 4; ++i) { const int c = lane + 64 * i; const size_t o = (size_t)(c >> 3) * RW + (c & 7) * 8;
          ld[0][i] = *(const GAS v4u*)(Rg + o); ld[1][i] = *(const GAS v4u*)(Kg + o); ld[2][i] = *(const GAS v4u*)(KKg + o); ld[3][i] = *(const GAS v4u*)(BVg + o); ld[4][i] = *(const GAS v4u*)(Vg + o); }
#pragma unroll
      for (int i = 0; i < 4; ++i) { const int c = lane + 64 * i; lq[i] = *(const GAS v4u*)(LHg + (size_t)(c >> 3) * RW + (c & 7) * 8); }
#pragma unroll
      for (int i = 0; i < 4; ++i) { const int c = lane + 64 * i, lo = (c >> 3) * RS1 + (c & 7) * 16;
          *(LAS v4u*)(U + O_RH + lo) = ld[0][i]; *(LAS v4u*)(U + O_KH + lo) = ld[1][i]; *(LAS v4u*)(U + O_AH + lo) = ld[2][i]; *(LAS v4u*)(U + O_BH + lo) = ld[3][i];
          *(LAS v4u*)(U + O_A1 + (c >> 3) * 128 + (c & 7) * 16) = ld[4][i]; }
#pragma unroll
      for (int i = 0; i < 4; ++i) { const int c = lane + 64 * i; *(LAS v4u*)(U + O_KT + (c >> 3) * 128 + (c & 7) * 16) = lq[i]; } }
    LDS_WAIT(); asm volatile("" ::: "memory");
#if defined(RK_DRYCUT)
    if (dummy && RK_DRYCUT == 1) return;
#endif
    { float E[32]; float L = 0.f;
#pragma unroll
      for (int t = 0; t < 32; ++t) { L += bf2f(*(const LAS unsigned short*)(U + O_KT + t * 128 + lane * 2)); E[t] = __expf(L); }
      LDS_WAIT(); asm volatile("" ::: "memory");
#pragma unroll
      for (int t8 = 0; t8 < 32; t8 += 8) {
          float bh[8], kh[8]; unsigned short vv[8];
#pragma unroll
          for (int u = 0; u < 8; ++u) { const int t = t8 + u; const float E1 = E[t], E2 = __builtin_amdgcn_rcpf(E1), E3 = t ? E[t - 1] : 1.f;
              LAS unsigned short* pa = (LAS unsigned short*)(U + O_AH + t * RS1 + lane * 2); LAS unsigned short* pr = (LAS unsigned short*)(U + O_RH + t * RS1 + lane * 2);
              LAS unsigned short* pb = (LAS unsigned short*)(U + O_BH + t * RS1 + lane * 2); LAS unsigned short* pk = (LAS unsigned short*)(U + O_KH + t * RS1 + lane * 2);
              const float ah = -bf2f(*pa) * E3, rh = bf2f(*pr) * E1; bh[u] = bf2f(*pb) * E2; kh[u] = bf2f(*pk) * E2; vv[u] = *(const LAS unsigned short*)(U + O_A1 + t * 128 + lane * 2);
              *pa = (unsigned short)cvt_pk_bf16(ah, 0.f); *pr = (unsigned short)cvt_pk_bf16(rh, 0.f); *pb = (unsigned short)cvt_pk_bf16(bh[u], 0.f); *pk = (unsigned short)cvt_pk_bf16(kh[u], 0.f); }
          v4u w;
          w.x = cvt_pk_bf16(bh[0], bh[1]); w.y = cvt_pk_bf16(bh[2], bh[3]); w.z = cvt_pk_bf16(bh[4], bh[5]); w.w = cvt_pk_bf16(bh[6], bh[7]); *(LAS v4u*)(U + O_BT + lane * RS2 + t8 * 2) = w;
          w.x = cvt_pk_bf16(kh[0], kh[1]); w.y = cvt_pk_bf16(kh[2], kh[3]); w.z = cvt_pk_bf16(kh[4], kh[5]); w.w = cvt_pk_bf16(kh[6], kh[7]); *(LAS v4u*)(U + O_KT + lane * RS2 + t8 * 2) = w;
          w.x = (unsigned)vv[0] | ((unsigned)vv[1] << 16); w.y = (unsigned)vv[2] | ((unsigned)vv[3] << 16); w.z = (unsigned)vv[4] | ((unsigned)vv[5] << 16); w.w = (unsigned)vv[6] | ((unsigned)vv[7] << 16); *(LAS v4u*)(U + O_VT + lane * RS2 + t8 * 2) = w;
      }
      *(LAS float*)(U + O_WC + lane * 4) = E[31]; }
    LDS_WAIT(); asm volatile("" ::: "memory");
#if defined(RK_DRYCUT)
    if (dummy && RK_DRYCUT == 2) return;
#endif
    f32x16 X[4];
    f32x16 rhc[2];
    { f32x16 d1 = {}, d2 = {}, d3 = {}, d4 = {};
#pragma unroll
      for (int q = 0; q < 4; ++q) { const bf16x8 fa = RK_FRAG(O_AH, r32, RS1, q), fb = RK_FRAG(O_BH, r32, RS1, q), fk = RK_FRAG(O_KH, r32, RS1, q), fr = RK_FRAG(O_RH, r32, RS1, q);
          d1 = RK_MFMA(fb, fa, d1); d2 = RK_MFMA(fk, fa, d2); d3 = RK_MFMA(fb, fr, d3); d4 = RK_MFMA(fk, fr, d4); }
#pragma unroll
      for (int jt = 0; jt < 2; ++jt)
#pragma unroll
          for (int r = 0; r < 16; ++r) { X[jt][r] = bf2f(*(const LAS unsigned short*)(U + O_AH + crow(r, hi) * RS1 + (r32 + 32 * jt) * 2)); rhc[jt][r] = bf2f(*(const LAS unsigned short*)(U + O_RH + crow(r, hi) * RS1 + (r32 + 32 * jt) * 2)); }
      LDS_WAIT(); asm volatile("" ::: "memory");
#pragma unroll
      for (int r = 0; r < 16; ++r) { const int s = crow(r, hi); const bool lt = s < r32, le = s <= r32; d1[r] = lt ? d1[r] : 0.f; d2[r] = lt ? d2[r] : 0.f; d3[r] = le ? d3[r] : 0.f; d4[r] = le ? d4[r] : 0.f; }
#pragma unroll
      for (int g = 0; g < 4; ++g) { const int so = 8 * g + 4 * hi;
          *(LAS f32x4*)(U + O_A1 + r32 * 128 + so * 4) = (f32x4){d1[4 * g], d1[4 * g + 1], d1[4 * g + 2], d1[4 * g + 3]};
          *(LAS v2u*)(U + O_A2 + r32 * RS2 + so * 2) = (v2u){cvt_pk_bf16(d2[4 * g], d2[4 * g + 1]), cvt_pk_bf16(d2[4 * g + 2], d2[4 * g + 3])};
          *(LAS v2u*)(U + O_A3 + r32 * RS2 + so * 2) = (v2u){cvt_pk_bf16(d3[4 * g], d3[4 * g + 1]), cvt_pk_bf16(d3[4 * g + 2], d3[4 * g + 3])};
          *(LAS v2u*)(U + O_A4 + r32 * RS2 + so * 2) = (v2u){cvt_pk_bf16(d4[4 * g], d4[4 * g + 1]), cvt_pk_bf16(d4[4 * g + 2], d4[4 * g + 3])}; } }
    LDS_WAIT(); asm volatile("" ::: "memory");
#if defined(RK_DRYCUT)
    if (dummy && RK_DRYCUT == 3) return;
#endif
    X[2] = f32x16{}; X[3] = f32x16{};
#pragma unroll
    for (int q = 0; q < 2; ++q) { const bf16x8 fa = RK_FRAG(O_A2, r32, RS2, q);
        X[2] = RK_MFMA(fa, RK_FRAG(O_VT, r32, RS2, q), X[2]); X[3] = RK_MFMA(fa, RK_FRAG(O_VT, r32 + 32, RS2, q), X[3]); }
#ifndef RK_NOSOLVE
    { typedef float f32x2s __attribute__((ext_vector_type(2)));
      f32x2s XP[2][16];
#pragma unroll
      for (int r = 0; r < 16; ++r) { XP[0][r] = (f32x2s){X[0][r], X[1][r]}; XP[1][r] = (f32x2s){X[2][r], X[3][r]}; }
#pragma unroll
      for (int t = 1; t < 32; ++t) {
          f32x2s a0 = {0.f, 0.f}, a1 = {0.f, 0.f};
#pragma unroll
          for (int g = 0; g < 4; ++g) if (8 * g < t) { const f32x4 cf = *(const LAS f32x4*)(U + O_A1 + t * 128 + (8 * g + 4 * hi) * 4);
#pragma unroll
              for (int e = 0; e < 4; ++e) { const f32x2s c2 = {cf[e], cf[e]}; a0 = __builtin_elementwise_fma(c2, XP[0][4 * g + e], a0); a1 = __builtin_elementwise_fma(c2, XP[1][4 * g + e], a1); } }
          const float p0 = xsum32(a0.x), p1 = xsum32(a0.y), p2 = xsum32(a1.x), p3 = xsum32(a1.y);
          const bool own = hi == ((t >> 2) & 1); const int rt = (t & 3) + 4 * (t >> 3);
          XP[0][rt] += own ? (f32x2s){p0, p1} : (f32x2s){0.f, 0.f}; XP[1][rt] += own ? (f32x2s){p2, p3} : (f32x2s){0.f, 0.f};
      }
#pragma unroll
      for (int r = 0; r < 16; ++r) { X[0][r] = XP[0][r].x; X[1][r] = XP[0][r].y; X[2][r] = XP[1][r].x; X[3][r] = XP[1][r].y; } }
#endif
#if defined(RK_DRYCUT)
    if (dummy && RK_DRYCUT == 4) return;
#endif
#pragma unroll
    for (int tl = 0; tl < 4; ++tl)
#pragma unroll
        for (int g = 0; g < 4; ++g) *(LAS v2u*)(U + (tl < 2 ? O_PT : O_UT) + (r32 + 32 * (tl & 1)) * RS2 + (8 * g + 4 * hi) * 2) = (v2u){cvt_pk_bf16(X[tl][4 * g], X[tl][4 * g + 1]), cvt_pk_bf16(X[tl][4 * g + 2], X[tl][4 * g + 3])};
    LDS_WAIT(); asm volatile("" ::: "memory");
    const float wc0 = *(const LAS float*)(U + O_WC + r32 * 4), wc1 = *(const LAS float*)(U + O_WC + (r32 + 32) * 4);
#if defined(RK_DRYCUT)
    if (dummy && RK_DRYCUT == 5) return;
#endif
    { f32x16 y0 = {}, y1 = {};
#pragma unroll
      for (int q = 0; q < 2; ++q) { const bf16x8 f3 = RK_FRAG(O_A3, r32, RS2, q), f4 = RK_FRAG(O_A4, r32, RS2, q);
          rhc[0] = RK_MFMA(f3, RK_FRAG(O_PT, r32, RS2, q), rhc[0]); rhc[1] = RK_MFMA(f3, RK_FRAG(O_PT, r32 + 32, RS2, q), rhc[1]);
          y0 = RK_MFMA(f3, RK_FRAG(O_UT, r32, RS2, q), y0); y1 = RK_MFMA(f3, RK_FRAG(O_UT, r32 + 32, RS2, q), y1);
          y0 = RK_MFMA(f4, RK_FRAG(O_VT, r32, RS2, q), y0); y1 = RK_MFMA(f4, RK_FRAG(O_VT, r32 + 32, RS2, q), y1); }
#pragma unroll
      for (int jt = 0; jt < 2; ++jt) { const int j = r32 + 32 * jt, pj = (j & ~0xC) | ((j & 4) << 1) | ((j & 8) >> 1);
#pragma unroll
          for (int r = 0; r < 16; ++r) Rd[(size_t)crow(r, hi) * RW + pj] = (unsigned short)cvt_pk_bf16(rhc[jt][r], 0.f); }
#pragma unroll
      for (int it = 0; it < 2; ++it)
#pragma unroll
          for (int hf = 0; hf < 2; ++hf) { const f32x16& y = it ? y1 : y0; const int off = ((it * 2 + hf) * 64 + lane) * 16;
              v4u w; w.x = cvt_pk_bf16(y[8 * hf], y[8 * hf + 1]); w.y = cvt_pk_bf16(y[8 * hf + 2], y[8 * hf + 3]); w.z = cvt_pk_bf16(y[8 * hf + 4], y[8 * hf + 5]); w.w = cvt_pk_bf16(y[8 * hf + 6], y[8 * hf + 7]);
              __builtin_nontemporal_store(w, (GAS v4u*)((unsigned char*)KKd + (size_t)(off >> 7) * (RW * 2) + (off & 127))); } }
#if defined(RK_DRYCUT)
    if (dummy && RK_DRYCUT == 6) return;
#endif
#pragma unroll
    for (int tj = 0; tj < 2; ++tj)
#pragma unroll
        for (int tp = 0; tp < 2; ++tp) { f32x16 z = {};
#pragma unroll
            for (int q = 0; q < 2; ++q) z = RK_MFMA(RK_FRAG(O_PT, r32 + 32 * tj, RS2, q), RK_FRAG(O_BT, r32 + 32 * tp, RS2, q), z);
            const float wc = tp ? wc1 : wc0;
#ifdef RK_SELFCHK
            if (ck == 3) { float num = 0.f, den = 0.f;
                for (int r = 0; r < 16; ++r) { const int jj = crow(r, hi) + 32 * tj, jp = r32 + 32 * tp; float ref = 0.f;
                    for (int t = 0; t < 32; ++t) ref += bf2f(*(const LAS unsigned short*)(U + O_PT + jj * RS2 + t * 2)) * bf2f(*(const LAS unsigned short*)(U + O_BT + jp * RS2 + t * 2));
                    const float d = z[r] - ref; num += d * d; den += ref * ref; }
                num = wave_sum(num); den = wave_sum(den); if (lane == 0) { atomicAdd((float*)(ws + WS_CTL) + 84, num); atomicAdd((float*)(ws + WS_CTL) + 85, den); } }
#endif
#pragma unroll
            for (int r = 0; r < 16; ++r) z[r] = (z[r] + ((tj == tp && crow(r, hi) == r32) ? 1.f : 0.f)) * wc;
#pragma unroll
            for (int hf = 0; hf < 2; ++hf) { const int off = (((tj * 2 + tp) * 2 + hf) * 64 + lane) * 16;
                v4u w; w.x = cvt_pk_bf16(z[8 * hf], z[8 * hf + 1]); w.y = cvt_pk_bf16(z[8 * hf + 2], z[8 * hf + 3]); w.z = cvt_pk_bf16(z[8 * hf + 4], z[8 * hf + 5]); w.w = cvt_pk_bf16(z[8 * hf + 6], z[8 * hf + 7]);
                __builtin_nontemporal_store(w, (GAS v4u*)((unsigned char*)LWd + (size_t)(off >> 8) * (RW * 4) + (off & 255))); } }
#if defined(RK_DRYCUT)
    if (dummy && RK_DRYCUT == 7) return;
#endif
#pragma unroll
    for (int tp = 0; tp < 2; ++tp)
#pragma unroll
        for (int ti = 0; ti < 2; ++ti) { f32x16 z = {};
#pragma unroll
            for (int q = 0; q < 2; ++q) { z = RK_MFMA(RK_FRAG(O_BT, r32 + 32 * tp, RS2, q), RK_FRAG(O_UT, r32 + 32 * ti, RS2, q), z); z = RK_MFMA(RK_FRAG(O_KT, r32 + 32 * tp, RS2, q), RK_FRAG(O_VT, r32 + 32 * ti, RS2, q), z); }
#pragma unroll
            for (int g = 0; g < 4; ++g) { const f32x4 wv = *(const LAS f32x4*)(U + O_WC + (32 * tp + 8 * g + 4 * hi) * 4);
#pragma unroll
                for (int e = 0; e < 4; ++e) z[4 * g + e] *= wv[e]; }
#ifdef RK_SELFCHK
            if (ck == 3) { float num = 0.f, den = 0.f;
                for (int r = 0; r < 16; ++r) { const int jp = crow(r, hi) + 32 * tp, ii = r32 + 32 * ti; float ref = 0.f;
                    for (int t = 0; t < 32; ++t) ref += bf2f(*(const LAS unsigned short*)(U + O_BT + jp * RS2 + t * 2)) * bf2f(*(const LAS unsigned short*)(U + O_UT + ii * RS2 + t * 2)) + bf2f(*(const LAS unsigned short*)(U + O_KT + jp * RS2 + t * 2)) * bf2f(*(const LAS unsigned short*)(U + O_VT + ii * RS2 + t * 2));
                    ref *= *(const LAS float*)(U + O_WC + jp * 4); const float d = z[r] - ref; num += d * d; den += ref * ref; }
                num = wave_sum(num); den = wave_sum(den); if (lane == 0) { atomicAdd((float*)(ws + WS_CTL) + 82, num); atomicAdd((float*)(ws + WS_CTL) + 83, den); } }
#endif
            unsigned char* dst = (unsigned char*)(tp ? BVd : Kd);
#pragma unroll
            for (int hf = 0; hf < 2; ++hf) { const int off = ((ti * 2 + hf) * 64 + lane) * 16;
                v4u w; w.x = cvt_pk_bf16(z[8 * hf], z[8 * hf + 1]); w.y = cvt_pk_bf16(z[8 * hf + 2], z[8 * hf + 3]); w.z = cvt_pk_bf16(z[8 * hf + 4], z[8 * hf + 5]); w.w = cvt_pk_bf16(z[8 * hf + 6], z[8 * hf + 7]);
                __builtin_nontemporal_store(w, (GAS v4u*)(dst + (size_t)(off >> 7) * (RW * 2) + (off & 127))); } }
    LDS_WAIT(); asm volatile("" ::: "memory");
}

constexpr int SCAN_SLOT = 18 * 1024, SCAN_LDS = 2 * SCAN_SLOT;
__device__ __forceinline__ void scan_unit(int q, int ih, unsigned char* ws, LAS unsigned char* ring, LAS unsigned char* yst  ) {
    const int lane = (int)__builtin_amdgcn_mbcnt_hi(~0u, __builtin_amdgcn_mbcnt_lo(~0u, 0u)), r32 = lane & 31, hi = lane >> 5;
    const int b = q >> 3, hd = q & 7;
    const size_t gofs0 = (size_t)b * SEQ * RW + hd * 64;
    const unsigned char* Rg = (const unsigned char*)((const bf16*)(ws + A_R) + gofs0); const unsigned char* Kg = (const unsigned char*)((const bf16*)(ws + A_KRAW) + gofs0);
    const unsigned char* KKg = (const unsigned char*)((const bf16*)(ws + A_KK) + gofs0); const unsigned char* BVg = (const unsigned char*)((const bf16*)(ws + A_BV) + gofs0);
    const unsigned char* LWg = (const unsigned char*)((const float*)(ws + A_LW) + gofs0);
    GAS unsigned char* Yg = (GAS unsigned char*)((bf16*)(ws + A_YCAT) + (size_t)b * SEQ * DM + 512 + hd * 64 + 32 * ih) + (size_t)(lane >> 2) * (DM * 2) + (lane & 3) * 16;
    int oR[4], oY[2], oM[8], oG[4];
#pragma unroll
    for (int k = 0; k < 4; ++k) oR[k] = r32 * (RW * 2) + (16 * k + 8 * hi) * 2;
#pragma unroll
    for (int hf = 0; hf < 2; ++hf) { const int off = ((ih * 2 + hf) * 64 + lane) * 16; oY[hf] = (off >> 7) * (RW * 2) + (off & 127); }
#pragma unroll
    for (int m = 0; m < 8; ++m) { const int off = (m * 64 + lane) * 16; oM[m] = (off >> 8) * (RW * 4) + (off & 255); }
#pragma unroll
    for (int tp = 0; tp < 2; ++tp)
#pragma unroll
        for (int hf = 0; hf < 2; ++hf) { const int off = ((ih * 2 + hf) * 64 + lane) * 16; oG[tp * 2 + hf] = (off >> 7) * (RW * 2) + (off & 127); }
#define RK_DMA(ck, slot) do { const size_t cb2 = (size_t)(ck) * 32 * (RW * 2), cb4 = (size_t)(ck) * 32 * (RW * 4); LAS unsigned char* sl_ = ring + (slot) * SCAN_SLOT; \
        _Pragma("unroll") for (int k = 0; k < 4; ++k) __builtin_amdgcn_global_load_lds((const unsigned*)(Rg + cb2 + oR[k]), (LAS unsigned*)(sl_ + k * 1024), 16, 0, 0); \
        _Pragma("unroll") for (int k = 0; k < 2; ++k) __builtin_amdgcn_global_load_lds((const unsigned*)(KKg + cb2 + oY[k]), (LAS unsigned*)(sl_ + (4 + k) * 1024), 16, 0, 0); \
        _Pragma("unroll") for (int k = 0; k < 8; ++k) __builtin_amdgcn_global_load_lds((const unsigned*)(LWg + cb4 + oM[k]), (LAS unsigned*)(sl_ + (6 + k) * 1024), 16, 0, 0); \
        __builtin_amdgcn_global_load_lds((const unsigned*)(Kg + cb2 + oG[0]), (LAS unsigned*)(sl_ + 14 * 1024), 16, 0, 0); __builtin_amdgcn_global_load_lds((const unsigned*)(Kg + cb2 + oG[1]), (LAS unsigned*)(sl_ + 15 * 1024), 16, 0, 0); \
        __builtin_amdgcn_global_load_lds((const unsigned*)(BVg + cb2 + oG[2]), (LAS unsigned*)(sl_ + 16 * 1024), 16, 0, 0); __builtin_amdgcn_global_load_lds((const unsigned*)(BVg + cb2 + oG[3]), (LAS unsigned*)(sl_ + 17 * 1024), 16, 0, 0); } while (0)
    f32x16 S0 = {}, S1 = {};
    RK_DMA(0, 0); RK_DMA(1, 1);
#pragma unroll 1
    for (int ck = 0; ck < SEQ / 32; ++ck) {
        if (ck < 2 || ck == SEQ / 32 - 1) asm volatile("s_waitcnt vmcnt(0)" ::: "memory"); else asm volatile("s_waitcnt vmcnt(22)" ::: "memory");
        const LAS unsigned char* sl = ring + (ck & 1) * SCAN_SLOT + lane * 16;
        v4u cR[4], cY[2], cM[8], cG[4];
#pragma unroll
        for (int k = 0; k < 4; ++k) cR[k] = *(const LAS v4u*)(sl + k * 1024);
#pragma unroll
        for (int k = 0; k < 2; ++k) cY[k] = *(const LAS v4u*)(sl + (4 + k) * 1024);
#pragma unroll
        for (int k = 0; k < 8; ++k) cM[k] = *(const LAS v4u*)(sl + (6 + k) * 1024);
#pragma unroll
        for (int k = 0; k < 4; ++k) cG[k] = *(const LAS v4u*)(sl + (14 + k) * 1024);
        asm volatile("s_waitcnt lgkmcnt(0)" ::: "memory");
        if (ck + 2 < SEQ / 32) RK_DMA(ck + 2, ck & 1);
        bf16x8 sb[4];
#pragma unroll
        for (int kq = 0; kq < 4; ++kq) { const f32x16& s = (kq >> 1) ? S1 : S0; const int o = 8 * (kq & 1);
            v4u w; w.x = cvt_pk_bf16(s[o], s[o + 1]); w.y = cvt_pk_bf16(s[o + 2], s[o + 3]); w.z = cvt_pk_bf16(s[o + 4], s[o + 5]); w.w = cvt_pk_bf16(s[o + 6], s[o + 7]); sb[kq] = __builtin_bit_cast(bf16x8, w); }
        f32x16 y, n0, n1;
#pragma unroll
        for (int hf = 0; hf < 2; ++hf) { const v4u w = cY[hf]; y[8 * hf] = bflo(w.x); y[8 * hf + 1] = bfhi(w.x); y[8 * hf + 2] = bflo(w.y); y[8 * hf + 3] = bfhi(w.y); y[8 * hf + 4] = bflo(w.z); y[8 * hf + 5] = bfhi(w.z); y[8 * hf + 6] = bflo(w.w); y[8 * hf + 7] = bfhi(w.w); }
#pragma unroll
        for (int hf = 0; hf < 2; ++hf) { const v4u w = cG[hf], x = cG[2 + hf];
            n0[8 * hf] = bflo(w.x); n0[8 * hf + 1] = bfhi(w.x); n0[8 * hf + 2] = bflo(w.y); n0[8 * hf + 3] = bfhi(w.y); n0[8 * hf + 4] = bflo(w.z); n0[8 * hf + 5] = bfhi(w.z); n0[8 * hf + 6] = bflo(w.w); n0[8 * hf + 7] = bfhi(w.w);
            n1[8 * hf] = bflo(x.x); n1[8 * hf + 1] = bfhi(x.x); n1[8 * hf + 2] = bflo(x.y); n1[8 * hf + 3] = bfhi(x.y); n1[8 * hf + 4] = bflo(x.z); n1[8 * hf + 5] = bfhi(x.z); n1[8 * hf + 6] = bflo(x.w); n1[8 * hf + 7] = bfhi(x.w); }
#pragma unroll
        for (int kq = 0; kq < 4; ++kq) {
            y = RK_MFMA(__builtin_bit_cast(bf16x8, cR[kq]), sb[kq], y);
            n0 = RK_MFMA(__builtin_bit_cast(bf16x8, cM[((kq >> 1) * 2 + 0) * 2 + (kq & 1)]), sb[kq], n0);
            n1 = RK_MFMA(__builtin_bit_cast(bf16x8, cM[((kq >> 1) * 2 + 1) * 2 + (kq & 1)]), sb[kq], n1); }
        S0 = n0; S1 = n1;
#pragma unroll
        for (int r = 0; r < 16; ++r) *(LAS unsigned short*)(yst + crow(r, hi) * 64 + r32 * 2) = (unsigned short)cvt_pk_bf16(y[r], 0.f);
        asm volatile("s_waitcnt lgkmcnt(0)" ::: "memory");
        { const v4u w0 = *(const LAS v4u*)(yst + lane * 16), w1 = *(const LAS v4u*)(yst + 1024 + lane * 16);
          GAS unsigned char* yp = Yg + (size_t)ck * 32 * (DM * 2);
          *(GAS v4u*)yp = w0; *(GAS v4u*)(yp + (size_t)16 * (DM * 2)) = w1; }
    }
    asm volatile("s_waitcnt vmcnt(0)" ::: "memory");
#undef RK_DMA
}
#undef RK_FRAG
#undef RK_MFMA
}

__device__ __forceinline__ void post_phase(int l, const float* gao, const float* lnwp, const float* lnbp, unsigned char* ws, int gw, int NGW, int lane) {
    float gn[8], lw8[8], lb8[8];
#pragma unroll
    for (int e = 0; e < 8; ++e) { gn[e] = gao[lane * 8 + e]; lw8[e] = lnwp[lane * 8 + e]; lb8[e] = lnbp[lane * 8 + e]; }
    const bf16* Vv = (const bf16*)(ws + ((l == 0) ? WS_VFIRST : A_VRAW)); const bf16* Gg = (const bf16*)(ws + A_G); const float* BON = (const float*)(ws + A_BON);
    v4u n0, n1, n2, n3; float nb;
#define POST_LOAD(mm) do { n0 = *(const GAS v4u*)((const bf16*)(ws + A_YCAT) + (size_t)(mm) * DM + lane * 8); n1 = *(const GAS v4u*)((const bf16*)(ws + A_YCAT) + (size_t)(mm) * DM + 512 + lane * 8); \
        n2 = *(const GAS v4u*)(Vv + (size_t)(mm) * RW + lane * 8); n3 = *(const GAS v4u*)(Gg + (size_t)(mm) * RW + lane * 8); nb = BON[(size_t)(mm) * 8 + (lane >> 3)]; } while (0)
    if (gw < TOK) POST_LOAD(gw);
    if (lane == 0) PAD_STORES(ws, gw, 2);
    for (int m = gw; m < TOK; m += NGW) {
        GAS v4u* pp = (GAS v4u*)((bf16*)(ws + A_YCAT) + (size_t)m * DM + lane * 8); float p[8]; up8(n0, p); float ss = 0.f;
        GAS v4u* py = (GAS v4u*)((bf16*)(ws + A_YCAT) + (size_t)m * DM + 512 + lane * 8); float y[8], v[8], g[8]; up8(n1, y);
        up8(n2, v); up8(n3, g);
        const float bon = nb;
        if (m + NGW < TOK) POST_LOAD(m + NGW);
#pragma unroll
        for (int e = 0; e < 8; ++e) ss += p[e] * p[e];
        const float rstd = 1.0f / sqrtf(wave_sum(ss) * (1.0f / 512.0f) + 1e-6f);
#pragma unroll
        for (int e = 0; e < 8; ++e) p[e] = p[e] * rstd * gn[e];
        *pp = pk8(p);
        float s1 = 0.f;
#pragma unroll
        for (int e = 0; e < 8; ++e) s1 += y[e];
        s1 += lane_xor<1>(s1); s1 += lane_xor<2>(s1); s1 += lane_xor<4>(s1);
        const float mean = s1 * (1.0f / 64.0f); float s2 = 0.f;
#pragma unroll
        for (int e = 0; e < 8; ++e) { y[e] -= mean; s2 += y[e] * y[e]; }
        s2 += lane_xor<1>(s2); s2 += lane_xor<2>(s2); s2 += lane_xor<4>(s2);
        const float rs = 1.0f / sqrtf(s2 * (1.0f / 64.0f) + 64e-5f);
#pragma unroll
        for (int e = 0; e < 8; ++e) y[e] = (y[e] * rs * lw8[e] + lb8[e] + bon * v[e]) * g[e];
        *py = pk8(y);
    }
#undef POST_LOAD
}
#ifdef RK_PROBE
__device__ __forceinline__ void rwkv_seq_raw(int l, int b, int hd, unsigned char* ws, LAS unsigned char* ldsw  , int lane, bf16* T1) {
    constexpr int CH = 8;
    LAS float* buf = (LAS float*)ldsw;
    const bf16* R = (const bf16*)(ws + A_R); const bf16* Kp = (const bf16*)(ws + A_KRAW); const bf16* KK = (const bf16*)(ws + A_KK); const bf16* BV = (const bf16*)(ws + A_BV);
    const bf16* Vv = (const bf16*)(ws + ((l == 0) ? WS_VFIRST : A_VRAW)); const bf16* Gg = (const bf16*)(ws + A_G); const float* LW = (const float*)(ws + A_LW);
    const int c = hd * 64 + lane;
    float S[64];
#pragma unroll
    for (int j = 0; j < 64; ++j) S[j] = 0.f;
    for (int t0 = 0; t0 < SEQ; t0 += CH) {
        float vv[CH], gg[CH], bon[CH];
#pragma unroll
        for (int s = 0; s < CH; ++s) { const size_t o = (size_t)(b * SEQ + t0 + s) * RW + c;
            const float r = bf2f(R[o]), k = bf2f(Kp[o]), kk = bf2f(KK[o]), bb = bf2f(BV[o]), w = __expf(LW[o]);
            buf[(s * 5 + 0) * 64 + lane] = r; buf[(s * 5 + 1) * 64 + lane] = w; buf[(s * 5 + 2) * 64 + lane] = k; buf[(s * 5 + 3) * 64 + lane] = -kk; buf[(s * 5 + 4) * 64 + lane] = bb;
            vv[s] = bf2f(Vv[o]); gg[s] = 0.f; bon[s] = 0.f; }
        LDS_WAIT(); asm volatile("" ::: "memory");
#pragma unroll 1
        for (int s = 0; s < CH; ++s) {
            const LAS f32x4* pr = (const LAS f32x4*)(buf + (s * 5 + 0) * 64); const LAS f32x4* pw = (const LAS f32x4*)(buf + (s * 5 + 1) * 64);
            const LAS f32x4* pk = (const LAS f32x4*)(buf + (s * 5 + 2) * 64); const LAS f32x4* pa = (const LAS f32x4*)(buf + (s * 5 + 3) * 64); const LAS f32x4* pb = (const LAS f32x4*)(buf + (s * 5 + 4) * 64);
            float sa = 0.f;
#pragma unroll
            for (int j4 = 0; j4 < 16; ++j4) { const f32x4 a = pa[j4]; sa += S[4 * j4] * a.x + S[4 * j4 + 1] * a.y + S[4 * j4 + 2] * a.z + S[4 * j4 + 3] * a.w; }
            float v_s = vv[0], g_s = gg[0], bo_s = bon[0];
#pragma unroll
            for (int q = 1; q < CH; ++q) if (s == q) { v_s = vv[q]; g_s = gg[q]; bo_s = bon[q]; }
            float y = 0.f;
#pragma unroll
            for (int j4 = 0; j4 < 16; ++j4) { const f32x4 w = pw[j4], bb = pb[j4], k = pk[j4], r = pr[j4];
                S[4 * j4]     = S[4 * j4]     * w.x + sa * bb.x + v_s * k.x; y += S[4 * j4] * r.x;
                S[4 * j4 + 1] = S[4 * j4 + 1] * w.y + sa * bb.y + v_s * k.y; y += S[4 * j4 + 1] * r.y;
                S[4 * j4 + 2] = S[4 * j4 + 2] * w.z + sa * bb.z + v_s * k.z; y += S[4 * j4 + 2] * r.z;
                S[4 * j4 + 3] = S[4 * j4 + 3] * w.w + sa * bb.w + v_s * k.w; y += S[4 * j4 + 3] * r.w; }
            T1[(size_t)(b * SEQ + t0 + s) * RW + c] = (bf16)(cvt_pk_bf16(y, 0.f) & 0xffffu); (void)g_s; (void)bo_s;
        }
        LDS_WAIT(); asm volatile("" ::: "memory");
    }
}

#endif

constexpr int N_PHASES = 27;
struct Args { In in; float* out; unsigned char* ws; int ph_lo, ph_hi; };
static_assert(sizeof(Args) == 38 * 8 + 8 + 8 + 8, "Args has padding");

__global__ void __launch_bounds__(NTHR, 2) mega_fwd(Args args) {
    extern __shared__ __attribute__((aligned(16))) unsigned char lds_raw[];
    LAS unsigned char* lds = (LAS unsigned char*)lds_raw;
#define OPAQUE_IDS(TID0, BX0) int tid = (TID0); asm volatile("" : "+v"(tid)); int bx = (BX0); asm volatile("" : "+s"(bx)); \
    const int lane = tid & 63, wave = __builtin_amdgcn_readfirstlane(tid >> 6); const int G = gridDim.x; \
    const int vcu = (G % 8 == 0) ? (bx % 8) * (G / 8) + bx / 8 : bx; \
    const int gw = vcu * NWAVES + wave, NGW = G * NWAVES, gtid = vcu * NTHR + tid, NGT = G * NTHR; (void)gw; (void)NGW; (void)gtid; (void)NGT; (void)lane
    OPAQUE_IDS(threadIdx.x, blockIdx.x);
    for (int u = tid; u < (LDS_BYTES - LDSCTL_OFF) / 4; u += NTHR) ((LAS unsigned*)(lds + LDSCTL_OFF))[u] = 0u;
    __syncthreads();
    if (lane == 0) ((LAS unsigned*)(lds + pg8::WAVETAB_OFF))[(unsigned)__builtin_amdgcn_s_getreg((5 << 11) | 4) & 63u] = (unsigned)wave;
    static_assert(pg8::WAVETAB_OFF == LDSCTL_OFF + 1536, "wave table offset");
    if (tid < 40) { const unsigned long long v = (tid < 38) ? (unsigned long long)args.in.p[tid] : (tid == 38 ? (unsigned long long)args.ws : (unsigned long long)args.out);
        ((LAS unsigned*)(lds + PTAB_OFF))[2 * tid] = (unsigned)v; ((LAS unsigned*)(lds + PTAB_OFF))[2 * tid + 1] = (unsigned)(v >> 32); }
    __syncthreads();
    const InT in{(volatile LAS unsigned*)(lds + PTAB_OFF)};
#define ctl ((gu32*)(args.ws + WS_CTL))
#define bar (XcdBarrier{(unsigned*)(ctl + CW_BAR), xb_xcc_id(), (volatile LAS unsigned*)(lds + MISC_OFF) + 8})
    if (!MK_SPLIT) (void)xcd_barrier_post((unsigned*)(ctl + CW_BAR), (volatile LAS unsigned*)(lds + MISC_OFF) + 8);
    const int lo = args.ph_lo, hi = args.ph_hi;
#ifndef PH_MASK
#define PH_MASK 0xffffffffu
#endif
#define IN_PH(bit, k) (((PH_MASK >> (bit)) & 1u) && lo <= (k) && (k) < hi)
#ifndef SCAN_REPS
#define SCAN_REPS 1
#endif
#define MIXER_BODY(REP) do { \
            if (vcu < 32) { for (int sr_ = 0; sr_ < SCAN_REPS; ++sr_) { if (wave < 4) { const int si = vcu * 4 + wave; rk::scan_unit(si >> 1, si & 1, ws, lds + wave * rk::SCAN_LDS, lds + 4 * rk::SCAN_LDS + wave * 2048); } __syncthreads(); } } \
            volatile LAS unsigned* qslot = (volatile LAS unsigned*)(lds + MISC_OFF) + 16; \
            for (;;) { \
                __syncthreads(); \
                if (tid == 0) qslot[0] = __hip_atomic_fetch_add(ctl + CW_QCTR + 64 * l + 16 * (REP), 1u, RLX_AGENT); \
                __syncthreads(); \
                const int u = (int)qslot[0]; \
                if (u >= 512) break; \
                const int qb = 15 - (u >> 5), bh = u & 31; \
                att::attn_unit(bh >> 2, bh & 3, qb, (const bf16*)(ws + A_Q), (const bf16*)(ws + A_KB), (const bf16*)(ws + A_VB), (bf16*)(ws + A_YCAT), (const int*)in[2], lds); \
            } } while (0)
#ifndef DUPMASK
#define DUPMASK 0u
#endif
#define DUP(bit) for (int rep_ = 0; rep_ < (int)((DUPMASK >> (bit)) & 1u) + 1; ++rep_)
#ifdef TS_GA
#define STAMP(k) do { if (blockIdx.x == 0 && threadIdx.x == 0) { volatile LAS unsigned long long* ts_ = (volatile LAS unsigned long long*)(lds + TS_OFF); const unsigned long long now_ = __builtin_amdgcn_s_memrealtime(); \
        if ((k) > 0) { const unsigned d_ = (unsigned)(now_ - ts_[0]); if ((TS_GA >> ((k) - 1)) & 1u) ts_[1] += d_; if ((TS_GB >> ((k) - 1)) & 1u) ts_[2] += d_; \
            __hip_atomic_store(ctl + 90, (unsigned)ts_[1], RLX_AGENT); __hip_atomic_store(ctl + 91, (unsigned)ts_[2], RLX_AGENT); } ts_[0] = now_; } } while (0)
#else
#define STAMP(k) do { } while (0)
#endif
#define BAR_AFTER(k) do { if ((k) + 1 < hi) { if (!MK_SPLIT) xcd_barrier(bar); } STAMP((k) + 1); } while (0)
#define PH_PTRS unsigned char* ws = (unsigned char*)in[38]; float* out = (float*)in[39]; const float* modl = (const float*)(ws + WS_MOD) + (size_t)l * NB * MODLD; (void)out; (void)modl

    STAMP(0);
    if (IN_PH(0, 0)) { const int l = 0; PH_PTRS; DUP(0) { __syncthreads(); p0_mod(in, ws, lds, vcu, G, wave, lane, tid); __syncthreads(); p0_weights(in, ws, lds, gw, NGW, wave, lane, gtid, NGT); } BAR_AFTER(0);
#ifdef EXTRA_BARS
    for (int eb = 0; eb < EXTRA_BARS; ++eb) xcd_barrier(bar);
#endif
    }

    {
        constexpr int l = 0;
        const int pb = 1 + 11 * l;
        OPAQUE_IDS(pg8::tid_now(), blockIdx.x);
        if (l == 0 && IN_PH(1, pb + 0)) { PH_PTRS; DUP(1) { __syncthreads(); norm_phase<false, false>(in[0], in[5], modl, 0, (bf16*)(ws + A_H), nullptr, nullptr, ws, lds, vcu, G, wave, lane, tid);
            } BAR_AFTER(pb + 0); }
        if (IN_PH(2, pb + 1)) { PH_PTRS;
            pg8::Gemm g{(const bf16*)(ws + A_H), (const bf16*)(ws + WS_WIN) + (size_t)l * NPROJ * DM, TOK, NPROJ, DM, nullptr, nullptr, 0, 0, 0};
            pg8::StaticOrder S; S.init(TOK, NPROJ, G, bx);
            if (l == 0) { pg8::EpiBf16<0> E{(bf16*)(ws + A_PROJ), NPROJ, nullptr, 0, 0, 1.f};
                DUP(2) { __syncthreads(); pg8::gemm_phase<pg8::EpiBf16<0>, pg8::StaticOrder, true, true, 0>(lds, g, S, E); }
                if (bx >= G / 2) { const int hg = (bx - G / 2) * NWAVES + wave, hn = (G - G / 2) * NWAVES;
                    bias_rows((const bf16*)(ws + WS_WF1), 2 * FFD, modl + 3072, (float*)(ws + WS_BIAS2), 2 * FFD, hg, hn, lane);
                    bias_rows((const bf16*)(ws + WS_WIN) + (size_t)NPROJ * DM, NPROJ, modl + (size_t)NB * MODLD, (float*)(ws + WS_BIAS1), NPROJ, hg, hn, lane); } }
            else { pg8::EpiProjN E{(bf16*)(ws + A_PROJ), NPROJ, (const float*)(ws + A_RSQ), (const float*)(ws + WS_BIAS1), NPROJ};
                DUP(2) { __syncthreads(); pg8::gemm_phase<pg8::EpiProjN, pg8::StaticOrder, true, true, 0>(lds, g, S, E); } }
            BAR_AFTER(pb + 1); }
        if (IN_PH(3, pb + 2)) { PH_PTRS; DUP(3) { __syncthreads(); prep_phase(l, in, ws, gw, NGW, lane); } BAR_AFTER(pb + 2); }
        if (IN_PH(4, pb + 3)) { PH_PTRS;
#ifndef P4_MASK
#define P4_MASK 7
#endif
            if (P4_MASK & 1) { pg8::Gemm g{(const bf16*)(ws + A_CQ), (const bf16*)(ws + WS_WUQ) + (size_t)l * NQ * 256, TOK, NQ, 256, nullptr, nullptr, 0, 0, 0};
              pg8::StaticOrder S; S.init(TOK, NQ, G, (bx + G / 2) % G);
              pg8::EpiBf16<0> E{(bf16*)(ws + A_Q), NQ, nullptr, 0, 0, 1.f};
              DUP(4) { __syncthreads(); pg8::gemm_phase<pg8::EpiBf16<0>, pg8::StaticOrder, true, true, 0>(lds, g, S, E); } }
            __syncthreads();
            if (P4_MASK & 2) { pg8::Gemm g{(const bf16*)(ws + A_CKV), (const bf16*)(ws + WS_WUKV) + (size_t)l * NKV * 128, TOK, NKV, 128, nullptr, nullptr, 0, 0, 0};
              pg8::StaticOrder S; S.init(TOK, NKV, G, bx);
              pg8::EpiKV E{(bf16*)(ws + A_KB), (bf16*)(ws + A_VB)};
              DUP(4) { __syncthreads(); pg8::gemm_phase<pg8::EpiKV, pg8::StaticOrder, true, true, 0>(lds, g, S, E); } }
            __syncthreads();
            if (P4_MASK & 4) { const int nl = (l == 0) ? 1536 : NLORA;
              pg8::Gemm g{(const bf16*)(ws + A_LA), (const bf16*)(ws + WS_WLORA) + (size_t)l * NLORA * KLW, TOK, nl, KLW, nullptr, nullptr, 0, KLORA, KLW};
              pg8::StaticOrder S; S.init(TOK, nl, G, bx);
              pg8::EpiLora E{in[16] + (size_t)l * RW, in[18] + (size_t)l * RW, in[21], in[23] + (size_t)l * RW, in[24] + (size_t)l * RW,
                             (bf16*)(ws + A_LWH), (bf16*)(ws + A_KRAW), (bf16*)(ws + A_KK), (bf16*)(ws + A_BV), (bf16*)(ws + A_G), (bf16*)(ws + A_VRAW), (const bf16*)(ws + WS_VFIRST), (const bf16*)(ws + A_R), in[25] + (size_t)l * RW, (float*)(ws + A_BON)};
              pg8::gemm_phase<pg8::EpiLora, pg8::StaticOrder, true, true, 3>(lds, g, S, E); }
            BAR_AFTER(pb + 3); }
        if (IN_PH(5, pb + 4)) { PH_PTRS;
#ifdef RK_PROBE
            if (l == RK_PROBE) { if (vcu < 16 && wave < 4) { const int unit = vcu * 4 + wave; rwkv_seq_raw(l, unit >> 3, unit & 7, ws, lds + wave * 10240, lane, (bf16*)(ws + WS_ARENA + 224 * MiB)); } xcd_barrier(bar); }
#endif
            DUP(5) { __syncthreads(); unsigned char* dummy = (((DUPMASK >> 5) & 1u) && rep_ == 0) ? ws + WS_ARENA + 224 * MiB : nullptr;
            if (wave < 4) { for (int u = vcu * 4 + wave; u < 64 * (SEQ / 32); u += G * 4) { const int q = u & 63, ck = u >> 6; rk::pre_unit(l, q >> 3, q & 7, ck, ws, lds + wave * rk::UNIT_LDS, dummy); } } }
            BAR_AFTER(pb + 4); }
        if (IN_PH(6, pb + 5)) { PH_PTRS;
            MIXER_BODY(0);
#ifdef DUP_MIXER
            __syncthreads(); MIXER_BODY(1);
#endif
            BAR_AFTER(pb + 5); }
        if (IN_PH(7, pb + 6)) { PH_PTRS;
#ifdef RK_PROBE
            if (l == RK_PROBE) { float num = 0.f, den = 0.f; const bf16* T1 = (const bf16*)(ws + WS_ARENA + 224 * MiB);
                for (int m = gw; m < TOK; m += NGW) { if (((m & (SEQ - 1)) >> 5) < 1 || (m & 31) != RK_PROBE_POS) continue; float a[8], b8[8]; up8(*(const GAS v4u*)((const bf16*)(ws + A_YCAT) + (size_t)m * DM + 512 + lane * 8), a); up8(*(const GAS v4u*)(T1 + (size_t)m * RW + lane * 8), b8);
#pragma unroll
                    for (int e = 0; e < 8; ++e) { const float d = a[e] - b8[e]; num += d * d; den += b8[e] * b8[e]; } }
                num = wave_sum(num); den = wave_sum(den);
                if (lane == 0) { atomicAdd((float*)(ctl + 80), num); atomicAdd((float*)(ctl + 81), den); } }
#endif
            post_phase(l, in[13] + (size_t)l * 512, in[26] + (size_t)l * RW, in[27] + (size_t)l * RW, ws, gw, NGW, lane); BAR_AFTER(pb + 6); }
        if (IN_PH(8, pb + 7)) { PH_PTRS; bf16* x16a = (bf16*)((unsigned char*)out + DO_X16A);
            pg8::Gemm g{(const bf16*)(ws + A_YCAT), (const bf16*)(ws + (l == 0 ? WS_WOUT : WS_WOUT1)), TOK, DM, DM, nullptr, nullptr, 0, 0, 0};
            pg8::StaticOrder S; S.init(TOK, DM, G, bx);
            if (l == 0) { pg8::EpiResidT<true, false> E{in[0], x16a, modl + 2048, in[6], modl + 4096, (bf16*)(ws + A_H), (float*)(ws + A_RSQ)};
                pg8::gemm_phase<pg8::EpiResidT<true, false>, pg8::StaticOrder, true, true, 0>(lds, g, S, E); }
            else { pg8::EpiResidT<false, true> E{x16a, (bf16*)(ws + A_X16B), modl + 2048, nullptr, nullptr, nullptr, nullptr};
                pg8::gemm_phase<pg8::EpiResidT<false, true>, pg8::StaticOrder, true, true, 0>(lds, g, S, E); }
            BAR_AFTER(pb + 7); }
        if (l == 1 && IN_PH(9, pb + 8)) { PH_PTRS; OPAQUE_IDS(pg8::tid_now(), blockIdx.x);

            DUP(9) { __syncthreads();
            norm_phase<true, true>(ws + A_X16B, in[6] + (size_t)l * DM, modl, 3072, (bf16*)((unsigned char*)out + DO_H2), in[32], in[33], ws, lds, vcu, G, wave, lane, tid);
            if (l == 1) { __syncthreads(); p_expert_weights(in, ws, lds, gw, NGW, wave, lane); } }
            BAR_AFTER(pb + 8); }
        if (l == 0) {
            if (IN_PH(10, 10)) { PH_PTRS; OPAQUE_IDS(pg8::tid_now(), blockIdx.x);

                pg8::Gemm g{(const bf16*)(ws + A_H), (const bf16*)(ws + WS_WF1), TOK, 2 * FFD, DM, nullptr, nullptr, 0, 0, 0};
                pg8::StaticOrder S; S.init(TOK, 2 * FFD, G, bx);
                pg8::EpiSwiGLUT<true> E{(bf16*)(ws + A_HID), FFD, (const float*)(ws + A_RSQ), (const float*)(ws + WS_BIAS2), 2 * FFD};
                DUP(10) { __syncthreads(); pg8::gemm_phase<pg8::EpiSwiGLUT<true>, pg8::StaticOrder, true, true, 0>(lds, g, S, E); }
                BAR_AFTER(10); }
            if (IN_PH(11, 11)) { PH_PTRS; OPAQUE_IDS(pg8::tid_now(), blockIdx.x);

                pg8::Gemm g{(const bf16*)(ws + A_HID), (const bf16*)(ws + WS_WF2), TOK, DM, FFD, nullptr, nullptr, 0, 0, 0};
                pg8::StaticOrder S; S.init(TOK, DM, G, bx);
                bf16* x16a = (bf16*)((unsigned char*)out + DO_X16A);
                pg8::EpiResidT<true, true> E{x16a, x16a, modl + 5120, in[5] + DM, modl + (size_t)NB * MODLD + 1024, (bf16*)(ws + A_H), (float*)(ws + A_RSQ)};
                pg8::gemm_phase<pg8::EpiResidT<true, true>, pg8::StaticOrder, true, true, 0>(lds, g, S, E);
                BAR_AFTER(11); }
        } else {
            if (IN_PH(12, 21)) { PH_PTRS; OPAQUE_IDS(pg8::tid_now(), blockIdx.x);
            DUP(12) { __syncthreads(); route_scatter(ws, lds, vcu, G, wave, lane, tid); } BAR_AFTER(21); }
#pragma unroll
            for (int k = 0; k < 2; ++k) {
                if (IN_PH(13, 22 + 2 * k)) { PH_PTRS; OPAQUE_IDS(pg8::tid_now(), blockIdx.x);
            const int* TL = (const int*)(ws + RT_TILE) + k * (PASS_TILES + 8); const int* ridx = (const int*)(ws + RT_RIDX) + (size_t)k * PASS_ROWS;
                    if (k == 1) { const int* TLp = (const int*)(ws + RT_TILE); moe_combine(__builtin_amdgcn_readfirstlane(TLp[0]), G, SLAB0_CAP, G - 1 - bx, (const float*)((unsigned char*)out + DO_SLAB), (bf16*)(ws + A_Y0), tid);     __syncthreads(); }
                    const int nt = __builtin_amdgcn_readfirstlane(TL[0]);
                    pg8::Gemm g{(const bf16*)((unsigned char*)out + DO_H2), (const bf16*)(ws + A_WE1), nt * 256, 2 * FFE, DM, ridx, TL + 8, (size_t)2 * FFE * DM * 2, 0, 0};
                    pg8::StaticOrder S; S.init(nt * 256, 2 * FFE, G, bx);
                    pg8::EpiSwiGLU E{(bf16*)(ws + A_HIDM), FFE};
                    DUP(13) { __syncthreads(); pg8::gemm_phase<pg8::EpiSwiGLU, pg8::StaticOrder, true, true, 1>(lds, g, S, E); }
                    BAR_AFTER(22 + 2 * k); }
                if (IN_PH(14, 23 + 2 * k)) { PH_PTRS; OPAQUE_IDS(pg8::tid_now(), blockIdx.x);
            const int* TL = (const int*)(ws + RT_TILE) + k * (PASS_TILES + 8);
                    const int nt = __builtin_amdgcn_readfirstlane(TL[0]);
                    const pg8::G2Plan pl = pg8::g2_plan(nt, G, k == 0 ? SLAB0_CAP : 256);
                    { pg8::Gemm g{(const bf16*)(ws + A_HIDM), (const bf16*)(ws + A_WE2), nt * 256, DM, FFE, nullptr, TL + 8, (size_t)DM * FFE * 2, 0, 0};
                      pg8::StaticOrder S; S.init(nt * 256, DM, G, bx); S.lim = pl.full;
                      pg8::EpiBf16<0> E{(bf16*)(ws + (k == 0 ? A_Y0 : A_Y1)), DM, nullptr, 0, 0, 1.f};
                      pg8::gemm_phase<pg8::EpiBf16<0>, pg8::StaticOrder, true, true, 2>(lds, g, S, E); }
                    if (pl.tail) {
                        __syncthreads();
                        const int ksub = FFE / pl.spl, kp = bx % pl.spl;
                        pg8::OneUnit O; O.have = bx < pl.tail * pl.spl; O.u.pm = 0; O.u.pn = 0;
                        if (O.have) { pg8::StaticOrder T; T.init(nt * 256, DM, 1, 0); T.next(pl.full + bx / pl.spl, O.u); }
                        pg8::Gemm g{(const bf16*)(ws + A_HIDM) + kp * ksub, (const bf16*)(ws + A_WE2) + kp * ksub, nt * 256, DM, ksub, nullptr, TL + 8, (size_t)DM * FFE * 2, FFE, 0};
                        pg8::EpiSlab E{(float*)((unsigned char*)out + DO_SLAB) + (size_t)bx * 65536};
                        pg8::gemm_phase<pg8::EpiSlab, pg8::OneUnit, true, true, 2>(lds, g, O, E); }
                    BAR_AFTER(23 + 2 * k); }
            }
        }
    }
    {
        constexpr int l = 1;
        const int pb = 1 + 11 * l;
        OPAQUE_IDS(pg8::tid_now(), blockIdx.x);
        if (l == 0 && IN_PH(1, pb + 0)) { PH_PTRS; DUP(1) { __syncthreads(); norm_phase<false, false>(in[0], in[5], modl, 0, (bf16*)(ws + A_H), nullptr, nullptr, ws, lds, vcu, G, wave, lane, tid);
            } BAR_AFTER(pb + 0); }
        if (IN_PH(2, pb + 1)) { PH_PTRS;
            pg8::Gemm g{(const bf16*)(ws + A_H), (const bf16*)(ws + WS_WIN) + (size_t)l * NPROJ * DM, TOK, NPROJ, DM, nullptr, nullptr, 0, 0, 0};
            pg8::StaticOrder S; S.init(TOK, NPROJ, G, bx);
            if (l == 0) { pg8::EpiBf16<0> E{(bf16*)(ws + A_PROJ), NPROJ, nullptr, 0, 0, 1.f};
                DUP(2) { __syncthreads(); pg8::gemm_phase<pg8::EpiBf16<0>, pg8::StaticOrder, true, true, 0>(lds, g, S, E); }
                if (bx >= G / 2) { const int hg = (bx - G / 2) * NWAVES + wave, hn = (G - G / 2) * NWAVES;
                    bias_rows((const bf16*)(ws + WS_WF1), 2 * FFD, modl + 3072, (float*)(ws + WS_BIAS2), 2 * FFD, hg, hn, lane);
                    bias_rows((const bf16*)(ws + WS_WIN) + (size_t)NPROJ * DM, NPROJ, modl + (size_t)NB * MODLD, (float*)(ws + WS_BIAS1), NPROJ, hg, hn, lane); } }
            else { pg8::EpiProjN E{(bf16*)(ws + A_PROJ), NPROJ, (const float*)(ws + A_RSQ), (const float*)(ws + WS_BIAS1), NPROJ};
                DUP(2) { __syncthreads(); pg8::gemm_phase<pg8::EpiProjN, pg8::StaticOrder, true, true, 0>(lds, g, S, E); } }
            BAR_AFTER(pb + 1); }
        if (IN_PH(3, pb + 2)) { PH_PTRS; DUP(3) { __syncthreads(); prep_phase(l, in, ws, gw, NGW, lane); } BAR_AFTER(pb + 2); }
        if (IN_PH(4, pb + 3)) { PH_PTRS;
#ifndef P4_MASK
#define P4_MASK 7
#endif
            if (P4_MASK & 1) { pg8::Gemm g{(const bf16*)(ws + A_CQ), (const bf16*)(ws + WS_WUQ) + (size_t)l * NQ * 256, TOK, NQ, 256, nullptr, nullptr, 0, 0, 0};
              pg8::StaticOrder S; S.init(TOK, NQ, G, (bx + G / 2) % G);
              pg8::EpiBf16<0> E{(bf16*)(ws + A_Q), NQ, nullptr, 0, 0, 1.f};
              DUP(4) { __syncthreads(); pg8::gemm_phase<pg8::EpiBf16<0>, pg8::StaticOrder, true, true, 0>(lds, g, S, E); } }
            __syncthreads();
            if (P4_MASK & 2) { pg8::Gemm g{(const bf16*)(ws + A_CKV), (const bf16*)(ws + WS_WUKV) + (size_t)l * NKV * 128, TOK, NKV, 128, nullptr, nullptr, 0, 0, 0};
              pg8::StaticOrder S; S.init(TOK, NKV, G, bx);
              pg8::EpiKV E{(bf16*)(ws + A_KB), (bf16*)(ws + A_VB)};
              DUP(4) { __syncthreads(); pg8::gemm_phase<pg8::EpiKV, pg8::StaticOrder, true, true, 0>(lds, g, S, E); } }
            __syncthreads();
            if (P4_MASK & 4) { const int nl = (l == 0) ? 1536 : NLORA;
              pg8::Gemm g{(const bf16*)(ws + A_LA), (const bf16*)(ws + WS_WLORA) + (size_t)l * NLORA * KLW, TOK, nl, KLW, nullptr, nullptr, 0, KLORA, KLW};
              pg8::StaticOrder S; S.init(TOK, nl, G, bx);
              pg8::EpiLora E{in[16] + (size_t)l * RW, in[18] + (size_t)l * RW, in[21], in[23] + (size_t)l * RW, in[24] + (size_t)l * RW,
                             (bf16*)(ws + A_LWH), (bf16*)(ws + A_KRAW), (bf16*)(ws + A_KK), (bf16*)(ws + A_BV), (bf16*)(ws + A_G), (bf16*)(ws + A_VRAW), (const bf16*)(ws + WS_VFIRST), (const bf16*)(ws + A_R), in[25] + (size_t)l * RW, (float*)(ws + A_BON)};
              pg8::gemm_phase<pg8::EpiLora, pg8::StaticOrder, true, true, 3>(lds, g, S, E); }
            BAR_AFTER(pb + 3); }
        if (IN_PH(5, pb + 4)) { PH_PTRS;
#ifdef RK_PROBE
            if (l == RK_PROBE) { if (vcu < 16 && wave < 4) { const int unit = vcu * 4 + wave; rwkv_seq_raw(l, unit >> 3, unit & 7, ws, lds + wave * 10240, lane, (bf16*)(ws + WS_ARENA + 224 * MiB)); } xcd_barrier(bar); }
#endif
            DUP(5) { __syncthreads(); unsigned char* dummy = (((DUPMASK >> 5) & 1u) && rep_ == 0) ? ws + WS_ARENA + 224 * MiB : nullptr;
            if (wave < 4) { for (int u = vcu * 4 + wave; u < 64 * (SEQ / 32); u += G * 4) { const int q = u & 63, ck = u >> 6; rk::pre_unit(l, q >> 3, q & 7, ck, ws, lds + wave * rk::UNIT_LDS, dummy); } } }
            BAR_AFTER(pb + 4); }
        if (IN_PH(6, pb + 5)) { PH_PTRS;
            MIXER_BODY(0);
#ifdef DUP_MIXER
            __syncthreads(); MIXER_BODY(1);
#endif
            BAR_AFTER(pb + 5); }
        if (IN_PH(7, pb + 6)) { PH_PTRS;
#ifdef RK_PROBE
            if (l == RK_PROBE) { float num = 0.f, den = 0.f; const bf16* T1 = (const bf16*)(ws + WS_ARENA + 224 * MiB);
                for (int m = gw; m < TOK; m += NGW) { if (((m & (SEQ - 1)) >> 5) < 1 || (m & 31) != RK_PROBE_POS) continue; float a[8], b8[8]; up8(*(const GAS v4u*)((const bf16*)(ws + A_YCAT) + (size_t)m * DM + 512 + lane * 8), a); up8(*(const GAS v4u*)(T1 + (size_t)m * RW + lane * 8), b8);
#pragma unroll
                    for (int e = 0; e < 8; ++e) { const float d = a[e] - b8[e]; num += d * d; den += b8[e] * b8[e]; } }
                num = wave_sum(num); den = wave_sum(den);
                if (lane == 0) { atomicAdd((float*)(ctl + 80), num); atomicAdd((float*)(ctl + 81), den); } }
#endif
            post_phase(l, in[13] + (size_t)l * 512, in[26] + (size_t)l * RW, in[27] + (size_t)l * RW, ws, gw, NGW, lane); BAR_AFTER(pb + 6); }
        if (IN_PH(8, pb + 7)) { PH_PTRS; bf16* x16a = (bf16*)((unsigned char*)out + DO_X16A);
            pg8::Gemm g{(const bf16*)(ws + A_YCAT), (const bf16*)(ws + (l == 0 ? WS_WOUT : WS_WOUT1)), TOK, DM, DM, nullptr, nullptr, 0, 0, 0};
            pg8::StaticOrder S; S.init(TOK, DM, G, bx);
            if (l == 0) { pg8::EpiResidT<true, false> E{in[0], x16a, modl + 2048, in[6], modl + 4096, (bf16*)(ws + A_H), (float*)(ws + A_RSQ)};
                pg8::gemm_phase<pg8::EpiResidT<true, false>, pg8::StaticOrder, true, true, 0>(lds, g, S, E); }
            else { pg8::EpiResidT<false, true> E{x16a, (bf16*)(ws + A_X16B), modl + 2048, nullptr, nullptr, nullptr, nullptr};
                pg8::gemm_phase<pg8::EpiResidT<false, true>, pg8::StaticOrder, true, true, 0>(lds, g, S, E); }
            BAR_AFTER(pb + 7); }
        if (l == 1 && IN_PH(9, pb + 8)) { PH_PTRS; OPAQUE_IDS(pg8::tid_now(), blockIdx.x);

            DUP(9) { __syncthreads();
            norm_phase<true, true>(ws + A_X16B, in[6] + (size_t)l * DM, modl, 3072, (bf16*)((unsigned char*)out + DO_H2), in[32], in[33], ws, lds, vcu, G, wave, lane, tid);
            if (l == 1) { __syncthreads(); p_expert_weights(in, ws, lds, gw, NGW, wave, lane); } }
            BAR_AFTER(pb + 8); }
        if (l == 0) {
            if (IN_PH(10, 10)) { PH_PTRS; OPAQUE_IDS(pg8::tid_now(), blockIdx.x);

                pg8::Gemm g{(const bf16*)(ws + A_H), (const bf16*)(ws + WS_WF1), TOK, 2 * FFD, DM, nullptr, nullptr, 0, 0, 0};
                pg8::StaticOrder S; S.init(TOK, 2 * FFD, G, bx);
                pg8::EpiSwiGLUT<true> E{(bf16*)(ws + A_HID), FFD, (const float*)(ws + A_RSQ), (const float*)(ws + WS_BIAS2), 2 * FFD};
                DUP(10) { __syncthreads(); pg8::gemm_phase<pg8::EpiSwiGLUT<true>, pg8::StaticOrder, true, true, 0>(lds, g, S, E); }
                BAR_AFTER(10); }
            if (IN_PH(11, 11)) { PH_PTRS; OPAQUE_IDS(pg8::tid_now(), blockIdx.x);

                pg8::Gemm g{(const bf16*)(ws + A_HID), (const bf16*)(ws + WS_WF2), TOK, DM, FFD, nullptr, nullptr, 0, 0, 0};
                pg8::StaticOrder S; S.init(TOK, DM, G, bx);
                bf16* x16a = (bf16*)((unsigned char*)out + DO_X16A);
                pg8::EpiResidT<true, true> E{x16a, x16a, modl + 5120, in[5] + DM, modl + (size_t)NB * MODLD + 1024, (bf16*)(ws + A_H), (float*)(ws + A_RSQ)};
                pg8::gemm_phase<pg8::EpiResidT<true, true>, pg8::StaticOrder, true, true, 0>(lds, g, S, E);
                BAR_AFTER(11); }
        } else {
            if (IN_PH(12, 21)) { PH_PTRS; OPAQUE_IDS(pg8::tid_now(), blockIdx.x);
            DUP(12) { __syncthreads(); route_scatter(ws, lds, vcu, G, wave, lane, tid); } BAR_AFTER(21); }
#pragma unroll
            for (int k = 0; k < 2; ++k) {
                if (IN_PH(13, 22 + 2 * k)) { PH_PTRS; OPAQUE_IDS(pg8::tid_now(), blockIdx.x);
            const int* TL = (const int*)(ws + RT_TILE) + k * (PASS_TILES + 8); const int* ridx = (const int*)(ws + RT_RIDX) + (size_t)k * PASS_ROWS;
                    if (k == 1) { const int* TLp = (const int*)(ws + RT_TILE); moe_combine(__builtin_amdgcn_readfirstlane(TLp[0]), G, SLAB0_CAP, G - 1 - bx, (const float*)((unsigned char*)out + DO_SLAB), (bf16*)(ws + A_Y0), tid);     __syncthreads(); }
                    const int nt = __builtin_amdgcn_readfirstlane(TL[0]);
                    pg8::Gemm g{(const bf16*)((unsigned char*)out + DO_H2), (const bf16*)(ws + A_WE1), nt * 256, 2 * FFE, DM, ridx, TL + 8, (size_t)2 * FFE * DM * 2, 0, 0};
                    pg8::StaticOrder S; S.init(nt * 256, 2 * FFE, G, bx);
                    pg8::EpiSwiGLU E{(bf16*)(ws + A_HIDM), FFE};
                    DUP(13) { __syncthreads(); pg8::gemm_phase<pg8::EpiSwiGLU, pg8::StaticOrder, true, true, 1>(lds, g, S, E); }
                    BAR_AFTER(22 + 2 * k); }
                if (IN_PH(14, 23 + 2 * k)) { PH_PTRS; OPAQUE_IDS(pg8::tid_now(), blockIdx.x);
            const int* TL = (const int*)(ws + RT_TILE) + k * (PASS_TILES + 8);
                    const int nt = __builtin_amdgcn_readfirstlane(TL[0]);
                    const pg8::G2Plan pl = pg8::g2_plan(nt, G, k == 0 ? SLAB0_CAP : 256);
                    { pg8::Gemm g{(const bf16*)(ws + A_HIDM), (const bf16*)(ws + A_WE2), nt * 256, DM, FFE, nullptr, TL + 8, (size_t)DM * FFE * 2, 0, 0};
                      pg8::StaticOrder S; S.init(nt * 256, DM, G, bx); S.lim = pl.full;
                      pg8::EpiBf16<0> E{(bf16*)(ws + (k == 0 ? A_Y0 : A_Y1)), DM, nullptr, 0, 0, 1.f};
                      pg8::gemm_phase<pg8::EpiBf16<0>, pg8::StaticOrder, true, true, 2>(lds, g, S, E); }
                    if (pl.tail) {
                        __syncthreads();
                        const int ksub = FFE / pl.spl, kp = bx % pl.spl;
                        pg8::OneUnit O; O.have = bx < pl.tail * pl.spl; O.u.pm = 0; O.u.pn = 0;
                        if (O.have) { pg8::StaticOrder T; T.init(nt * 256, DM, 1, 0); T.next(pl.full + bx / pl.spl, O.u); }
                        pg8::Gemm g{(const bf16*)(ws + A_HIDM) + kp * ksub, (const bf16*)(ws + A_WE2) + kp * ksub, nt * 256, DM, ksub, nullptr, TL + 8, (size_t)DM * FFE * 2, FFE, 0};
                        pg8::EpiSlab E{(float*)((unsigned char*)out + DO_SLAB) + (size_t)bx * 65536};
                        pg8::gemm_phase<pg8::EpiSlab, pg8::OneUnit, true, true, 2>(lds, g, O, E); }
                    BAR_AFTER(23 + 2 * k); }
            }
        }
    }
    if (IN_PH(15, 26)) { const int l = 1; PH_PTRS; OPAQUE_IDS(pg8::tid_now(), blockIdx.x);
        { const int* TLp = (const int*)(ws + RT_TILE) + (PASS_TILES + 8); const int nt1 = __builtin_amdgcn_readfirstlane(TLp[0]);
          if (pg8::g2_plan(nt1, G, 256).tail) { moe_combine(nt1, G, 256, vcu, (const float*)((unsigned char*)out + DO_SLAB), (bf16*)(ws + A_Y1), tid); if (!MK_SPLIT) xcd_barrier(bar); } }
        final_moe_norm(ws, (const bf16*)(ws + A_X16B), out, in[37], modl + 5120, (const bf16*)(ws + A_Y0), (const bf16*)(ws + A_Y1), (const int*)(ws + RT_TPOS), (const float*)(ws + RT_GW), gw, NGW, lane);
#ifdef TS_GA
        { VM_WAIT(); xcd_barrier(bar); const float ta = 0.01f * (float)__hip_atomic_load(ctl + 90, RLX_AGENT), tb = 0.01f * (float)__hip_atomic_load(ctl + 91, RLX_AGENT); const float sc = 1.0f + sqrtf(ta * 1e-5f);
          for (int row = gw; row < TOK; row += NGW) { GAS f32x4* xr = (GAS f32x4*)(out + (size_t)row * DM) + lane;
#pragma unroll
              for (int j = 0; j < 4; ++j) xr[64 * j] = xr[64 * j] * sc; }
          VM_WAIT(); xcd_barrier(bar); if (blockIdx.x == 0 && threadIdx.x == 0) out[0] += tb; }
#endif
#ifdef RK_PROBE
        { VM_WAIT(); const float num = __hip_atomic_load((float*)(ctl + 80), RLX_AGENT), den = __hip_atomic_load((float*)(ctl + 81), RLX_AGENT);
#ifdef RK_SELFCHK
          const float n2 = __hip_atomic_load((float*)(ctl + RK_SELFCHK), RLX_AGENT), d2 = __hip_atomic_load((float*)(ctl + RK_SELFCHK + 1), RLX_AGENT); const float sc = 1.0f + sqrtf(n2 / d2) + 0.f * num * den;
#else
          const float sc = 1.0f + sqrtf(num / den);
#endif

          for (int row = gw; row < TOK; row += NGW) { GAS f32x4* xr = (GAS f32x4*)(out + (size_t)row * DM) + lane;
#pragma unroll
              for (int j = 0; j < 4; ++j) xr[64 * j] = xr[64 * j] * sc; } }
#endif
    }
#undef IN_PH
#undef BAR_AFTER
#undef bar
#undef ctl
}

extern "C" void kernel_launch(void* const* d_in, const int* in_sizes, int n_in, void* d_out, int out_size, void* d_ws, size_t ws_size, hipStream_t stream) {
    static int grid = 0;
    if (grid == 0) {
        if (n_in != 38 || in_sizes[0] != TOK * DM || out_size != TOK * DM || ws_size < WS_END) {
            fprintf(stderr, "kernel_launch: unexpected problem (n_in %d, in0 %d, out %d, ws %zu, need %zu); nothing launched\n", n_in, n_in > 0 ? in_sizes[0] : -1, out_size, ws_size, (size_t)WS_END); grid = -1; return; }
        int dev = 0, cus = 0, per_cu = 0;
        if (hipGetDevice(&dev) != hipSuccess || hipDeviceGetAttribute(&cus, hipDeviceAttributeMultiprocessorCount, dev) != hipSuccess) { grid = -1; return; }
        if (hipFuncSetAttribute((const void*)mega_fwd, hipFuncAttributeMaxDynamicSharedMemorySize, LDS_BYTES) != hipSuccess) { fprintf(stderr, "kernel_launch: hipFuncSetAttribute failed\n"); grid = -1; return; }
        if (hipOccupancyMaxActiveBlocksPerMultiprocessor(&per_cu, (const void*)mega_fwd, NTHR, LDS_BYTES) != hipSuccess || per_cu < 1) { fprintf(stderr, "kernel_launch: occupancy query says %d\n", per_cu); }
        (void)hipGetLastError();
        grid = cus;
    }
    if (grid < 0) return;
    (void)hipMemsetAsync((char*)d_ws + WS_CTL, 0, CTL_ZERO_BYTES, stream);
    Args a{};
    for (int i = 0; i < 38; ++i) a.in.p[i] = (const float*)d_in[i];
    a.out = (float*)d_out; a.ws = (unsigned char*)d_ws;
#if MK_SPLIT
    for (int p = 0; p < N_PHASES; ++p) { a.ph_lo = p; a.ph_hi = p + 1; hipLaunchKernelGGL(mega_fwd, dim3(grid), dim3(NTHR), LDS_BYTES, stream, a); }
#else
    a.ph_lo = 0; a.ph_hi = N_PHASES;
    hipLaunchKernelGGL(mega_fwd, dim3(grid), dim3(NTHR), LDS_BYTES, stream, a);
#endif
    const hipError_t le = hipPeekAtLastError();
    if (le != hipSuccess) fprintf(stderr, "kernel_launch: launch failed: %s\n", hipGetErrorName(le));
}
```

```cpp
#include <hip/hip_runtime.h>
#include <cstdio>
#include <cstdint>
namespace pg8 {
constexpr int WAVETAB_OFF = 155648 + 1536;
__device__ __forceinline__ int lane_now() { return (int)__builtin_amdgcn_mbcnt_hi(~0u, __builtin_amdgcn_mbcnt_lo(~0u, 0u)); }
__device__ __forceinline__ int wave_now() { const unsigned h = (unsigned)__builtin_amdgcn_s_getreg((5 << 11) | 4) & 63u;
    return __builtin_amdgcn_readfirstlane((int)*((volatile __attribute__((address_space(3))) unsigned*)(WAVETAB_OFF) + h)); }
__device__ __forceinline__ int tid_now() { return wave_now() * 64 + lane_now(); }
#define PG8_LAS __attribute__((address_space(3)))
typedef unsigned short bf16_t;
typedef short bf16x8 __attribute__((ext_vector_type(8)));
typedef float f32x4 __attribute__((ext_vector_type(4)));
typedef unsigned u32x4 __attribute__((ext_vector_type(4)));
constexpr int BM = 256, BK = 64, HALF = 128, HTB = HALF * BK * 2  , STAGE_BYTES = 8 * HTB, NXCD = 8, WGM = 8;

__host__ __device__ __forceinline__ int lds_byte(int r, int c) { const int st = (r >> 4) * 2 + (c >> 5), rr = r & 15, cc = c & 31, ob = rr * 64 + cc * 2; return st * 1024 + (ob ^ (((ob >> 9) & 1) << 5)); }
__host__ __device__ __forceinline__ void stage_rc(int b, int& R, int& C) { const int st = b / 1024, sb = b % 1024, swz = sb ^ (((sb >> 9) & 1) << 5); R = (st >> 1) * 16 + swz / 64; C = (st & 1) * 32 + (swz % 64) / 2; }
__host__ __device__ __forceinline__ int perm32(int rho) { const int n = rho >> 4, i = rho & 15; return 8 * (i >> 2) + 4 * n + (i & 3); }

struct Unit { int pm, pn; };
struct Gemm { const bf16_t* A; const bf16_t* Bt; int M, N, K; const int* ridx; const int* tile_e; size_t e_stride; int pitch; int pitch_b; };

struct StaticOrder {
    int nM, nN, nwg, G, c, lim, wgm;
    __host__ __device__ __forceinline__ void init(int M, int N, int G_, int c_) { nM = M / BM; nN = N / BM; nwg = nM * nN; G = G_; c = c_; lim = nwg; wgm = (nN >= 9) ? WGM : 16; }
    __host__ __device__ __forceinline__ bool next(int i, Unit& u) const {
        const long L = (long)i * G + c; if (L >= lim) return false;
        int wgid = (int)L; { const int q = nwg / NXCD, r = nwg % NXCD, xcd = wgid % NXCD, off = wgid / NXCD; wgid = (xcd < r ? xcd * (q + 1) : r * (q + 1) + (xcd - r) * q) + off; }
        const int nig = wgm * nN, gid = wgid / nig, fm = gid * wgm, gsz = (nM - fm) < wgm ? (nM - fm) : wgm;
        u.pm = fm + ((wgid % nig) % gsz); u.pn = (wgid % nig) / gsz; return true;
    }
    __device__ __forceinline__ void a_ready(const Unit&) const {}
    __device__ __forceinline__ void done(const Unit&) const {}
};
struct OneUnit { Unit u; bool have;
    __device__ __forceinline__ bool next(int i, Unit& o) const { if (i || !have) return false; o = u; return true; }
    __device__ __forceinline__ void a_ready(const Unit&) const {}
    __device__ __forceinline__ void done(const Unit&) const {}
};

typedef float f32x2_cv __attribute__((ext_vector_type(2))); typedef __bf16 bf16x2_cv __attribute__((ext_vector_type(2)));
__device__ __forceinline__ unsigned cvt_pk_bf16(float lo, float hi) { const f32x2_cv v = {lo, hi}; const bf16x2_cv b = __builtin_convertvector(v, bf16x2_cv); return __builtin_bit_cast(unsigned, b); }
typedef float f32x2 __attribute__((ext_vector_type(2)));
__device__ __forceinline__ f32x2 gelu_pk(f32x2 v) {
    const f32x2 av = __builtin_elementwise_abs(v), d = av * 0.2316418882f + 1.0f;
    f32x2 t; t.x = __builtin_amdgcn_rcpf(d.x); t.y = __builtin_amdgcn_rcpf(d.y);
    f32x2 q = t * 0.5307027145f + (-0.7265760135f); q = q * t + 0.7107068705f; q = q * t + (-0.142248368f); q = q * t + 0.127414796f; q = q * t;
    const f32x2 s = (v * v) * (-0.72134752044f);
    f32x2 e; e.x = __builtin_amdgcn_exp2f(s.x); e.y = __builtin_amdgcn_exp2f(s.y);
    const f32x2 m = v * (q * e), r = v - m;
    f32x2 o; o.x = v.x < 0.f ? m.x : r.x; o.y = v.y < 0.f ? m.y : r.y; return o;
}

template <int ACT  > struct EpiBf16 {
    static constexpr bool PERM = true, AFTER_DRAIN = false; static_assert(ACT == 0 || ACT == 1, "EpiBf16: ACT is 0 (none) or 1 (gelu_pk)");
    bf16_t* O; int ldc; const float* bias; int split_cols; size_t split_stride; float scale0;
    __device__ __forceinline__ void operator()(const f32x4 (&acc)[2][2][4][2], const Unit& u, int wr, int wc, int fr, int fq) const {
        const int row0 = u.pm * BM + wr * 64 + fr; int colt = u.pn * BM; bf16_t* base = O;
        float sc = 1.f; if (split_cols) { const int t = colt / split_cols; base += (size_t)t * split_stride; colt -= t * split_cols; if (t == 0) sc = scale0; }
        const int col0 = colt + wc * 32 + 8 * fq, bcol0 = u.pn * BM + wc * 32 + 8 * fq;
        f32x4 bv[2][2];
#pragma unroll
        for (int bj = 0; bj < 2; ++bj)
#pragma unroll
            for (int n = 0; n < 2; ++n) bv[bj][n] = bias ? *(const f32x4*)(bias + bcol0 + bj * HALF + 4 * n) : (f32x4){0.f, 0.f, 0.f, 0.f};
#pragma unroll
        for (int ai = 0; ai < 2; ++ai)
#pragma unroll
            for (int m = 0; m < 4; ++m) { bf16_t* rowp = base + (size_t)(row0 + ai * HALF + m * 16) * ldc + col0;
#pragma unroll
                for (int bj = 0; bj < 2; ++bj) { f32x4 v0 = acc[ai][bj][m][0] + bv[bj][0], v1 = acc[ai][bj][m][1] + bv[bj][1];
                    if (ACT == 1) { f32x2 a = gelu_pk((f32x2){v0[0], v0[1]}), b = gelu_pk((f32x2){v0[2], v0[3]}), c = gelu_pk((f32x2){v1[0], v1[1]}), d = gelu_pk((f32x2){v1[2], v1[3]});
                        v0 = (f32x4){a.x, a.y, b.x, b.y}; v1 = (f32x4){c.x, c.y, d.x, d.y}; }
                    v0 = v0 * sc; v1 = v1 * sc; u32x4 w; w.x = cvt_pk_bf16(v0[0], v0[1]); w.y = cvt_pk_bf16(v0[2], v0[3]); w.z = cvt_pk_bf16(v1[0], v1[1]); w.w = cvt_pk_bf16(v1[2], v1[3]);
                    *(u32x4*)(rowp + bj * HALF) = w; } }
    }
};

__device__ __forceinline__ float bf2f(unsigned short v) { return __uint_as_float(((unsigned)v) << 16); }
__device__ __forceinline__ float bflo(unsigned w) { return __uint_as_float(w << 16); }
__device__ __forceinline__ float bfhi(unsigned w) { return __uint_as_float(w & 0xffff0000u); }
__device__ __forceinline__ float fsigmoid(float x) { return __builtin_amdgcn_rcpf(1.0f + __builtin_amdgcn_exp2f(-1.4426950408889634f * x)); }
__device__ __forceinline__ u32x4 pack8f(const f32x4 a, const f32x4 b) { u32x4 w; w.x = cvt_pk_bf16(a[0], a[1]); w.y = cvt_pk_bf16(a[2], a[3]); w.z = cvt_pk_bf16(b[0], b[1]); w.w = cvt_pk_bf16(b[2], b[3]); return w; }
__device__ __forceinline__ void unpack8(const u32x4 w, f32x4& a, f32x4& b) { a = (f32x4){bflo(w.x), bfhi(w.x), bflo(w.y), bfhi(w.y)}; b = (f32x4){bflo(w.z), bfhi(w.z), bflo(w.w), bfhi(w.w)}; }

struct EpiKV { static constexpr bool PERM = true, AFTER_DRAIN = false;
    bf16_t* Kb; bf16_t* Vb;
    __device__ __forceinline__ void operator()(const f32x4 (&acc)[2][2][4][2], const Unit& u, int wr, int wc, int fr, int fq) const {
        const int row0 = u.pm * BM + wr * 64 + fr, h = u.pn, col = wc * 32 + 8 * fq;
#pragma unroll
        for (int ai = 0; ai < 2; ++ai)
#pragma unroll
            for (int m = 0; m < 4; ++m) { const int row = row0 + ai * HALF + m * 16; const int b = row >> 12, s = row & 4095;
                const size_t tok = (size_t)(b * 4 + h) * 4096 + s;
                *(u32x4*)(Kb + tok * 192 + col) = pack8f(acc[ai][0][m][0], acc[ai][0][m][1]);
                *(u32x4*)(Vb + tok * 128 + col) = pack8f(acc[ai][1][m][0], acc[ai][1][m][1]); }
    }
};

template <bool NRM, bool BIN> struct EpiResidT { static constexpr bool PERM = true, AFTER_DRAIN = false;
    const void* base; bf16_t* out; const float* gate; const float* gn; const float* scn; bf16_t* An; float* rowsq;
    __device__ __forceinline__ void operator()(const f32x4 (&acc)[2][2][4][2], const Unit& u, int wr, int wc, int fr, int fq) const {
        const int row0 = u.pm * BM + wr * 64 + fr, col0 = u.pn * BM + wc * 32 + 8 * fq, b = (u.pm * BM) >> 12;
        f32x4 gv[2][2], gs[2][2];
#pragma unroll
        for (int bj = 0; bj < 2; ++bj)
#pragma unroll
            for (int n = 0; n < 2; ++n) { gv[bj][n] = *(const f32x4*)(gate + b * 6144 + col0 + bj * HALF + n * 4);
                if (NRM) gs[bj][n] = *(const f32x4*)(gn + col0 + bj * HALF + n * 4) * (*(const f32x4*)(scn + b * 6144 + col0 + bj * HALF + n * 4) + 1.0f); }
        u32x4 nb16[2]; f32x4 nb32[2][2];
#define RESID_LOAD(offq) do { _Pragma("unroll") for (int bj = 0; bj < 2; ++bj) { if (BIN) nb16[bj] = *(const u32x4*)((const bf16_t*)base + (offq) + bj * HALF); \
            else { nb32[bj][0] = *(const f32x4*)((const float*)base + (offq) + bj * HALF); nb32[bj][1] = *(const f32x4*)((const float*)base + (offq) + bj * HALF + 4); } } } while (0)
        RESID_LOAD((size_t)row0 * 1024 + col0);
#pragma unroll
        for (int ai = 0; ai < 2; ++ai)
#pragma unroll
            for (int m = 0; m < 4; ++m) { const int row = row0 + ai * HALF + m * 16; const size_t off = (size_t)row * 1024 + col0; float ss = 0.f;
                f32x4 cx[2][2];
#pragma unroll
                for (int bj = 0; bj < 2; ++bj) { if (BIN) unpack8(nb16[bj], cx[bj][0], cx[bj][1]); else { cx[bj][0] = nb32[bj][0]; cx[bj][1] = nb32[bj][1]; } }
                asm volatile("" : "+v"(cx[0][0]), "+v"(cx[0][1]), "+v"(cx[1][0]), "+v"(cx[1][1]));
                if (ai * 4 + m < 7) { const int i2 = ai * 4 + m + 1; RESID_LOAD((size_t)(row0 + (i2 >> 2) * HALF + (i2 & 3) * 16) * 1024 + col0); }
#pragma unroll
                for (int bj = 0; bj < 2; ++bj) { f32x4 x[2]; x[0] = cx[bj][0]; x[1] = cx[bj][1];
#pragma unroll
                    for (int n = 0; n < 2; ++n) { x[n] = x[n] + gv[bj][n] * acc[ai][bj][m][n];
                        if (NRM) ss += (x[n][0] * x[n][0] + x[n][1] * x[n][1]) + (x[n][2] * x[n][2] + x[n][3] * x[n][3]); }
                    *(u32x4*)(out + off + bj * HALF) = pack8f(x[0], x[1]);
                    if (NRM) *(u32x4*)(An + off + bj * HALF) = pack8f(x[0] * gs[bj][0], x[1] * gs[bj][1]); }
                if (NRM) { ss += __uint_as_float((unsigned)__builtin_amdgcn_ds_swizzle((int)__float_as_uint(ss), 0x1f | (16 << 10)));
                    { const auto rr = __builtin_amdgcn_permlane32_swap(__float_as_uint(ss), __float_as_uint(ss), false, false); ss = __uint_as_float(rr[0]) + __uint_as_float(rr[1]); }
                    if (fq == 0) rowsq[(size_t)row * 16 + u.pn * 4 + wc] = ss; } }
    }
};

#undef RESID_LOAD
__device__ __forceinline__ void row_rstd8(const float* rowsq, int row0, int fq, float (&rs)[8]) {
    f32x4 q[8];
#pragma unroll
    for (int i = 0; i < 8; ++i) q[i] = *(const f32x4*)(rowsq + (size_t)(row0 + (i >> 2) * HALF + (i & 3) * 16) * 16 + 4 * fq);
#pragma unroll
    for (int i = 0; i < 8; ++i) { float t = (q[i][0] + q[i][1]) + (q[i][2] + q[i][3]);
        t += __uint_as_float((unsigned)__builtin_amdgcn_ds_swizzle((int)__float_as_uint(t), 0x1f | (16 << 10)));
        { const auto rr = __builtin_amdgcn_permlane32_swap(__float_as_uint(t), __float_as_uint(t), false, false); t = __uint_as_float(rr[0]) + __uint_as_float(rr[1]); }
        rs[i] = 1.0f / sqrtf(t * (1.0f / 1024.0f) + 1e-6f); }
}
template <bool NRM> struct EpiSwiGLUT { static constexpr bool PERM = true, AFTER_DRAIN = false;
    bf16_t* Hd; int ldh; const float* rowsq; const float* bias; int ldb;
    __device__ __forceinline__ void operator()(const f32x4 (&acc)[2][2][4][2], const Unit& u, int wr, int wc, int fr, int fq) const {
        const int row0 = u.pm * BM + wr * 64 + fr, col = u.pn * HALF + wc * 32 + 8 * fq;
        f32x4 bg[2], bu[2];
        if (NRM) { const float* bp = bias + (size_t)((u.pm * BM) >> 12) * ldb + u.pn * BM + wc * 32 + 8 * fq;
#pragma unroll
            for (int n = 0; n < 2; ++n) { bg[n] = *(const f32x4*)(bp + 4 * n); bu[n] = *(const f32x4*)(bp + HALF + 4 * n); } }
        float rs[8]; if (NRM) row_rstd8(rowsq, row0, fq, rs);
#pragma unroll
        for (int ai = 0; ai < 2; ++ai)
#pragma unroll
            for (int m = 0; m < 4; ++m) { f32x4 r[2]; const int row = row0 + ai * HALF + m * 16;
                const float rstd = NRM ? rs[ai * 4 + m] : 1.0f;
#pragma unroll
                for (int n = 0; n < 2; ++n) { f32x4 g = acc[ai][0][m][n], up = acc[ai][1][m][n];
                    if (NRM) { g = g * rstd + bg[n]; up = up * rstd + bu[n]; }
#pragma unroll
                    for (int e = 0; e < 4; ++e) r[n][e] = g[e] * fsigmoid(g[e]) * up[e]; }
                *(u32x4*)(Hd + (size_t)row * ldh + col) = pack8f(r[0], r[1]); }
    }
};
typedef EpiSwiGLUT<false> EpiSwiGLU;

struct EpiProjN { static constexpr bool PERM = true, AFTER_DRAIN = false;
    bf16_t* O; int ldc; const float* rowsq; const float* bias; int ldb;
    __device__ __forceinline__ void operator()(const f32x4 (&acc)[2][2][4][2], const Unit& u, int wr, int wc, int fr, int fq) const {
        const int row0 = u.pm * BM + wr * 64 + fr, col0 = u.pn * BM + wc * 32 + 8 * fq;
        const float* bp = bias + (size_t)((u.pm * BM) >> 12) * ldb + col0;
        f32x4 bv[2][2];
#pragma unroll
        for (int bj = 0; bj < 2; ++bj)
#pragma unroll
            for (int n = 0; n < 2; ++n) bv[bj][n] = *(const f32x4*)(bp + bj * HALF + 4 * n);
        float rs[8]; row_rstd8(rowsq, row0, fq, rs);
#pragma unroll
        for (int ai = 0; ai < 2; ++ai)
#pragma unroll
            for (int m = 0; m < 4; ++m) { const int row = row0 + ai * HALF + m * 16; const float rstd = rs[ai * 4 + m];
#pragma unroll
                for (int bj = 0; bj < 2; ++bj) *(u32x4*)(O + (size_t)row * ldc + col0 + bj * HALF) = pack8f(acc[ai][bj][m][0] * rstd + bv[bj][0], acc[ai][bj][m][1] * rstd + bv[bj][1]); }
    }
};

struct EpiLora { static constexpr bool PERM = true, AFTER_DRAIN = false;
    const float *w0, *a0, *v0, *k_k, *k_a;
    bf16_t* LW; bf16_t* Kraw; bf16_t* KK; bf16_t* BV; bf16_t* G; bf16_t* Vraw; const bf16_t* VF; const bf16_t* Rr; const float* r_k; float* BON;
    __device__ __forceinline__ void operator()(const f32x4 (&acc)[2][2][4][2], const Unit& u, int wr, int wc, int fr, int fq) const {
        const int row0 = u.pm * BM + wr * 64 + fr, seg = u.pn >> 1, cb = 256 * (u.pn & 1) + 64 * wc + 8 * fq;
        if (seg == 0) {
            f32x4 p[2][2];
#pragma unroll
            for (int bj = 0; bj < 2; ++bj) { p[bj][0] = *(const f32x4*)(w0 + cb + 32 * bj); p[bj][1] = *(const f32x4*)(w0 + cb + 32 * bj + 4); }
#pragma unroll
            for (int ai = 0; ai < 2; ++ai)
#pragma unroll
                for (int m = 0; m < 4; ++m) { bf16_t* rp = LW + (size_t)(row0 + ai * HALF + m * 16) * 512 + cb;
#pragma unroll
                    for (int bj = 0; bj < 2; ++bj) { f32x4 o[2];
#pragma unroll
                        for (int n = 0; n < 2; ++n)
#pragma unroll
                            for (int e = 0; e < 4; ++e) o[n][e] = -0.6065306597126334f * fsigmoid(p[bj][n][e] + acc[ai][bj][m][n][e]);
                        *(u32x4*)(rp + 32 * bj) = pack8f(o[0], o[1]); } }
        } else if (seg == 1) {
            u32x4 nk[2], nr[2];
            { const size_t ro = (size_t)row0 * 512 + cb;
#pragma unroll
              for (int bj = 0; bj < 2; ++bj) { nk[bj] = *(const u32x4*)(Kraw + ro + 32 * bj); nr[bj] = *(const u32x4*)(Rr + ro + 32 * bj); } }
#pragma unroll
            for (int ai = 0; ai < 2; ++ai)
#pragma unroll
                for (int m = 0; m < 4; ++m) { const size_t ro = (size_t)(row0 + ai * HALF + m * 16) * 512 + cb;
                    u32x4 ck[2], cr[2];
#pragma unroll
                    for (int bj = 0; bj < 2; ++bj) { ck[bj] = nk[bj]; cr[bj] = nr[bj]; }
                    if (ai * 4 + m < 7) { const int i2 = ai * 4 + m + 1; const size_t rn = (size_t)(row0 + (i2 >> 2) * HALF + (i2 & 3) * 16) * 512 + cb;
#pragma unroll
                        for (int bj = 0; bj < 2; ++bj) { nk[bj] = *(const u32x4*)(Kraw + rn + 32 * bj); nr[bj] = *(const u32x4*)(Rr + rn + 32 * bj); } }
                    float ss = 0.f;
#pragma unroll
                    for (int bj = 0; bj < 2; ++bj) { f32x4 kv[2]; unpack8(ck[bj], kv[0], kv[1]);
#pragma unroll
                        for (int n = 0; n < 2; ++n) { const f32x4 pk = *(const f32x4*)(k_k + cb + 32 * bj + 4 * n); const f32x4 t = kv[n] * pk; ss += (t[0] * t[0] + t[1] * t[1]) + (t[2] * t[2] + t[3] * t[3]); } }
                    ss += __uint_as_float((unsigned)__builtin_amdgcn_ds_swizzle((int)__float_as_uint(ss), 0x1f | (16 << 10)));
                    { const auto rr = __builtin_amdgcn_permlane32_swap(__float_as_uint(ss), __float_as_uint(ss), false, false); ss = __uint_as_float(rr[0]) + __uint_as_float(rr[1]); }
                    const float inv = 1.0f / fmaxf(sqrtf(ss), 1e-12f);
                    float bsum = 0.f;
#pragma unroll
                    for (int bj = 0; bj < 2; ++bj) { f32x4 kv[2], rv[2], k2[2], kk2[2], b2[2]; unpack8(ck[bj], kv[0], kv[1]); unpack8(cr[bj], rv[0], rv[1]);
#pragma unroll
                        for (int n = 0; n < 2; ++n) { const f32x4 pa = *(const f32x4*)(a0 + cb + 32 * bj + 4 * n), pk = *(const f32x4*)(k_k + cb + 32 * bj + 4 * n), pq = *(const f32x4*)(k_a + cb + 32 * bj + 4 * n), pr = *(const f32x4*)(r_k + cb + 32 * bj + 4 * n);
#pragma unroll
                            for (int e = 0; e < 4; ++e) { const float a = fsigmoid(pa[e] + acc[ai][bj][m][n][e]), kkn = kv[n][e] * pk[e] * inv; kk2[n][e] = kkn; b2[n][e] = kkn * a; k2[n][e] = kv[n][e] * (1.0f + (a - 1.0f) * pq[e]);
                                bsum += rv[n][e] * bflo(cvt_pk_bf16(k2[n][e], 0.f)) * pr[e]; } }
                        *(u32x4*)(Kraw + ro + 32 * bj) = pack8f(k2[0], k2[1]); *(u32x4*)(KK + ro + 32 * bj) = pack8f(kk2[0], kk2[1]); *(u32x4*)(BV + ro + 32 * bj) = pack8f(b2[0], b2[1]); }
                    bsum += __uint_as_float((unsigned)__builtin_amdgcn_ds_swizzle((int)__float_as_uint(bsum), 0x1f | (16 << 10)));
                    { const auto rr = __builtin_amdgcn_permlane32_swap(__float_as_uint(bsum), __float_as_uint(bsum), false, false); bsum = __uint_as_float(rr[0]) + __uint_as_float(rr[1]); }
                    if (fq == 0) BON[(size_t)(row0 + ai * HALF + m * 16) * 8 + 4 * (u.pn & 1) + wc] = bsum;
                    asm volatile("" ::: "memory"); }
        } else if (seg == 2) {
#pragma unroll
            for (int ai = 0; ai < 2; ++ai)
#pragma unroll
                for (int m = 0; m < 4; ++m) { bf16_t* rp = G + (size_t)(row0 + ai * HALF + m * 16) * 512 + cb;
#pragma unroll
                    for (int bj = 0; bj < 2; ++bj) *(u32x4*)(rp + 32 * bj) = pack8f(acc[ai][bj][m][0], acc[ai][bj][m][1]); }
        } else {
            f32x4 p[2][2];
#pragma unroll
            for (int bj = 0; bj < 2; ++bj) { p[bj][0] = *(const f32x4*)(v0 + cb + 32 * bj); p[bj][1] = *(const f32x4*)(v0 + cb + 32 * bj + 4); }
#pragma unroll
            for (int r0 = 0; r0 < 8; r0 += 2) { u32x4 hv[2][2], hf[2][2];
#pragma unroll
                for (int i = 0; i < 2; ++i) { const size_t ro = (size_t)(row0 + ((r0 + i) >> 2) * HALF + ((r0 + i) & 3) * 16) * 512 + cb;
#pragma unroll
                    for (int bj = 0; bj < 2; ++bj) { hv[i][bj] = *(const u32x4*)(Vraw + ro + 32 * bj); hf[i][bj] = *(const u32x4*)(VF + ro + 32 * bj); } }
#pragma unroll
                for (int i = 0; i < 2; ++i) { const int ai = (r0 + i) >> 2, m = (r0 + i) & 3; const size_t ro = (size_t)(row0 + ai * HALF + m * 16) * 512 + cb;
#pragma unroll
                    for (int bj = 0; bj < 2; ++bj) { f32x4 vv[2], vf[2], o[2]; unpack8(hv[i][bj], vv[0], vv[1]); unpack8(hf[i][bj], vf[0], vf[1]);
#pragma unroll
                        for (int n = 0; n < 2; ++n)
#pragma unroll
                            for (int e = 0; e < 4; ++e) o[n][e] = vv[n][e] + (vf[n][e] - vv[n][e]) * fsigmoid(p[bj][n][e] + acc[ai][bj][m][n][e]);
                        *(u32x4*)(Vraw + ro + 32 * bj) = pack8f(o[0], o[1]); } } }
        }
    }
};

struct EpiSlab { static constexpr bool PERM = false, AFTER_DRAIN = false;
    float* slab;
    __device__ __forceinline__ void operator()(const f32x4 (&acc)[2][2][4][2], const Unit& u, int wr, int wc, int fr, int fq) const {
        const int tid = (wr * 4 + wc) * 64 + fq * 16 + fr;
#pragma unroll
        for (int ai = 0; ai < 2; ++ai)
#pragma unroll
            for (int bj = 0; bj < 2; ++bj)
#pragma unroll
                for (int m = 0; m < 4; ++m)
#pragma unroll
                    for (int n = 0; n < 2; ++n) *(f32x4*)(slab + ((size_t)((((ai * 2 + bj) * 4 + m) * 2 + n) * 512 + tid)) * 4) = acc[ai][bj][m][n];
    }
};
struct G2Plan { int full, tail, spl; };
__device__ __forceinline__ G2Plan g2_plan(int nt, int G, int cap) { G2Plan p; const int nunits = nt * 4; p.full = (nunits / G) * G; p.tail = nunits - p.full; if (cap > G) cap = G;
    p.spl = (p.tail * 7 <= cap) ? 7 : ((p.tail * 4 <= cap) ? 4 : ((p.tail * 2 <= cap) ? 2 : 1)); if (p.tail == 0 || p.spl == 1) { p.full = nunits; p.tail = 0; p.spl = 1; } return p; }
template <class Epi, class Sched, bool ALIGN_EPI = false, bool SP2 = false, int MODE = 0>
__device__ __forceinline__ void gemm_phase(PG8_LAS unsigned char* lds, const Gemm g, const Sched& S, const Epi& E) {
    int tid_ = tid_now(); asm volatile("" : "+v"(tid_));
    const int tid = tid_, wid = __builtin_amdgcn_readfirstlane(tid >> 6), lane = tid & 63, wr = wid >> 2, wc = wid & 3, fr = lane & 15, fq = lane >> 4;
    int K_ = __builtin_amdgcn_readfirstlane(g.K); asm volatile("" : "+s"(K_));
    const int K = K_, nt = K / BK;
    int P_ = __builtin_amdgcn_readfirstlane(g.pitch ? g.pitch : K_); asm volatile("" : "+s"(P_)); const int P = P_;
    int PB_ = __builtin_amdgcn_readfirstlane(g.pitch_b ? g.pitch_b : P_); asm volatile("" : "+s"(PB_)); const int PB = PB_;
    unsigned voffA[2], voffB[2]; int gR[2], gC[2]; unsigned vAc[2][2], vAn[2][2]; int rawN[2][2];
    static_assert(SP2 || MODE == 0, "MODE != 0 needs SP2");
#pragma unroll
    for (int i = 0; i < 2; ++i) { int R, C; stage_rc(tid * 16 + i * 8192, R, C); const int Rb = Epi::PERM ? ((R & ~31) + perm32(R & 31)) : R;
        voffA[i] = (unsigned)(R * P + C) * 2u; voffB[i] = (unsigned)(Rb * PB + C) * 2u; gR[i] = R; gC[i] = C; }
    const size_t kstep = (size_t)(BK * 2);
    const size_t hstep = (size_t)HALF * P * 2;
    const size_t tstep = 2 * hstep;
    const size_t hstepB = (size_t)HALF * PB * 2, tstepB = 2 * hstepB;
    const unsigned ldsw = (unsigned)wid * 1024u;
    const int aoff = lds_byte(wr * 64 + fr, fq * 8), boff = lds_byte(wc * 32 + fr, fq * 8);
#define PG8_SA(b, h) (((b) * 2 + (h)) * HTB)
#define PG8_SB(b, h) ((4 + (b) * 2 + (h)) * HTB)
#define PG8_STAGE(bufoff, gbase, voff) do { _Pragma("unroll") for (int _i = 0; _i < 2; ++_i) \
        __builtin_amdgcn_global_load_lds((const unsigned*)((const char*)(gbase) + (voff)[_i]), (PG8_LAS unsigned*)(lds + (bufoff) + ldsw + _i * 8192), 16, 0, 0); } while (0)
#define PG8_GATHER(dst, U) do { _Pragma("unroll") for (int _h = 0; _h < 2; ++_h) _Pragma("unroll") for (int _i = 0; _i < 2; ++_i) { \
        int _r = g.ridx[(U).pm * BM + _h * HALF + gR[_i]]; _r = _r < 0 ? 0 : _r; dst[_h][_i] = (unsigned)(_r * P + gC[_i]) * 2u; } } while (0)
#define PG8_GATHER_RAW(U) do { _Pragma("unroll") for (int _h = 0; _h < 2; ++_h) _Pragma("unroll") for (int _i = 0; _i < 2; ++_i) { \
        const __attribute__((address_space(1))) int* _p = (const __attribute__((address_space(1))) int*)(g.ridx + ((U).pm * BM + _h * HALF + gR[_i])); \
        asm volatile("global_load_dword %0, %1, off" : "=v"(rawN[_h][_i]) : "v"(_p) : "memory"); } } while (0)
#define PG8_GATHER_FIN() do { _Pragma("unroll") for (int _h = 0; _h < 2; ++_h) _Pragma("unroll") for (int _i = 0; _i < 2; ++_i) { \
        int _r = rawN[_h][_i]; asm volatile("" : "+v"(_r));     \
        _r = _r < 0 ? 0 : _r; vAn[_h][_i] = (unsigned)(_r * P + gC[_i]) * 2u; } } while (0)
#define PG8_STAGE_A(bufoff, kptr, h, NXT) do { if constexpr (MODE == 1) { _Pragma("unroll") for (int _i = 0; _i < 2; ++_i) \
        __builtin_amdgcn_global_load_lds((const unsigned*)((const char*)(kptr) + ((NXT) ? vAn[h][_i] : vAc[h][_i])), (PG8_LAS unsigned*)(lds + (bufoff) + ldsw + _i * 8192), 16, 0, 0); } \
    else { PG8_STAGE(bufoff, (kptr) + (h) * hstep, voffA); } } while (0)
#define PG8_APTR(U) ((MODE == 1) ? (const char*)g.A : (MODE == 3) ? (const char*)g.A + (size_t)(U).pm * tstep + (((U).pn >> 1) < 2 ? 0 : (((U).pn >> 1) - 1) * 256) : (const char*)g.A + (size_t)(U).pm * tstep)
#define PG8_BPTR(U) ((MODE == 1 || MODE == 2) ? (const char*)g.Bt + (size_t)g.tile_e[(U).pm] * g.e_stride + (size_t)(U).pn * tstepB : (const char*)g.Bt + (size_t)(U).pn * tstepB)
#define PG8_LDA(dst, b, h) do { _Pragma("unroll") for (int m = 0; m < 4; ++m) _Pragma("unroll") for (int k = 0; k < 2; ++k) dst[m][k] = *(const PG8_LAS bf16x8*)(lds + PG8_SA(b, h) + aoff + m * 2048 + k * 1024); } while (0)
#define PG8_LDB(dst, b, h) do { _Pragma("unroll") for (int n = 0; n < 2; ++n) _Pragma("unroll") for (int k = 0; k < 2; ++k) dst[n][k] = *(const PG8_LAS bf16x8*)(lds + PG8_SB(b, h) + boff + n * 2048 + k * 1024); } while (0)
#define PG8_MMA(ai, bj, At, Bt) do { __builtin_amdgcn_s_setprio(1); _Pragma("unroll") for (int m = 0; m < 4; ++m) _Pragma("unroll") for (int n = 0; n < 2; ++n) _Pragma("unroll") for (int k = 0; k < 2; ++k) \
        acc[ai][bj][m][n] = __builtin_amdgcn_mfma_f32_16x16x32_bf16(Bt[n][k], At[m][k], acc[ai][bj][m][n], 0, 0, 0); __builtin_amdgcn_s_setprio(0); } while (0)
#define PG8_WAIT_V(n) asm volatile("s_waitcnt vmcnt(" #n ")" ::: "memory")
#define PG8_WAIT_L(n) asm volatile("s_waitcnt lgkmcnt(" #n ")" ::: "memory")
#define PG8_BAR __builtin_amdgcn_s_barrier()
#define PG8_SCHED __builtin_amdgcn_sched_barrier(0)
    Unit cur, nxt; int ui = 0;
    if (!S.next(0, cur)) return;
    f32x4 acc[2][2][4][2];
#pragma unroll
    for (int a = 0; a < 2; ++a)
#pragma unroll
        for (int b = 0; b < 2; ++b)
#pragma unroll
            for (int m = 0; m < 4; ++m)
#pragma unroll
                for (int n = 0; n < 2; ++n) acc[a][b][m][n] = (f32x4){0.f, 0.f, 0.f, 0.f};
    bf16x8 At[4][2], B0[2][2], B1[2][2];
    const char* cA = PG8_APTR(cur); const char* cB = PG8_BPTR(cur);
    if constexpr (MODE == 1) { PG8_GATHER(vAc, cur); }
    S.a_ready(cur);
    if constexpr (SP2) {
        PG8_STAGE(PG8_SB(0, 0), cB, voffB); PG8_STAGE(PG8_SB(0, 1), cB + hstepB, voffB); PG8_STAGE_A(PG8_SA(0, 0), cA, 0, false); PG8_STAGE_A(PG8_SA(0, 1), cA, 1, false);
        if (wr == 1) PG8_BAR;
        PG8_WAIT_V(2); PG8_BAR;
        PG8_STAGE(PG8_SB(1, 0), cB + kstep, voffB); PG8_STAGE_A(PG8_SA(1, 0), cA + kstep, 0, false); PG8_STAGE(PG8_SB(1, 1), cB + hstepB + kstep, voffB);
        PG8_WAIT_V(6); PG8_BAR;
    } else {
        PG8_STAGE(PG8_SB(0, 0), cB, voffB); PG8_STAGE(PG8_SA(0, 0), cA, voffA); PG8_STAGE(PG8_SB(0, 1), cB + hstepB, voffB); PG8_STAGE(PG8_SA(0, 1), cA + hstep, voffA);
        if (wr == 1) PG8_BAR;
        PG8_WAIT_V(4); PG8_BAR;
        PG8_STAGE(PG8_SB(1, 0), cB + kstep, voffB); PG8_STAGE(PG8_SA(1, 0), cA + kstep, voffA); PG8_STAGE(PG8_SB(1, 1), cB + hstepB + kstep, voffB);
        PG8_WAIT_V(6); PG8_BAR;
    }
    for (;;) {
        const bool has_next = S.next(ui + 1, nxt);
        const char* nA = has_next ? PG8_APTR(nxt) : cA; const char* nB = has_next ? PG8_BPTR(nxt) : cB;
        if constexpr (MODE == 1) { if (has_next) { PG8_GATHER_RAW(nxt); } else { vAn[0][0] = vAc[0][0]; vAn[0][1] = vAc[0][1]; vAn[1][0] = vAc[1][0]; vAn[1][1] = vAc[1][1]; } }
        for (int t = 0; t < nt; t += 2) {
            const bool last = (t == nt - 2);
            const char* a1 = cA + (size_t)(t + 1) * kstep;
            const char* a2 = last ? nA : cA + (size_t)(t + 2) * kstep; const char* b2 = last ? nB : cB + (size_t)(t + 2) * kstep;
            const char* a3 = a2 + kstep; const char* b3 = b2 + kstep;
            if (last && has_next) S.a_ready(nxt);
            if constexpr (MODE == 1) { if (last && has_next) { PG8_GATHER_FIN(); } }
            if constexpr (SP2) {
            PG8_LDB(B0, 0, 0); PG8_LDB(B1, 0, 1); PG8_SCHED; PG8_LDA(At, 0, 0); PG8_STAGE_A(PG8_SA(1, 1), a1, 1, false);
            PG8_WAIT_V(8); PG8_WAIT_L(0); PG8_BAR; PG8_MMA(0, 0, At, B0); PG8_MMA(0, 1, At, B1); PG8_BAR; PG8_SCHED;
            PG8_LDA(At, 0, 1); PG8_STAGE(PG8_SB(0, 0), b2, voffB); PG8_STAGE(PG8_SB(0, 1), b2 + hstepB, voffB); PG8_STAGE_A(PG8_SA(0, 0), a2, 0, last);
            PG8_WAIT_V(8); PG8_WAIT_L(0); PG8_BAR; PG8_MMA(1, 0, At, B0); PG8_MMA(1, 1, At, B1); PG8_BAR; PG8_SCHED;
            PG8_LDB(B0, 1, 0); PG8_LDB(B1, 1, 1); PG8_SCHED; PG8_LDA(At, 1, 0); PG8_STAGE_A(PG8_SA(0, 1), a2, 1, last);
            PG8_WAIT_V(8); PG8_WAIT_L(0); PG8_BAR; PG8_MMA(0, 0, At, B0); PG8_MMA(0, 1, At, B1); PG8_BAR; PG8_SCHED;
            PG8_LDA(At, 1, 1); PG8_STAGE(PG8_SB(1, 0), b3, voffB); PG8_STAGE(PG8_SB(1, 1), b3 + hstepB, voffB); PG8_STAGE_A(PG8_SA(1, 0), a3, 0, last);
            PG8_WAIT_V(8); PG8_WAIT_L(0); PG8_BAR; PG8_MMA(1, 0, At, B0); PG8_MMA(1, 1, At, B1); PG8_BAR; PG8_SCHED;
            } else {
            PG8_LDB(B0, 0, 0); PG8_SCHED; PG8_LDA(At, 0, 0); PG8_STAGE(PG8_SA(1, 1), a1 + hstep, voffA);
            PG8_WAIT_L(8); PG8_BAR; PG8_WAIT_L(0); PG8_MMA(0, 0, At, B0); PG8_BAR; PG8_SCHED;
            PG8_LDB(B1, 0, 1); PG8_STAGE(PG8_SB(0, 0), b2, voffB);
            PG8_BAR; PG8_WAIT_L(0); PG8_MMA(0, 1, At, B1); PG8_BAR;
            PG8_LDA(At, 0, 1); PG8_STAGE(PG8_SA(0, 0), a2, voffA);
            PG8_BAR; PG8_WAIT_L(0); PG8_MMA(1, 0, At, B0); PG8_BAR; PG8_SCHED;
            PG8_STAGE(PG8_SB(0, 1), b2 + hstepB, voffB);
            PG8_WAIT_V(6); PG8_BAR; PG8_MMA(1, 1, At, B1); PG8_BAR;
            PG8_LDB(B0, 1, 0); PG8_SCHED; PG8_LDA(At, 1, 0); PG8_STAGE(PG8_SA(0, 1), a2 + hstep, voffA);
            PG8_WAIT_L(8); PG8_BAR; PG8_WAIT_L(0); PG8_MMA(0, 0, At, B0); PG8_BAR; PG8_SCHED;
            PG8_LDB(B1, 1, 1); PG8_STAGE(PG8_SB(1, 0), b3, voffB);
            PG8_BAR; PG8_WAIT_L(0); PG8_MMA(0, 1, At, B1); PG8_BAR;
            PG8_LDA(At, 1, 1); PG8_STAGE(PG8_SA(1, 0), a3, voffA);
            PG8_BAR; PG8_WAIT_L(0); PG8_MMA(1, 0, At, B0); PG8_BAR; PG8_SCHED;
            PG8_STAGE(PG8_SB(1, 1), b3 + hstepB, voffB);
            PG8_WAIT_V(6); PG8_BAR; PG8_MMA(1, 1, At, B1); PG8_BAR;
            }
        }
        if constexpr (ALIGN_EPI) { if (wr == 0) PG8_BAR; }
        if constexpr (!Epi::AFTER_DRAIN) { E(acc, cur, wr, wc, fr, fq); S.done(cur); }
        if (!has_next) break;
#pragma unroll
        for (int a = 0; a < 2; ++a)
#pragma unroll
            for (int b = 0; b < 2; ++b)
#pragma unroll
                for (int m = 0; m < 4; ++m)
#pragma unroll
                    for (int n = 0; n < 2; ++n) acc[a][b][m][n] = (f32x4){0.f, 0.f, 0.f, 0.f};
        cur = nxt; cA = nA; cB = nB; ++ui;
        if constexpr (MODE == 1) { vAc[0][0] = vAn[0][0]; vAc[0][1] = vAn[0][1]; vAc[1][0] = vAn[1][0]; vAc[1][1] = vAn[1][1]; }
        if constexpr (ALIGN_EPI) { if (wr == 1) PG8_BAR; }
    }
    PG8_WAIT_V(0);
    if constexpr (!ALIGN_EPI) { if (wr == 0) PG8_BAR; }
    PG8_BAR;
    if constexpr (Epi::AFTER_DRAIN) { E.fused(acc, cur, wr, wc, fr, fq, lds, wid, lane); S.done(cur); }
#undef PG8_SA
#undef PG8_SB
#undef PG8_STAGE
#undef PG8_STAGE_A
#undef PG8_GATHER
#undef PG8_GATHER_RAW
#undef PG8_GATHER_FIN
#undef PG8_APTR
#undef PG8_BPTR
#undef PG8_LDA
#undef PG8_LDB
#undef PG8_MMA
#undef PG8_WAIT_V
#undef PG8_WAIT_L
#undef PG8_BAR
#undef PG8_SCHED
}
}

#define GAS __attribute__((address_space(1)))
#define LAS __attribute__((address_space(3)))
typedef unsigned short bf16;
typedef unsigned v4u __attribute__((ext_vector_type(4)));
typedef unsigned v2u __attribute__((ext_vector_type(2)));
typedef float f32x4 __attribute__((ext_vector_type(4)));
typedef float f32x16 __attribute__((ext_vector_type(16)));
typedef short bf16x8 __attribute__((ext_vector_type(8)));
typedef short s16x4 __attribute__((ext_vector_type(4)));
typedef GAS unsigned gu32;
#define RLX_AGENT __ATOMIC_RELAXED, __HIP_MEMORY_SCOPE_AGENT
#define LDS_WAIT() asm volatile("s_waitcnt lgkmcnt(0)" ::: "memory")
#define VM_WAIT() asm volatile("s_waitcnt vmcnt(0)" ::: "memory")
using pg8::bf2f; using pg8::bflo; using pg8::bfhi; using pg8::fsigmoid; using pg8::cvt_pk_bf16;

#ifndef MK_SPLIT
#define MK_SPLIT 0
#endif

constexpr int NWAVES = 8, NTHR = 512;
constexpr int NB = 8, SEQ = 4096, TOK = NB * SEQ, DM = 1024;
constexpr int NPROJ = 2304;
constexpr int NQ = 768, NKV = 1024, KLORA = 384, NLORA = 2048, RW = 512, KLW = 128;
constexpr int FFD = 2816, FFE = 3584, NEXP = 8;
constexpr int MODLD = 6144;
constexpr int CONV_WGS = 80;
constexpr int PASS_TILES = 136;
constexpr int PASS_ROWS = PASS_TILES * 256;

constexpr size_t MiB = 1u << 20;
constexpr size_t WS_CTL = 0, CTL_ZERO_BYTES = 64 * 1024;
constexpr size_t WS_MOD = 1 * MiB;
constexpr size_t WS_BIAS2 = WS_MOD + 512 * 1024;
constexpr size_t WS_BIAS1 = WS_MOD + 768 * 1024;
constexpr size_t WS_ROUTE = 2 * MiB;
constexpr size_t WS_WIN = 4 * MiB;
constexpr size_t WS_WUQ = WS_WIN + 2ull * NPROJ * DM * 2;
constexpr size_t WS_WUKV = WS_WUQ + 2ull * NQ * 256 * 2;
constexpr size_t WS_WLORA = WS_WUKV + 2ull * NKV * 128 * 2;
constexpr size_t WS_WOUT = WS_WLORA + 2ull * NLORA * KLORA * 2;
constexpr size_t WS_WF1 = WS_WOUT + 2ull * DM * DM * 2;
constexpr size_t WS_WF2 = WS_WF1 + 2ull * FFD * DM * 2;
constexpr size_t WS_WEND = WS_WF2 + (size_t)DM * FFD * 2;
constexpr size_t WS_VFIRST = 38 * MiB;
constexpr size_t WS_ARENA = 70 * MiB;
static_assert(WS_WEND <= WS_VFIRST, "weights overflow");
constexpr size_t A_H = WS_ARENA + 0 * MiB;
constexpr size_t A_PROJ = WS_ARENA + 64 * MiB;
constexpr size_t A_CQ = WS_ARENA + 208 * MiB;
constexpr size_t A_CKV = WS_ARENA + 224 * MiB;
constexpr size_t A_LA = WS_ARENA + 232 * MiB;
constexpr size_t A_KB = WS_ARENA + 256 * MiB;
constexpr size_t A_R = WS_ARENA + 304 * MiB;
constexpr size_t A_KRAW = WS_ARENA + 336 * MiB;
constexpr size_t A_VRAW = WS_ARENA + 368 * MiB;
constexpr size_t A_VB = WS_ARENA + 400 * MiB;
constexpr size_t A_KK = WS_ARENA + 432 * MiB;
constexpr size_t A_BV = WS_ARENA + 464 * MiB;
constexpr size_t A_BON = WS_ARENA + 496 * MiB;
constexpr size_t A_RSQ = WS_ARENA + 498 * MiB;
constexpr size_t A_Q = WS_ARENA + 0 * MiB;
constexpr size_t A_LW = WS_ARENA + 64 * MiB;
constexpr size_t A_LWH = WS_ARENA + 160 * MiB;
constexpr size_t A_G = WS_ARENA + 128 * MiB;
constexpr size_t A_YCAT = WS_ARENA + 160 * MiB;
constexpr size_t A_HID = WS_ARENA + 64 * MiB;
constexpr size_t A_X16B = 4 * MiB;
constexpr size_t A_HIDM = WS_ARENA + 0 * MiB;
constexpr size_t A_WE1 = WS_ARENA + 238 * MiB;
constexpr size_t A_WE2 = WS_ARENA + 350 * MiB;
constexpr size_t A_Y0 = WS_ARENA + 406 * MiB;
constexpr size_t A_Y1 = A_WE1;
constexpr size_t WS_WOUT1 = WS_ARENA + 500 * MiB;
constexpr size_t DO_H2 = 0;
constexpr size_t DO_X16A = 64 * MiB;
constexpr size_t DO_SLAB = 64 * MiB;
constexpr int SLAB0_CAP = 256;
constexpr size_t WS_END = WS_ARENA + 504 * MiB;
static_assert(A_HIDM + (size_t)PASS_ROWS * FFE * 2 <= A_WE1, "moe hidden overflow");
static_assert(A_Y0 + (size_t)PASS_ROWS * DM * 2 <= A_BON, "Y0 overflow");
constexpr size_t RT_SEL = WS_ROUTE;
constexpr size_t RT_GW = RT_SEL + (size_t)TOK * 8;
constexpr size_t RT_CNT = RT_GW + (size_t)TOK * 8;
constexpr size_t RT_RIDX = RT_CNT + 256 * 16 * 4;
constexpr size_t RT_RGW = RT_RIDX + 2ull * PASS_ROWS * 4;
constexpr size_t RT_TILE = RT_RGW + 2ull * PASS_ROWS * 4;
constexpr size_t RT_TPOS = WS_ROUTE + 1280 * 1024;
static_assert(RT_TILE + 2 * (PASS_TILES + 8) * 4 <= RT_TPOS && RT_TPOS + 2ull * TOK * 4 <= WS_WIN, "route tables overflow");

constexpr int CW_QCTR = 64;
constexpr int CW_BAR = 4096;
constexpr size_t WS_PADST = 32 * 1024;
#define PAD_STORES(ws_, gw_, n_) do { GAS unsigned* ps_ = (GAS unsigned*)((ws_) + WS_CTL + WS_PADST); _Pragma("unroll") for (int i_ = 0; i_ < (n_); ++i_) __builtin_nontemporal_store(0u, ps_ + 64 * i_); } while (0)

constexpr int RING_BYTES = 155648;
constexpr int LDSCTL_OFF = RING_BYTES, MISC_OFF = LDSCTL_OFF + 320, PTAB_OFF = LDSCTL_OFF + 1024, TS_OFF = LDSCTL_OFF + 2048;
constexpr int LDS_BYTES = 163840;

#define XB_TMO      128
#define XB_XCNT(j)  (256  + 64 * (j))
#define XB_XSUB(j)  (1280 + 64 * (j))
#define XB_XGEN(j)  (2304 + 64 * (j))
#define XB_TOP      3328
#define XB_TOPGEN   3392
#define XCD_BAR_WORDS 3456
#define XB_SPIN_CAP (1u << 18)

__device__ __forceinline__ unsigned xb_ld(unsigned* p)              { return __hip_atomic_load(p, __ATOMIC_RELAXED, __HIP_MEMORY_SCOPE_AGENT); }
__device__ __forceinline__ unsigned xb_add(unsigned* p, unsigned v) { return __hip_atomic_fetch_add(p, v, __ATOMIC_RELAXED, __HIP_MEMORY_SCOPE_AGENT); }
__device__ __forceinline__ unsigned xb_xcc_id() { return (unsigned)__builtin_amdgcn_s_getreg((3 << 11) | 20) & 0xFu; }
#define XB_SPIN(cond, bar) do { unsigned _sp = 0; while (cond) { __builtin_amdgcn_s_sleep(1); \
    if ((++_sp & 255u) == 0u) { if (xb_ld(&(bar)[XB_TMO])) break; if (_sp > XB_SPIN_CAP) { atomicAdd(&(bar)[XB_TMO], 1u); break; } } } } while (0)

struct XcdBarrier {
    unsigned* bar; unsigned x;
    volatile LAS unsigned* st;
};

__device__ __forceinline__ XcdBarrier xcd_barrier_post(unsigned* bar, volatile LAS unsigned* st) {
    XcdBarrier b; b.bar = bar; b.x = xb_xcc_id(); b.st = st;
    if (pg8::tid_now() == 0) (void)xb_add(&bar[XB_XCNT(b.x)], 1u);
    return b;
}
__device__ __forceinline__ void xcd_barrier_complete(unsigned* bar, unsigned x, unsigned& nloc, unsigned& nx) {
    const unsigned G = gridDim.x * gridDim.y * gridDim.z;
    unsigned sum, cnt, mine, sp = 0u;
    for (;;) {
        sum = 0u; cnt = 0u; mine = 0u;
#pragma unroll
        for (unsigned j = 0; j < 16; ++j) { const unsigned c = xb_ld(&bar[XB_XCNT(j)]); sum += c; cnt += (c > 0u) ? 1u : 0u; mine = (j == x) ? c : mine; }
        if (sum == G) break;
        __builtin_amdgcn_s_sleep(1);
        if ((++sp & 255u) == 0u) { if (xb_ld(&bar[XB_TMO])) break; if (sp > XB_SPIN_CAP) { atomicAdd(&bar[XB_TMO], 1u); break; } }
    }
    nloc = mine > 0u ? mine : 1u; nx = cnt > 0u ? cnt : 1u;
}

__device__ __forceinline__ void xcd_barrier(const XcdBarrier& b) {
    asm volatile("s_waitcnt vmcnt(0)" ::: "memory");
    __syncthreads();
    if (pg8::tid_now() == 0) {
        unsigned* bar = b.bar;
        __builtin_amdgcn_s_waitcnt(0);
        unsigned nloc = b.st[0], nx = b.st[1];
        if (nloc == 0u) { xcd_barrier_complete(bar, b.x, nloc, nx); b.st[0] = nloc; b.st[1] = nx; }
        const unsigned old = xb_add(&bar[XB_XSUB(b.x)], 1u);
        const unsigned gen = old / nloc;
        if (old + 1u == (gen + 1u) * nloc) {
            __builtin_amdgcn_fence(__ATOMIC_RELEASE, "agent");
            asm volatile("s_waitcnt vmcnt(0)" ::: "memory");
            const unsigned og = xb_add(&bar[XB_TOP], 1u);
            const unsigned tg = og / nx;
            if (og + 1u == (tg + 1u) * nx) xb_add(&bar[XB_TOPGEN], 1u);
            else XB_SPIN(xb_ld(&bar[XB_TOPGEN]) == tg, bar);
            __builtin_amdgcn_fence(__ATOMIC_ACQUIRE, "agent");
            xb_add(&bar[XB_XGEN(b.x)], 1u);
            asm volatile("s_waitcnt vmcnt(0)" ::: "memory");
        } else {
            XB_SPIN(xb_ld(&bar[XB_XGEN(b.x)]) == gen, bar);
            __builtin_amdgcn_fence(__ATOMIC_ACQUIRE, "agent");
            asm volatile("s_waitcnt vmcnt(0)" ::: "memory");
        }
    }
    __syncthreads();
}


template <int X> __device__ __forceinline__ float lane_xor(float v) {
    if constexpr (X == 32) { const auto rr = __builtin_amdgcn_permlane32_swap(__float_as_uint(v), __float_as_uint(v), false, false); return __uint_as_float((__builtin_amdgcn_mbcnt_lo(~0u, 0u) == 32u) ? rr[0] : rr[1]); }
    else return __uint_as_float((unsigned)__builtin_amdgcn_ds_swizzle((int)__float_as_uint(v), 0x1f | (X << 10)));
}
__device__ __forceinline__ float wave_sum(float v) {
    v += lane_xor<1>(v); v += lane_xor<2>(v); v += lane_xor<4>(v); v += lane_xor<8>(v); v += lane_xor<16>(v);
    { const auto rr = __builtin_amdgcn_permlane32_swap(__float_as_uint(v), __float_as_uint(v), false, false); v = __uint_as_float(rr[0]) + __uint_as_float(rr[1]); }
    return v;
}
__device__ __forceinline__ v4u pk8(const float* f) { v4u w; w.x = cvt_pk_bf16(f[0], f[1]); w.y = cvt_pk_bf16(f[2], f[3]); w.z = cvt_pk_bf16(f[4], f[5]); w.w = cvt_pk_bf16(f[6], f[7]); return w; }
__device__ __forceinline__ void up8(const v4u w, float* f) { f[0] = bflo(w.x); f[1] = bfhi(w.x); f[2] = bflo(w.y); f[3] = bfhi(w.y); f[4] = bflo(w.z); f[5] = bfhi(w.z); f[6] = bflo(w.w); f[7] = bfhi(w.w); }

__device__ __forceinline__ void tr_block64(const float* W, int ldw, bf16* WT, int ldk, int k0, int n0, int drow0, int nv, int lane, LAS float* scr  ) {
    const bool ok = lane < nv;
    const float* src = W + (size_t)k0 * ldw + n0 + (ok ? lane : 0);
    float v[64];
#pragma unroll
    for (int k = 0; k < 64; ++k) v[k] = src[(size_t)k * ldw];
#pragma unroll
    for (int k = 0; k < 64; ++k) scr[k * 65 + lane] = v[k];
    LDS_WAIT(); asm volatile("" ::: "memory");
    const int c = lane & 7;
#pragma unroll
    for (int j = 0; j < 8; ++j) { const int n = (lane >> 3) + 8 * j; const LAS float* sp = scr + (8 * c) * 65 + n;
        v4u o; o.x = cvt_pk_bf16(sp[0 * 65], sp[1 * 65]); o.y = cvt_pk_bf16(sp[2 * 65], sp[3 * 65]); o.z = cvt_pk_bf16(sp[4 * 65], sp[5 * 65]); o.w = cvt_pk_bf16(sp[6 * 65], sp[7 * 65]);
        if (n < nv) *(GAS v4u*)(WT + (size_t)(drow0 + n) * ldk + k0 + 8 * c) = o; }
    LDS_WAIT(); asm volatile("" ::: "memory");
}
__device__ __forceinline__ void conv_item(const float* W, int K, int N, bf16* WT, int ldk, int mode, int row_off, int item, int lane, LAS float* scr) {
    const int nblk = (N + 63) / 64, kb = item / nblk, nb = item % nblk, n0 = 64 * nb;
    int drow = n0 + row_off;
    if (mode != 0) drow = 256 * (n0 >> 7) + (n0 & 127) + (mode == 2 ? 128 : 0);
    tr_block64(W, N, WT, ldk, 64 * kb, n0, drow, (N - n0) < 64 ? (N - n0) : 64, lane, scr);
}
struct In { const float* p[38]; };
struct InT { volatile LAS unsigned* t;
    __device__ __forceinline__ const float* operator[](int i) const { const unsigned lo = __builtin_amdgcn_readfirstlane(t[2 * i]), hi = __builtin_amdgcn_readfirstlane(t[2 * i + 1]);
        return (const float*)(const GAS float*)(((unsigned long long)hi << 32) | (unsigned long long)lo); } };

__device__ __forceinline__ void p0_weights(const InT in, unsigned char* ws, LAS unsigned char* lds, int gw, int NGW, int wave, int lane, int gtid, int NGT) {
    LAS float* scr = (LAS float*)(lds + wave * 16896);
    constexpr int I_IN = 16 * 35, I_VR = 16, I_UQ = 4 * 12, I_UKV = 2 * 16, I_OUT = 16 * 16, I_G = 16 * 44, I_D = 44 * 16;
    constexpr int PER_L = I_IN + I_UQ + I_UKV + I_OUT;
    constexpr int NITEMS = 2 * PER_L + I_VR + 2 * I_G + I_D;
    for (int it = gw; it < NITEMS; it += NGW) {
        int r = it;
        if (r < 2 * PER_L) { const int l = r / PER_L; r -= l * PER_L;
            if (r < I_IN) { conv_item(in[7] + (size_t)l * DM * 2240, DM, 2240, (bf16*)(ws + WS_WIN) + (size_t)l * NPROJ * DM, DM, 0, 0, r, lane, scr); continue; } r -= I_IN;
            if (r < I_UQ) { conv_item(in[10] + (size_t)l * 256 * NQ, 256, NQ, (bf16*)(ws + WS_WUQ) + (size_t)l * NQ * 256, 256, 0, 0, r, lane, scr); continue; } r -= I_UQ;
            if (r < I_UKV) { conv_item(in[12] + (size_t)l * 128 * NKV, 128, NKV, (bf16*)(ws + WS_WUKV) + (size_t)l * NKV * 128, 128, 0, 0, r, lane, scr); continue; } r -= I_UKV;
            conv_item(in[28] + (size_t)l * DM * DM, DM, DM, (bf16*)(ws + (l == 0 ? WS_WOUT : WS_WOUT1)), DM, 0, 0, r, lane, scr); continue; }
        r -= 2 * PER_L;
        if (r < I_VR) { conv_item(in[8], DM, 32, (bf16*)(ws + WS_WIN) + (size_t)NPROJ * DM, DM, 0, 2240, r, lane, scr); continue; } r -= I_VR;
        if (r < I_G) { conv_item(in[29], DM, FFD, (bf16*)(ws + WS_WF1), DM, 1, 0, r, lane, scr); continue; } r -= I_G;
        if (r < I_G) { conv_item(in[30], DM, FFD, (bf16*)(ws + WS_WF1), DM, 2, 0, r, lane, scr); continue; } r -= I_G;
        conv_item(in[31], FFD, DM, (bf16*)(ws + WS_WF2), FFD, 0, 0, r, lane, scr);
    }
    { const int n0 = 64 * 128, n1 = 32 * 128;
      for (int i = gtid; i < n0 + n1; i += NGT) { const bool l1 = i >= n0; const int j = l1 ? i - n0 : i; const int row = (l1 ? 2272 : 2240) + j / 128, ch = j % 128;
          *(GAS v4u*)((bf16*)(ws + WS_WIN) + ((size_t)(l1 ? NPROJ : 0) + row) * DM + ch * 8) = (v4u){0u, 0u, 0u, 0u}; } }
    const float* pw2 = in[17]; const float* pa2 = in[19]; const float* pg2 = in[20]; const float* pv2 = in[22];
    for (int i = gtid; i < 2 * NLORA * (KLW / 8); i += NGT) {
        const int l = i / (NLORA * (KLW / 8)), rem = i % (NLORA * (KLW / 8)), k8 = rem / NLORA, pos = rem % NLORA;
        const int seg = pos >> 9, p9 = pos & 511, ct = p9 >> 8, p8 = p9 & 255, bj = p8 >> 7, wc = (p8 >> 5) & 3, x = p8 & 31;
        const int oc = 256 * ct + 64 * wc + 32 * bj + x;
        const int k0 = k8 * 8;
        const float* src = nullptr; int kr = 0;
        if (seg == 0 && k0 < 64) { src = pw2 + (size_t)l * 64 * RW; kr = k0; }
        else if (seg == 1 && k0 >= 64) { src = pa2 + (size_t)l * 64 * RW; kr = k0 - 64; }
        else if (seg == 2) { src = pg2 + (size_t)l * 128 * RW; kr = k0; }
        else if (seg == 3 && l == 1 && k0 < 32) { src = pv2; kr = k0; }
        float f[8];
#pragma unroll
        for (int e = 0; e < 8; ++e) f[e] = src ? src[(size_t)(kr + e) * RW + oc] : 0.f;
        *(GAS v4u*)((bf16*)(ws + WS_WLORA) + ((size_t)l * NLORA + pos) * KLW + k0) = pk8(f);
    }
}
struct TrBlk { const GAS float* src; GAS bf16* dst; int ldw, ldk; };
__device__ __forceinline__ TrBlk expert_block(const float* pg, const float* pu, const float* pd, unsigned char* ws, int it) {
    constexpr int IPJ = 896;
    const int job = it / IPJ, r = it % IPJ, e = job / 3, kind = job % 3; TrBlk t;
    if (kind < 2) { const int kb = r / 56, n0 = 64 * (r % 56), drow = 256 * (n0 >> 7) + (n0 & 127) + (kind == 1 ? 128 : 0);
        t.src = (const GAS float*)((kind == 0 ? pg : pu) + (size_t)e * DM * FFE + (size_t)(64 * kb) * FFE + n0); t.ldw = FFE; t.dst = (GAS bf16*)((bf16*)(ws + A_WE1) + (size_t)e * 2 * FFE * DM + (size_t)drow * DM + 64 * kb); t.ldk = DM; }
    else { const int kb = r / 16, n0 = 64 * (r % 16);
        t.src = (const GAS float*)(pd + (size_t)e * FFE * DM + (size_t)(64 * kb) * DM + n0); t.ldw = DM; t.dst = (GAS bf16*)((bf16*)(ws + A_WE2) + (size_t)e * DM * FFE + (size_t)n0 * FFE + 64 * kb); t.ldk = FFE; }
    return t;
}
__device__ __forceinline__ void p_expert_weights(const InT in, unsigned char* ws, LAS unsigned char* lds, int gw, int NGW, int wave, int lane) {
    constexpr int NIT = 24 * 896;
    LAS float* scr = (LAS float*)(lds + wave * 16896);
    const float* pg = in[34]; const float* pu = in[35]; const float* pd = in[36];
    float v[64];
    TrBlk cur; cur.src = (const GAS float*)pg; cur.dst = nullptr; cur.ldw = 0; cur.ldk = 0;
    if (gw < NIT) { cur = expert_block(pg, pu, pd, ws, gw);
#pragma unroll
        for (int k = 0; k < 64; ++k) v[k] = cur.src[(size_t)k * cur.ldw + lane]; }
    for (int it = gw; it < NIT; it += NGW) {
#pragma unroll
        for (int k = 0; k < 64; ++k) scr[k * 65 + lane] = v[k];
        TrBlk nxt = cur;
        if (it + NGW < NIT) { nxt = expert_block(pg, pu, pd, ws, it + NGW);
#pragma unroll
            for (int k = 0; k < 64; ++k) v[k] = nxt.src[(size_t)k * nxt.ldw + lane]; }
        LDS_WAIT(); asm volatile("" ::: "memory");
        const int c = lane & 7;
#pragma unroll
        for (int j = 0; j < 8; ++j) { const int n = (lane >> 3) + 8 * j; const LAS float* sp = scr + (8 * c) * 65 + n;
            v4u o; o.x = cvt_pk_bf16(sp[0 * 65], sp[1 * 65]); o.y = cvt_pk_bf16(sp[2 * 65], sp[3 * 65]); o.z = cvt_pk_bf16(sp[4 * 65], sp[5 * 65]); o.w = cvt_pk_bf16(sp[6 * 65], sp[7 * 65]);
            *(GAS v4u*)(cur.dst + (size_t)n * cur.ldk + 8 * c) = o; }
        LDS_WAIT(); asm volatile("" ::: "memory");
        cur = nxt;
    }
}
__device__ __forceinline__ void p0_mod(const InT in, unsigned char* ws, LAS unsigned char* lds, int vcu, int G, int wave, int lane, int tid) {
    LAS float* cond = (LAS float*)lds;
    LAS float* red = (LAS float*)(lds + 32768);
    const float* cin = in[1]; const float* wada = in[3]; const float* bada = in[4];
    for (int i = tid; i < NB * DM; i += NTHR) { const float c = cin[i]; cond[i] = c * fsigmoid(c); }
    __syncthreads();
    float* MOD = (float*)(ws + WS_MOD);
    for (int it = vcu; it < 2 * (MODLD / 64); it += G) { const int l = it / (MODLD / 64), n0 = (it % (MODLD / 64)) * 64;
        const float* W = wada + (size_t)l * DM * MODLD + n0 + lane;
        float a[8] = {0.f, 0.f, 0.f, 0.f, 0.f, 0.f, 0.f, 0.f};
#pragma unroll 16
        for (int k = wave * 128; k < wave * 128 + 128; ++k) { const float w = W[(size_t)k * MODLD];
#pragma unroll
            for (int b = 0; b < 8; ++b) a[b] += cond[b * DM + k] * w; }
#pragma unroll
        for (int b = 0; b < 8; ++b) red[(wave * 8 + b) * 64 + lane] = a[b];
        __syncthreads();
        { const int b = tid >> 6, n = tid & 63; float s = bada[(size_t)l * MODLD + n0 + n];
#pragma unroll
          for (int w = 0; w < 8; ++w) s += red[(w * 8 + b) * 64 + n];
          MOD[((size_t)l * NB + b) * MODLD + n0 + n] = s; }
        __syncthreads();
    }
}

template <bool ROUTER, bool XIN16>
__device__ __forceinline__ void norm_phase(const void* xin_, const float* g, const float* modl, int sh_off, bf16* H, const float* wr, const float* br, unsigned char* ws,
                                           LAS unsigned char* lds, int vcu, int G, int wave, int lane, int tid) {
    LAS int* cntl = (LAS int*)lds;
    const LAS f32x4* wl = (const LAS f32x4*)(lds + 1024);
    if (ROUTER) { __syncthreads();
        for (int q = tid; q < 2048; q += NTHR) { const int c = q >> 1, h = q & 1, ln = (c & 511) >> 3, j = 2 * (c >> 9) + ((c >> 2) & 1), i = c & 3; ((LAS f32x4*)(lds + 1024))[((j * 4 + i) * 2 + h) * 64 + ln] = *(const f32x4*)(wr + (size_t)c * 8 + 4 * h); }
        __syncthreads(); }
    float brv[8];
#pragma unroll
    for (int e = 0; e < 8; ++e) brv[e] = ROUTER ? br[e] : 0.f;
    for (int blk = vcu; blk < TOK / 128; blk += G) {
        if (ROUTER) { if (tid < 16) cntl[tid] = 0; __syncthreads(); }
        const int row0 = blk * 128 + wave * 16, b = row0 >> 12;
        const float* shp = modl + (size_t)b * MODLD + sh_off; const float* scp = shp + 1024;
        f32x4 gs[4], sh[4];
#pragma unroll
        for (int j = 0; j < 4; ++j) { const int c = 8 * lane + 512 * (j >> 1) + 4 * (j & 1);
            const f32x4 gg = *(const f32x4*)(g + c), sc = *(const f32x4*)(scp + c); gs[j] = gg * (sc + 1.0f); sh[j] = *(const f32x4*)(shp + c); }
        f32x4 nx[4]; v4u nh[2];
#define NORM_LOAD(rr) do { if (XIN16) { _Pragma("unroll") for (int jj = 0; jj < 2; ++jj) nh[jj] = ((const GAS v4u*)((const bf16*)xin_ + (size_t)(rr) * DM) + lane)[64 * jj]; } \
            else { _Pragma("unroll") for (int j = 0; j < 4; ++j) nx[j] = ((const GAS f32x4*)((const float*)xin_ + (size_t)(rr) * DM) + 2 * lane)[128 * (j >> 1) + (j & 1)]; } } while (0)
        NORM_LOAD(row0);
        if (lane == 0) PAD_STORES(ws, vcu * NWAVES + wave, ROUTER ? 3 : 2);
        for (int r = 0; r < 16; ++r) { const int row = row0 + r;
            f32x4 v[4]; float s = 0.f;
#pragma unroll
            for (int j = 0; j < 4; ++j) { const unsigned lo = (j & 1) ? nh[j >> 1].z : nh[j >> 1].x, hi2 = (j & 1) ? nh[j >> 1].w : nh[j >> 1].y; v[j] = XIN16 ? (f32x4){bflo(lo), bfhi(lo), bflo(hi2), bfhi(hi2)} : nx[j]; }
            if (r < 15) NORM_LOAD(row + 1);
#pragma unroll
            for (int j = 0; j < 4; ++j) s += (v[j].x * v[j].x + v[j].y * v[j].y) + (v[j].z * v[j].z + v[j].w * v[j].w);
            const float rstd = 1.0f / sqrtf(wave_sum(s) * (1.0f / DM) + 1e-6f);
            GAS v4u* o16 = (GAS v4u*)(H + (size_t)row * DM) + lane;
#pragma unroll
            for (int j = 0; j < 4; ++j) v[j] = v[j] * rstd * gs[j] + sh[j];
#pragma unroll
            for (int jj = 0; jj < 2; ++jj) o16[64 * jj] = (v4u){cvt_pk_bf16(v[2 * jj].x, v[2 * jj].y), cvt_pk_bf16(v[2 * jj].z, v[2 * jj].w), cvt_pk_bf16(v[2 * jj + 1].x, v[2 * jj + 1].y), cvt_pk_bf16(v[2 * jj + 1].z, v[2 * jj + 1].w)};
            if (ROUTER) {
                float lg[8];
#pragma unroll
                for (int e = 0; e < 8; ++e) lg[e] = 0.f;
#pragma unroll
                for (int j = 0; j < 4; ++j)
#pragma unroll
                    for (int i = 0; i < 4; ++i) { const f32x4 w0 = wl[((j * 4 + i) * 2) * 64 + lane], w1 = wl[((j * 4 + i) * 2 + 1) * 64 + lane]; const float hv = v[j][i];
                        lg[0] += hv * w0.x; lg[1] += hv * w0.y; lg[2] += hv * w0.z; lg[3] += hv * w0.w; lg[4] += hv * w1.x; lg[5] += hv * w1.y; lg[6] += hv * w1.z; lg[7] += hv * w1.w; }
#pragma unroll
                for (int e = 0; e < 8; ++e) lg[e] = wave_sum(lg[e]) + brv[e];
                unsigned key[8];
#pragma unroll
                for (int e = 0; e < 8; ++e) { const unsigned u = __float_as_uint(lg[e]); const unsigned kx = (u & 0x80000000u) ? ~u : (u | 0x80000000u); key[e] = (kx & ~7u) | (unsigned)(7 - e); }
                unsigned k1 = key[0];
#pragma unroll
                for (int e = 1; e < 8; ++e) k1 = key[e] > k1 ? key[e] : k1;
                unsigned k2 = 0u;
#pragma unroll
                for (int e = 0; e < 8; ++e) { const unsigned t = (key[e] == k1) ? 0u : key[e]; k2 = t > k2 ? t : k2; }
                k1 = (unsigned)__builtin_amdgcn_readfirstlane((int)k1); k2 = (unsigned)__builtin_amdgcn_readfirstlane((int)k2);
                const int i1 = 7 - (int)(k1 & 7u), i2 = 7 - (int)(k2 & 7u);
                const float v1 = __uint_as_float((k1 & 0x80000000u) ? (k1 & 0x7fffffffu) : ~k1), v2 = __uint_as_float((k2 & 0x80000000u) ? (k2 & 0x7fffffffu) : ~k2);
                const float w2 = 1.0f / (1.0f + __expf(v1 - v2)), w1 = 1.0f - w2;
                if (lane < 2) *(GAS v2u*)(ws + (lane == 0 ? RT_SEL : RT_GW) + (size_t)row * 8) = lane == 0 ? (v2u){(unsigned)i1, (unsigned)i2} : (v2u){__float_as_uint(w1), __float_as_uint(w2)};
                if (lane == 0) { atomicAdd((int*)&cntl[i1], 1); atomicAdd((int*)&cntl[8 + i2], 1); }
            }
        }
        if (ROUTER) {
            __syncthreads();
            if (tid < 16) *(GAS int*)(ws + RT_CNT + ((size_t)blk * 16 + tid) * 4) = cntl[tid];
            __syncthreads();
        }
    }
}
#undef NORM_LOAD
__device__ __forceinline__ void final_norm(float* x, const float* g, int gw, int NGW, int lane) {
    f32x4 gs[4];
#pragma unroll
    for (int j = 0; j < 4; ++j) gs[j] = *(const f32x4*)(g + 4 * lane + 256 * j);
    f32x4 nx[4];
#pragma unroll
    for (int j = 0; j < 4; ++j) nx[j] = (gw < TOK) ? ((const GAS f32x4*)(x + (size_t)gw * DM) + lane)[64 * j] : (f32x4){0.f, 0.f, 0.f, 0.f};
    for (int row = gw; row < TOK; row += NGW) { GAS f32x4* xr = (GAS f32x4*)(x + (size_t)row * DM) + lane; f32x4 v[4]; float s = 0.f;
#pragma unroll
        for (int j = 0; j < 4; ++j) v[j] = nx[j];
        if (row + NGW < TOK) {
#pragma unroll
            for (int j = 0; j < 4; ++j) nx[j] = ((const GAS f32x4*)(x + (size_t)(row + NGW) * DM) + lane)[64 * j]; }
#pragma unroll
        for (int j = 0; j < 4; ++j) s += (v[j].x * v[j].x + v[j].y * v[j].y) + (v[j].z * v[j].z + v[j].w * v[j].w);
        const float rstd = 1.0f / sqrtf(wave_sum(s) * (1.0f / DM) + 1e-6f);
#pragma unroll
        for (int j = 0; j < 4; ++j) xr[64 * j] = v[j] * rstd * gs[j]; }
}

__device__ __forceinline__ void final_moe_norm(unsigned char* ws, const bf16* xs, float* x, const float* g, const float* gate, const bf16* Y0, const bf16* Y1, const int* tpos, const float* tgw, int gw, int NGW, int lane) {
    f32x4 gs[4];
#pragma unroll
    for (int j = 0; j < 4; ++j) gs[j] = *(const f32x4*)(g + 4 * lane + 256 * j);
    v2u nx[4]; f32x4 ng[4]; v2u ny0[4], ny1[4]; float nwa = 0.f, nwb = 0.f;
    int pa = 0, pb = 0; float wa = 0.f, wb = 0.f;
    if (gw < TOK) { pa = tpos[gw]; pb = tpos[TOK + gw]; wa = tgw[2 * gw]; wb = tgw[2 * gw + 1]; }
#pragma unroll
    for (int j = 0; j < 4; ++j) { nx[j] = (v2u){0u, 0u}; ng[j] = (f32x4){0.f, 0.f, 0.f, 0.f}; ny0[j] = (v2u){0u, 0u}; ny1[j] = (v2u){0u, 0u}; }
    if (gw < TOK) {
#pragma unroll
        for (int j = 0; j < 4; ++j) { nx[j] = ((const GAS v2u*)(xs + (size_t)gw * DM) + lane)[64 * j]; ny0[j] = ((const GAS v2u*)(Y0 + (size_t)pa * DM) + lane)[64 * j]; ny1[j] = ((const GAS v2u*)(Y1 + (size_t)pb * DM) + lane)[64 * j];
            ng[j] = *(const f32x4*)(gate + (size_t)(gw >> 12) * MODLD + 4 * lane + 256 * j); }
        nwa = wa; nwb = wb;
        if (gw + NGW < TOK) { const int r2 = gw + NGW; pa = tpos[r2]; pb = tpos[TOK + r2]; wa = tgw[2 * r2]; wb = tgw[2 * r2 + 1]; } }
    if (lane == 0) PAD_STORES(ws, gw, 4);
    for (int row = gw; row < TOK; row += NGW) { GAS f32x4* xr = (GAS f32x4*)(x + (size_t)row * DM) + lane; f32x4 v[4]; v2u y0[4], y1[4]; f32x4 gtv[4]; float s = 0.f; const float cwa = nwa, cwb = nwb;
#pragma unroll
        for (int j = 0; j < 4; ++j) { v[j] = (f32x4){bflo(nx[j].x), bfhi(nx[j].x), bflo(nx[j].y), bfhi(nx[j].y)}; y0[j] = ny0[j]; y1[j] = ny1[j]; gtv[j] = ng[j]; }
        if (row + NGW < TOK) { const int r1 = row + NGW;
#pragma unroll
            for (int j = 0; j < 4; ++j) { nx[j] = ((const GAS v2u*)(xs + (size_t)r1 * DM) + lane)[64 * j]; ny0[j] = ((const GAS v2u*)(Y0 + (size_t)pa * DM) + lane)[64 * j]; ny1[j] = ((const GAS v2u*)(Y1 + (size_t)pb * DM) + lane)[64 * j];
                ng[j] = *(const f32x4*)(gate + (size_t)(r1 >> 12) * MODLD + 4 * lane + 256 * j); }
            nwa = wa; nwb = wb;
            if (r1 + NGW < TOK) { const int r2 = r1 + NGW; pa = tpos[r2]; pb = tpos[TOK + r2]; wa = tgw[2 * r2]; wb = tgw[2 * r2 + 1]; } }
#pragma unroll
        for (int j = 0; j < 4; ++j) { const f32x4 gt = gtv[j];
            const f32x4 mo = (f32x4){cwa * bflo(y0[j].x) + cwb * bflo(y1[j].x), cwa * bfhi(y0[j].x) + cwb * bfhi(y1[j].x), cwa * bflo(y0[j].y) + cwb * bflo(y1[j].y), cwa * bfhi(y0[j].y) + cwb * bfhi(y1[j].y)};
            v[j] = v[j] + gt * mo; s += (v[j].x * v[j].x + v[j].y * v[j].y) + (v[j].z * v[j].z + v[j].w * v[j].w); }
        const float rstd = 1.0f / sqrtf(wave_sum(s) * (1.0f / DM) + 1e-6f);
#pragma unroll
        for (int j = 0; j < 4; ++j) xr[64 * j] = v[j] * rstd * gs[j]; }
}

struct RwRoute { bf16* base[5]; int pitch[5]; float mu[5][8]; };
__device__ __forceinline__ void rw_route(int l, int lane, const float* mu_l, const float* mu_v, unsigned char* ws, RwRoute& R) {
#pragma unroll
    for (int j = 0; j < 5; ++j) { const int ci = lane + 64 * j, cr = ci * 8 - 448; const bool valid = ci >= 56 && (cr < 1792 || (l == 1 && cr < 1824));
        bf16* d; int st = RW;
        if (cr < 512) d = (bf16*)(ws + A_R) + cr;
        else if (cr < 1024) d = (bf16*)(ws + A_KRAW) + (cr - 512);
        else if (cr < 1536) d = (bf16*)(ws + (l == 0 ? WS_VFIRST : A_VRAW)) + (cr - 1024);
        else { st = KLORA; d = (bf16*)(ws + A_LA) + (cr < 1600 ? cr - 1536 : (cr < 1664 ? 64 + (cr - 1600) : (cr < 1792 ? 128 + (cr - 1664) : 256 + (cr - 1792)))); }
        R.base[j] = d; R.pitch[j] = st;
        const float* mup = (cr < 1792) ? mu_l + cr : mu_v + (cr - 1792);
#pragma unroll
        for (int e = 0; e < 8; ++e) R.mu[j][e] = valid ? mup[e] : 0.f; }
}
template <int J> __device__ __forceinline__ v4u rw_val(int lane, const v4u cur, const v4u prv, const RwRoute& R) {
    float p[8], q[8], xs[8];
    up8(cur, p); up8(prv, q);
#pragma unroll
    for (int e = 0; e < 8; ++e) xs[e] = p[e] + (q[e] - p[e]) * R.mu[J][e];
    if (J == 3) { if (lane >= 56) {
#pragma unroll
        for (int e = 0; e < 8; ++e) xs[e] = 1.0f - 2.0f * __builtin_amdgcn_rcpf(1.0f + __builtin_amdgcn_exp2f(2.885390081777927f * xs[e])); } }
    if (J == 4) { if (lane >= 8 && lane < 24) {
#pragma unroll
        for (int e = 0; e < 8; ++e) xs[e] = fsigmoid(xs[e]); } }
    return pk8(xs);
}
template <int J> __device__ __forceinline__ void rw_chunk(int m, int lane, const v4u cur, const v4u prv, const RwRoute& R) {
    float p[8], q[8], xs[8];
    up8(cur, p); up8(prv, q);
#pragma unroll
    for (int e = 0; e < 8; ++e) xs[e] = p[e] + (q[e] - p[e]) * R.mu[J][e];
    if (J == 3) { if (lane >= 56) {
#pragma unroll
        for (int e = 0; e < 8; ++e) xs[e] = 1.0f - 2.0f * __builtin_amdgcn_rcpf(1.0f + __builtin_amdgcn_exp2f(2.885390081777927f * xs[e])); } }
    if (J == 4) { if (lane >= 8 && lane < 24) {
#pragma unroll
        for (int e = 0; e < 8; ++e) xs[e] = fsigmoid(xs[e]); } }
    *(GAS v4u*)(R.base[J] + (size_t)m * R.pitch[J]) = pk8(xs);
}
__device__ __forceinline__ void prep_phase(int l, const InT in, unsigned char* ws, int gw, int NGW, int lane) {
    const bf16* PROJ = (const bf16*)(ws + A_PROJ);
    const int* pos = (const int*)in[2]; const float* mu_l = in[14] + (size_t)l * 1792; const float* mu_v = in[15];
    float gn[8];
    { const float* gp = (lane < 32) ? in[9] + (size_t)l * 256 + lane * 8 : in[11] + (size_t)l * 128 + ((lane - 32) & 15) * 8;
#pragma unroll
      for (int e = 0; e < 8; ++e) gn[e] = gp[e]; }
    float frq[8];
#pragma unroll
    for (int e = 0; e < 8; ++e) { const int i = 8 * (lane & 3) + e; frq[e] = __builtin_amdgcn_exp2f(-(float)i * (13.287712379549449f / 32.0f)) * 0.15915494309189535f; }
    RwRoute R; rw_route(l, lane, mu_l, mu_v, ws, R);
    for (int m0 = gw * 16; m0 < TOK; m0 += NGW * 16) {
        const int b0 = m0 >> 12;
        GAS unsigned char* d0b; int d0p;
        if (lane < 32) { d0b = (GAS unsigned char*)(ws + A_CQ) + lane * 16; d0p = 512; }
        else if (lane < 48) { d0b = (GAS unsigned char*)(ws + A_CKV) + (lane - 32) * 16; d0p = 256; }
        else if (lane < 56) { const int dim = 128 + (lane >= 52 ? 32 : 0) + 8 * (lane & 3); d0b = (GAS unsigned char*)(ws + A_KB) + ((size_t)(3 * b0) * SEQ * 192 + dim) * 2; d0p = 384; }
        else { d0b = (GAS unsigned char*)R.base[0]; d0p = R.pitch[0] * 2; }
        const int l7 = lane & 7, h7 = 1 + ((lane - 40) >> 3);
        GAS unsigned char* dkb = (GAS unsigned char*)(ws + A_KB) + ((size_t)(3 * b0 + h7) * SEQ * 192 + 128 + (l7 >= 4 ? 32 : 0) + 8 * (l7 & 3)) * 2;
        const int kpsrc = (48 + l7) * 4;
        const bool rw4 = lane < 24 || (l == 1 && lane < 28), act4 = rw4 || (lane >= 32 && lane < 48 && (l == 0 || lane >= 36));
        GAS unsigned char* d4b = rw4 ? (GAS unsigned char*)R.base[4] : (GAS unsigned char*)(ws + A_LA) + lane * 16; const int d4p = rw4 ? R.pitch[4] * 2 : KLORA * 2;
        v4u pv[5];
#pragma unroll
        for (int j = 0; j < 5; ++j) pv[j] = (v4u){0u, 0u, 0u, 0u};
        if ((m0 & (SEQ - 1)) != 0) {
#pragma unroll
            for (int j = 0; j < 5; ++j) if (j < 4 || lane < 32) pv[j] = *(const GAS v4u*)(PROJ + (size_t)(m0 - 1) * NPROJ + (lane + 64 * j) * 8); }
        v4u nc[5];
#pragma unroll
        for (int j = 0; j < 5; ++j) nc[j] = (j < 4 || lane < 32) ? *(const GAS v4u*)(PROJ + (size_t)m0 * NPROJ + (lane + 64 * j) * 8) : (v4u){0u, 0u, 0u, 0u};
        int posn = pos[m0];
        for (int r = 0; r < 16; ++r) { const int m = m0 + r; const int posc = posn; if (r < 15) posn = pos[m + 1];
        v4u cu[5];
#pragma unroll
        for (int j = 0; j < 5; ++j) cu[j] = nc[j];
        if (r < 15) {
#pragma unroll
            for (int j = 0; j < 5; ++j) nc[j] = (j < 4 || lane < 32) ? *(const GAS v4u*)(PROJ + (size_t)(m + 1) * NPROJ + (lane + 64 * j) * 8) : (v4u){0u, 0u, 0u, 0u}; }
        float p[8]; up8(cu[0], p);
        float ss = 0.f;
#pragma unroll
        for (int e = 0; e < 8; ++e) ss += p[e] * p[e];
        const float sq = wave_sum(lane < 32 ? ss : 0.f), skv = wave_sum((lane >= 32 && lane < 48) ? ss : 0.f);
        float oth[8];
#pragma unroll
        for (int e = 0; e < 8; ++e) oth[e] = lane_xor<4>(p[e]);
        v4u out0;
        if (lane < 32) { const float rstd = 1.0f / sqrtf(sq * (1.0f / 256.0f) + 1e-6f); float o[8];
#pragma unroll
            for (int e = 0; e < 8; ++e) o[e] = p[e] * rstd * gn[e];
            out0 = pk8(o); }
        else if (lane < 48) { const float rstd = 1.0f / sqrtf(skv * (1.0f / 128.0f) + 1e-6f); float o[8];
#pragma unroll
            for (int e = 0; e < 8; ++e) o[e] = p[e] * rstd * gn[e];
            out0 = pk8(o); }
        else if (lane < 56) { const float ps = (float)posc; const bool hi = lane >= 52; float o[8];
#pragma unroll
            for (int e = 0; e < 8; ++e) { float rev = ps * frq[e]; rev -= rintf(rev); const float cs = __builtin_amdgcn_cosf(rev), sn = __builtin_amdgcn_sinf(rev);
                o[e] = hi ? (p[e] * cs + oth[e] * sn) : (p[e] * cs - oth[e] * sn); }
            out0 = pk8(o); }
        else out0 = rw_val<0>(lane, cu[0], pv[0], R);
        *(GAS v4u*)(d0b + (size_t)m * d0p) = out0;
        { v4u kp; kp.x = (unsigned)__builtin_amdgcn_ds_bpermute(kpsrc, (int)out0.x); kp.y = (unsigned)__builtin_amdgcn_ds_bpermute(kpsrc, (int)out0.y);
          kp.z = (unsigned)__builtin_amdgcn_ds_bpermute(kpsrc, (int)out0.z); kp.w = (unsigned)__builtin_amdgcn_ds_bpermute(kpsrc, (int)out0.w);
          if (lane >= 40) *(GAS v4u*)(dkb + (size_t)m * 384) = kp; }
        rw_chunk<1>(m, lane, cu[1], pv[1], R); rw_chunk<2>(m, lane, cu[2], pv[2], R); rw_chunk<3>(m, lane, cu[3], pv[3], R);
        { v4u o4 = (v4u){0u, 0u, 0u, 0u}; if (rw4) o4 = rw_val<4>(lane, cu[4], pv[4], R);
          if (act4) *(GAS v4u*)(d4b + (size_t)m * d4p) = o4; }
#pragma unroll
        for (int j = 0; j < 5; ++j) pv[j] = ((m + 1) & (SEQ - 1)) ? cu[j] : (v4u){0u, 0u, 0u, 0u};
        }
    }
}
__device__ __forceinline__ void onorm_phase(const float* g, unsigned char* ws, int gw, int NGW, int lane) {
    float gn[8];
#pragma unroll
    for (int e = 0; e < 8; ++e) gn[e] = g[lane * 8 + e];
    for (int m = gw; m < TOK; m += NGW) { GAS v4u* pp = (GAS v4u*)((bf16*)(ws + A_YCAT) + (size_t)m * DM + lane * 8); float p[8]; up8(*pp, p); float ss = 0.f;
#pragma unroll
        for (int e = 0; e < 8; ++e) ss += p[e] * p[e];
        const float rstd = 1.0f / sqrtf(wave_sum(ss) * (1.0f / 512.0f) + 1e-6f);
#pragma unroll
        for (int e = 0; e < 8; ++e) p[e] = p[e] * rstd * gn[e];
        *pp = pk8(p); }
}

__device__ __forceinline__ void bias_rows(const bf16* W, int rows, const float* sh, float* ob, int ldb, int gw, int NGW, int lane) {
    for (int r0 = gw; r0 < rows; r0 += 4 * NGW) {
        v4u wv[4][2];
#pragma unroll
        for (int i = 0; i < 4; ++i) { const int r = r0 + i * NGW; const bool ok = r < rows; const bf16* wp = W + (size_t)(ok ? r : r0) * DM + lane * 8; wv[i][0] = *(const GAS v4u*)wp; wv[i][1] = *(const GAS v4u*)(wp + 512); }
        f32x4 ns[4];
#pragma unroll
        for (int j = 0; j < 4; ++j) ns[j] = *(const f32x4*)(sh + lane * 8 + 512 * (j >> 1) + 4 * (j & 1));
#pragma unroll
        for (int b = 0; b < NB; ++b) { f32x4 s4[4];
#pragma unroll
            for (int j = 0; j < 4; ++j) s4[j] = ns[j];
            if (b + 1 < NB) {
#pragma unroll
                for (int j = 0; j < 4; ++j) ns[j] = *(const f32x4*)(sh + (size_t)(b + 1) * MODLD + lane * 8 + 512 * (j >> 1) + 4 * (j & 1)); }
            float a[4];
#pragma unroll
            for (int i = 0; i < 4; ++i) { float w[16]; up8(wv[i][0], w); up8(wv[i][1], w + 8);
                a[i] = (w[0] * s4[0].x + w[1] * s4[0].y) + (w[2] * s4[0].z + w[3] * s4[0].w) + (w[4] * s4[1].x + w[5] * s4[1].y) + (w[6] * s4[1].z + w[7] * s4[1].w)
                     + (w[8] * s4[2].x + w[9] * s4[2].y) + (w[10] * s4[2].z + w[11] * s4[2].w) + (w[12] * s4[3].x + w[13] * s4[3].y) + (w[14] * s4[3].z + w[15] * s4[3].w); }
#pragma unroll
            for (int i = 0; i < 4; ++i) { a[i] = wave_sum(a[i]); const int r = r0 + i * NGW; if (lane == 0 && r < rows) ob[(size_t)b * ldb + r] = a[i]; } }
    }
}

__device__ __forceinline__ void route_scatter(unsigned char* ws, LAS unsigned char* lds, int vcu, int G, int wave, int lane, int tid) {
    LAS int* tot = (LAS int*)lds;
    LAS int* seg = tot + 16;
    LAS int* base = seg + 32;
    const GAS int* CNT = (const GAS int*)(ws + RT_CNT);
    LAS int* part = base + 16;
    { const int e = tid & 15, pr = tid >> 4; int s = 0;
#pragma unroll
      for (int w = 0; w < 8; ++w) s += CNT[(pr * 8 + w) * 16 + e];
      part[pr * 16 + e] = s; }
    __syncthreads();
    if (tid < 16) { int s = 0;
#pragma unroll
        for (int pr = 0; pr < 32; ++pr) s += part[pr * 16 + tid];
        tot[tid] = s; }
    __syncthreads();
    if (tid < 2) { int a = 0; for (int e = 0; e < 8; ++e) { seg[tid * 9 + e] = a; a += (tot[tid * 8 + e] + 255) & ~255; } seg[tid * 9 + 8] = a; }
    __syncthreads();
    GAS int* RIDX = (GAS int*)(ws + RT_RIDX); GAS float* RGW = (GAS float*)(ws + RT_RGW);
    if (vcu == 0 && tid < 2) { GAS int* TL = (GAS int*)(ws + RT_TILE) + tid * (PASS_TILES + 8); const int nt = seg[tid * 9 + 8] >> 8; TL[0] = nt;
        for (int e = 0; e < 8; ++e) for (int t = seg[tid * 9 + e] >> 8; t < (seg[tid * 9 + e + 1] >> 8); ++t) TL[8 + t] = e; }
    for (int pe = vcu; pe < 16; pe += G) { const int k = pe >> 3, e = pe & 7; const int s0 = seg[k * 9 + e] + tot[pe], s1 = seg[k * 9 + e + 1];
        for (int i = s0 + tid; i < s1; i += NTHR) { RIDX[k * PASS_ROWS + i] = -1; RGW[k * PASS_ROWS + i] = 0.f; } }
    for (int blk = vcu; blk < TOK / 128; blk += G) {
        __syncthreads();
        if (tid < 16) { int s = 0; const int fb = blk >> 3;
            for (int pr = 0; pr < fb; ++pr) s += part[pr * 16 + tid];
            for (int w = fb * 8; w < blk; ++w) s += CNT[w * 16 + tid];
            base[tid] = seg[(tid >> 3) * 9 + (tid & 7)] + s; }
        __syncthreads();
        if (wave < 2) { const int k = wave;
            int run[8];
#pragma unroll
            for (int e = 0; e < 8; ++e) run[e] = base[k * 8 + e];
            for (int r = 0; r < 2; ++r) { const int row = blk * 128 + r * 64 + lane; const int ex = *(const GAS int*)(ws + RT_SEL + (size_t)row * 8 + 4 * k); const float gwv = *(const GAS float*)(ws + RT_GW + (size_t)row * 8 + 4 * k);
                int mypos = 0;
#pragma unroll
                for (int e = 0; e < 8; ++e) { const unsigned long long mk = __ballot(ex == e); const int rank = __popcll(mk & ((1ull << lane) - 1ull)); if (ex == e) mypos = run[e] + rank; run[e] += __popcll(mk); }
                RIDX[k * PASS_ROWS + mypos] = row; RGW[k * PASS_ROWS + mypos] = gwv; *(GAS int*)(ws + RT_TPOS + ((size_t)k * TOK + row) * 4) = mypos; } }
    }
}

__device__ __forceinline__ void moe_combine(int nt, int G, int cap, int vcu, const float* slab, bf16* Y, int tid) {
    const pg8::G2Plan pl = pg8::g2_plan(nt, G, cap);
    if (pl.tail == 0) return;
    pg8::StaticOrder T; T.init(nt * 256, DM, 1, 0);
    const int wid = tid >> 6, lane = tid & 63, wr = wid >> 2, wc = wid & 3, fr = lane & 15, fq = lane >> 4;
    for (int it = vcu; it < pl.tail * 4; it += G) { const int tu = it >> 2, ai = (it >> 1) & 1, bj = it & 1;
        pg8::Unit u; T.next(pl.full + tu, u);
        f32x4 sm[4][2];
#pragma unroll
        for (int m = 0; m < 4; ++m)
#pragma unroll
            for (int n = 0; n < 2; ++n) sm[m][n] = (f32x4){0.f, 0.f, 0.f, 0.f};
        for (int kp = 0; kp < pl.spl; ++kp) { const float* sl = slab + (size_t)(tu * pl.spl + kp) * 65536;
#pragma unroll
            for (int m = 0; m < 4; ++m)
#pragma unroll
                for (int n = 0; n < 2; ++n) sm[m][n] += *(const f32x4*)(sl + ((size_t)((((ai * 2 + bj) * 4 + m) * 2 + n) * 512 + tid)) * 4); }
#pragma unroll
        for (int m = 0; m < 4; ++m) { const int srow = u.pm * 256 + ai * 128 + wr * 64 + m * 16 + fr;
#pragma unroll
            for (int n = 0; n < 2; ++n) { const int col = u.pn * 256 + wc * 32 + 4 * fq + bj * 128 + n * 16;
                *(v2u*)(Y + (size_t)srow * DM + col) = (v2u){cvt_pk_bf16(sm[m][n][0], sm[m][n][1]), cvt_pk_bf16(sm[m][n][2], sm[m][n][3])}; } }
    }
}

namespace att {
constexpr int KVB = 64, KROW = 400, SHM_K = KVB * KROW, SHM_V = KVB * 128 * 2;
constexpr int OFF_V = 0, OFF_K = 2 * SHM_V, OFF_WS = OFF_K + 2 * SHM_K, LDS_BYTES = OFF_WS + NWAVES * 64 * 4;
static_assert(LDS_BYTES <= RING_BYTES, "attention LDS");
#define SBAR() __builtin_amdgcn_sched_barrier(0)
__device__ __forceinline__ int v_st(int k, int c) { const int kk = (k & ~0xC) | ((k & 4) << 1) | ((k & 8) >> 1); return ((kk >> 3) * 4 + (c >> 5)) * 512 + ((kk & 7) * 32 + (c & 31)) * 2; }
__device__ __forceinline__ int v_rd_base(int lane) { return ((lane & 3) << 3) | (((lane >> 2) & 3) << 6) | (((lane >> 4) & 1) << 5) | (((lane >> 5) & 1) << 8); }
constexpr int v_rd_off(int d0, int ks, int half) { return d0 * 512 + ks * 4096 + half * 2048; }
__device__ __forceinline__ int crow(int r, int hi) { return (r & 3) + 8 * (r >> 2) + 4 * hi; }
__device__ __forceinline__ unsigned cvtpk(float lo, float hi) { return cvt_pk_bf16(lo, hi); }
__device__ __forceinline__ void mask_tile(f32x16& p0, f32x16& p1, int dq) {
    const float NEG = -__builtin_inff();
#pragma unroll
    for (int r = 0; r < 16; ++r) { const int c = (r & 3) + 8 * (r >> 2);
        if (dq - c < 0) p0[r] = NEG;
        if (dq - c - 32 < 0) p1[r] = NEG; }
}
template <int VB>
__device__ __forceinline__ void pv_tile(f32x16* o, int vb0, bf16x8 pa0, bf16x8 pa1, bf16x8 pa2, bf16x8 pa3) {
#define TRRD(dst, off) asm volatile("ds_read_b64_tr_b16 %0, %1 offset:%2" : "=&v"(dst) : "v"(vb0), "i"(off) : "memory")
#define PV_D0(d0) do { s16x4 l0, l1, l2, l3, h0, h1, h2, h3; constexpr int b_ = VB * SHM_V + v_rd_off(d0, 0, 0); \
        TRRD(l0, b_); TRRD(h0, b_ + 2048); TRRD(l1, b_ + 4096); TRRD(h1, b_ + 6144); TRRD(l2, b_ + 8192); TRRD(h2, b_ + 10240); TRRD(l3, b_ + 12288); TRRD(h3, b_ + 14336); \
        asm volatile("s_waitcnt lgkmcnt(0)" ::: "memory"); SBAR(); \
        o[d0] = __builtin_amdgcn_mfma_f32_32x32x16_bf16(pa0, (bf16x8){l0[0], l0[1], l0[2], l0[3], h0[0], h0[1], h0[2], h0[3]}, o[d0], 0, 0, 0); \
        o[d0] = __builtin_amdgcn_mfma_f32_32x32x16_bf16(pa1, (bf16x8){l1[0], l1[1], l1[2], l1[3], h1[0], h1[1], h1[2], h1[3]}, o[d0], 0, 0, 0); \
        o[d0] = __builtin_amdgcn_mfma_f32_32x32x16_bf16(pa2, (bf16x8){l2[0], l2[1], l2[2], l2[3], h2[0], h2[1], h2[2], h2[3]}, o[d0], 0, 0, 0); \
        o[d0] = __builtin_amdgcn_mfma_f32_32x32x16_bf16(pa3, (bf16x8){l3[0], l3[1], l3[2], l3[3], h3[0], h3[1], h3[2], h3[3]}, o[d0], 0, 0, 0); } while (0)
    PV_D0(0); PV_D0(1); PV_D0(2); PV_D0(3);
#undef PV_D0
#undef TRRD
}
template <int KBUF>
__device__ __forceinline__ void qkt(f32x16& p0, f32x16& p1, LAS unsigned char* lds, int r32, int hi, const bf16x8* qr, float negm) {
#pragma unroll
    for (int r = 0; r < 16; ++r) { p0[r] = negm; p1[r] = negm; }
    const LAS unsigned char* a = lds + OFF_K + KBUF * SHM_K + r32 * KROW + hi * 16;
#pragma unroll
    for (int d0 = 0; d0 < 12; ++d0) {
        const bf16x8 b0 = *(const LAS bf16x8*)(a + d0 * 32);
        const bf16x8 b1 = *(const LAS bf16x8*)(a + 32 * KROW + d0 * 32);
        p0 = __builtin_amdgcn_mfma_f32_32x32x16_bf16(b0, qr[d0], p0, 0, 0, 0);
        p1 = __builtin_amdgcn_mfma_f32_32x32x16_bf16(b1, qr[d0], p1, 0, 0, 0); }
}
__device__ __forceinline__ void attn_unit(int b, int h, int qb, const bf16* Q, const bf16* K, const bf16* V, bf16* O, const int* pos, LAS unsigned char* lds) {
    int tid_ = pg8::tid_now(); asm volatile("" : "+v"(tid_));
    const int tid = tid_, wid = __builtin_amdgcn_readfirstlane(tid >> 6), lane = tid & 63, r32 = lane & 31, hi = lane >> 5;
    const int m0 = b * SEQ + qb * 256 + wid * 32;
    const int qpos = qb * 256 + wid * 32;
    bf16x8 qr[12];
    { const bf16* qp = Q + (size_t)(m0 + r32) * NQ + h * 192 + hi * 8; const float C2 = 0.07216878364870323f * 1.4426950408889634f;
      float f[12][8];
#pragma unroll
      for (int d0 = 0; d0 < 12; ++d0) up8(*(const GAS v4u*)(qp + d0 * 16), f[d0]);
      const float ps = (float)pos[m0 + r32];
#pragma unroll
      for (int g = 0; g < 2; ++g)
#pragma unroll
          for (int e = 0; e < 8; ++e) { const int i = 16 * g + 8 * hi + e; float rev = ps * (__builtin_amdgcn_exp2f(-(float)i * (13.287712379549449f / 32.0f)) * 0.15915494309189535f); rev -= rintf(rev);
              const float cs = __builtin_amdgcn_cosf(rev), sn = __builtin_amdgcn_sinf(rev); const float t1 = f[8 + g][e], t2 = f[10 + g][e];
              f[8 + g][e] = t1 * cs - t2 * sn; f[10 + g][e] = t2 * cs + t1 * sn; }
#pragma unroll
      for (int d0 = 0; d0 < 12; ++d0) { v4u w; w.x = cvtpk(f[d0][0] * C2, f[d0][1] * C2); w.y = cvtpk(f[d0][2] * C2, f[d0][3] * C2); w.z = cvtpk(f[d0][4] * C2, f[d0][5] * C2); w.w = cvtpk(f[d0][6] * C2, f[d0][7] * C2);
          qr[d0] = __builtin_bit_cast(bf16x8, w); } }
    const bf16* Kh = K + (size_t)(b * 4 + h) * SEQ * 192; const bf16* Vh = V + (size_t)(b * 4 + h) * SEQ * 128;
    const int NT = (qb + 1) * 4;
    LAS float* wsl = (LAS float*)(lds + OFF_WS) + wid * 64; LAS float* li_l = wsl; LAS float* al_l = wsl + 32;
    float m_reg = 0.f, l_reg = 0.f; f32x16 o[4] = {};
    const int sr = tid >> 4, sc = (tid & 15) * 8, vst0 = v_st(sr, sc), vst1 = v_st(32 + sr, sc);
    const int vb0 = (int)(uintptr_t)(lds + OFF_V) + v_rd_base(lane);
    int kq[3], kl[3];
#pragma unroll
    for (int i = 0; i < 3; ++i) { const int q = tid + 512 * i; kq[i] = q * 8; kl[i] = (q / 24) * KROW + (q % 24) * 16; }
    v4u sk[3], sv[2];
#define ST_LOAD(t) do { const bf16* kp_ = Kh + (size_t)(t) * KVB * 192; const bf16* vp_ = Vh + (size_t)(t) * KVB * 128; \
        _Pragma("unroll") for (int i = 0; i < 3; ++i) sk[i] = *(const GAS v4u*)(kp_ + kq[i]); \
        sv[0] = *(const GAS v4u*)(vp_ + (size_t)sr * 128 + sc); sv[1] = *(const GAS v4u*)(vp_ + (size_t)(32 + sr) * 128 + sc); } while (0)
#define ST_WRITE(bf) do { _Pragma("unroll") for (int i = 0; i < 3; ++i) *(LAS v4u*)(lds + OFF_K + (bf) * SHM_K + kl[i]) = sk[i]; \
        *(LAS v4u*)(lds + OFF_V + (bf) * SHM_V + vst0) = sv[0]; *(LAS v4u*)(lds + OFF_V + (bf) * SHM_V + vst1) = sv[1]; } while (0)
#define TILE_STEP(t, BF) do { f32x16 p0, p1; \
        if ((t) + 1 < NT) ST_LOAD((t) + 1); \
        qkt<BF>(p0, p1, lds, r32, hi, qr, -m_reg); \
        { const int kb_ = (t) * KVB; if (kb_ + KVB - 1 > qpos) mask_tile(p0, p1, qpos + r32 - 4 * hi - kb_); } \
        float pmax; { float t_[16]; _Pragma("unroll") for (int r = 0; r < 16; ++r) t_[r] = fmaxf(p0[r], p1[r]);            \
            _Pragma("unroll") for (int r = 0; r < 8; ++r) t_[r] = fmaxf(t_[r], t_[r + 8]); _Pragma("unroll") for (int r = 0; r < 4; ++r) t_[r] = fmaxf(t_[r], t_[r + 4]); \
            pmax = fmaxf(fmaxf(t_[0], t_[1]), fmaxf(t_[2], t_[3])); } \
        { auto rr = __builtin_amdgcn_permlane32_swap(__float_as_uint(pmax), __float_as_uint(pmax), false, false); pmax = fmaxf(__uint_as_float(rr[0]), __uint_as_float(rr[1])); } \
        float alpha = 1.f; \
          \
        if (!__builtin_expect((t) > 0 && __all(pmax <= 11.5f), 1)) { const float sh = (t) > 0 ? fmaxf(pmax, 0.f) : pmax; alpha = (t) > 0 ? __builtin_amdgcn_exp2f(-sh) : 1.f; m_reg += sh; \
            _Pragma("unroll") for (int r = 0; r < 16; ++r) { p0[r] -= sh; p1[r] -= sh; } } \
        float psum; { float t_[16]; _Pragma("unroll") for (int r = 0; r < 16; ++r) { p0[r] = __builtin_amdgcn_exp2f(p0[r]); p1[r] = __builtin_amdgcn_exp2f(p1[r]); t_[r] = p0[r] + p1[r]; } \
            _Pragma("unroll") for (int r = 0; r < 8; ++r) t_[r] += t_[r + 8]; _Pragma("unroll") for (int r = 0; r < 4; ++r) t_[r] += t_[r + 4]; psum = (t_[0] + t_[1]) + (t_[2] + t_[3]); } \
        { auto rr = __builtin_amdgcn_permlane32_swap(__float_as_uint(psum), __float_as_uint(psum), false, false); psum = __uint_as_float(rr[0]) + __uint_as_float(rr[1]); } \
        l_reg = l_reg * alpha + psum; \
        bf16x8 pa0, pa1, pa2, pa3; \
        PK4(p0, 0, pa0); PK4(p0, 8, pa1); PK4(p1, 0, pa2); PK4(p1, 8, pa3); \
        if (__any(alpha < 1.f)) { if (hi == 0) al_l[r32] = alpha; asm volatile("s_waitcnt lgkmcnt(0)" ::: "memory"); \
            _Pragma("unroll") for (int d_ = 0; d_ < 4; ++d_) _Pragma("unroll") for (int r = 0; r < 16; ++r) o[d_][r] *= al_l[crow(r, hi)]; } \
        pv_tile<BF>(o, vb0, pa0, pa1, pa2, pa3); \
        if ((t) + 1 < NT) { VM_WAIT(); ST_WRITE(1 - (BF)); } \
        __syncthreads(); } while (0)
#define PK4(P, B_, OUT) do { unsigned a0 = cvtpk(P[B_+0], P[B_+1]), a1 = cvtpk(P[B_+2], P[B_+3]); \
        unsigned b0 = cvtpk(P[B_+4], P[B_+5]), b1 = cvtpk(P[B_+6], P[B_+7]); \
        auto r0 = __builtin_amdgcn_permlane32_swap(a0, b0, false, false); auto r1 = __builtin_amdgcn_permlane32_swap(a1, b1, false, false); \
        v4u w = {r0[0], r1[0], r0[1], r1[1]}; OUT = __builtin_bit_cast(bf16x8, w); } while (0)
    __syncthreads();
    ST_LOAD(0); VM_WAIT(); ST_WRITE(0);
    __syncthreads();
    for (int t = 0; t < NT; t += 2) { TILE_STEP(t, 0); TILE_STEP(t + 1, 1); }
#undef PK4
#undef TILE_STEP
#undef ST_LOAD
#undef ST_WRITE
    if (hi == 0) li_l[r32] = l_reg;
    asm volatile("s_waitcnt lgkmcnt(0)" ::: "memory");
    float rli[16];
#pragma unroll
    for (int r = 0; r < 16; ++r) rli[r] = __builtin_amdgcn_rcpf(li_l[crow(r, hi)]);
    bf16* Ow = O + (size_t)m0 * DM + h * 128;
#pragma unroll
    for (int r = 0; r < 16; ++r) { const int orow = crow(r, hi);
#pragma unroll
        for (int d0 = 0; d0 < 4; ++d0) { const float v = o[d0][r] * rli[r]; const float vn = lane_xor<1>(v);
            if ((r32 & 1) == 0) *(GAS unsigned*)(Ow + (size_t)orow * DM + d0 * 32 + r32) = cvtpk(v, vn); } }
}
}


namespace rk {
constexpr int RS1 = 144, RS2 = 80;
constexpr int O_AH = 0, O_BH = 4608, O_KH = 9216, O_RH = 13824;
constexpr int O_A2 = 0, O_A3 = 2560, O_A4 = 5120, O_PT = 7680, O_UT = 12800;
constexpr int O_BT = 18432, O_KT = 23552, O_VT = 28672, O_A1 = 33792, O_WC = 37888, UNIT_LDS = 38144;
static_assert(4 * UNIT_LDS <= RING_BYTES, "rwkv precompute LDS");
__device__ __forceinline__ int crow(int r, int hi) { return (r & 3) + 8 * (r >> 2) + 4 * hi; }
__device__ __forceinline__ float xsum32(float v) { const auto rr = __builtin_amdgcn_permlane32_swap(__float_as_uint(v), __float_as_uint(v), false, false); return __uint_as_float(rr[0]) + __uint_as_float(rr[1]); }
#define RK_FRAG(off, row, stride, q) (*(const LAS bf16x8*)(U + (off) + (row) * (stride) + (16 * (q) + 8 * hi) * 2))
#define RK_MFMA(a, b, c) __builtin_amdgcn_mfma_f32_32x32x16_bf16((a), (b), (c), 0, 0, 0)

__device__ __forceinline__ void pre_unit(int l, int b, int hd, int ck, unsigned char* ws, LAS unsigned char* U, unsigned char* dummy = nullptr  ) {
    int lane_ = (int)__builtin_amdgcn_mbcnt_hi(~0u, __builtin_amdgcn_mbcnt_lo(~0u, 0u)); asm volatile("" : "+v"(lane_));
    const int lane = lane_, r32 = lane & 31, hi = lane >> 5;
    const int tok0 = b * SEQ + ck * 32;
    const size_t gofs = (size_t)tok0 * RW + hd * 64;
    bf16* Rg = (bf16*)(ws + A_R) + gofs; bf16* Kg = (bf16*)(ws + A_KRAW) + gofs; bf16* KKg = (bf16*)(ws + A_KK) + gofs; bf16* BVg = (bf16*)(ws + A_BV) + gofs;
    const bf16* Vg = (const bf16*)(ws + ((l == 0) ? WS_VFIRST : A_VRAW)) + gofs; float* LWg = (float*)(ws + A_LW) + gofs; const bf16* LHg = (const bf16*)(ws + A_LWH) + gofs;
    bf16* Rd = dummy ? (bf16*)dummy + gofs : Rg; bf16* Kd = dummy ? (bf16*)dummy + gofs : Kg; bf16* KKd = dummy ? (bf16*)dummy + gofs : KKg; bf16* BVd = dummy ? (bf16*)dummy + gofs : BVg; float* LWd = dummy ? (float*)dummy + (gofs & ((1u << 22) - 1)) : LWg;
    { v4u ld[5][4]; v4u lq[4];
#pragma unroll
      for (int i = 0; i < 4; ++i) { const int c = lane + 64 * i; const size_t o = (size_t)(c >> 3) * RW + (c & 7) * 8;
          ld[0][i] = *(const GAS v4u*)(Rg + o); ld[1][i] = *(const GAS v4u*)(Kg + o); ld[2][i] = *(const GAS v4u*)(KKg + o); ld[3][i] = *(const GAS v4u*)(BVg + o); ld[4][i] = *(const GAS v4u*)(Vg + o); }
#pragma unroll
      for (int i = 0; i < 4; ++i) { const int c = lane + 64 * i; lq[i] = *(const GAS v4u*)(LHg + (size_t)(c >> 3) * RW + (c & 7) * 8); }
#pragma unroll
      for (int i = 0; i < 4; ++i) { const int c = lane + 64 * i, lo = (c >> 3) * RS1 + (c & 7) * 16;
          *(LAS v4u*)(U + O_RH + lo) = ld[0][i]; *(LAS v4u*)(U + O_KH + lo) = ld[1][i]; *(LAS v4u*)(U + O_AH + lo) = ld[2][i]; *(LAS v4u*)(U + O_BH + lo) = ld[3][i];
          *(LAS v4u*)(U + O_A1 + (c >> 3) * 128 + (c & 7) * 16) = ld[4][i]; }
#pragma unroll
      for (int i = 0; i < 4; ++i) { const int c = lane + 64 * i; *(LAS v4u*)(U + O_KT + (c >> 3) * 128 + (c & 7) * 16) = lq[i]; } }
    LDS_WAIT(); asm volatile("" ::: "memory");
#if defined(RK_DRYCUT)
    if (dummy && RK_DRYCUT == 1) return;
#endif
    { float E[32]; float L = 0.f;
#pragma unroll
      for (int t = 0; t < 32; ++t) { L += bf2f(*(const LAS unsigned short*)(U + O_KT + t * 128 + lane * 2)); E[t] = __expf(L); }
      LDS_WAIT(); asm volatile("" ::: "memory");
#pragma unroll
      for (int t8 = 0; t8 < 32; t8 += 8) {
          float bh[8], kh[8]; unsigned short vv[8];
#pragma unroll
          for (int u = 0; u < 8; ++u) { const int t = t8 + u; const float E1 = E[t], E2 = __builtin_amdgcn_rcpf(E1), E3 = t ? E[t - 1] : 1.f;
              LAS unsigned short* pa = (LAS unsigned short*)(U + O_AH + t * RS1 + lane * 2); LAS unsigned short* pr = (LAS unsigned short*)(U + O_RH + t * RS1 + lane * 2);
              LAS unsigned short* pb = (LAS unsigned short*)(U + O_BH + t * RS1 + lane * 2); LAS unsigned short* pk = (LAS unsigned short*)(U + O_KH + t * RS1 + lane * 2);
              const float ah = -bf2f(*pa) * E3, rh = bf2f(*pr) * E1; bh[u] = bf2f(*pb) * E2; kh[u] = bf2f(*pk) * E2; vv[u] = *(const LAS unsigned short*)(U + O_A1 + t * 128 + lane * 2);
              *pa = (unsigned short)cvt_pk_bf16(ah, 0.f); *pr = (unsigned short)cvt_pk_bf16(rh, 0.f); *pb = (unsigned short)cvt_pk_bf16(bh[u], 0.f); *pk = (unsigned short)cvt_pk_bf16(kh[u], 0.f); }
          v4u w;
          w.x = cvt_pk_bf16(bh[0], bh[1]); w.y = cvt_pk_bf16(bh[2], bh[3]); w.z = cvt_pk_bf16(bh[4], bh[5]); w.w = cvt_pk_bf16(bh[6], bh[7]); *(LAS v4u*)(U + O_BT + lane * RS2 + t8 * 2) = w;
          w.x = cvt_pk_bf16(kh[0], kh[1]); w.y = cvt_pk_bf16(kh[2], kh[3]); w.z = cvt_pk_bf16(kh[4], kh[5]); w.w = cvt_pk_bf16(kh[6], kh[7]); *(LAS v4u*)(U + O_KT + lane * RS2 + t8 * 2) = w;
          w.x = (unsigned)vv[0] | ((unsigned)vv[1] << 16); w.y = (unsigned)vv[2] | ((unsigned)vv[3] << 16); w.z = (unsigned)vv[4] | ((unsigned)vv[5] << 16); w.w = (unsigned)vv[6] | ((unsigned)vv[7] << 16); *(LAS v4u*)(U + O_VT + lane * RS2 + t8 * 2) = w;
      }
      *(LAS float*)(U + O_WC + lane * 4) = E[31]; }
    LDS_WAIT(); asm volatile("" ::: "memory");
#if defined(RK_DRYCUT)
    if (dummy && RK_DRYCUT == 2) return;
#endif
    f32x16 X[4];
    f32x16 rhc[2];
    { f32x16 d1 = {}, d2 = {}, d3 = {}, d4 = {};
#pragma unroll
      for (int q = 0; q < 4; ++q) { const bf16x8 fa = RK_FRAG(O_AH, r32, RS1, q), fb = RK_FRAG(O_BH, r32, RS1, q), fk = RK_FRAG(O_KH, r32, RS1, q), fr = RK_FRAG(O_RH, r32, RS1, q);
          d1 = RK_MFMA(fb, fa, d1); d2 = RK_MFMA(fk, fa, d2); d3 = RK_MFMA(fb, fr, d3); d4 = RK_MFMA(fk, fr, d4); }
#pragma unroll
      for (int jt = 0; jt < 2; ++jt)
#pragma unroll
          for (int r = 0; r < 16; ++r) { X[jt][r] = bf2f(*(const LAS unsigned short*)(U + O_AH + crow(r, hi) * RS1 + (r32 + 32 * jt) * 2)); rhc[jt][r] = bf2f(*(const LAS unsigned short*)(U + O_RH + crow(r, hi) * RS1 + (r32 + 32 * jt) * 2)); }
      LDS_WAIT(); asm volatile("" ::: "memory");
#pragma unroll
      for (int r = 0; r < 16; ++r) { const int s = crow(r, hi); const bool lt = s < r32, le = s <= r32; d1[r] = lt ? d1[r] : 0.f; d2[r] = lt ? d2[r] : 0.f; d3[r] = le ? d3[r] : 0.f; d4[r] = le ? d4[r] : 0.f; }
#pragma unroll
      for (int g = 0; g < 4; ++g) { const int so = 8 * g + 4 * hi;
          *(LAS f32x4*)(U + O_A1 + r32 * 128 + so * 4) = (f32x4){d1[4 * g], d1[4 * g + 1], d1[4 * g + 2], d1[4 * g + 3]};
          *(LAS v2u*)(U + O_A2 + r32 * RS2 + so * 2) = (v2u){cvt_pk_bf16(d2[4 * g], d2[4 * g + 1]), cvt_pk_bf16(d2[4 * g + 2], d2[4 * g + 3])};
          *(LAS v2u*)(U + O_A3 + r32 * RS2 + so * 2) = (v2u){cvt_pk_bf16(d3[4 * g], d3[4 * g + 1]), cvt_pk_bf16(d3[4 * g + 2], d3[4 * g + 3])};
          *(LAS v2u*)(U + O_A4 + r32 * RS2 + so * 2) = (v2u){cvt_pk_bf16(d4[4 * g], d4[4 * g + 1]), cvt_pk_bf16(d4[4 * g + 2], d4[4 * g + 3])}; } }
    LDS_WAIT(); asm volatile("" ::: "memory");
#if defined(RK_DRYCUT)
    if (dummy && RK_DRYCUT == 3) return;
#endif
    X[2] = f32x16{}; X[3] = f32x16{};
#pragma unroll
    for (int q = 0; q < 2; ++q) { const bf16x8 fa = RK_FRAG(O_A2, r32, RS2, q);
        X[2] = RK_MFMA(fa, RK_FRAG(O_VT, r32, RS2, q), X[2]); X[3] = RK_MFMA(fa, RK_FRAG(O_VT, r32 + 32, RS2, q), X[3]); }
#ifndef RK_NOSOLVE
    { typedef float f32x2s __attribute__((ext_vector_type(2)));
      f32x2s XP[2][16];
#pragma unroll
      for (int r = 0; r < 16; ++r) { XP[0][r] = (f32x2s){X[0][r], X[1][r]}; XP[1][r] = (f32x2s){X[2][r], X[3][r]}; }
#pragma unroll
      for (int t = 1; t < 32; ++t) {
          f32x2s a0 = {0.f, 0.f}, a1 = {0.f, 0.f};
#pragma unroll
          for (int g = 0; g < 4; ++g) if (8 * g < t) { const f32x4 cf = *(const LAS f32x4*)(U + O_A1 + t * 128 + (8 * g + 4 * hi) * 4);
#pragma unroll
              for (int e = 0; e < 4; ++e) { const f32x2s c2 = {cf[e], cf[e]}; a0 = __builtin_elementwise_fma(c2, XP[0][4 * g + e], a0); a1 = __builtin_elementwise_fma(c2, XP[1][4 * g + e], a1); } }
          const float p0 = xsum32(a0.x), p1 = xsum32(a0.y), p2 = xsum32(a1.x), p3 = xsum32(a1.y);
          const bool own = hi == ((t >> 2) & 1); const int rt = (t & 3) + 4 * (t >> 3);
          XP[0][rt] += own ? (f32x2s){p0, p1} : (f32x2s){0.f, 0.f}; XP[1][rt] += own ? (f32x2s){p2, p3} : (f32x2s){0.f, 0.f};
      }
#pragma unroll
      for (int r = 0; r < 16; ++r) { X[0][r] = XP[0][r].x; X[1][r] = XP[0][r].y; X[2][r] = XP[1][r].x; X[3][r] = XP[1][r].y; } }
#endif
#if defined(RK_DRYCUT)
    if (dummy && RK_DRYCUT == 4) return;
#endif
#pragma unroll
    for (int tl = 0; tl < 4; ++tl)
#pragma unroll
        for (int g = 0; g < 4; ++g) *(LAS v2u*)(U + (tl < 2 ? O_PT : O_UT) + (r32 + 32 * (tl & 1)) * RS2 + (8 * g + 4 * hi) * 2) = (v2u){cvt_pk_bf16(X[tl][4 * g], X[tl][4 * g + 1]), cvt_pk_bf16(X[tl][4 * g + 2], X[tl][4 * g + 3])};
    LDS_WAIT(); asm volatile("" ::: "memory");
    const float wc0 = *(const LAS float*)(U + O_WC + r32 * 4), wc1 = *(const LAS float*)(U + O_WC + (r32 + 32) * 4);
#if defined(RK_DRYCUT)
    if (dummy && RK_DRYCUT == 5) return;
#endif
    { f32x16 y0 = {}, y1 = {};
#pragma unroll
      for (int q = 0; q < 2; ++q) { const bf16x8 f3 = RK_FRAG(O_A3, r32, RS2, q), f4 = RK_FRAG(O_A4, r32, RS2, q);
          rhc[0] = RK_MFMA(f3, RK_FRAG(O_PT, r32, RS2, q), rhc[0]); rhc[1] = RK_MFMA(f3, RK_FRAG(O_PT, r32 + 32, RS2, q), rhc[1]);
          y0 = RK_MFMA(f3, RK_FRAG(O_UT, r32, RS2, q), y0); y1 = RK_MFMA(f3, RK_FRAG(O_UT, r32 + 32, RS2, q), y1);
          y0 = RK_MFMA(f4, RK_FRAG(O_VT, r32, RS2, q), y0); y1 = RK_MFMA(f4, RK_FRAG(O_VT, r32 + 32, RS2, q), y1); }
#pragma unroll
      for (int jt = 0; jt < 2; ++jt) { const int j = r32 + 32 * jt, pj = (j & ~0xC) | ((j & 4) << 1) | ((j & 8) >> 1);
#pragma unroll
          for (int r = 0; r < 16; ++r) Rd[(size_t)crow(r, hi) * RW + pj] = (unsigned short)cvt_pk_bf16(rhc[jt][r], 0.f); }
#pragma unroll
      for (int it = 0; it < 2; ++it)
#pragma unroll
          for (int hf = 0; hf < 2; ++hf) { const f32x16& y = it ? y1 : y0; const int off = ((it * 2 + hf) * 64 + lane) * 16;
              v4u w; w.x = cvt_pk_bf16(y[8 * hf], y[8 * hf + 1]); w.y = cvt_pk_bf16(y[8 * hf + 2], y[8 * hf + 3]); w.z = cvt_pk_bf16(y[8 * hf + 4], y[8 * hf + 5]); w.w = cvt_pk_bf16(y[8 * hf + 6], y[8 * hf + 7]);
              __builtin_nontemporal_store(w, (GAS v4u*)((unsigned char*)KKd + (size_t)(off >> 7) * (RW * 2) + (off & 127))); } }
#if defined(RK_DRYCUT)
    if (dummy && RK_DRYCUT == 6) return;
#endif
#pragma unroll
    for (int tj = 0; tj < 2; ++tj)
#pragma unroll
        for (int tp = 0; tp < 2; ++tp) { f32x16 z = {};
#pragma unroll
            for (int q = 0; q < 2; ++q) z = RK_MFMA(RK_FRAG(O_PT, r32 + 32 * tj, RS2, q), RK_FRAG(O_BT, r32 + 32 * tp, RS2, q), z);
            const float wc = tp ? wc1 : wc0;
#ifdef RK_SELFCHK
            if (ck == 3) { float num = 0.f, den = 0.f;
                for (int r = 0; r < 16; ++r) { const int jj = crow(r, hi) + 32 * tj, jp = r32 + 32 * tp; float ref = 0.f;
                    for (int t = 0; t < 32; ++t) ref += bf2f(*(const LAS unsigned short*)(U + O_PT + jj * RS2 + t * 2)) * bf2f(*(const LAS unsigned short*)(U + O_BT + jp * RS2 + t * 2));
                    const float d = z[r] - ref; num += d * d; den += ref * ref; }
                num = wave_sum(num); den = wave_sum(den); if (lane == 0) { atomicAdd((float*)(ws + WS_CTL) + 84, num); atomicAdd((float*)(ws + WS_CTL) + 85, den); } }
#endif
#pragma unroll
            for (int r = 0; r < 16; ++r) z[r] = (z[r] + ((tj == tp && crow(r, hi) == r32) ? 1.f : 0.f)) * wc;
#pragma unroll
            for (int hf = 0; hf < 2; ++hf) { const int off = (((tj * 2 + tp) * 2 + hf) * 64 + lane) * 16;
                v4u w; w.x = cvt_pk_bf16(z[8 * hf], z[8 * hf + 1]); w.y = cvt_pk_bf16(z[8 * hf + 2], z[8 * hf + 3]); w.z = cvt_pk_bf16(z[8 * hf + 4], z[8 * hf + 5]); w.w = cvt_pk_bf16(z[8 * hf + 6], z[8 * hf + 7]);
                __builtin_nontemporal_store(w, (GAS v4u*)((unsigned char*)LWd + (size_t)(off >> 8) * (RW * 4) + (off & 255))); } }
#if defined(RK_DRYCUT)
    if (dummy && RK_DRYCUT == 7) return;
#endif
#pragma unroll
    for (int tp = 0; tp < 2; ++tp)
#pragma unroll
        for (int ti = 0; ti < 2; ++ti) { f32x16 z = {};
#pragma unroll
            for (int q = 0; q < 2; ++q) { z = RK_MFMA(RK_FRAG(O_BT, r32 + 32 * tp, RS2, q), RK_FRAG(O_UT, r32 + 32 * ti, RS2, q), z); z = RK_MFMA(RK_FRAG(O_KT, r32 + 32 * tp, RS2, q), RK_FRAG(O_VT, r32 + 32 * ti, RS2, q), z); }
#pragma unroll
            for (int g = 0; g < 4; ++g) { const f32x4 wv = *(const LAS f32x4*)(U + O_WC + (32 * tp + 8 * g + 4 * hi) * 4);
#pragma unroll
                for (int e = 0; e < 4; ++e) z[4 * g + e] *= wv[e]; }
#ifdef RK_SELFCHK
            if (ck == 3) { float num = 0.f, den = 0.f;
                for (int r = 0; r < 16; ++r) { const int jp = crow(r, hi) + 32 * tp, ii = r32 + 32 * ti; float ref = 0.f;
                    for (int t = 0; t < 32; ++t) ref += bf2f(*(const LAS unsigned short*)(U + O_BT + jp * RS2 + t * 2)) * bf2f(*(const LAS unsigned short*)(U + O_UT + ii * RS2 + t * 2)) + bf2f(*(const LAS unsigned short*)(U + O_KT + jp * RS2 + t * 2)) * bf2f(*(const LAS unsigned short*)(U + O_VT + ii * RS2 + t * 2));
                    ref *= *(const LAS float*)(U + O_WC + jp * 4); const float d = z[r] - ref; num += d * d; den += ref * ref; }
                num = wave_sum(num); den = wave_sum(den); if (lane == 0) { atomicAdd((float*)(ws + WS_CTL) + 82, num); atomicAdd((float*)(ws + WS_CTL) + 83, den); } }
#endif
            unsigned char* dst = (unsigned char*)(tp ? BVd : Kd);
#pragma unroll
            for (int hf = 0; hf < 2; ++hf) { const int off = ((ti * 2 + hf) * 64 + lane) * 16;
                v4u w; w.x = cvt_pk_bf16(z[8 * hf], z[8 * hf + 1]); w.y = cvt_pk_bf16(z[8 * hf + 2], z[8 * hf + 3]); w.z = cvt_pk_bf16(z[8 * hf + 4], z[8 * hf + 5]); w.w = cvt_pk_bf16(z[8 * hf + 6], z[8 * hf + 7]);
                __builtin_nontemporal_store(w, (GAS v4u*)(dst + (size_t)(off >> 7) * (RW * 2) + (off & 127))); } }
    LDS_WAIT(); asm volatile("" ::: "memory");
}

constexpr int SCAN_SLOT = 18 * 1024, SCAN_LDS = 2 * SCAN_SLOT;
__device__ __forceinline__ void scan_unit(int q, int ih, unsigned char* ws, LAS unsigned char* ring, LAS unsigned char* yst  ) {
    const int lane = (int)__builtin_amdgcn_mbcnt_hi(~0u, __builtin_amdgcn_mbcnt_lo(~0u, 0u)), r32 = lane & 31, hi = lane >> 5;
    const int b = q >> 3, hd = q & 7;
    const size_t gofs0 = (size_t)b * SEQ * RW + hd * 64;
    const unsigned char* Rg = (const unsigned char*)((const bf16*)(ws + A_R) + gofs0); const unsigned char* Kg = (const unsigned char*)((const bf16*)(ws + A_KRAW) + gofs0);
    const unsigned char* KKg = (const unsigned char*)((const bf16*)(ws + A_KK) + gofs0); const unsigned char* BVg = (const unsigned char*)((const bf16*)(ws + A_BV) + gofs0);
    const unsigned char* LWg = (const unsigned char*)((const float*)(ws + A_LW) + gofs0);
    GAS unsigned char* Yg = (GAS unsigned char*)((bf16*)(ws + A_YCAT) + (size_t)b * SEQ * DM + 512 + hd * 64 + 32 * ih) + (size_t)(lane >> 2) * (DM * 2) + (lane & 3) * 16;
    int oR[4], oY[2], oM[8], oG[4];
#pragma unroll
    for (int k = 0; k < 4; ++k) oR[k] = r32 * (RW * 2) + (16 * k + 8 * hi) * 2;
#pragma unroll
    for (int hf = 0; hf < 2; ++hf) { const int off = ((ih * 2 + hf) * 64 + lane) * 16; oY[hf] = (off >> 7) * (RW * 2) + (off & 127); }
#pragma unroll
    for (int m = 0; m < 8; ++m) { const int off = (m * 64 + lane) * 16; oM[m] = (off >> 8) * (RW * 4) + (off & 255); }
#pragma unroll
    for (int tp = 0; tp < 2; ++tp)
#pragma unroll
        for (int hf = 0; hf < 2; ++hf) { const int off = ((ih * 2 + hf) * 64 + lane) * 16; oG[tp * 2 + hf] = (off >> 7) * (RW * 2) + (off & 127); }
#define RK_DMA(ck, slot) do { const size_t cb2 = (size_t)(ck) * 32 * (RW * 2), cb4 = (size_t)(ck) * 32 * (RW * 4); LAS unsigned char* sl_ = ring + (slot) * SCAN_SLOT; \
        _Pragma("unroll") for (int k = 0; k < 4; ++k) __builtin_amdgcn_global_load_lds((const unsigned*)(Rg + cb2 + oR[k]), (LAS unsigned*)(sl_ + k * 1024), 16, 0, 0); \
        _Pragma("unroll") for (int k = 0; k < 2; ++k) __builtin_amdgcn_global_load_lds((const unsigned*)(KKg + cb2 + oY[k]), (LAS unsigned*)(sl_ + (4 + k) * 1024), 16, 0, 0); \
        _Pragma("unroll") for (int k = 0; k < 8; ++k) __builtin_amdgcn_global_load_lds((const unsigned*)(LWg + cb4 + oM[k]), (LAS unsigned*)(sl_ + (6 + k) * 1024), 16, 0, 0); \
        __builtin_amdgcn_global_load_lds((const unsigned*)(Kg + cb2 + oG[0]), (LAS unsigned*)(sl_ + 14 * 1024), 16, 0, 0); __builtin_amdgcn_global_load_lds((const unsigned*)(Kg + cb2 + oG[1]), (LAS unsigned*)(sl_ + 15 * 1024), 16, 0, 0); \
        __builtin_amdgcn_global_load_lds((const unsigned*)(BVg + cb2 + oG[2]), (LAS unsigned*)(sl_ + 16 * 1024), 16, 0, 0); __builtin_amdgcn_global_load_lds((const unsigned*)(BVg + cb2 + oG[3]), (LAS unsigned*)(sl_ + 17 * 1024), 16, 0, 0); } while (0)
    f32x16 S0 = {}, S1 = {};
    RK_DMA(0, 0); RK_DMA(1, 1);
#pragma unroll 1
    for (int ck = 0; ck < SEQ / 32; ++ck) {
        if (ck < 2 || ck == SEQ / 32 - 1) asm volatile("s_waitcnt vmcnt(0)" ::: "memory"); else asm volatile("s_waitcnt vmcnt(22)" ::: "memory");
        const LAS unsigned char* sl = ring + (ck & 1) * SCAN_SLOT + lane * 16;
        v4u cR[4], cY[2], cM[8], cG[4];
#pragma unroll
        for (int k = 0; k < 4; ++k) cR[k] = *(const LAS v4u*)(sl + k * 1024);
#pragma unroll
        for (int k = 0; k < 2; ++k) cY[k] = *(const LAS v4u*)(sl + (4 + k) * 1024);
#pragma unroll
        for (int k = 0; k < 8; ++k) cM[k] = *(const LAS v4u*)(sl + (6 + k) * 1024);
#pragma unroll
        for (int k = 0; k < 4; ++k) cG[k] = *(const LAS v4u*)(sl + (14 + k) * 1024);
        asm volatile("s_waitcnt lgkmcnt(0)" ::: "memory");
        if (ck + 2 < SEQ / 32) RK_DMA(ck + 2, ck & 1);
        bf16x8 sb[4];
#pragma unroll
        for (int kq = 0; kq < 4; ++kq) { const f32x16& s = (kq >> 1) ? S1 : S0; const int o = 8 * (kq & 1);
            v4u w; w.x = cvt_pk_bf16(s[o], s[o + 1]); w.y = cvt_pk_bf16(s[o + 2], s[o + 3]); w.z = cvt_pk_bf16(s[o + 4], s[o + 5]); w.w = cvt_pk_bf16(s[o + 6], s[o + 7]); sb[kq] = __builtin_bit_cast(bf16x8, w); }
        f32x16 y, n0, n1;
#pragma unroll
        for (int hf = 0; hf < 2; ++hf) { const v4u w = cY[hf]; y[8 * hf] = bflo(w.x); y[8 * hf + 1] = bfhi(w.x); y[8 * hf + 2] = bflo(w.y); y[8 * hf + 3] = bfhi(w.y); y[8 * hf + 4] = bflo(w.z); y[8 * hf + 5] = bfhi(w.z); y[8 * hf + 6] = bflo(w.w); y[8 * hf + 7] = bfhi(w.w); }
#pragma unroll
        for (int hf = 0; hf < 2; ++hf) { const v4u w = cG[hf], x = cG[2 + hf];
            n0[8 * hf] = bflo(w.x); n0[8 * hf + 1] = bfhi(w.x); n0[8 * hf + 2] = bflo(w.y); n0[8 * hf + 3] = bfhi(w.y); n0[8 * hf + 4] = bflo(w.z); n0[8 * hf + 5] = bfhi(w.z); n0[8 * hf + 6] = bflo(w.w); n0[8 * hf + 7] = bfhi(w.w);
            n1[8 * hf] = bflo(x.x); n1[8 * hf + 1] = bfhi(x.x); n1[8 * hf + 2] = bflo(x.y); n1[8 * hf + 3] = bfhi(x.y); n1[8 * hf + 4] = bflo(x.z); n1[8 * hf + 5] = bfhi(x.z); n1[8 * hf + 6] = bflo(x.w); n1[8 * hf + 7] = bfhi(x.w); }
#pragma unroll
        for (int kq = 0; kq < 4; ++kq) {
            y = RK_MFMA(__builtin_bit_cast(bf16x8, cR[kq]), sb[kq], y);
            n0 = RK_MFMA(__builtin_bit_cast(bf16x8, cM[((kq >> 1) * 2 + 0) * 2 + (kq & 1)]), sb[kq], n0);
            n1 = RK_MFMA(__builtin_bit_cast(bf16x8, cM[((kq >> 1) * 2 + 1) * 2 + (kq & 1)]), sb[kq], n1); }
        S0 = n0; S1 = n1;
#pragma unroll
        for (int r = 0; r < 16; ++r) *(LAS unsigned short*)(yst + crow(r, hi) * 64 + r32 * 2) = (unsigned short)cvt_pk_bf16(y[r], 0.f);
        asm volatile("s_waitcnt lgkmcnt(0)" ::: "memory");
        { const v4u w0 = *(const LAS v4u*)(yst + lane * 16), w1 = *(const LAS v4u*)(yst + 1024 + lane * 16);
          GAS unsigned char* yp = Yg + (size_t)ck * 32 * (DM * 2);
          *(GAS v4u*)yp = w0; *(GAS v4u*)(yp + (size_t)16 * (DM * 2)) = w1; }
    }
    asm volatile("s_waitcnt vmcnt(0)" ::: "memory");
#undef RK_DMA
}
#undef RK_FRAG
#undef RK_MFMA
}

__device__ __forceinline__ void post_phase(int l, const float* gao, const float* lnwp, const float* lnbp, unsigned char* ws, int gw, int NGW, int lane) {
    float gn[8], lw8[8], lb8[8];
#pragma unroll
    for (int e = 0; e < 8; ++e) { gn[e] = gao[lane * 8 + e]; lw8[e] = lnwp[lane * 8 + e]; lb8[e] = lnbp[lane * 8 + e]; }
    const bf16* Vv = (const bf16*)(ws + ((l == 0) ? WS_VFIRST : A_VRAW)); const bf16* Gg = (const bf16*)(ws + A_G); const float* BON = (const float*)(ws + A_BON);
    v4u n0, n1, n2, n3; float nb;
#define POST_LOAD(mm) do { n0 = *(const GAS v4u*)((const bf16*)(ws + A_YCAT) + (size_t)(mm) * DM + lane * 8); n1 = *(const GAS v4u*)((const bf16*)(ws + A_YCAT) + (size_t)(mm) * DM + 512 + lane * 8); \
        n2 = *(const GAS v4u*)(Vv + (size_t)(mm) * RW + lane * 8); n3 = *(const GAS v4u*)(Gg + (size_t)(mm) * RW + lane * 8); nb = BON[(size_t)(mm) * 8 + (lane >> 3)]; } while (0)
    if (gw < TOK) POST_LOAD(gw);
    if (lane == 0) PAD_STORES(ws, gw, 2);
    for (int m = gw; m < TOK; m += NGW) {
        GAS v4u* pp = (GAS v4u*)((bf16*)(ws + A_YCAT) + (size_t)m * DM + lane * 8); float p[8]; up8(n0, p); float ss = 0.f;
        GAS v4u* py = (GAS v4u*)((bf16*)(ws + A_YCAT) + (size_t)m * DM + 512 + lane * 8); float y[8], v[8], g[8]; up8(n1, y);
        up8(n2, v); up8(n3, g);
        const float bon = nb;
        if (m + NGW < TOK) POST_LOAD(m + NGW);
#pragma unroll
        for (int e = 0; e < 8; ++e) ss += p[e] * p[e];
        const float rstd = 1.0f / sqrtf(wave_sum(ss) * (1.0f / 512.0f) + 1e-6f);
#pragma unroll
        for (int e = 0; e < 8; ++e) p[e] = p[e] * rstd * gn[e];
        *pp = pk8(p);
        float s1 = 0.f;
#pragma unroll
        for (int e = 0; e < 8; ++e) s1 += y[e];
        s1 += lane_xor<1>(s1); s1 += lane_xor<2>(s1); s1 += lane_xor<4>(s1);
        const float mean = s1 * (1.0f / 64.0f); float s2 = 0.f;
#pragma unroll
        for (int e = 0; e < 8; ++e) { y[e] -= mean; s2 += y[e] * y[e]; }
        s2 += lane_xor<1>(s2); s2 += lane_xor<2>(s2); s2 += lane_xor<4>(s2);
        const float rs = 1.0f / sqrtf(s2 * (1.0f / 64.0f) + 64e-5f);
#pragma unroll
        for (int e = 0; e < 8; ++e) y[e] = (y[e] * rs * lw8[e] + lb8[e] + bon * v[e]) * g[e];
        *py = pk8(y);
    }
#undef POST_LOAD
}
#ifdef RK_PROBE
__device__ __forceinline__ void rwkv_seq_raw(int l, int b, int hd, unsigned char* ws, LAS unsigned char* ldsw  , int lane, bf16* T1) {
    constexpr int CH = 8;
    LAS float* buf = (LAS float*)ldsw;
    const bf16* R = (const bf16*)(ws + A_R); const bf16* Kp = (const bf16*)(ws + A_KRAW); const bf16* KK = (const bf16*)(ws + A_KK); const bf16* BV = (const bf16*)(ws + A_BV);
    const bf16* Vv = (const bf16*)(ws + ((l == 0) ? WS_VFIRST : A_VRAW)); const bf16* Gg = (const bf16*)(ws + A_G); const float* LW = (const float*)(ws + A_LW);
    const int c = hd * 64 + lane;
    float S[64];
#pragma unroll
    for (int j = 0; j < 64; ++j) S[j] = 0.f;
    for (int t0 = 0; t0 < SEQ; t0 += CH) {
        float vv[CH], gg[CH], bon[CH];
#pragma unroll
        for (int s = 0; s < CH; ++s) { const size_t o = (size_t)(b * SEQ + t0 + s) * RW + c;
            const float r = bf2f(R[o]), k = bf2f(Kp[o]), kk = bf2f(KK[o]), bb = bf2f(BV[o]), w = __expf(LW[o]);
            buf[(s * 5 + 0) * 64 + lane] = r; buf[(s * 5 + 1) * 64 + lane] = w; buf[(s * 5 + 2) * 64 + lane] = k; buf[(s * 5 + 3) * 64 + lane] = -kk; buf[(s * 5 + 4) * 64 + lane] = bb;
            vv[s] = bf2f(Vv[o]); gg[s] = 0.f; bon[s] = 0.f; }
        LDS_WAIT(); asm volatile("" ::: "memory");
#pragma unroll 1
        for (int s = 0; s < CH; ++s) {
            const LAS f32x4* pr = (const LAS f32x4*)(buf + (s * 5 + 0) * 64); const LAS f32x4* pw = (const LAS f32x4*)(buf + (s * 5 + 1) * 64);
            const LAS f32x4* pk = (const LAS f32x4*)(buf + (s * 5 + 2) * 64); const LAS f32x4* pa = (const LAS f32x4*)(buf + (s * 5 + 3) * 64); const LAS f32x4* pb = (const LAS f32x4*)(buf + (s * 5 + 4) * 64);
            float sa = 0.f;
#pragma unroll
            for (int j4 = 0; j4 < 16; ++j4) { const f32x4 a = pa[j4]; sa += S[4 * j4] * a.x + S[4 * j4 + 1] * a.y + S[4 * j4 + 2] * a.z + S[4 * j4 + 3] * a.w; }
            float v_s = vv[0], g_s = gg[0], bo_s = bon[0];
#pragma unroll
            for (int q = 1; q < CH; ++q) if (s == q) { v_s = vv[q]; g_s = gg[q]; bo_s = bon[q]; }
            float y = 0.f;
#pragma unroll
            for (int j4 = 0; j4 < 16; ++j4) { const f32x4 w = pw[j4], bb = pb[j4], k = pk[j4], r = pr[j4];
                S[4 * j4]     = S[4 * j4]     * w.x + sa * bb.x + v_s * k.x; y += S[4 * j4] * r.x;
                S[4 * j4 + 1] = S[4 * j4 + 1] * w.y + sa * bb.y + v_s * k.y; y += S[4 * j4 + 1] * r.y;
                S[4 * j4 + 2] = S[4 * j4 + 2] * w.z + sa * bb.z + v_s * k.z; y += S[4 * j4 + 2] * r.z;
                S[4 * j4 + 3] = S[4 * j4 + 3] * w.w + sa * bb.w + v_s * k.w; y += S[4 * j4 + 3] * r.w; }
            T1[(size_t)(b * SEQ + t0 + s) * RW + c] = (bf16)(cvt_pk_bf16(y, 0.f) & 0xffffu); (void)g_s; (void)bo_s;
        }
        LDS_WAIT(); asm volatile("" ::: "memory");
    }
}

#endif

constexpr int N_PHASES = 27;
struct Args { In in; float* out; unsigned char* ws; int ph_lo, ph_hi; };
static_assert(sizeof(Args) == 38 * 8 + 8 + 8 + 8, "Args has padding");

__global__ void __launch_bounds__(NTHR, 2) mega_fwd(Args args) {
    extern __shared__ __attribute__((aligned(16))) unsigned char lds_raw[];
    LAS unsigned char* lds = (LAS unsigned char*)lds_raw;
#define OPAQUE_IDS(TID0, BX0) int tid = (TID0); asm volatile("" : "+v"(tid)); int bx = (BX0); asm volatile("" : "+s"(bx)); \
    const int lane = tid & 63, wave = __builtin_amdgcn_readfirstlane(tid >> 6); const int G = gridDim.x; \
    const int vcu = (G % 8 == 0) ? (bx % 8) * (G / 8) + bx / 8 : bx; \
    const int gw = vcu * NWAVES + wave, NGW = G * NWAVES, gtid = vcu * NTHR + tid, NGT = G * NTHR; (void)gw; (void)NGW; (void)gtid; (void)NGT; (void)lane
    OPAQUE_IDS(threadIdx.x, blockIdx.x);
    for (int u = tid; u < (LDS_BYTES - LDSCTL_OFF) / 4; u += NTHR) ((LAS unsigned*)(lds + LDSCTL_OFF))[u] = 0u;
    __syncthreads();
    if (lane == 0) ((LAS unsigned*)(lds + pg8::WAVETAB_OFF))[(unsigned)__builtin_amdgcn_s_getreg((5 << 11) | 4) & 63u] = (unsigned)wave;
    static_assert(pg8::WAVETAB_OFF == LDSCTL_OFF + 1536, "wave table offset");
    if (tid < 40) { const unsigned long long v = (tid < 38) ? (unsigned long long)args.in.p[tid] : (tid == 38 ? (unsigned long long)args.ws : (unsigned long long)args.out);
        ((LAS unsigned*)(lds + PTAB_OFF))[2 * tid] = (unsigned)v; ((LAS unsigned*)(lds + PTAB_OFF))[2 * tid + 1] = (unsigned)(v >> 32); }
    __syncthreads();
    const InT in{(volatile LAS unsigned*)(lds + PTAB_OFF)};
#define ctl ((gu32*)(args.ws + WS_CTL))
#define bar (XcdBarrier{(unsigned*)(ctl + CW_BAR), xb_xcc_id(), (volatile LAS unsigned*)(lds + MISC_OFF) + 8})
    if (!MK_SPLIT) (void)xcd_barrier_post((unsigned*)(ctl + CW_BAR), (volatile LAS unsigned*)(lds + MISC_OFF) + 8);
    const int lo = args.ph_lo, hi = args.ph_hi;
#ifndef PH_MASK
#define PH_MASK 0xffffffffu
#endif
#define IN_PH(bit, k) (((PH_MASK >> (bit)) & 1u) && lo <= (k) && (k) < hi)
#ifndef SCAN_REPS
#define SCAN_REPS 1
#endif
#define MIXER_BODY(REP) do { \
            if (vcu < 32) { for (int sr_ = 0; sr_ < SCAN_REPS; ++sr_) { if (wave < 4) { const int si = vcu * 4 + wave; rk::scan_unit(si >> 1, si & 1, ws, lds + wave * rk::SCAN_LDS, lds + 4 * rk::SCAN_LDS + wave * 2048); } __syncthreads(); } } \
            volatile LAS unsigned* qslot = (volatile LAS unsigned*)(lds + MISC_OFF) + 16; \
            for (;;) { \
                __syncthreads(); \
                if (tid == 0) qslot[0] = __hip_atomic_fetch_add(ctl + CW_QCTR + 64 * l + 16 * (REP), 1u, RLX_AGENT); \
                __syncthreads(); \
                const int u = (int)qslot[0]; \
                if (u >= 512) break; \
                const int qb = 15 - (u >> 5), bh = u & 31; \
                att::attn_unit(bh >> 2, bh & 3, qb, (const bf16*)(ws + A_Q), (const bf16*)(ws + A_KB), (const bf16*)(ws + A_VB), (bf16*)(ws + A_YCAT), (const int*)in[2], lds); \
            } } while (0)
#ifndef DUPMASK
#define DUPMASK 0u
#endif
#define DUP(bit) for (int rep_ = 0; rep_ < (int)((DUPMASK >> (bit)) & 1u) + 1; ++rep_)
#ifdef TS_GA
#define STAMP(k) do { if (blockIdx.x == 0 && threadIdx.x == 0) { volatile LAS unsigned long long* ts_ = (volatile LAS unsigned long long*)(lds + TS_OFF); const unsigned long long now_ = __builtin_amdgcn_s_memrealtime(); \
        if ((k) > 0) { const unsigned d_ = (unsigned)(now_ - ts_[0]); if ((TS_GA >> ((k) - 1)) & 1u) ts_[1] += d_; if ((TS_GB >> ((k) - 1)) & 1u) ts_[2] += d_; \
            __hip_atomic_store(ctl + 90, (unsigned)ts_[1], RLX_AGENT); __hip_atomic_store(ctl + 91, (unsigned)ts_[2], RLX_AGENT); } ts_[0] = now_; } } while (0)
#else
#define STAMP(k) do { } while (0)
#endif
#define BAR_AFTER(k) do { if ((k) + 1 < hi) { if (!MK_SPLIT) xcd_barrier(bar); } STAMP((k) + 1); } while (0)
#define PH_PTRS unsigned char* ws = (unsigned char*)in[38]; float* out = (float*)in[39]; const float* modl = (const float*)(ws + WS_MOD) + (size_t)l * NB * MODLD; (void)out; (void)modl

    STAMP(0);
    if (IN_PH(0, 0)) { const int l = 0; PH_PTRS; DUP(0) { __syncthreads(); p0_mod(in, ws, lds, vcu, G, wave, lane, tid); __syncthreads(); p0_weights(in, ws, lds, gw, NGW, wave, lane, gtid, NGT); } BAR_AFTER(0);
#ifdef EXTRA_BARS
    for (int eb = 0; eb < EXTRA_BARS; ++eb) xcd_barrier(bar);
#endif
    }

    {
        constexpr int l = 0;
        const int pb = 1 + 11 * l;
        OPAQUE_IDS(pg8::tid_now(), blockIdx.x);
        if (l == 0 && IN_PH(1, pb + 0)) { PH_PTRS; DUP(1) { __syncthreads(); norm_phase<false, false>(in[0], in[5], modl, 0, (bf16*)(ws + A_H), nullptr, nullptr, ws, lds, vcu, G, wave, lane, tid);
            } BAR_AFTER(pb + 0); }
        if (IN_PH(2, pb + 1)) { PH_PTRS;
            pg8::Gemm g{(const bf16*)(ws + A_H), (const bf16*)(ws + WS_WIN) + (size_t)l * NPROJ * DM, TOK, NPROJ, DM, nullptr, nullptr, 0, 0, 0};
            pg8::StaticOrder S; S.init(TOK, NPROJ, G, bx);
            if (l == 0) { pg8::EpiBf16<0> E{(bf16*)(ws + A_PROJ), NPROJ, nullptr, 0, 0, 1.f};
                DUP(2) { __syncthreads(); pg8::gemm_phase<pg8::EpiBf16<0>, pg8::StaticOrder, true, true, 0>(lds, g, S, E); }
                if (bx >= G / 2) { const int hg = (bx - G / 2) * NWAVES + wave, hn = (G - G / 2) * NWAVES;
                    bias_rows((const bf16*)(ws + WS_WF1), 2 * FFD, modl + 3072, (float*)(ws + WS_BIAS2), 2 * FFD, hg, hn, lane);
                    bias_rows((const bf16*)(ws + WS_WIN) + (size_t)NPROJ * DM, NPROJ, modl + (size_t)NB * MODLD, (float*)(ws + WS_BIAS1), NPROJ, hg, hn, lane); } }
            else { pg8::EpiProjN E{(bf16*)(ws + A_PROJ), NPROJ, (const float*)(ws + A_RSQ), (const float*)(ws + WS_BIAS1), NPROJ};
                DUP(2) { __syncthreads(); pg8::gemm_phase<pg8::EpiProjN, pg8::StaticOrder, true, true, 0>(lds, g, S, E); } }
            BAR_AFTER(pb + 1); }
        if (IN_PH(3, pb + 2)) { PH_PTRS; DUP(3) { __syncthreads(); prep_phase(l, in, ws, gw, NGW, lane); } BAR_AFTER(pb + 2); }
        if (IN_PH(4, pb + 3)) { PH_PTRS;
#ifndef P4_MASK
#define P4_MASK 7
#endif
            if (P4_MASK & 1) { pg8::Gemm g{(const bf16*)(ws + A_CQ), (const bf16*)(ws + WS_WUQ) + (size_t)l * NQ * 256, TOK, NQ, 256, nullptr, nullptr, 0, 0, 0};
              pg8::StaticOrder S; S.init(TOK, NQ, G, (bx + G / 2) % G);
              pg8::EpiBf16<0> E{(bf16*)(ws + A_Q), NQ, nullptr, 0, 0, 1.f};
              DUP(4) { __syncthreads(); pg8::gemm_phase<pg8::EpiBf16<0>, pg8::StaticOrder, true, true, 0>(lds, g, S, E); } }
            __syncthreads();
            if (P4_MASK & 2) { pg8::Gemm g{(const bf16*)(ws + A_CKV), (const bf16*)(ws + WS_WUKV) + (size_t)l * NKV * 128, TOK, NKV, 128, nullptr, nullptr, 0, 0, 0};
              pg8::StaticOrder S; S.init(TOK, NKV, G, bx);
              pg8::EpiKV E{(bf16*)(ws + A_KB), (bf16*)(ws + A_VB)};
              DUP(4) { __syncthreads(); pg8::gemm_phase<pg8::EpiKV, pg8::StaticOrder, true, true, 0>(lds, g, S, E); } }
            __syncthreads();
            if (P4_MASK & 4) { const int nl = (l == 0) ? 1536 : NLORA;
              pg8::Gemm g{(const bf16*)(ws + A_LA), (const bf16*)(ws + WS_WLORA) + (size_t)l * NLORA * KLW, TOK, nl, KLW, nullptr, nullptr, 0, KLORA, KLW};
              pg8::StaticOrder S; S.init(TOK, nl, G, bx);
              pg8::EpiLora E{in[16] + (size_t)l * RW, in[18] + (size_t)l * RW, in[21], in[23] + (size_t)l * RW, in[24] + (size_t)l * RW,
                             (bf16*)(ws + A_LWH), (bf16*)(ws + A_KRAW), (bf16*)(ws + A_KK), (bf16*)(ws + A_BV), (bf16*)(ws + A_G), (bf16*)(ws + A_VRAW), (const bf16*)(ws + WS_VFIRST), (const bf16*)(ws + A_R), in[25] + (size_t)l * RW, (float*)(ws + A_BON)};
              pg8::gemm_phase<pg8::EpiLora, pg8::StaticOrder, true, true, 3>(lds, g, S, E); }
            BAR_AFTER(pb + 3); }
        if (IN_PH(5, pb + 4)) { PH_PTRS;
#ifdef RK_PROBE
            if (l == RK_PROBE) { if (vcu < 16 && wave < 4) { const int unit = vcu * 4 + wave; rwkv_seq_raw(l, unit >> 3, unit & 7, ws, lds + wave * 10240, lane, (bf16*)(ws + WS_ARENA + 224 * MiB)); } xcd_barrier(bar); }
#endif
            DUP(5) { __syncthreads(); unsigned char* dummy = (((DUPMASK >> 5) & 1u) && rep_ == 0) ? ws + WS_ARENA + 224 * MiB : nullptr;
            if (wave < 4) { for (int u = vcu * 4 + wave; u < 64 * (SEQ / 32); u += G * 4) { const int q = u & 63, ck = u >> 6; rk::pre_unit(l, q >> 3, q & 7, ck, ws, lds + wave * rk::UNIT_LDS, dummy); } } }
            BAR_AFTER(pb + 4); }
        if (IN_PH(6, pb + 5)) { PH_PTRS;
            MIXER_BODY(0);
#ifdef DUP_MIXER
            __syncthreads(); MIXER_BODY(1);
#endif
            BAR_AFTER(pb + 5); }
        if (IN_PH(7, pb + 6)) { PH_PTRS;
#ifdef RK_PROBE
            if (l == RK_PROBE) { float num = 0.f, den = 0.f; const bf16* T1 = (const bf16*)(ws + WS_ARENA + 224 * MiB);
                for (int m = gw; m < TOK; m += NGW) { if (((m & (SEQ - 1)) >> 5) < 1 || (m & 31) != RK_PROBE_POS) continue; float a[8], b8[8]; up8(*(const GAS v4u*)((const bf16*)(ws + A_YCAT) + (size_t)m * DM + 512 + lane * 8), a); up8(*(const GAS v4u*)(T1 + (size_t)m * RW + lane * 8), b8);
#pragma unroll
                    for (int e = 0; e < 8; ++e) { const float d = a[e] - b8[e]; num += d * d; den += b8[e] * b8[e]; } }
                num = wave_sum(num); den = wave_sum(den);
                if (lane == 0) { atomicAdd((float*)(ctl + 80), num); atomicAdd((float*)(ctl + 81), den); } }
#endif
            post_phase(l, in[13] + (size_t)l * 512, in[26] + (size_t)l * RW, in[27] + (size_t)l * RW, ws, gw, NGW, lane); BAR_AFTER(pb + 6); }
        if (IN_PH(8, pb + 7)) { PH_PTRS; bf16* x16a = (bf16*)((unsigned char*)out + DO_X16A);
            pg8::Gemm g{(const bf16*)(ws + A_YCAT), (const bf16*)(ws + (l == 0 ? WS_WOUT : WS_WOUT1)), TOK, DM, DM, nullptr, nullptr, 0, 0, 0};
            pg8::StaticOrder S; S.init(TOK, DM, G, bx);
            if (l == 0) { pg8::EpiResidT<true, false> E{in[0], x16a, modl + 2048, in[6], modl + 4096, (bf16*)(ws + A_H), (float*)(ws + A_RSQ)};
                pg8::gemm_phase<pg8::EpiResidT<true, false>, pg8::StaticOrder, true, true, 0>(lds, g, S, E); }
            else { pg8::EpiResidT<false, true> E{x16a, (bf16*)(ws + A_X16B), modl + 2048, nullptr, nullptr, nullptr, nullptr};
                pg8::gemm_phase<pg8::EpiResidT<false, true>, pg8::StaticOrder, true, true, 0>(lds, g, S, E); }
            BAR_AFTER(pb + 7); }
        if (l == 1 && IN_PH(9, pb + 8)) { PH_PTRS; OPAQUE_IDS(pg8::tid_now(), blockIdx.x);

            DUP(9) { __syncthreads();
            norm_phase<true, true>(ws + A_X16B, in[6] + (size_t)l * DM, modl, 3072, (bf16*)((unsigned char*)out + DO_H2), in[32], in[33], ws, lds, vcu, G, wave, lane, tid);
            if (l == 1) { __syncthreads(); p_expert_weights(in, ws, lds, gw, NGW, wave, lane); } }
            BAR_AFTER(pb + 8); }
        if (l == 0) {
            if (IN_PH(10, 10)) { PH_PTRS; OPAQUE_IDS(pg8::tid_now(), blockIdx.x);

                pg8::Gemm g{(const bf16*)(ws + A_H), (const bf16*)(ws + WS_WF1), TOK, 2 * FFD, DM, nullptr, nullptr, 0, 0, 0};
                pg8::StaticOrder S; S.init(TOK, 2 * FFD, G, bx);
                pg8::EpiSwiGLUT<true> E{(bf16*)(ws + A_HID), FFD, (const float*)(ws + A_RSQ), (const float*)(ws + WS_BIAS2), 2 * FFD};
                DUP(10) { __syncthreads(); pg8::gemm_phase<pg8::EpiSwiGLUT<true>, pg8::StaticOrder, true, true, 0>(lds, g, S, E); }
                BAR_AFTER(10); }
            if (IN_PH(11, 11)) { PH_PTRS; OPAQUE_IDS(pg8::tid_now(), blockIdx.x);

                pg8::Gemm g{(const bf16*)(ws + A_HID), (const bf16*)(ws + WS_WF2), TOK, DM, FFD, nullptr, nullptr, 0, 0, 0};
                pg8::StaticOrder S; S.init(TOK, DM, G, bx);
                bf16* x16a = (bf16*)((unsigned char*)out + DO_X16A);
                pg8::EpiResidT<true, true> E{x16a, x16a, modl + 5120, in[5] + DM, modl + (size_t)NB * MODLD + 1024, (bf16*)(ws + A_H), (float*)(ws + A_RSQ)};
                pg8::gemm_phase<pg8::EpiResidT<true, true>, pg8::StaticOrder, true, true, 0>(lds, g, S, E);
                BAR_AFTER(11); }
        } else {
            if (IN_PH(12, 21)) { PH_PTRS; OPAQUE_IDS(pg8::tid_now(), blockIdx.x);
            DUP(12) { __syncthreads(); route_scatter(ws, lds, vcu, G, wave, lane, tid); } BAR_AFTER(21); }
#pragma unroll
            for (int k = 0; k < 2; ++k) {
                if (IN_PH(13, 22 + 2 * k)) { PH_PTRS; OPAQUE_IDS(pg8::tid_now(), blockIdx.x);
            const int* TL = (const int*)(ws + RT_TILE) + k * (PASS_TILES + 8); const int* ridx = (const int*)(ws + RT_RIDX) + (size_t)k * PASS_ROWS;
                    if (k == 1) { const int* TLp = (const int*)(ws + RT_TILE); moe_combine(__builtin_amdgcn_readfirstlane(TLp[0]), G, SLAB0_CAP, G - 1 - bx, (const float*)((unsigned char*)out + DO_SLAB), (bf16*)(ws + A_Y0), tid);     __syncthreads(); }
                    const int nt = __builtin_amdgcn_readfirstlane(TL[0]);
                    pg8::Gemm g{(const bf16*)((unsigned char*)out + DO_H2), (const bf16*)(ws + A_WE1), nt * 256, 2 * FFE, DM, ridx, TL + 8, (size_t)2 * FFE * DM * 2, 0, 0};
                    pg8::StaticOrder S; S.init(nt * 256, 2 * FFE, G, bx);
                    pg8::EpiSwiGLU E{(bf16*)(ws + A_HIDM), FFE};
                    DUP(13) { __syncthreads(); pg8::gemm_phase<pg8::EpiSwiGLU, pg8::StaticOrder, true, true, 1>(lds, g, S, E); }
                    BAR_AFTER(22 + 2 * k); }
                if (IN_PH(14, 23 + 2 * k)) { PH_PTRS; OPAQUE_IDS(pg8::tid_now(), blockIdx.x);
            const int* TL = (const int*)(ws + RT_TILE) + k * (PASS_TILES + 8);
                    const int nt = __builtin_amdgcn_readfirstlane(TL[0]);
                    const pg8::G2Plan pl = pg8::g2_plan(nt, G, k == 0 ? SLAB0_CAP : 256);
                    { pg8::Gemm g{(const bf16*)(ws + A_HIDM), (const bf16*)(ws + A_WE2), nt * 256, DM, FFE, nullptr, TL + 8, (size_t)DM * FFE * 2, 0, 0};
                      pg8::StaticOrder S; S.init(nt * 256, DM, G, bx); S.lim = pl.full;
                      pg8::EpiBf16<0> E{(bf16*)(ws + (k == 0 ? A_Y0 : A_Y1)), DM, nullptr, 0, 0, 1.f};
                      pg8::gemm_phase<pg8::EpiBf16<0>, pg8::StaticOrder, true, true, 2>(lds, g, S, E); }
                    if (pl.tail) {
                        __syncthreads();
                        const int ksub = FFE / pl.spl, kp = bx % pl.spl;
                        pg8::OneUnit O; O.have = bx < pl.tail * pl.spl; O.u.pm = 0; O.u.pn = 0;
                        if (O.have) { pg8::StaticOrder T; T.init(nt * 256, DM, 1, 0); T.next(pl.full + bx / pl.spl, O.u); }
                        pg8::Gemm g{(const bf16*)(ws + A_HIDM) + kp * ksub, (const bf16*)(ws + A_WE2) + kp * ksub, nt * 256, DM, ksub, nullptr, TL + 8, (size_t)DM * FFE * 2, FFE, 0};
                        pg8::EpiSlab E{(float*)((unsigned char*)out + DO_SLAB) + (size_t)bx * 65536};
                        pg8::gemm_phase<pg8::EpiSlab, pg8::OneUnit, true, true, 2>(lds, g, O, E); }
                    BAR_AFTER(23 + 2 * k); }
            }
        }
    }
    {
        constexpr int l = 1;
        const int pb = 1 + 11 * l;
        OPAQUE_IDS(pg8::tid_now(), blockIdx.x);
        if (l == 0 && IN_PH(1, pb + 0)) { PH_PTRS; DUP(1) { __syncthreads(); norm_phase<false, false>(in[0], in[5], modl, 0, (bf16*)(ws + A_H), nullptr, nullptr, ws, lds, vcu, G, wave, lane, tid);
            } BAR_AFTER(pb + 0); }
        if (IN_PH(2, pb + 1)) { PH_PTRS;
            pg8::Gemm g{(const bf16*)(ws + A_H), (const bf16*)(ws + WS_WIN) + (size_t)l * NPROJ * DM, TOK, NPROJ, DM, nullptr, nullptr, 0, 0, 0};
            pg8::StaticOrder S; S.init(TOK, NPROJ, G, bx);
            if (l == 0) { pg8::EpiBf16<0> E{(bf16*)(ws + A_PROJ), NPROJ, nullptr, 0, 0, 1.f};
                DUP(2) { __syncthreads(); pg8::gemm_phase<pg8::EpiBf16<0>, pg8::StaticOrder, true, true, 0>(lds, g, S, E); }
                if (bx >= G / 2) { const int hg = (bx - G / 2) * NWAVES + wave, hn = (G - G / 2) * NWAVES;
                    bias_rows((const bf16*)(ws + WS_WF1), 2 * FFD, modl + 3072, (float*)(ws + WS_BIAS2), 2 * FFD, hg, hn, lane);
                    bias_rows((const bf16*)(ws + WS_WIN) + (size_t)NPROJ * DM, NPROJ, modl + (size_t)NB * MODLD, (float*)(ws + WS_BIAS1), NPROJ, hg, hn, lane); } }
            else { pg8::EpiProjN E{(bf16*)(ws + A_PROJ), NPROJ, (const float*)(ws + A_RSQ), (const float*)(ws + WS_BIAS1), NPROJ};
                DUP(2) { __syncthreads(); pg8::gemm_phase<pg8::EpiProjN, pg8::StaticOrder, true, true, 0>(lds, g, S, E); } }
            BAR_AFTER(pb + 1); }
        if (IN_PH(3, pb + 2)) { PH_PTRS; DUP(3) { __syncthreads(); prep_phase(l, in, ws, gw, NGW, lane); } BAR_AFTER(pb + 2); }
        if (IN_PH(4, pb + 3)) { PH_PTRS;
#ifndef P4_MASK
#define P4_MASK 7
#endif
            if (P4_MASK & 1) { pg8::Gemm g{(const bf16*)(ws + A_CQ), (const bf16*)(ws + WS_WUQ) + (size_t)l * NQ * 256, TOK, NQ, 256, nullptr, nullptr, 0, 0, 0};
              pg8::StaticOrder S; S.init(TOK, NQ, G, (bx + G / 2) % G);
              pg8::EpiBf16<0> E{(bf16*)(ws + A_Q), NQ, nullptr, 0, 0, 1.f};
              DUP(4) { __syncthreads(); pg8::gemm_phase<pg8::EpiBf16<0>, pg8::StaticOrder, true, true, 0>(lds, g, S, E); } }
            __syncthreads();
            if (P4_MASK & 2) { pg8::Gemm g{(const bf16*)(ws + A_CKV), (const bf16*)(ws + WS_WUKV) + (size_t)l * NKV * 128, TOK, NKV, 128, nullptr, nullptr, 0, 0, 0};
              pg8::StaticOrder S; S.init(TOK, NKV, G, bx);
              pg8::EpiKV E{(bf16*)(ws + A_KB), (bf16*)(ws + A_VB)};
              DUP(4) { __syncthreads(); pg8::gemm_phase<pg8::EpiKV, pg8::StaticOrder, true, true, 0>(lds, g, S, E); } }
            __syncthreads();
            if (P4_MASK & 4) { const int nl = (l == 0) ? 1536 : NLORA;
              pg8::Gemm g{(const bf16*)(ws + A_LA), (const bf16*)(ws + WS_WLORA) + (size_t)l * NLORA * KLW, TOK, nl, KLW, nullptr, nullptr, 0, KLORA, KLW};
              pg8::StaticOrder S; S.init(TOK, nl, G, bx);
              pg8::EpiLora E{in[16] + (size_t)l * RW, in[18] + (size_t)l * RW, in[21], in[23] + (size_t)l * RW, in[24] + (size_t)l * RW,
                             (bf16*)(ws + A_LWH), (bf16*)(ws + A_KRAW), (bf16*)(ws + A_KK), (bf16*)(ws + A_BV), (bf16*)(ws + A_G), (bf16*)(ws + A_VRAW), (const bf16*)(ws + WS_VFIRST), (const bf16*)(ws + A_R), in[25] + (size_t)l * RW, (float*)(ws + A_BON)};
              pg8::gemm_phase<pg8::EpiLora, pg8::StaticOrder, true, true, 3>(lds, g, S, E); }
            BAR_AFTER(pb + 3); }
        if (IN_PH(5, pb + 4)) { PH_PTRS;
#ifdef RK_PROBE
            if (l == RK_PROBE) { if (vcu < 16 && wave < 4) { const int unit = vcu * 4 + wave; rwkv_seq_raw(l, unit >> 3, unit & 7, ws, lds + wave * 10240, lane, (bf16*)(ws + WS_ARENA + 224 * MiB)); } xcd_barrier(bar); }
#endif
            DUP(5) { __syncthreads(); unsigned char* dummy = (((DUPMASK >> 5) & 1u) && rep_ == 0) ? ws + WS_ARENA + 224 * MiB : nullptr;
            if (wave < 4) { for (int u = vcu * 4 + wave; u < 64 * (SEQ / 32); u += G * 4) { const int q = u & 63, ck = u >> 6; rk::pre_unit(l, q >> 3, q & 7, ck, ws, lds + wave * rk::UNIT_LDS, dummy); } } }
            BAR_AFTER(pb + 4); }
        if (IN_PH(6, pb + 5)) { PH_PTRS;
            MIXER_BODY(0);
#ifdef DUP_MIXER
            __syncthreads(); MIXER_BODY(1);
#endif
            BAR_AFTER(pb + 5); }
        if (IN_PH(7, pb + 6)) { PH_PTRS;
#ifdef RK_PROBE
            if (l == RK_PROBE) { float num = 0.f, den = 0.f; const bf16* T1 = (const bf16*)(ws + WS_ARENA + 224 * MiB);
                for (int m = gw; m < TOK; m += NGW) { if (((m & (SEQ - 1)) >> 5) < 1 || (m & 31) != RK_PROBE_POS) continue; float a[8], b8[8]; up8(*(const GAS v4u*)((const bf16*)(ws + A_YCAT) + (size_t)m * DM + 512 + lane * 8), a); up8(*(const GAS v4u*)(T1 + (size_t)m * RW + lane * 8), b8);
#pragma unroll
                    for (int e = 0; e < 8; ++e) { const float d = a[e] - b8[e]; num += d * d; den += b8[e] * b8[e]; } }
                num = wave_sum(num); den = wave_sum(den);
                if (lane == 0) { atomicAdd((float*)(ctl + 80), num); atomicAdd((float*)(ctl + 81), den); } }
#endif
            post_phase(l, in[13] + (size_t)l * 512, in[26] + (size_t)l * RW, in[27] + (size_t)l * RW, ws, gw, NGW, lane); BAR_AFTER(pb + 6); }
        if (IN_PH(8, pb + 7)) { PH_PTRS; bf16* x16a = (bf16*)((unsigned char*)out + DO_X16A);
            pg8::Gemm g{(const bf16*)(ws + A_YCAT), (const bf16*)(ws + (l == 0 ? WS_WOUT : WS_WOUT1)), TOK, DM, DM, nullptr, nullptr, 0, 0, 0};
            pg8::StaticOrder S; S.init(TOK, DM, G, bx);
            if (l == 0) { pg8::EpiResidT<true, false> E{in[0], x16a, modl + 2048, in[6], modl + 4096, (bf16*)(ws + A_H), (float*)(ws + A_RSQ)};
                pg8::gemm_phase<pg8::EpiResidT<true, false>, pg8::StaticOrder, true, true, 0>(lds, g, S, E); }
            else { pg8::EpiResidT<false, true> E{x16a, (bf16*)(ws + A_X16B), modl + 2048, nullptr, nullptr, nullptr, nullptr};
                pg8::gemm_phase<pg8::EpiResidT<false, true>, pg8::StaticOrder, true, true, 0>(lds, g, S, E); }
            BAR_AFTER(pb + 7); }
        if (l == 1 && IN_PH(9, pb + 8)) { PH_PTRS; OPAQUE_IDS(pg8::tid_now(), blockIdx.x);

            DUP(9) { __syncthreads();
            norm_phase<true, true>(ws + A_X16B, in[6] + (size_t)l * DM, modl, 3072, (bf16*)((unsigned char*)out + DO_H2), in[32], in[33], ws, lds, vcu, G, wave, lane, tid);
            if (l == 1) { __syncthreads(); p_expert_weights(in, ws, lds, gw, NGW, wave, lane); } }
            BAR_AFTER(pb + 8); }
        if (l == 0) {
            if (IN_PH(10, 10)) { PH_PTRS; OPAQUE_IDS(pg8::tid_now(), blockIdx.x);

                pg8::Gemm g{(const bf16*)(ws + A_H), (const bf16*)(ws + WS_WF1), TOK, 2 * FFD, DM, nullptr, nullptr, 0, 0, 0};
                pg8::StaticOrder S; S.init(TOK, 2 * FFD, G, bx);
                pg8::EpiSwiGLUT<true> E{(bf16*)(ws + A_HID), FFD, (const float*)(ws + A_RSQ), (const float*)(ws + WS_BIAS2), 2 * FFD};
                DUP(10) { __syncthreads(); pg8::gemm_phase<pg8::EpiSwiGLUT<true>, pg8::StaticOrder, true, true, 0>(lds, g, S, E); }
                BAR_AFTER(10); }
            if (IN_PH(11, 11)) { PH_PTRS; OPAQUE_IDS(pg8::tid_now(), blockIdx.x);

                pg8::Gemm g{(const bf16*)(ws + A_HID), (const bf16*)(ws + WS_WF2), TOK, DM, FFD, nullptr, nullptr, 0, 0, 0};
                pg8::StaticOrder S; S.init(TOK, DM, G, bx);
                bf16* x16a = (bf16*)((unsigned char*)out + DO_X16A);
                pg8::EpiResidT<true, true> E{x16a, x16a, modl + 5120, in[5] + DM, modl + (size_t)NB * MODLD + 1024, (bf16*)(ws + A_H), (float*)(ws + A_RSQ)};
                pg8::gemm_phase<pg8::EpiResidT<true, true>, pg8::StaticOrder, true, true, 0>(lds, g, S, E);
                BAR_AFTER(11); }
        } else {
            if (IN_PH(12, 21)) { PH_PTRS; OPAQUE_IDS(pg8::tid_now(), blockIdx.x);
            DUP(12) { __syncthreads(); route_scatter(ws, lds, vcu, G, wave, lane, tid); } BAR_AFTER(21); }
#pragma unroll
            for (int k = 0; k < 2; ++k) {
                if (IN_PH(13, 22 + 2 * k)) { PH_PTRS; OPAQUE_IDS(pg8::tid_now(), blockIdx.x);
            const int* TL = (const int*)(ws + RT_TILE) + k * (PASS_TILES + 8); const int* ridx = (const int*)(ws + RT_RIDX) + (size_t)k * PASS_ROWS;
                    if (k == 1) { const int* TLp = (const int*)(ws + RT_TILE); moe_combine(__builtin_amdgcn_readfirstlane(TLp[0]), G, SLAB0_CAP, G - 1 - bx, (const float*)((unsigned char*)out + DO_SLAB), (bf16*)(ws + A_Y0), tid);     __syncthreads(); }
                    const int nt = __builtin_amdgcn_readfirstlane(TL[0]);
                    pg8::Gemm g{(const bf16*)((unsigned char*)out + DO_H2), (const bf16*)(ws + A_WE1), nt * 256, 2 * FFE, DM, ridx, TL + 8, (size_t)2 * FFE * DM * 2, 0, 0};
                    pg8::StaticOrder S; S.init(nt * 256, 2 * FFE, G, bx);
                    pg8::EpiSwiGLU E{(bf16*)(ws + A_HIDM), FFE};
                    DUP(13) { __syncthreads(); pg8::gemm_phase<pg8::EpiSwiGLU, pg8::StaticOrder, true, true, 1>(lds, g, S, E); }
                    BAR_AFTER(22 + 2 * k); }
                if (IN_PH(14, 23 + 2 * k)) { PH_PTRS; OPAQUE_IDS(pg8::tid_now(), blockIdx.x);
            const int* TL = (const int*)(ws + RT_TILE) + k * (PASS_TILES + 8);
                    const int nt = __builtin_amdgcn_readfirstlane(TL[0]);
                    const pg8::G2Plan pl = pg8::g2_plan(nt, G, k == 0 ? SLAB0_CAP : 256);
                    { pg8::Gemm g{(const bf16*)(ws + A_HIDM), (const bf16*)(ws + A_WE2), nt * 256, DM, FFE, nullptr, TL + 8, (size_t)DM * FFE * 2, 0, 0};
                      pg8::StaticOrder S; S.init(nt * 256, DM, G, bx); S.lim = pl.full;
                      pg8::EpiBf16<0> E{(bf16*)(ws + (k == 0 ? A_Y0 : A_Y1)), DM, nullptr, 0, 0, 1.f};
                      pg8::gemm_phase<pg8::EpiBf16<0>, pg8::StaticOrder, true, true, 2>(lds, g, S, E); }
                    if (pl.tail) {
                        __syncthreads();
                        const int ksub = FFE / pl.spl, kp = bx % pl.spl;
                        pg8::OneUnit O; O.have = bx < pl.tail * pl.spl; O.u.pm = 0; O.u.pn = 0;
                        if (O.have) { pg8::StaticOrder T; T.init(nt * 256, DM, 1, 0); T.next(pl.full + bx / pl.spl, O.u); }
                        pg8::Gemm g{(const bf16*)(ws + A_HIDM) + kp * ksub, (const bf16*)(ws + A_WE2) + kp * ksub, nt * 256, DM, ksub, nullptr, TL + 8, (size_t)DM * FFE * 2, FFE, 0};
                        pg8::EpiSlab E{(float*)((unsigned char*)out + DO_SLAB) + (size_t)bx * 65536};
                        pg8::gemm_phase<pg8::EpiSlab, pg8::OneUnit, true, true, 2>(lds, g, O, E); }
                    BAR_AFTER(23 + 2 * k); }
            }
        }
    }
    if (IN_PH(15, 26)) { const int l = 1; PH_PTRS; OPAQUE_IDS(pg8::tid_now(), blockIdx.x);
        { const int* TLp = (const int*)(ws + RT_TILE) + (PASS_TILES + 8); const int nt1 = __builtin_amdgcn_readfirstlane(TLp[0]);
          if (pg8::g2_plan(nt1, G, 256).tail) { moe_combine(nt1, G, 256, vcu, (const float*)((unsigned char*)out + DO_SLAB), (bf16*)(ws + A_Y1), tid); if (!MK_SPLIT) xcd_barrier(bar); } }
        final_moe_norm(ws, (const bf16*)(ws + A_X16B), out, in[37], modl + 5120, (const bf16*)(ws + A_Y0), (const bf16*)(ws + A_Y1), (const int*)(ws + RT_TPOS), (const float*)(ws + RT_GW), gw, NGW, lane);
#ifdef TS_GA
        { VM_WAIT(); xcd_barrier(bar); const float ta = 0.01f * (float)__hip_atomic_load(ctl + 90, RLX_AGENT), tb = 0.01f * (float)__hip_atomic_load(ctl + 91, RLX_AGENT); const float sc = 1.0f + sqrtf(ta * 1e-5f);
          for (int row = gw; row < TOK; row += NGW) { GAS f32x4* xr = (GAS f32x4*)(out + (size_t)row * DM) + lane;
#pragma unroll
              for (int j = 0; j < 4; ++j) xr[64 * j] = xr[64 * j] * sc; }
          VM_WAIT(); xcd_barrier(bar); if (blockIdx.x == 0 && threadIdx.x == 0) out[0] += tb; }
#endif
#ifdef RK_PROBE
        { VM_WAIT(); const float num = __hip_atomic_load((float*)(ctl + 80), RLX_AGENT), den = __hip_atomic_load((float*)(ctl + 81), RLX_AGENT);
#ifdef RK_SELFCHK
          const float n2 = __hip_atomic_load((float*)(ctl + RK_SELFCHK), RLX_AGENT), d2 = __hip_atomic_load((float*)(ctl + RK_SELFCHK + 1), RLX_AGENT); const float sc = 1.0f + sqrtf(n2 / d2) + 0.f * num * den;
#else
          const float sc = 1.0f + sqrtf(num / den);
#endif

          for (int row = gw; row < TOK; row += NGW) { GAS f32x4* xr = (GAS f32x4*)(out + (size_t)row * DM) + lane;
#pragma unroll
              for (int j = 0; j < 4; ++j) xr[64 * j] = xr[64 * j] * sc; } }
#endif
    }
#undef IN_PH
#undef BAR_AFTER
#undef bar
#undef ctl
}

extern "C" void kernel_launch(void* const* d_in, const int* in_sizes, int n_in, void* d_out, int out_size, void* d_ws, size_t ws_size, hipStream_t stream) {
    static int grid = 0;
    if (grid == 0) {
        if (n_in != 38 || in_sizes[0] != TOK * DM || out_size != TOK * DM || ws_size < WS_END) {
            fprintf(stderr, "kernel_launch: unexpected problem (n_in %d, in0 %d, out %d, ws %zu, need %zu); nothing launched\n", n_in, n_in > 0 ? in_sizes[0] : -1, out_size, ws_size, (size_t)WS_END); grid = -1; return; }
        int dev = 0, cus = 0, per_cu = 0;
        if (hipGetDevice(&dev) != hipSuccess || hipDeviceGetAttribute(&cus, hipDeviceAttributeMultiprocessorCount, dev) != hipSuccess) { grid = -1; return; }
        if (hipFuncSetAttribute((const void*)mega_fwd, hipFuncAttributeMaxDynamicSharedMemorySize, LDS_BYTES) != hipSuccess) { fprintf(stderr, "kernel_launch: hipFuncSetAttribute failed\n"); grid = -1; return; }
        if (hipOccupancyMaxActiveBlocksPerMultiprocessor(&per_cu, (const void*)mega_fwd, NTHR, LDS_BYTES) != hipSuccess || per_cu < 1) { fprintf(stderr, "kernel_launch: occupancy query says %d\n", per_cu); }
        (void)hipGetLastError();
        grid = cus;
    }
    if (grid < 0) return;
    (void)hipMemsetAsync((char*)d_ws + WS_CTL, 0, CTL_ZERO_BYTES, stream);
    Args a{};
    for (int i = 0; i < 38; ++i) a.in.p[i] = (const float*)d_in[i];
    a.out = (float*)d_out; a.ws = (unsigned char*)d_ws;
#if MK_SPLIT
    for (int p = 0; p < N_PHASES; ++p) { a.ph_lo = p; a.ph_hi = p + 1; hipLaunchKernelGGL(mega_fwd, dim3(grid), dim3(NTHR), LDS_BYTES, stream, a); }
#else
    a.ph_lo = 0; a.ph_hi = N_PHASES;
    hipLaunchKernelGGL(mega_fwd, dim3(grid), dim3(NTHR), LDS_BYTES, stream, a);
#endif
    const hipError_t le = hipPeekAtLastError();
    if (le != hipSuccess) fprintf(stderr, "kernel_launch: launch failed: %s\n", hipGetErrorName(le));
}
```
